# Optimizing an MI355X kernel written in HIP

```python
import math
import jax
import jax.numpy as jnp
from jax import lax
import numpy as np

D_MODEL = 2048
BATCH = 4
SEQ = 2048
DEPTH = 4
DEC_BATCH = 16
DEC_SEQ = 2048
PAST_LEN = 128

GRID_W = 64
EPS = 1e-6
LB_FLOOR = 1e-30
SSM_WIDTH = D_MODEL // 4
SSM_GROUP = 16
SSM_GROUPS = SSM_WIDTH // SSM_GROUP
SSM_STATE = 64
HG_HEAD_DIM = 128
HG_WIDTH = D_MODEL // 4
HG_HEADS = HG_WIDTH // HG_HEAD_DIM
HG_CHUNK = 64
HEAD_DIM = 128
ATT_Q_HEADS = 8
ATT_KV_HEADS = 2
ATT_WIDTH = ATT_Q_HEADS * HEAD_DIM
KV_WIDTH = ATT_KV_HEADS * HEAD_DIM
Q_BLOCK = 128
ROPE_BASE = 10000.0
ROPE_AXIS_DIM = HEAD_DIM // 2
N_BRANCH = 3
MIX_WIDTH = SSM_WIDTH + HG_WIDTH + ATT_WIDTH
D_FF = 5632
SPLIT_SIZES = (SSM_WIDTH, HG_WIDTH, HG_WIDTH, HG_WIDTH, HG_WIDTH, HG_WIDTH, ATT_WIDTH, KV_WIDTH, KV_WIDTH, N_BRANCH * D_MODEL)
IN_WIDTH = SSM_WIDTH + 5 * HG_WIDTH + ATT_WIDTH + 2 * KV_WIDTH + N_BRANCH * D_MODEL

kernel_name = "hybrid_s5_hgrn2_gqa_encoder"


def rms_norm(x, gain):
    xf = x.astype(jnp.float32)
    y = xf * lax.rsqrt(jnp.mean(xf * xf, axis=-1, keepdims=True) + EPS)
    return (y * gain.astype(jnp.float32)).astype(x.dtype)


def swiglu_ffn(x, w_gate_up, w_down):
    gate, up = jnp.split(x @ w_gate_up, 2, axis=-1)
    return (jax.nn.silu(gate) * up) @ w_down


def axial_rope_tables(seq_len):
    rows = seq_len // GRID_W
    row_idx = jnp.broadcast_to(jnp.arange(rows, dtype=jnp.float32)[:, None], (rows, GRID_W)).reshape(-1)
    col_idx = jnp.broadcast_to(jnp.arange(GRID_W, dtype=jnp.float32)[None, :], (rows, GRID_W)).reshape(-1)
    inv_freq = ROPE_BASE ** (-jnp.arange(0, ROPE_AXIS_DIM, 2, dtype=jnp.float32) / ROPE_AXIS_DIM)
    ang_row = row_idx[:, None] * inv_freq[None, :]
    ang_col = col_idx[:, None] * inv_freq[None, :]
    return (jnp.cos(ang_row), jnp.sin(ang_row), jnp.cos(ang_col), jnp.sin(ang_col))


def _rotate(x, cos, sin):
    x1, x2 = jnp.split(x, 2, axis=-1)
    c = cos[None, :, None, :]
    s = sin[None, :, None, :]
    return jnp.concatenate([x1 * c - x2 * s, x2 * c + x1 * s], axis=-1)


def apply_axial_rope(x, tables):
    cos_r, sin_r, cos_c, sin_c = tables
    xf = x.astype(jnp.float32)
    out = jnp.concatenate([_rotate(xf[..., :ROPE_AXIS_DIM], cos_r, sin_r),
                           _rotate(xf[..., ROPE_AXIS_DIM:], cos_c, sin_c)], axis=-1)
    return out.astype(x.dtype)


def gqa_block_attention(q, k, v):
    bsz, seq_len = q.shape[:2]
    n_blocks = seq_len // Q_BLOCK
    group = ATT_Q_HEADS // ATT_KV_HEADS
    q_blocks = q.reshape(bsz, n_blocks, Q_BLOCK, ATT_KV_HEADS, group, HEAD_DIM).transpose(1, 0, 2, 3, 4, 5)
    scale = HEAD_DIM ** -0.5

    def attend(q_blk):
        s = jnp.einsum('bqhgd,bkhd->bhgqk', q_blk, k, preferred_element_type=jnp.float32) * scale
        p = jax.nn.softmax(s, axis=-1).astype(v.dtype)
        return jnp.einsum('bhgqk,bkhd->bqhgd', p, v)

    out = lax.map(attend, q_blocks)
    return out.transpose(1, 0, 2, 3, 4, 5).reshape(bsz, seq_len, ATT_WIDTH)


def s5_discretize(lam_re, lam_im, log_dt, b_re, b_im):
    dt = jnp.exp(log_dt)[:, None]
    mag = jnp.exp(lam_re * dt)
    a_re = mag * jnp.cos(lam_im * dt)
    a_im = mag * jnp.sin(lam_im * dt)
    den = lam_re * lam_re + lam_im * lam_im
    num_re = a_re - 1.0
    coef_re = (num_re * lam_re + a_im * lam_im) / den
    coef_im = (a_im * lam_re - num_re * lam_im) / den
    bb_re = coef_re[..., None] * b_re - coef_im[..., None] * b_im
    bb_im = coef_re[..., None] * b_im + coef_im[..., None] * b_re
    return a_re, a_im, bb_re, bb_im


def _complex_affine_combine(earlier, later):
    a1r, a1i, b1r, b1i = earlier
    a2r, a2i, b2r, b2i = later
    return (a2r * a1r - a2i * a1i, a2r * a1i + a2i * a1r,
            a2r * b1r - a2i * b1i + b2r, a2r * b1i + a2i * b1r + b2i)


def complex_diag_scan(a_re, a_im, bu_re, bu_im):
    seq_len = bu_re.shape[1]
    a_re_t = jnp.broadcast_to(a_re, (seq_len,) + a_re.shape)
    a_im_t = jnp.broadcast_to(a_im, (seq_len,) + a_im.shape)

    def one_sequence(br, bi):
        _, _, xr, xi = lax.associative_scan(_complex_affine_combine, (a_re_t, a_im_t, br, bi), axis=0)
        return xr, xi

    return jax.vmap(one_sequence)(bu_re, bu_im)


def s5_bidirectional(u, lam_re, lam_im, log_dt, b_re, b_im, c_re, c_im, d_skip, w_glu):
    bsz, seq_len, _ = u.shape
    uf = u.astype(jnp.float32)
    ug = uf.reshape(bsz, seq_len, SSM_GROUPS, SSM_GROUP)
    y = d_skip.astype(jnp.float32) * uf
    for direction in range(2):
        a_re, a_im, bb_re, bb_im = s5_discretize(
            lam_re[direction].astype(jnp.float32), lam_im[direction].astype(jnp.float32),
            log_dt[direction].astype(jnp.float32), b_re[direction].astype(jnp.float32),
            b_im[direction].astype(jnp.float32))
        ud = ug if direction == 0 else jnp.flip(ug, axis=1)
        bu_re = jnp.einsum('blgp,gnp->blgn', ud, bb_re)
        bu_im = jnp.einsum('blgp,gnp->blgn', ud, bb_im)
        xr, xi = complex_diag_scan(a_re, a_im, bu_re, bu_im)
        yd = (jnp.einsum('blgn,gpn->blgp', xr, c_re[direction].astype(jnp.float32))
              - jnp.einsum('blgn,gpn->blgp', xi, c_im[direction].astype(jnp.float32)))
        if direction == 1:
            yd = jnp.flip(yd, axis=1)
        y = y + yd.reshape(bsz, seq_len, SSM_WIDTH)
    z = jax.nn.gelu(y).astype(u.dtype)
    return z * jax.nn.sigmoid(z @ w_glu)


def _hgrn2_chunk_scan(q, k, v, log_f):
    bsz, seq_len, n_heads, dk = q.shape
    dv = v.shape[-1]
    n_chunks = seq_len // HG_CHUNK

    def to_chunks(t):
        return t.reshape(bsz, n_chunks, HG_CHUNK, n_heads, t.shape[-1]).transpose(1, 0, 3, 2, 4)

    causal = jnp.tril(jnp.ones((HG_CHUNK, HG_CHUNK), dtype=bool))[:, :, None]

    def step(state, inp):
        qc, kc, vc, lf = inp
        cum = jnp.cumsum(lf, axis=2)
        diff = cum[:, :, :, None, :] - cum[:, :, None, :, :]
        decay = jnp.where(causal, jnp.exp(jnp.where(causal, diff, 0.0)), 0.0)
        scores = jnp.einsum('bhjd,bhsd,bhjsd->bhjs', qc, kc, decay)
        out = (jnp.einsum('bhjs,bhsv->bhjv', scores, vc)
               + jnp.einsum('bhjd,bhdv->bhjv', qc * jnp.exp(cum), state))
        last = cum[:, :, -1:, :]
        new_state = (jnp.exp(last)[:, :, 0, :, None] * state
                     + jnp.einsum('bhsd,bhsv->bhdv', kc * jnp.exp(last - cum), vc))
        return new_state, out

    state0 = jnp.zeros((bsz, n_heads, dk, dv), jnp.float32)
    _, out = lax.scan(step, state0, (to_chunks(q), to_chunks(k), to_chunks(v), to_chunks(log_f)))
    return out.transpose(1, 0, 3, 2, 4).reshape(bsz, seq_len, n_heads, dv)


def hgrn2_bidirectional(q_raw, f_raw_fwd, f_raw_bwd, i_raw, g_raw, lower_bound, out_gain):
    bsz, seq_len, _ = q_raw.shape

    def heads(t):
        return t.astype(jnp.float32).reshape(bsz, seq_len, HG_HEADS, HG_HEAD_DIM)

    def flip(t):
        return jnp.flip(t, axis=1)

    q = jax.nn.silu(heads(q_raw))
    v = heads(i_raw)
    out = jnp.zeros((bsz, seq_len, HG_HEADS, HG_HEAD_DIM), jnp.float32)
    for direction, f_raw in enumerate((f_raw_fwd, f_raw_bwd)):
        lb = lower_bound[direction].astype(jnp.float32).reshape(HG_HEADS, HG_HEAD_DIM)
        z = heads(f_raw)
        log_f = jnp.logaddexp(jnp.log(jnp.maximum(lb, LB_FLOOR)), jnp.log1p(-lb) + jax.nn.log_sigmoid(z))
        k = (1.0 - lb) * jax.nn.sigmoid(-z)
        if direction == 0:
            out = out + _hgrn2_chunk_scan(q, k, v, log_f)
        else:
            out = out + flip(_hgrn2_chunk_scan(flip(q), flip(k), flip(v), flip(log_f)))
    gated = rms_norm(out, out_gain) * jax.nn.silu(heads(g_raw))
    return gated.reshape(bsz, seq_len, HG_WIDTH).astype(q_raw.dtype)


def encoder_layer(x, rope, ffn1_norm, ffn1_w_gate_up, ffn1_w_down, mix_norm, w_in,
                  lam_re, lam_im, log_dt, b_re, b_im, c_re, c_im, d_skip, w_glu,
                  lower_bound, hg_out_norm, q_norm, k_norm, w_branch, w_out,
                  ffn2_norm, ffn2_w_gate_up, ffn2_w_down):
    bsz, seq_len, _ = x.shape
    h = x + 0.5 * swiglu_ffn(rms_norm(x, ffn1_norm), ffn1_w_gate_up, ffn1_w_down)
    u = rms_norm(h, mix_norm)
    offsets = np.cumsum(SPLIT_SIZES)[:-1].tolist()
    (u_ssm, hg_q, hg_f_fwd, hg_f_bwd, hg_i, hg_g, att_q, att_k, att_v, gate_logits) = jnp.split(u @ w_in, offsets, axis=-1)
    y_ssm = s5_bidirectional(u_ssm, lam_re, lam_im, log_dt, b_re, b_im, c_re, c_im, d_skip, w_glu)
    y_hg = hgrn2_bidirectional(hg_q, hg_f_fwd, hg_f_bwd, hg_i, hg_g, lower_bound, hg_out_norm)
    q = apply_axial_rope(rms_norm(att_q.reshape(bsz, seq_len, ATT_Q_HEADS, HEAD_DIM), q_norm), rope)
    k = apply_axial_rope(rms_norm(att_k.reshape(bsz, seq_len, ATT_KV_HEADS, HEAD_DIM), k_norm), rope)
    v = att_v.reshape(bsz, seq_len, ATT_KV_HEADS, HEAD_DIM)
    y_att = gqa_block_attention(q, k, v)
    gates = jax.nn.sigmoid(gate_logits.reshape(bsz, seq_len, N_BRANCH, D_MODEL))
    w_ssm, w_hg, w_att = jnp.split(w_branch, [SSM_WIDTH, SSM_WIDTH + HG_WIDTH], axis=0)
    merged = (gates[:, :, 0] * (y_ssm @ w_ssm)
              + gates[:, :, 1] * (y_hg @ w_hg)
              + gates[:, :, 2] * (y_att @ w_att))
    h = h + merged @ w_out
    return h + 0.5 * swiglu_ffn(rms_norm(h, ffn2_norm), ffn2_w_gate_up, ffn2_w_down)


def encoder_trunk(x, stacked):
    rope = axial_rope_tables(x.shape[1])
    for layer in range(DEPTH):
        x = encoder_layer(x, rope, *[p[layer] for p in stacked])
    return x


def setup_inputs(seed: int = 0) -> dict:
    key = jax.random.key(seed)
    ks = jax.random.split(key, 32)
    f32 = jnp.float32

    def normal(k, shape, scale):
        return scale * jax.random.normal(k, shape, f32)

    def gain(k, shape):
        return 1.0 + 0.01 * jax.random.normal(k, shape, f32)

    ssm_shape = (DEPTH, 2, SSM_GROUPS, SSM_STATE)
    n_idx = jnp.arange(SSM_STATE, dtype=f32)
    return {
        "x_prompt": normal(ks[0], (BATCH, SEQ, D_MODEL), 1.0),
        "x_sample": normal(ks[1], (DEC_BATCH, DEC_SEQ, D_MODEL), 1.0),
        "ffn1_norm": gain(ks[2], (DEPTH, D_MODEL)),
        "ffn1_w_gate_up": normal(ks[3], (DEPTH, D_MODEL, 2 * D_FF), D_MODEL ** -0.5),
        "ffn1_w_down": normal(ks[4], (DEPTH, D_FF, D_MODEL), D_FF ** -0.5),
        "mix_norm": gain(ks[5], (DEPTH, D_MODEL)),
        "w_in": normal(ks[6], (DEPTH, D_MODEL, IN_WIDTH), D_MODEL ** -0.5),
        "ssm_lambda_re": -0.5 + normal(ks[7], ssm_shape, 0.01),
        "ssm_lambda_im": math.pi * n_idx + normal(ks[8], ssm_shape, 0.01),
        "ssm_log_dt": jax.random.uniform(ks[9], (DEPTH, 2, SSM_GROUPS), f32, math.log(1e-3), math.log(1e-1)),
        "ssm_b_re": normal(ks[10], (DEPTH, 2, SSM_GROUPS, SSM_STATE, SSM_GROUP), SSM_GROUP ** -0.5),
        "ssm_b_im": normal(ks[11], (DEPTH, 2, SSM_GROUPS, SSM_STATE, SSM_GROUP), SSM_GROUP ** -0.5),
        "ssm_c_re": normal(ks[12], (DEPTH, 2, SSM_GROUPS, SSM_GROUP, SSM_STATE), SSM_STATE ** -0.5),
        "ssm_c_im": normal(ks[13], (DEPTH, 2, SSM_GROUPS, SSM_GROUP, SSM_STATE), SSM_STATE ** -0.5),
        "ssm_d": normal(ks[14], (DEPTH, SSM_WIDTH), 1.0),
        "ssm_w_glu": normal(ks[15], (DEPTH, SSM_WIDTH, SSM_WIDTH), SSM_WIDTH ** -0.5),
        "hg_lb_logits": normal(ks[16], (DEPTH, 2, HG_WIDTH), 1.0),
        "hg_out_norm": gain(ks[17], (DEPTH, HG_HEAD_DIM)),
        "att_q_norm": gain(ks[18], (DEPTH, HEAD_DIM)),
        "att_k_norm": gain(ks[19], (DEPTH, HEAD_DIM)),
        "w_branch": normal(ks[20], (DEPTH, MIX_WIDTH, D_MODEL), MIX_WIDTH ** -0.5),
        "w_out": normal(ks[21], (DEPTH, D_MODEL, D_MODEL), D_MODEL ** -0.5),
        "ffn2_norm": gain(ks[22], (DEPTH, D_MODEL)),
        "ffn2_w_gate_up": normal(ks[23], (DEPTH, D_MODEL, 2 * D_FF), D_MODEL ** -0.5),
        "ffn2_w_down": normal(ks[24], (DEPTH, D_FF, D_MODEL), D_FF ** -0.5),
    }


def reference(x_prompt, x_sample, ffn1_norm, ffn1_w_gate_up, ffn1_w_down, mix_norm, w_in,
              ssm_lambda_re, ssm_lambda_im, ssm_log_dt, ssm_b_re, ssm_b_im, ssm_c_re, ssm_c_im,
              ssm_d, ssm_w_glu, hg_lb_logits, hg_out_norm, att_q_norm, att_k_norm,
              w_branch, w_out, ffn2_norm, ffn2_w_gate_up, ffn2_w_down):
    lb_p = jax.nn.softmax(hg_lb_logits.astype(jnp.float32), axis=0)
    hg_lower_bound = jnp.clip(jnp.cumsum(lb_p, axis=0) - lb_p[:1], 0.0, 1.0 - 1e-6)
    stacked = (ffn1_norm, ffn1_w_gate_up, ffn1_w_down, mix_norm, w_in,
               ssm_lambda_re, ssm_lambda_im, ssm_log_dt, ssm_b_re, ssm_b_im, ssm_c_re, ssm_c_im,
               ssm_d, ssm_w_glu, hg_lower_bound, hg_out_norm, att_q_norm, att_k_norm,
               w_branch, w_out, ffn2_norm, ffn2_w_gate_up, ffn2_w_down)
    y_prompt = encoder_trunk(x_prompt, stacked)
    y_sample = encoder_trunk(x_sample, stacked)
    return (y_prompt, y_sample)
```

```cpp
#include <hip/hip_runtime.h>
#include <cstdio>
#include <cstdint>
#include <cstring>

#define LAS __attribute__((address_space(3)))
#ifndef CHK_ROW0
#define CHK_ROW0 18432
#endif
typedef unsigned short bf16_t;
typedef short bf16x8 __attribute__((ext_vector_type(8)));
typedef short s16x4 __attribute__((ext_vector_type(4)));
typedef float f32x2 __attribute__((ext_vector_type(2)));
typedef float f32x4 __attribute__((ext_vector_type(4)));
typedef float f32x8 __attribute__((ext_vector_type(8)));
typedef float f32x16 __attribute__((ext_vector_type(16)));
typedef unsigned u32x2 __attribute__((ext_vector_type(2)));
typedef unsigned u32x4 __attribute__((ext_vector_type(4)));

constexpr int MT = 40960;
constexpr int NSEQ = 20, SEQL = 2048, PROMPT_ROWS = 8192;
constexpr int DM = 2048, DFF = 5632, NIN = 10752, DEPTH = 4;
constexpr int NTHREADS = 512;
constexpr int LDS_BYTES = 147456;
constexpr int LDS_MISC = 131072;

constexpr size_t MiB = 1048576;
constexpr size_t WS_BAR  = 0;
constexpr size_t WS_SSQ  = 2359296;
constexpr size_t WS_ATAB = 65536;
constexpr size_t WS_BM   = WS_ATAB + 131072;
constexpr size_t WS_CM   = WS_BM + 1048576;
constexpr size_t WS_LB   = WS_CM + 1048576;
constexpr size_t WS_WB   = 8 * MiB; static_assert(WS_LB + 16384 <= WS_SSQ && WS_SSQ + (size_t)MT * 128 <= WS_WB, "small tables");
constexpr size_t WB_GU1 = 0;
constexpr size_t WB_D1  = WB_GU1 + (size_t)11264 * 2048 * 2;
constexpr size_t WB_IN  = WB_D1 + (size_t)2048 * 5632 * 2;
constexpr size_t WB_GLU = WB_IN + (size_t)NIN * 2048 * 2;
constexpr size_t WB_BS  = WB_GLU + (size_t)512 * 512 * 2;
constexpr size_t WB_BH  = WB_BS + (size_t)2048 * 512 * 2;
constexpr size_t WB_BA  = WB_BH + (size_t)2048 * 512 * 2;
constexpr size_t WB_OUT = WB_BA + (size_t)2048 * 1024 * 2;
constexpr size_t WB_GU2 = WB_OUT + (size_t)2048 * 2048 * 2;
constexpr size_t WB_D2  = WB_GU2 + (size_t)11264 * 2048 * 2;
constexpr size_t WB_END = WB_D2 + (size_t)2048 * 5632 * 2;
constexpr size_t WS_HB   = WS_WB + 192 * MiB;
constexpr size_t WS_R    = WS_HB + (size_t)MT * 2048 * 2;
static_assert(WB_END <= 192 * MiB, "weights region");
constexpr size_t R_HID  = 0;
constexpr size_t SZ512  = (size_t)MT * 512 * 2;
constexpr size_t R_US   = 0;
constexpr size_t R_HGQ  = R_US + SZ512;
constexpr size_t R_MRG  = R_HGQ;
constexpr size_t R_AQ   = R_HGQ + 5 * SZ512;
constexpr size_t R_AK   = R_AQ + 2 * SZ512;
constexpr size_t R_AV   = R_AK + SZ512 / 2;
constexpr size_t R_GATE = R_AV + SZ512 / 2;
constexpr size_t R_YD   = R_GATE + 12 * SZ512;
constexpr size_t R_OHG  = R_YD + 4 * SZ512;
constexpr size_t R_YSS  = R_OHG + 4 * SZ512;
constexpr size_t R_YHG  = R_YSS + SZ512;
constexpr size_t R_YAT  = R_YHG + SZ512;
constexpr size_t R_END  = R_YAT + 2 * SZ512;
static_assert(R_MRG + 4 * SZ512 <= R_HGQ + 4 * SZ512, "merged overlay");
static_assert((size_t)MT * DFF * 2 <= R_END, "hid fits");
constexpr size_t WS_END  = WS_R + R_END;
constexpr size_t WS_CHK  = WS_END;

typedef __bf16 bf16x2_n __attribute__((ext_vector_type(2)));
__device__ __forceinline__ unsigned cvtpk(float lo, float hi) { f32x2 v = {lo, hi}; bf16x2_n b = __builtin_convertvector(v, bf16x2_n); return __builtin_bit_cast(unsigned, b); }
__device__ __forceinline__ float bf2f(bf16_t b) { return __uint_as_float(((unsigned)b) << 16); }
__device__ __forceinline__ float bflo(unsigned w) { return __uint_as_float(w << 16); }
__device__ __forceinline__ float bfhi(unsigned w) { return __uint_as_float(w & 0xffff0000u); }
__device__ __forceinline__ bf16_t f2bf(float f) { return (bf16_t)(cvtpk(f, 0.f) & 0xffffu); }
__device__ __forceinline__ float sigm(float x) { return __builtin_amdgcn_rcpf(1.0f + __expf(-x)); }
__device__ __forceinline__ float siluf(float x) { return x * sigm(x); }
__device__ __forceinline__ float gelu_tanh(float x) {
    const float u = 0.7978845608028654f * (x + 0.044715f * x * x * x);
    return x * sigm(2.0f * u);
}
#define WAIT_VM0() asm volatile("s_waitcnt vmcnt(0)" ::: "memory")
#define WAIT_LGKM0() asm volatile("s_waitcnt lgkmcnt(0)" ::: "memory")
namespace pg8 {
#define PG8_LAS __attribute__((address_space(3)))
typedef unsigned short bf16_t;
typedef short bf16x8 __attribute__((ext_vector_type(8)));
typedef float f32x4 __attribute__((ext_vector_type(4)));
typedef unsigned u32x4 __attribute__((ext_vector_type(4)));
constexpr int BM = 256, BK = 64, HALF = 128, HTB = HALF * BK * 2  , STAGE_BYTES = 8 * HTB, NXCD = 8, WGM = 8;

__host__ __device__ __forceinline__ int lds_byte(int r, int c) { const int st = (r >> 4) * 2 + (c >> 5), rr = r & 15, cc = c & 31, ob = rr * 64 + cc * 2; return st * 1024 + (ob ^ (((ob >> 9) & 1) << 5)); }
__host__ __device__ __forceinline__ void stage_rc(int b, int& R, int& C) { const int st = b / 1024, sb = b % 1024, swz = sb ^ (((sb >> 9) & 1) << 5); R = (st >> 1) * 16 + swz / 64; C = (st & 1) * 32 + (swz % 64) / 2; }
__host__ __device__ __forceinline__ int perm32(int rho) { const int n = rho >> 4, i = rho & 15; return 8 * (i >> 2) + 4 * n + (i & 3); }

struct Unit { int pm, pn; };
struct Gemm { const bf16_t* A; const bf16_t* Bt; int M, N, K; };

struct StaticOrder {
    int nM, nN, nwg, G, c;
    __host__ __device__ void init(int M, int N, int G_, int c_) { nM = M / BM; nN = N / BM; nwg = nM * nN; G = G_; c = c_; }
    __host__ __device__ bool next(int i, Unit& u) const {
        const long L = (long)i * G + c; if (L >= nwg) return false;
        int wgid = (int)L; { const int q = nwg / NXCD, r = nwg % NXCD, xcd = wgid % NXCD, off = wgid / NXCD; wgid = (xcd < r ? xcd * (q + 1) : r * (q + 1) + (xcd - r) * q) + off; }
        const int nig = WGM * nN, gid = wgid / nig, fm = gid * WGM, gsz = (nM - fm) < WGM ? (nM - fm) : WGM;
        u.pm = fm + ((wgid % nig) % gsz); u.pn = (wgid % nig) / gsz; return true;
    }
    __device__ __forceinline__ void a_ready(const Unit&) const {}
    __device__ __forceinline__ void done(const Unit&) const {}
};


template <class Epi, class Sched, bool ALIGN_EPI = false, bool SP2 = false>
__device__ __forceinline__ void gemm_phase(PG8_LAS unsigned char* lds, const Gemm g, const Sched& S, const Epi& E) {
    int tid_l = threadIdx.x; asm volatile("" : "+v"(tid_l));
    const int tid = tid_l, wid = __builtin_amdgcn_readfirstlane(tid >> 6), lane = tid & 63, wr = wid >> 2, wc = wid & 3, fr = lane & 15, fq = lane >> 4;
    const int K = g.K, nt = K / BK;
    unsigned voffA[2], voffB[2];
#pragma unroll
    for (int i = 0; i < 2; ++i) { int R, C; stage_rc(tid * 16 + i * 8192, R, C); const int Rb = Epi::PERM ? ((R & ~31) + perm32(R & 31)) : R;
        voffA[i] = (unsigned)(R * K + C) * 2u; voffB[i] = (unsigned)(Rb * K + C) * 2u; }
    const size_t kstep = (size_t)(BK * 2);
    const size_t hstep = (size_t)HALF * K * 2;
    const size_t tstep = 2 * hstep;
    const unsigned ldsw = (unsigned)wid * 1024u;
    const int aoff = lds_byte(wr * 64 + fr, fq * 8), boff = lds_byte(wc * 32 + fr, fq * 8);
#define PG8_SA(b, h) (((b) * 2 + (h)) * HTB)
#define PG8_SB(b, h) ((4 + (b) * 2 + (h)) * HTB)
#define PG8_STAGE(bufoff, gbase, voff) do { _Pragma("unroll") for (int _i = 0; _i < 2; ++_i) \
        __builtin_amdgcn_global_load_lds((const unsigned*)((const char*)(gbase) + (voff)[_i]), (PG8_LAS unsigned*)(lds + (bufoff) + ldsw + _i * 8192), 16, 0, 0); } while (0)
#define PG8_LDA(dst, b, h) do { _Pragma("unroll") for (int m = 0; m < 4; ++m) _Pragma("unroll") for (int k = 0; k < 2; ++k) dst[m][k] = *(const PG8_LAS bf16x8*)(lds + PG8_SA(b, h) + aoff + m * 2048 + k * 1024); } while (0)
#define PG8_LDB(dst, b, h) do { _Pragma("unroll") for (int n = 0; n < 2; ++n) _Pragma("unroll") for (int k = 0; k < 2; ++k) dst[n][k] = *(const PG8_LAS bf16x8*)(lds + PG8_SB(b, h) + boff + n * 2048 + k * 1024); } while (0)
#define PG8_MMA(ai, bj, At, Bt) do { __builtin_amdgcn_s_setprio(1); _Pragma("unroll") for (int m = 0; m < 4; ++m) _Pragma("unroll") for (int n = 0; n < 2; ++n) _Pragma("unroll") for (int k = 0; k < 2; ++k) \
        acc[ai][bj][m][n] = __builtin_amdgcn_mfma_f32_16x16x32_bf16(Bt[n][k], At[m][k], acc[ai][bj][m][n], 0, 0, 0); __builtin_amdgcn_s_setprio(0); } while (0)
#define PG8_WAIT_V(n) asm volatile("s_waitcnt vmcnt(" #n ")" ::: "memory")
#define PG8_WAIT_L(n) asm volatile("s_waitcnt lgkmcnt(" #n ")" ::: "memory")
#define PG8_BAR __builtin_amdgcn_s_barrier()
#define PG8_SCHED __builtin_amdgcn_sched_barrier(0)
    Unit cur, nxt; int ui = 0;
    if (!S.next(0, cur)) return;
    f32x4 acc[2][2][4][2];
#pragma unroll
    for (int a = 0; a < 2; ++a)
#pragma unroll
        for (int b = 0; b < 2; ++b)
#pragma unroll
            for (int m = 0; m < 4; ++m)
#pragma unroll
                for (int n = 0; n < 2; ++n) acc[a][b][m][n] = (f32x4){0.f, 0.f, 0.f, 0.f};
    bf16x8 At[4][2], B0[2][2], B1[2][2];
    const char* cA = (const char*)g.A + (size_t)cur.pm * tstep; const char* cB = (const char*)g.Bt + (size_t)cur.pn * tstep;
    S.a_ready(cur);
    if constexpr (SP2) {
        PG8_STAGE(PG8_SB(0, 0), cB, voffB); PG8_STAGE(PG8_SB(0, 1), cB + hstep, voffB); PG8_STAGE(PG8_SA(0, 0), cA, voffA); PG8_STAGE(PG8_SA(0, 1), cA + hstep, voffA);
        if (wr == 1) PG8_BAR;
        PG8_WAIT_V(2); PG8_BAR;
        PG8_STAGE(PG8_SB(1, 0), cB + kstep, voffB); PG8_STAGE(PG8_SA(1, 0), cA + kstep, voffA); PG8_STAGE(PG8_SB(1, 1), cB + hstep + kstep, voffB);
        PG8_WAIT_V(6); PG8_BAR;
    } else {
        PG8_STAGE(PG8_SB(0, 0), cB, voffB); PG8_STAGE(PG8_SA(0, 0), cA, voffA); PG8_STAGE(PG8_SB(0, 1), cB + hstep, voffB); PG8_STAGE(PG8_SA(0, 1), cA + hstep, voffA);
        if (wr == 1) PG8_BAR;
        PG8_WAIT_V(4); PG8_BAR;
        PG8_STAGE(PG8_SB(1, 0), cB + kstep, voffB); PG8_STAGE(PG8_SA(1, 0), cA + kstep, voffA); PG8_STAGE(PG8_SB(1, 1), cB + hstep + kstep, voffB);
        PG8_WAIT_V(6); PG8_BAR;
    }
    for (;;) {
        const bool has_next = S.next(ui + 1, nxt);
        const char* nA = has_next ? (const char*)g.A + (size_t)nxt.pm * tstep : cA; const char* nB = has_next ? (const char*)g.Bt + (size_t)nxt.pn * tstep : cB;
        for (int t = 0; t < nt; t += 2) {
            const bool last = (t == nt - 2);
            const char* a1 = cA + (size_t)(t + 1) * kstep;
            const char* a2 = last ? nA : cA + (size_t)(t + 2) * kstep; const char* b2 = last ? nB : cB + (size_t)(t + 2) * kstep;
            const char* a3 = a2 + kstep; const char* b3 = b2 + kstep;
            if (last && has_next) S.a_ready(nxt);
            if constexpr (SP2) {
            PG8_LDB(B0, 0, 0); PG8_LDB(B1, 0, 1); PG8_SCHED; PG8_LDA(At, 0, 0); PG8_STAGE(PG8_SA(1, 1), a1 + hstep, voffA);
            PG8_WAIT_V(8); PG8_WAIT_L(0); PG8_BAR; PG8_MMA(0, 0, At, B0); PG8_MMA(0, 1, At, B1); PG8_BAR; PG8_SCHED;
            PG8_LDA(At, 0, 1); PG8_STAGE(PG8_SB(0, 0), b2, voffB); PG8_STAGE(PG8_SB(0, 1), b2 + hstep, voffB); PG8_STAGE(PG8_SA(0, 0), a2, voffA);
            PG8_WAIT_V(8); PG8_WAIT_L(0); PG8_BAR; PG8_MMA(1, 0, At, B0); PG8_MMA(1, 1, At, B1); PG8_BAR; PG8_SCHED;
            PG8_LDB(B0, 1, 0); PG8_LDB(B1, 1, 1); PG8_SCHED; PG8_LDA(At, 1, 0); PG8_STAGE(PG8_SA(0, 1), a2 + hstep, voffA);
            PG8_WAIT_V(8); PG8_WAIT_L(0); PG8_BAR; PG8_MMA(0, 0, At, B0); PG8_MMA(0, 1, At, B1); PG8_BAR; PG8_SCHED;
            PG8_LDA(At, 1, 1); PG8_STAGE(PG8_SB(1, 0), b3, voffB); PG8_STAGE(PG8_SB(1, 1), b3 + hstep, voffB); PG8_STAGE(PG8_SA(1, 0), a3, voffA);
            PG8_WAIT_V(8); PG8_WAIT_L(0); PG8_BAR; PG8_MMA(1, 0, At, B0); PG8_MMA(1, 1, At, B1); PG8_BAR; PG8_SCHED;
            } else {
            PG8_LDB(B0, 0, 0); PG8_SCHED; PG8_LDA(At, 0, 0); PG8_STAGE(PG8_SA(1, 1), a1 + hstep, voffA);
            PG8_WAIT_L(8); PG8_BAR; PG8_WAIT_L(0); PG8_MMA(0, 0, At, B0); PG8_BAR; PG8_SCHED;
            PG8_LDB(B1, 0, 1); PG8_STAGE(PG8_SB(0, 0), b2, voffB);
            PG8_BAR; PG8_WAIT_L(0); PG8_MMA(0, 1, At, B1); PG8_BAR;
            PG8_LDA(At, 0, 1); PG8_STAGE(PG8_SA(0, 0), a2, voffA);
            PG8_BAR; PG8_WAIT_L(0); PG8_MMA(1, 0, At, B0); PG8_BAR; PG8_SCHED;
            PG8_STAGE(PG8_SB(0, 1), b2 + hstep, voffB);
            PG8_WAIT_V(6); PG8_BAR; PG8_MMA(1, 1, At, B1); PG8_BAR;
            PG8_LDB(B0, 1, 0); PG8_SCHED; PG8_LDA(At, 1, 0); PG8_STAGE(PG8_SA(0, 1), a2 + hstep, voffA);
            PG8_WAIT_L(8); PG8_BAR; PG8_WAIT_L(0); PG8_MMA(0, 0, At, B0); PG8_BAR; PG8_SCHED;
            PG8_LDB(B1, 1, 1); PG8_STAGE(PG8_SB(1, 0), b3, voffB);
            PG8_BAR; PG8_WAIT_L(0); PG8_MMA(0, 1, At, B1); PG8_BAR;
            PG8_LDA(At, 1, 1); PG8_STAGE(PG8_SA(1, 0), a3, voffA);
            PG8_BAR; PG8_WAIT_L(0); PG8_MMA(1, 0, At, B0); PG8_BAR; PG8_SCHED;
            PG8_STAGE(PG8_SB(1, 1), b3 + hstep, voffB);
            PG8_WAIT_V(6); PG8_BAR; PG8_MMA(1, 1, At, B1); PG8_BAR;
            }
        }
        if constexpr (ALIGN_EPI) { if (wr == 0) PG8_BAR; }
        if constexpr (!Epi::AFTER_DRAIN) { E(acc, cur, wr, wc, fr, fq); S.done(cur); }
        if (!has_next) break;
#pragma unroll
        for (int a = 0; a < 2; ++a)
#pragma unroll
            for (int b = 0; b < 2; ++b)
#pragma unroll
                for (int m = 0; m < 4; ++m)
#pragma unroll
                    for (int n = 0; n < 2; ++n) acc[a][b][m][n] = (f32x4){0.f, 0.f, 0.f, 0.f};
        cur = nxt; cA = nA; cB = nB; ++ui;
        if constexpr (ALIGN_EPI) { if (wr == 1) PG8_BAR; }
    }
    PG8_WAIT_V(0);
    if constexpr (!ALIGN_EPI) { if (wr == 0) PG8_BAR; }
    PG8_BAR;
    if constexpr (Epi::AFTER_DRAIN) { E.fused(acc, cur, wr, wc, fr, fq, lds, wid, lane); S.done(cur); }
#undef PG8_SA
#undef PG8_SB
#undef PG8_STAGE
#undef PG8_LDA
#undef PG8_LDB
#undef PG8_MMA
#undef PG8_WAIT_V
#undef PG8_WAIT_L
#undef PG8_BAR
#undef PG8_SCHED
}
}
namespace epi {
using pg8::Unit;
constexpr float RMS_EPS = 1e-6f;
__device__ __forceinline__ float row_rstd(const float* ssq, int row) {
    const f32x4* p = (const f32x4*)(ssq + (size_t)row * 32);
    f32x4 a = p[0] + p[1], b = p[2] + p[3], c = p[4] + p[5], d = p[6] + p[7];
    a = (a + b) + (c + d);
    return __builtin_amdgcn_rsqf(((a[0] + a[1]) + (a[2] + a[3])) * (1.0f / 2048.0f) + RMS_EPS);
}

struct Swiglu {
    static constexpr bool PERM = true, AFTER_DRAIN = false;
    bf16_t* H; const float* ssq;
    __device__ __forceinline__ void operator()(const f32x4 (&acc)[2][2][4][2], const Unit& u, int wr, int wc, int fr, int fq) const {
        const int row0 = u.pm * 256 + wr * 64 + fr, col0 = u.pn * 128 + wc * 32 + 8 * fq;
#pragma unroll
        for (int ai = 0; ai < 2; ++ai)
#pragma unroll
            for (int m = 0; m < 4; ++m) {
                const int row = row0 + ai * 128 + m * 16;
                const float rstd = row_rstd(ssq, row);
                float o[8];
#pragma unroll
                for (int n = 0; n < 2; ++n)
#pragma unroll
                    for (int j = 0; j < 4; ++j) { const float g = acc[ai][0][m][n][j] * rstd, up = acc[ai][1][m][n][j] * rstd; o[n * 4 + j] = siluf(g) * up; }
                u32x4 w; w.x = cvtpk(o[0], o[1]); w.y = cvtpk(o[2], o[3]); w.z = cvtpk(o[4], o[5]); w.w = cvtpk(o[6], o[7]);
                *(u32x4*)(H + (size_t)row * DFF + col0) = w;
            }
    }
};

struct Resid {
    static constexpr bool PERM = false, AFTER_DRAIN = false;
    const float* base0; const float* base1; int split_row; float scale; float* out; bf16_t* hb; float* ssq_out;
    __device__ __forceinline__ void operator()(const f32x4 (&acc)[2][2][4][2], const Unit& u, int wr, int wc, int fr, int fq) const {
        const int row0 = u.pm * 256 + wr * 64 + fr, col0 = u.pn * 256 + wc * 32 + 4 * fq;
#pragma unroll
        for (int ai = 0; ai < 2; ++ai)
#pragma unroll
            for (int m = 0; m < 4; ++m) {
                const int row = row0 + ai * 128 + m * 16;
                const float* bp = (row < split_row) ? base0 + (size_t)row * DM : base1 + (size_t)(row - split_row) * DM;
                float* op = out + (size_t)row * DM; bf16_t* hp = hb + (size_t)row * DM;
                float s = 0.f;
#pragma unroll
                for (int bj = 0; bj < 2; ++bj)
#pragma unroll
                    for (int n = 0; n < 2; ++n) {
                        const int c = col0 + bj * 128 + n * 16;
                        const f32x4 b = *(const f32x4*)(bp + c);
                        const f32x4 o = b + acc[ai][bj][m][n] * scale;
                        *(f32x4*)(op + c) = o;
                        s += (o[0] * o[0] + o[1] * o[1]) + (o[2] * o[2] + o[3] * o[3]);
                        u32x2 w; w.x = cvtpk(o[0], o[1]); w.y = cvtpk(o[2], o[3]);
                        *(u32x2*)(hp + c) = w;
                    }
                s += __shfl_xor(s, 16); s += __shfl_xor(s, 32);
                if (fq == 0) ssq_out[(size_t)row * 32 + u.pn * 4 + wc] = s;
                asm volatile("" ::: "memory");
            }
    }
};

struct WinSplit {
    static constexpr bool PERM = true, AFTER_DRAIN = false;
    unsigned char* R; const float* ssq;
    __device__ __forceinline__ void operator()(const f32x4 (&acc)[2][2][4][2], const Unit& u, int wr, int wc, int fr, int fq) const {
        const int pn = u.pn; bf16_t* dst; int ld, colt; bool sg = false;
        if (pn < 12)       { dst = (bf16_t*)(R + R_US + (size_t)(pn >> 1) * SZ512); ld = 512; colt = (pn & 1) * 256; }
        else if (pn < 16)  { dst = (bf16_t*)(R + R_AQ); ld = 1024; colt = (pn - 12) * 256; }
        else if (pn == 16) { dst = (bf16_t*)(R + R_AK); ld = 256; colt = 0; }
        else if (pn == 17) { dst = (bf16_t*)(R + R_AV); ld = 256; colt = 0; }
        else { const int g = (pn - 18) >> 3; dst = (bf16_t*)(R + R_GATE + (size_t)g * 4 * SZ512); ld = 2048; colt = ((pn - 18) & 7) * 256; sg = true; }
        const int row0 = u.pm * 256 + wr * 64 + fr, col0 = colt + wc * 32 + 8 * fq;
#pragma unroll
        for (int ai = 0; ai < 2; ++ai)
#pragma unroll
            for (int m = 0; m < 4; ++m) {
                const int row = row0 + ai * 128 + m * 16;
                const float rstd = row_rstd(ssq, row);
#pragma unroll
                for (int bj = 0; bj < 2; ++bj) {
                    f32x4 v0 = acc[ai][bj][m][0] * rstd, v1 = acc[ai][bj][m][1] * rstd;
                    if (sg) {
#pragma unroll
                        for (int j = 0; j < 4; ++j) { v0[j] = sigm(v0[j]); v1[j] = sigm(v1[j]); }
                    }
                    u32x4 w; w.x = cvtpk(v0[0], v0[1]); w.y = cvtpk(v0[2], v0[3]); w.z = cvtpk(v1[0], v1[1]); w.w = cvtpk(v1[2], v1[3]);
                    *(u32x4*)(dst + (size_t)row * ld + col0 + bj * 128) = w;
                }
            }
    }
};

struct Glu {
    static constexpr bool PERM = true, AFTER_DRAIN = false;
    const bf16_t* Z; bf16_t* Y;
    __device__ __forceinline__ void operator()(const f32x4 (&acc)[2][2][4][2], const Unit& u, int wr, int wc, int fr, int fq) const {
        const int row0 = u.pm * 256 + wr * 64 + fr, col0 = u.pn * 256 + wc * 32 + 8 * fq;
#pragma unroll
        for (int ai = 0; ai < 2; ++ai)
#pragma unroll
            for (int m = 0; m < 4; ++m) {
                const int row = row0 + ai * 128 + m * 16;
#pragma unroll
                for (int bj = 0; bj < 2; ++bj) {
                    const size_t off = (size_t)row * 512 + col0 + bj * 128;
                    const u32x4 z = *(const u32x4*)(Z + off);
                    const f32x4 a0 = acc[ai][bj][m][0], a1 = acc[ai][bj][m][1];
                    u32x4 w;
                    w.x = cvtpk(bflo(z.x) * sigm(a0[0]), bfhi(z.x) * sigm(a0[1])); w.y = cvtpk(bflo(z.y) * sigm(a0[2]), bfhi(z.y) * sigm(a0[3]));
                    w.z = cvtpk(bflo(z.z) * sigm(a1[0]), bfhi(z.z) * sigm(a1[1])); w.w = cvtpk(bflo(z.w) * sigm(a1[2]), bfhi(z.w) * sigm(a1[3]));
                    *(u32x4*)(Y + off) = w;
                }
            }
    }
};

struct Merge {
    static constexpr bool PERM = true, AFTER_DRAIN = false;
    const bf16_t* G; const bf16_t* Pin; bf16_t* Mg;
    __device__ __forceinline__ void operator()(const f32x4 (&acc)[2][2][4][2], const Unit& u, int wr, int wc, int fr, int fq) const {
        const int row0 = u.pm * 256 + wr * 64 + fr, col0 = u.pn * 256 + wc * 32 + 8 * fq;
#pragma unroll
        for (int ai = 0; ai < 2; ++ai)
#pragma unroll
            for (int m = 0; m < 4; ++m) {
                const int row = row0 + ai * 128 + m * 16;
#pragma unroll
                for (int bj = 0; bj < 2; ++bj) {
                    const size_t off = (size_t)row * DM + col0 + bj * 128;
                    const u32x4 g = *(const u32x4*)(G + off);
                    u32x4 p = (u32x4){0u, 0u, 0u, 0u};
                    if (Pin) p = *(const u32x4*)(Pin + off);
                    const f32x4 a0 = acc[ai][bj][m][0], a1 = acc[ai][bj][m][1];
                    u32x4 w;
                    w.x = cvtpk(bflo(p.x) + bflo(g.x) * a0[0], bfhi(p.x) + bfhi(g.x) * a0[1]); w.y = cvtpk(bflo(p.y) + bflo(g.y) * a0[2], bfhi(p.y) + bfhi(g.y) * a0[3]);
                    w.z = cvtpk(bflo(p.z) + bflo(g.z) * a1[0], bfhi(p.z) + bfhi(g.z) * a1[1]); w.w = cvtpk(bflo(p.w) + bflo(g.w) * a1[2], bfhi(p.w) + bfhi(g.w) * a1[3]);
                    *(u32x4*)(Mg + off) = w;
                }
            }
    }
};
}
#define MFMA16(a, b, c) __builtin_amdgcn_mfma_f32_16x16x32_bf16((a), (b), (c), 0, 0, 0)
#define MFMA32(a, b, c) __builtin_amdgcn_mfma_f32_32x32x16_bf16((a), (b), (c), 0, 0, 0)

struct CvtJob { const float* W; const float* gain; bf16_t* dst; int ldw, K, Np, mode; };
__device__ __forceinline__ int cvt_col(int np, int mode) { if (mode == 0) return np; const int t = np >> 8, w = np & 255; return (w < 128) ? t * 128 + w : DFF + t * 128 + (w - 128); }
__device__ __forceinline__ void cvt_tile(LAS unsigned char* lds, const CvtJob& J, int tn, int tk) {
    LAS bf16_t* T = (LAS bf16_t*)lds;
    int tid_l = threadIdx.x; asm volatile("" : "+v"(tid_l)); const int tid = tid_l, c = tid & 63, r0 = tid >> 6, k0 = tk * 128;
    const int col = cvt_col(tn * 64 + c, J.mode);
    const float* src = J.W + (size_t)k0 * J.ldw + col;
#pragma unroll
    for (int i = 0; i < 16; ++i) {
        const int k = r0 + 8 * i;
        float v = src[(size_t)k * J.ldw];
        if (J.gain) v *= J.gain[k0 + k];
        T[c * 136 + k] = f2bf(v);
    }
    __syncthreads();
    const int row = tid >> 3, seg = tid & 7;
    const LAS u32x4* s = (const LAS u32x4*)(T + row * 136 + seg * 16);
    u32x4* d = (u32x4*)(J.dst + (size_t)(tn * 64 + row) * J.K + k0 + seg * 16);
    d[0] = s[0]; d[1] = s[1];
    __syncthreads();
}
__device__ __forceinline__ void cvt_job(LAS unsigned char* lds, const CvtJob& J, int& base) {
    const int ntn = J.Np / 64, ntk = J.K / 128, nt = ntn * ntk;
    const int G = gridDim.x;
    int first = (int)blockIdx.x - (base % G); if (first < 0) first += G;
    for (int t = first; t < nt; t += G) cvt_tile(lds, J, t % ntn, t / ntn);
    base += nt;
}

__device__ __forceinline__ void sincos_d(double x, double& s, double& c) {
    const double k = rint(x * 0.63661977236758134308);
    const double r = (x - k * 1.5707963267948966192) - k * 6.123233995736766e-17;
    const double r2 = r * r;
    double sp = -1.0 / 1307674368000.0; sp = sp * r2 + 1.0 / 6227020800.0; sp = sp * r2 - 1.0 / 39916800.0; sp = sp * r2 + 1.0 / 362880.0; sp = sp * r2 - 1.0 / 5040.0; sp = sp * r2 + 1.0 / 120.0; sp = sp * r2 - 1.0 / 6.0; sp = sp * r2 + 1.0;
    double cp = 1.0 / 20922789888000.0; cp = cp * r2 - 1.0 / 87178291200.0; cp = cp * r2 + 1.0 / 479001600.0; cp = cp * r2 - 1.0 / 3628800.0; cp = cp * r2 + 1.0 / 40320.0; cp = cp * r2 - 1.0 / 720.0; cp = cp * r2 + 1.0 / 24.0; cp = cp * r2 - 0.5; cp = cp * r2 + 1.0;
    const double sr = sp * r, cr = cp;
    const int q = ((int)k) & 3;
    s = (q == 0) ? sr : (q == 1) ? cr : (q == 2) ? -sr : -cr;
    c = (q == 0) ? cr : (q == 1) ? -sr : (q == 2) ? -cr : sr;
}
__device__ __forceinline__ double exp_d(double x) {
    const double k = rint(x * 1.4426950408889634074);
    const double r = x - k * 0.69314718055994530942;
    double p = 1.0 / 479001600.0; p = p * r + 1.0 / 39916800.0; p = p * r + 1.0 / 3628800.0; p = p * r + 1.0 / 362880.0; p = p * r + 1.0 / 40320.0; p = p * r + 1.0 / 5040.0; p = p * r + 1.0 / 720.0;
    p = p * r + 1.0 / 120.0; p = p * r + 1.0 / 24.0; p = p * r + 1.0 / 6.0; p = p * r + 0.5; p = p * r + 1.0; p = p * r + 1.0;
    return ldexp(p, (int)k);
}

struct ProArgs {
    const float* x_prompt; const float* x_sample;
    const float* lam_re; const float* lam_im; const float* log_dt; const float* b_re; const float* b_im; const float* c_re; const float* c_im; const float* lb_logits;
    unsigned char* ws;
};
__device__ __forceinline__ void prologue_phase(const ProArgs& A) {
    int tid_l = threadIdx.x; asm volatile("" : "+v"(tid_l)); const int tid = tid_l, G = gridDim.x; const size_t gtid = (size_t)blockIdx.x * NTHREADS + tid, gstride = (size_t)G * NTHREADS;
    for (size_t i = gtid; i < (size_t)DEPTH * 2 * 32 * 64; i += gstride) {
        const int n = (int)(i & 63); const size_t ldg = i >> 6;
        const double dt = exp_d((double)A.log_dt[ldg]);
        const double lr = (double)A.lam_re[i], li = (double)A.lam_im[i];
        const double mag = exp_d(lr * dt); double sn, cs; sincos_d(li * dt, sn, cs);
        const double are = mag * cs, aim = mag * sn;
        const double den = lr * lr + li * li, nre = are - 1.0;
        const double cre = (nre * lr + aim * li) / den, cim = (aim * lr - nre * li) / den;
        ((f32x2*)(A.ws + WS_ATAB))[i] = (f32x2){(float)are, (float)aim};
        bf16_t* Bm = (bf16_t*)(A.ws + WS_BM) + ldg * 128 * 16; bf16_t* Cm = (bf16_t*)(A.ws + WS_CM) + ldg * 16 * 128;
        const float* bre = A.b_re + i * 16; const float* bim = A.b_im + i * 16;
#pragma unroll
        for (int p = 0; p < 16; ++p) {
            const double br = (double)bre[p], bi = (double)bim[p];
            Bm[n * 16 + p] = f2bf((float)(cre * br - cim * bi));
            Bm[(64 + n) * 16 + p] = f2bf((float)(cre * bi + cim * br));
            Cm[p * 128 + n] = f2bf(A.c_re[(ldg * 16 + p) * 64 + n]);
            Cm[p * 128 + 64 + n] = f2bf(-A.c_im[(ldg * 16 + p) * 64 + n]);
        }
    }
    for (size_t i = gtid; i < 1024; i += gstride) {
        float lg[DEPTH], mx = -1e30f;
#pragma unroll
        for (int l = 0; l < DEPTH; ++l) { lg[l] = A.lb_logits[l * 1024 + i]; mx = fmaxf(mx, lg[l]); }
        float sum = 0.f;
#pragma unroll
        for (int l = 0; l < DEPTH; ++l) { lg[l] = expf(lg[l] - mx); sum += lg[l]; }
        float cum = 0.f; const float p0 = lg[0] / sum;
#pragma unroll
        for (int l = 0; l < DEPTH; ++l) { cum += lg[l] / sum; float v = cum - p0; v = fminf(fmaxf(v, 0.f), 1.0f - 1e-6f); ((float*)(A.ws + WS_LB))[l * 1024 + i] = v; }
    }
    {
        const int wave = tid >> 6, lane = tid & 63; float* ssq = (float*)(A.ws + WS_SSQ); bf16_t* hb = (bf16_t*)(A.ws + WS_HB);
        for (int row = blockIdx.x * 8 + wave; row < MT; row += G * 8) {
            const float* xp = (row < PROMPT_ROWS) ? A.x_prompt + (size_t)row * DM : A.x_sample + (size_t)(row - PROMPT_ROWS) * DM;
            float s = 0.f;
#pragma unroll
            for (int i = 0; i < 4; ++i) {
                const int c = (i * 64 + lane) * 8;
                const f32x4 a = *(const f32x4*)(xp + c), b = *(const f32x4*)(xp + c + 4);
                s += (a[0] * a[0] + a[1] * a[1]) + (a[2] * a[2] + a[3] * a[3]) + (b[0] * b[0] + b[1] * b[1]) + (b[2] * b[2] + b[3] * b[3]);
                u32x4 w; w.x = cvtpk(a[0], a[1]); w.y = cvtpk(a[2], a[3]); w.z = cvtpk(b[0], b[1]); w.w = cvtpk(b[2], b[3]);
                *(u32x4*)(hb + (size_t)row * DM + c) = w;
            }
#pragma unroll
            for (int o = 32; o >= 1; o >>= 1) s += __shfl_xor(s, o);
            if (lane < 32) ssq[(size_t)row * 32 + lane] = (lane == 0) ? s : 0.f;
        }
    }
}

struct S5Args { bf16_t* us; float* yd; const f32x2* atab; const bf16_t* Bm; const bf16_t* Cm; const float* dskip; };
__device__ __forceinline__ int crow16(int r) { return (r & 3) + 8 * (r >> 2); }
__device__ __forceinline__ void s5_unit(LAS unsigned char* lds, const S5Args& A, int unit) {
    int tid_l = threadIdx.x; asm volatile("" : "+v"(tid_l)); const int tid = tid_l, w = __builtin_amdgcn_readfirstlane(tid >> 6), lane = tid & 63, l31 = lane & 31, hi = lane >> 5, fr = lane & 15, fq = lane >> 4;
    const int b = unit >> 3, gq = unit & 7, dir = w >> 2, g = gq * 4 + (w & 3);
    const size_t row0 = (size_t)b * SEQL;
    const f32x2 a = A.atab[(dir * 32 + g) * 64 + lane];
    const bf16_t* Bm = A.Bm + (size_t)(dir * 32 + g) * 128 * 16;
    const bf16_t* Cm = A.Cm + (size_t)(dir * 32 + g) * 16 * 128;
    bf16x8 bfrag[4], cfrag[4];
#pragma unroll
    for (int j = 0; j < 4; ++j) { bfrag[j] = *(const bf16x8*)(Bm + (j * 32 + l31) * 16 + hi * 8); cfrag[j] = *(const bf16x8*)(Cm + fr * 128 + j * 32 + fq * 8); }
    LAS unsigned char* X = lds + w * 8704;
    const bf16_t* ug = A.us + row0 * 512 + g * 16 + hi * 8;
    float* ydw = A.yd + ((size_t)dir * MT + row0) * 512 + g * 16 + fr;
    float xr = 0.f, xi = 0.f;
    const int tA0 = dir ? (SEQL - 1 - l31) : l31;
    bf16x8 ua = *(const bf16x8*)(ug + (size_t)tA0 * 512);
    for (int c = 0; c < SEQL / 32; ++c) {
        bf16x8 ua_n = ua;
        if (c + 1 < SEQL / 32) { const int tn = dir ? tA0 - 32 * (c + 1) : tA0 + 32 * (c + 1); ua_n = *(const bf16x8*)(ug + (size_t)tn * 512); }
        const f32x16 zero = {};
        f32x16 d0 = MFMA32(ua, bfrag[0], zero), d1 = MFMA32(ua, bfrag[1], zero), d2 = MFMA32(ua, bfrag[2], zero), d3 = MFMA32(ua, bfrag[3], zero);
        float p0r[16], p1r[16], p0i[16], p1i[16];
#pragma unroll
        for (int r = 0; r < 16; ++r) {
            auto s = __builtin_amdgcn_permlane32_swap(__float_as_uint(d0[r]), __float_as_uint(d1[r]), false, false);
            p0r[r] = __uint_as_float(s[0]); p1r[r] = __uint_as_float(s[1]);
            auto q = __builtin_amdgcn_permlane32_swap(__float_as_uint(d2[r]), __float_as_uint(d3[r]), false, false);
            p0i[r] = __uint_as_float(q[0]); p1i[r] = __uint_as_float(q[1]);
        }
#pragma unroll
        for (int t8 = 0; t8 < 4; ++t8) {
#pragma unroll
            for (int q = 0; q < 4; ++q) { const int r = 4 * t8 + q; const float nr = a.x * xr - a.y * xi + p0r[r], ni = a.x * xi + a.y * xr + p0i[r]; xr = nr; xi = ni; p0r[r] = xr; p0i[r] = xi; }
#pragma unroll
            for (int q = 0; q < 4; ++q) { const int r = 4 * t8 + q; const float nr = a.x * xr - a.y * xi + p1r[r], ni = a.x * xi + a.y * xr + p1i[r]; xr = nr; xi = ni; p1r[r] = xr; p1i[r] = xi; }
        }
        asm volatile("" ::: "memory");
#pragma unroll
        for (int r = 0; r < 16; ++r) {
            const int t0 = crow16(r);
            *(LAS bf16_t*)(X + t0 * 272 + lane * 2) = f2bf(p0r[r]);       *(LAS bf16_t*)(X + t0 * 272 + 128 + lane * 2) = f2bf(p0i[r]);
            *(LAS bf16_t*)(X + (t0 + 4) * 272 + lane * 2) = f2bf(p1r[r]); *(LAS bf16_t*)(X + (t0 + 4) * 272 + 128 + lane * 2) = f2bf(p1i[r]);
        }
        asm volatile("" ::: "memory"); __builtin_amdgcn_wave_barrier(); asm volatile("" ::: "memory");
#pragma unroll
        for (int tt = 0; tt < 2; ++tt) {
            f32x4 y = {0.f, 0.f, 0.f, 0.f};
#pragma unroll
            for (int kk = 0; kk < 4; ++kk) { const bf16x8 af = *(const LAS bf16x8*)(X + (tt * 16 + fr) * 272 + (kk * 32 + fq * 8) * 2); y = MFMA16(af, cfrag[kk], y); }
#pragma unroll
            for (int r = 0; r < 4; ++r) { const int s = c * 32 + tt * 16 + 4 * fq + r; const int tok = dir ? (SEQL - 1 - s) : s; ydw[(size_t)tok * 512] = y[r]; }
        }
        asm volatile("" ::: "memory"); __builtin_amdgcn_wave_barrier(); asm volatile("" ::: "memory");
        ua = ua_n;
    }
    __threadfence(); __syncthreads();
    {
        const int ch = gq * 64 + (tid & 63), t0 = tid >> 6; const float dsk = A.dskip[ch];
        bf16_t* up = A.us + row0 * 512 + ch; const float* y0 = A.yd + row0 * 512 + ch; const float* y1 = y0 + (size_t)MT * 512;
        for (int t = t0; t < SEQL; t += 8) {
            const size_t o = (size_t)t * 512;
            const float y = dsk * bf2f(up[o]) + y0[o] + y1[o];
            up[o] = f2bf(gelu_tanh(y));
        }
    }
    __syncthreads();
}

struct HgArgs { const bf16_t* q; const bf16_t* ff; const bf16_t* fb; const bf16_t* iv; float* o; const float* lb; float* dbg; };
namespace hg {
constexpr int QT = 0, KT = 17408, KDT = 34816, VT = 53248, ST = 71680, AB = 106496, CQ = 115712, EL = 117760, END = 118272;
}
__device__ __forceinline__ void hgrn_unit(LAS unsigned char* lds, const HgArgs& A, int unit) {
    using namespace hg;
    int tid_l = threadIdx.x; asm volatile("" : "+v"(tid_l)); const int tid = tid_l, w = __builtin_amdgcn_readfirstlane(tid >> 6), lane = tid & 63, fr = lane & 15, fq = lane >> 4;
    const int dir = unit & 1, h = (unit >> 1) & 3, b = unit >> 3;
    const size_t row0 = (size_t)b * SEQL;
    const int d = tid & 127, tq = tid >> 7, col = h * 128 + d;
    const float lbv = A.lb[dir * 512 + col], oml = 1.0f - lbv;
    const bf16_t* fsrc = dir ? A.fb : A.ff;
    f32x4 sacc[8];
#pragma unroll
    for (int i = 0; i < 8; ++i) sacc[i] = (f32x4){0.f, 0.f, 0.f, 0.f};
    for (int i = tid; i < 34816 / 16; i += NTHREADS) *(LAS u32x4*)(lds + ST + i * 16) = (u32x4){0u, 0u, 0u, 0u};
    __syncthreads();
    for (int c = 0; c < SEQL / 64; ++c) {
        float cl[16], kk[16], qv[16]; unsigned vv[8];
        {
            float run = 0.f;
#pragma unroll
            for (int j = 0; j < 16; ++j) {
                const int s = c * 64 + tq * 16 + j; const size_t tok = row0 + (dir ? (SEQL - 1 - s) : s);
                const float z = bf2f(fsrc[tok * 512 + col]);
                const float sg = sigm(z);
                const float f = fmaxf(lbv + oml * sg, 1e-30f);
                run += __logf(f); cl[j] = run;
                kk[j] = oml * (1.0f - sg);
                qv[j] = siluf(bf2f(A.q[tok * 512 + col]));
                const unsigned vb = A.iv[tok * 512 + col];
                if (j & 1) vv[j >> 1] |= vb << 16; else vv[j >> 1] = vb;
            }
            ((LAS float*)(lds + CQ))[tq * 128 + d] = run;
        }
        __syncthreads();
        {
            const LAS float* cq = (const LAS float*)(lds + CQ);
            const float c0 = cq[d], c1 = cq[128 + d], c2 = cq[256 + d], c3 = cq[384 + d];
            const float tot = (c0 + c1) + (c2 + c3);
            const float off = (tq == 0) ? 0.f : (tq == 1) ? c0 : (tq == 2) ? (c0 + c1) : (c0 + c1) + c2;
            unsigned kd[8];
#pragma unroll
            for (int j = 0; j < 16; ++j) {
                const float cum = off + cl[j];
                const int i = tq * 16 + j;
                *(LAS bf16_t*)(lds + QT + i * 272 + d * 2) = f2bf(qv[j] * __expf(cum));
                *(LAS bf16_t*)(lds + KT + i * 272 + d * 2) = f2bf(kk[j] * __expf(fminf(-cum, 80.0f)));
                const float kdv = kk[j] * __expf(tot - cum);
                if (j & 1) kd[j >> 1] = cvtpk(__uint_as_float(kd[j >> 1]), kdv); else kd[j >> 1] = __float_as_uint(kdv);
            }
            LAS u32x4* kp = (LAS u32x4*)(lds + KDT + d * 144 + tq * 32); kp[0] = (u32x4){kd[0], kd[1], kd[2], kd[3]}; kp[1] = (u32x4){kd[4], kd[5], kd[6], kd[7]};
            LAS u32x4* vp = (LAS u32x4*)(lds + VT + d * 144 + tq * 32);  vp[0] = (u32x4){vv[0], vv[1], vv[2], vv[3]}; vp[1] = (u32x4){vv[4], vv[5], vv[6], vv[7]};
            if (tq == 0) ((LAS float*)(lds + EL))[d] = __expf(tot);
        }
        __syncthreads();
        {
            const int ti = w >> 1;
#pragma unroll
            for (int sj = 0; sj < 2; ++sj) {
                const int si = 2 * (w & 1) + sj;
                f32x4 acc = {0.f, 0.f, 0.f, 0.f};
                if (si <= ti) {
#pragma unroll
                    for (int k = 0; k < 4; ++k) {
                        const bf16x8 ka = *(const LAS bf16x8*)(lds + KT + (16 * si + fr) * 272 + (k * 32 + fq * 8) * 2);
                        const bf16x8 qb = *(const LAS bf16x8*)(lds + QT + (16 * ti + fr) * 272 + (k * 32 + fq * 8) * 2);
                        acc = MFMA16(ka, qb, acc);
                    }
                    if (si == ti) {
#pragma unroll
                        for (int r = 0; r < 4; ++r) if (4 * fq + r > fr) acc[r] = 0.f;
                    }
                }
                u32x2 pk; pk.x = cvtpk(acc[0], acc[1]); pk.y = cvtpk(acc[2], acc[3]);
                *(LAS u32x2*)(lds + AB + (16 * ti + fr) * 144 + (16 * si + 4 * fq) * 2) = pk;
            }
        }
        f32x4 oacc[4];
#pragma unroll
        for (int ti = 0; ti < 4; ++ti) oacc[ti] = (f32x4){0.f, 0.f, 0.f, 0.f};
#pragma unroll
        for (int k = 0; k < 4; ++k) {
            const bf16x8 sb = *(const LAS bf16x8*)(lds + ST + (16 * w + fr) * 272 + (k * 32 + fq * 8) * 2);
#pragma unroll
            for (int ti = 0; ti < 4; ++ti) { const bf16x8 qa = *(const LAS bf16x8*)(lds + QT + (16 * ti + fr) * 272 + (k * 32 + fq * 8) * 2); oacc[ti] = MFMA16(qa, sb, oacc[ti]); }
        }
        __syncthreads();
        bf16x8 vb[2];
#pragma unroll
        for (int k = 0; k < 2; ++k) vb[k] = *(const LAS bf16x8*)(lds + VT + (16 * w + fr) * 144 + (k * 32 + fq * 8) * 2);
#pragma unroll
        for (int k = 0; k < 2; ++k)
#pragma unroll
            for (int ti = 0; ti < 4; ++ti) { const bf16x8 aa = *(const LAS bf16x8*)(lds + AB + (16 * ti + fr) * 144 + (k * 32 + fq * 8) * 2); oacc[ti] = MFMA16(aa, vb[k], oacc[ti]); }
        {
            float* op = A.o + ((size_t)dir * MT + row0) * 512 + h * 128 + 16 * w + fr;
#pragma unroll
            for (int ti = 0; ti < 4; ++ti)
#pragma unroll
                for (int r = 0; r < 4; ++r) { const int s = c * 64 + 16 * ti + 4 * fq + r; const int tok = dir ? (SEQL - 1 - s) : s; op[(size_t)tok * 512] = oacc[ti][r]; }
        }
#pragma unroll
        for (int di = 0; di < 8; ++di) {
            const f32x4 el = *(const LAS f32x4*)(lds + EL + (16 * di + 4 * fq) * 4);
            sacc[di] = sacc[di] * el;
#pragma unroll
            for (int k = 0; k < 2; ++k) { const bf16x8 ka = *(const LAS bf16x8*)(lds + KDT + (16 * di + fr) * 144 + (k * 32 + fq * 8) * 2); sacc[di] = MFMA16(ka, vb[k], sacc[di]); }
            u32x2 pk; pk.x = cvtpk(sacc[di][0], sacc[di][1]); pk.y = cvtpk(sacc[di][2], sacc[di][3]);
            *(LAS u32x2*)(lds + ST + (16 * w + fr) * 272 + (16 * di + 4 * fq) * 2) = pk;
#ifdef SELFCHECK
            if (A.dbg && c < 2 && b == CHK_ROW0 / SEQL) {
#pragma unroll
                for (int r = 0; r < 4; ++r) A.dbg[(((size_t)c * 8 + (h * 2 + dir)) * 128 + 16 * di + 4 * fq + r) * 128 + 16 * w + fr] = sacc[di][r];
            }
#endif
        }
        __syncthreads();
    }
}

struct QkArgs { bf16_t* aq; bf16_t* ak; const float* qn; const float* kn; };
__device__ __forceinline__ void qkprep_phase(const QkArgs& A, int first_block, int nblocks) {
    int tid_l = threadIdx.x; asm volatile("" : "+v"(tid_l)); const int tid = tid_l, j = tid & 15, axis = j >> 3, sub = j & 7;
    const int bid = (int)blockIdx.x - first_block; if (bid < 0 || bid >= nblocks) return;
    for (int item = bid * 32 + (tid >> 4); item < MT * 10; item += nblocks * 32) {
        const int row = item / 10, hh = item - row * 10;
        bf16_t* p; const float* gn;
        if (hh < 8) { p = A.aq + (size_t)row * 1024 + hh * 128; gn = A.qn; } else { p = A.ak + (size_t)row * 256 + (hh - 8) * 128; gn = A.kn; }
        const int d1 = axis * 64 + 4 * sub, d2 = d1 + 32;
        const u32x2 w1 = *(const u32x2*)(p + d1), w2 = *(const u32x2*)(p + d2);
        float x1[4] = {bflo(w1.x), bfhi(w1.x), bflo(w1.y), bfhi(w1.y)}, x2[4] = {bflo(w2.x), bfhi(w2.x), bflo(w2.y), bfhi(w2.y)};
        float s = 0.f;
#pragma unroll
        for (int e = 0; e < 4; ++e) s += x1[e] * x1[e] + x2[e] * x2[e];
        s += __shfl_xor(s, 1); s += __shfl_xor(s, 2); s += __shfl_xor(s, 4); s += __shfl_xor(s, 8);
        const float rstd = __builtin_amdgcn_rsqf(s * (1.0f / 128.0f) + 1e-6f);
        const int t = row & (SEQL - 1); const float pos = (float)(axis == 0 ? (t >> 6) : (t & 63));
        const f32x4 g1 = *(const f32x4*)(gn + d1), g2 = *(const f32x4*)(gn + d2);
        float o1[4], o2[4];
#pragma unroll
        for (int e = 0; e < 4; ++e) {
            const float inv = __builtin_amdgcn_exp2f(-(float)(4 * sub + e) * (13.287712379549449f / 32.0f));
            const float ang = pos * inv, cs = __cosf(ang), sn = __sinf(ang);
            const float y1 = x1[e] * rstd * g1[e], y2 = x2[e] * rstd * g2[e];
            o1[e] = y1 * cs - y2 * sn; o2[e] = y2 * cs + y1 * sn;
        }
        u32x2 r1, r2; r1.x = cvtpk(o1[0], o1[1]); r1.y = cvtpk(o1[2], o1[3]); r2.x = cvtpk(o2[0], o2[1]); r2.y = cvtpk(o2[2], o2[3]);
        *(u32x2*)(p + d1) = r1; *(u32x2*)(p + d2) = r2;
    }
}

struct HfArgs { const float* o; const bf16_t* g; const float* gain; bf16_t* y; };
__device__ __forceinline__ void hgfin_phase(const HfArgs& A) {
    int tid_l = threadIdx.x; asm volatile("" : "+v"(tid_l)); const int tid = tid_l, j = tid & 15;
    for (int item = blockIdx.x * 32 + (tid >> 4); item < MT * 4; item += gridDim.x * 32) {
        const size_t off = (size_t)item * 128 + j * 8;
        const f32x4 a0 = *(const f32x4*)(A.o + off), a1 = *(const f32x4*)(A.o + off + 4);
        const f32x4 b0 = *(const f32x4*)(A.o + (size_t)MT * 512 + off), b1 = *(const f32x4*)(A.o + (size_t)MT * 512 + off + 4);
        const f32x4 s0 = a0 + b0, s1 = a1 + b1;
        float s = (s0[0] * s0[0] + s0[1] * s0[1]) + (s0[2] * s0[2] + s0[3] * s0[3]) + (s1[0] * s1[0] + s1[1] * s1[1]) + (s1[2] * s1[2] + s1[3] * s1[3]);
        s += __shfl_xor(s, 1); s += __shfl_xor(s, 2); s += __shfl_xor(s, 4); s += __shfl_xor(s, 8);
        const float rstd = __builtin_amdgcn_rsqf(s * (1.0f / 128.0f) + 1e-6f);
        const f32x4 g0 = *(const f32x4*)(A.gain + j * 8), g1 = *(const f32x4*)(A.gain + j * 8 + 4);
        const u32x4 gg = *(const u32x4*)(A.g + off);
        u32x4 w;
        w.x = cvtpk(s0[0] * rstd * g0[0] * siluf(bflo(gg.x)), s0[1] * rstd * g0[1] * siluf(bfhi(gg.x)));
        w.y = cvtpk(s0[2] * rstd * g0[2] * siluf(bflo(gg.y)), s0[3] * rstd * g0[3] * siluf(bfhi(gg.y)));
        w.z = cvtpk(s1[0] * rstd * g1[0] * siluf(bflo(gg.z)), s1[1] * rstd * g1[1] * siluf(bfhi(gg.z)));
        w.w = cvtpk(s1[2] * rstd * g1[2] * siluf(bflo(gg.w)), s1[3] * rstd * g1[3] * siluf(bfhi(gg.w)));
        *(u32x4*)(A.y + off) = w;
    }
}
namespace att {
constexpr int D = 128, NW = 8, QBLK = 32, KVBLK = 64;
constexpr float SCALE = 0.088388347648318440f;
constexpr float THR = 8.f;
constexpr int LDQ = 1024, LDK = 256, LDO = 1024;
constexpr size_t SHM_V = KVBLK * D * 2, SHM_K = KVBLK * D * 2, SHM_ATTN = 2 * SHM_V + 2 * SHM_K + NW * 64 * 4;
#define KSWZ(row, colB) ((row) * 256 + ((colB) ^ (((row) & 7) << 4)))
#define SBAR() __builtin_amdgcn_sched_barrier(0)
__device__ __forceinline__ int crow(int r, int hi) { return (r & 3) + 8 * (r >> 2) + 4 * hi; }
__device__ __forceinline__ unsigned cvtpkv(float lo, float hi) { return cvtpk(lo, hi); }

__device__ __forceinline__ void partialSM(f32x16& p0, f32x16& p1, float& m_reg, float& mn, float& alpha) {
  constexpr float C = SCALE * 1.4426950408889634f;
  float pmax = p0[0]; for (int r = 1; r < 16; ++r) pmax = fmaxf(pmax, p0[r]); for (int r = 0; r < 16; ++r) pmax = fmaxf(pmax, p1[r]);
  { auto rr = __builtin_amdgcn_permlane32_swap(__float_as_uint(pmax), __float_as_uint(pmax), false, false);
    pmax = fmaxf(__uint_as_float(rr[0]), __uint_as_float(rr[1])); }
  if (__builtin_expect(__all(pmax - m_reg <= THR / SCALE), 1)) { mn = m_reg; alpha = 1.f; }
  else { mn = fmaxf(m_reg, pmax); alpha = __builtin_amdgcn_exp2f((m_reg - mn) * C); m_reg = mn; }
  float mnC = -mn * C;
  for (int r = 0; r < 16; ++r) p0[r] = fmaf(p0[r], C, mnC); for (int r = 0; r < 16; ++r) p1[r] = fmaf(p1[r], C, mnC);
  for (int r = 0; r < 16; ++r) p0[r] = __builtin_amdgcn_exp2f(p0[r]);
}
__device__ __forceinline__ void finishSM(f32x16& p0, f32x16& p1, float alpha, float& l_reg, bf16x8& pa0, bf16x8& pa1, bf16x8& pa2, bf16x8& pa3) {
  for (int r = 0; r < 16; ++r) p1[r] = __builtin_amdgcn_exp2f(p1[r]);
  float ps = 0; for (int r = 0; r < 16; ++r) ps += p0[r]; for (int r = 0; r < 16; ++r) ps += p1[r];
  { auto rr = __builtin_amdgcn_permlane32_swap(__float_as_uint(ps), __float_as_uint(ps), false, false);
    ps = __uint_as_float(rr[0]) + __uint_as_float(rr[1]); }
  l_reg = l_reg * alpha + ps;
#define PK4(P, BASE, OUT) do { unsigned a0 = cvtpkv(P[BASE + 0], P[BASE + 1]), a1 = cvtpkv(P[BASE + 2], P[BASE + 3]);   \
    unsigned b0 = cvtpkv(P[BASE + 4], P[BASE + 5]), b1 = cvtpkv(P[BASE + 6], P[BASE + 7]);                              \
    auto r0 = __builtin_amdgcn_permlane32_swap(a0, b0, false, false); auto r1 = __builtin_amdgcn_permlane32_swap(a1, b1, false, false); \
    u32x4 w = {r0[0], r1[0], r0[1], r1[1]}; OUT = *reinterpret_cast<bf16x8*>(&w); } while (0)
  PK4(p0, 0, pa0); PK4(p0, 8, pa1); PK4(p1, 0, pa2); PK4(p1, 8, pa3);
#undef PK4
}
__device__ __forceinline__ void qkt(f32x16& p0, f32x16& p1, const bf16_t* Ks, const bf16x8* qr, int r32, int hi) {
  p0 = f32x16{}; p1 = f32x16{};
  for (int d0 = 0; d0 < 8; ++d0) { int cb = (d0 * 16 + hi * 8) * 2;
    bf16x8 b0 = *reinterpret_cast<const bf16x8*>((const char*)Ks + KSWZ(r32, cb));
    bf16x8 b1 = *reinterpret_cast<const bf16x8*>((const char*)Ks + KSWZ(32 + r32, cb));
    p0 = __builtin_amdgcn_mfma_f32_32x32x16_bf16(b0, qr[d0], p0, 0, 0, 0);
    p1 = __builtin_amdgcn_mfma_f32_32x32x16_bf16(b1, qr[d0], p1, 0, 0, 0); }
}
__device__ __forceinline__ int v_st(int k, int c) { const int kk = (k & ~0xC) | ((k & 4) << 1) | ((k & 8) >> 1); return ((kk >> 3) * 4 + (c >> 5)) * 512 + ((kk & 7) * 32 + (c & 31)) * 2; }
__device__ __forceinline__ int v_rd_base(int lane) { return ((lane & 3) << 3) | (((lane >> 2) & 3) << 6) | (((lane >> 4) & 1) << 5) | (((lane >> 5) & 1) << 8); }
constexpr int v_rd_off(int d0, int ks, int half) { return d0 * 512 + ks * 4096 + half * 2048; }
template <int OFF> __device__ __forceinline__ s16x4 tr_read(int vb) {
  s16x4 r; asm volatile("ds_read_b64_tr_b16 %0, %1 offset:%2" : "=&v"(r) : "v"(vb), "i"(OFF) : "memory"); return r;
}
template <int D0> __device__ __forceinline__ void pv_one(f32x16& od, int vb, bf16x8 pa0, bf16x8 pa1, bf16x8 pa2, bf16x8 pa3) {
  const s16x4 l0 = tr_read<v_rd_off(D0, 0, 0)>(vb), h0 = tr_read<v_rd_off(D0, 0, 1)>(vb), l1 = tr_read<v_rd_off(D0, 1, 0)>(vb), h1 = tr_read<v_rd_off(D0, 1, 1)>(vb);
  const s16x4 l2 = tr_read<v_rd_off(D0, 2, 0)>(vb), h2 = tr_read<v_rd_off(D0, 2, 1)>(vb), l3 = tr_read<v_rd_off(D0, 3, 0)>(vb), h3 = tr_read<v_rd_off(D0, 3, 1)>(vb);
  asm volatile("s_waitcnt lgkmcnt(0)" ::: "memory"); SBAR();
#define PK(L, H) (bf16x8){L[0], L[1], L[2], L[3], H[0], H[1], H[2], H[3]}
  od = __builtin_amdgcn_mfma_f32_32x32x16_bf16(pa0, PK(l0, h0), od, 0, 0, 0);
  od = __builtin_amdgcn_mfma_f32_32x32x16_bf16(pa1, PK(l1, h1), od, 0, 0, 0);
  od = __builtin_amdgcn_mfma_f32_32x32x16_bf16(pa2, PK(l2, h2), od, 0, 0, 0);
  od = __builtin_amdgcn_mfma_f32_32x32x16_bf16(pa3, PK(l3, h3), od, 0, 0, 0);
#undef PK
}
__device__ __forceinline__ void pv_d0(f32x16* o, int vb, bf16x8 pa0, bf16x8 pa1, bf16x8 pa2, bf16x8 pa3) {
  pv_one<0>(o[0], vb, pa0, pa1, pa2, pa3); pv_one<1>(o[1], vb, pa0, pa1, pa2, pa3); pv_one<2>(o[2], vb, pa0, pa1, pa2, pa3); pv_one<3>(o[3], vb, pa0, pa1, pa2, pa3);
}
__device__ __forceinline__ void attn_dense_body(const bf16_t* __restrict__ Qb, const bf16_t* __restrict__ Kh, const bf16_t* __restrict__ Vh, bf16_t* __restrict__ Ob, int seq, char* lds) {
  int tid_l = threadIdx.x; asm volatile("" : "+v"(tid_l)); const int tid = tid_l, wid = tid >> 6, lane = tid & 63, r32 = lane & 31, hi = lane >> 5;
  bf16_t* V_lds = (bf16_t*)lds; bf16_t* K_lds = (bf16_t*)(lds + 2 * SHM_V);
  float* ws = (float*)(lds + 2 * SHM_V + 2 * SHM_K) + wid * 64; float* li_l = ws; float* al_l = ws + 32;
  float m_reg = -1e30f, l_reg = 0; f32x16 o[4] = {}; bf16x8 qr[8];
  const bf16_t* Qw = Qb + (long)(wid * QBLK + r32) * LDQ + hi * 8;
#pragma unroll
  for (int d0 = 0; d0 < 8; ++d0) qr[d0] = *reinterpret_cast<const bf16x8*>(Qw + d0 * 16);
  const int sr = tid >> 4, sc = (tid & 15) * 8, vst0 = v_st(sr, sc), vst1 = v_st(32 + sr, sc);
  const int vb0 = (int)(uintptr_t)V_lds + v_rd_base(lane);
  struct { bf16x8 vs0, vs1, ks0, ks1; } sr_[2];
#define SLOAD(i, k0) do { sr_[i].vs0 = *reinterpret_cast<const bf16x8*>(&Vh[(long)((k0) + sr) * LDK + sc]); sr_[i].vs1 = *reinterpret_cast<const bf16x8*>(&Vh[(long)((k0) + 32 + sr) * LDK + sc]); \
    sr_[i].ks0 = *reinterpret_cast<const bf16x8*>(&Kh[(long)((k0) + sr) * LDK + sc]); sr_[i].ks1 = *reinterpret_cast<const bf16x8*>(&Kh[(long)((k0) + 32 + sr) * LDK + sc]); } while (0)
#define SWRITE(b, i) do { *(bf16x8*)((char*)V_lds + (b) * SHM_V + vst0) = sr_[i].vs0;          \
    *(bf16x8*)((char*)V_lds + (b) * SHM_V + vst1) = sr_[i].vs1; int kc = sc * 2;               \
    *(bf16x8*)((char*)K_lds + (b) * SHM_K + KSWZ(sr, kc)) = sr_[i].ks0;                       \
    *(bf16x8*)((char*)K_lds + (b) * SHM_K + KSWZ(32 + sr, kc)) = sr_[i].ks1; } while (0)
#define SWAIT() asm volatile("s_waitcnt vmcnt(4)" ::: "memory")
#define RESC(a) do { if (__any((a) < 1.f)) { if (hi == 0) al_l[r32] = (a); asm volatile("s_waitcnt lgkmcnt(0)" ::: "memory"); \
    for (int d = 0; d < 4; ++d) for (int r = 0; r < 16; ++r) o[d][r] *= al_l[crow(r, hi)]; } } while (0)
  f32x16 pA0, pA1, pB0, pB1; float mnA, mnB, alA, alB; bf16x8 pa0, pa1, pa2, pa3; const int NT = seq / KVBLK;
  constexpr int SE = 0, SO = 1;
  SLOAD(SE, 0); asm volatile("s_waitcnt vmcnt(0)" ::: "memory"); SWRITE(0, SE); __syncthreads();
  qkt(pA0, pA1, K_lds, qr, r32, hi); partialSM(pA0, pA1, m_reg, mnA, alA);
  SLOAD(SO, KVBLK); if (2 < NT) SLOAD(SE, 2 * KVBLK);
  SWAIT(); SWRITE(1, SO); __syncthreads();
  for (int j = 1; j + 1 < NT; j += 2) {
    SBAR(); qkt(pB0, pB1, (bf16_t*)((char*)K_lds + SHM_K), qr, r32, hi);
    finishSM(pA0, pA1, alA, l_reg, pa0, pa1, pa2, pa3); SBAR();
    SLOAD(SO, (j + 2) * KVBLK); SBAR();
    pv_d0(o, vb0, pa0, pa1, pa2, pa3); partialSM(pB0, pB1, m_reg, mnB, alB);
    __syncthreads(); SWAIT(); SWRITE(0, SE);
    RESC(alB); __syncthreads();
    SBAR(); qkt(pA0, pA1, K_lds, qr, r32, hi);
    finishSM(pB0, pB1, alB, l_reg, pa0, pa1, pa2, pa3); SBAR();
    if (j + 3 < NT) SLOAD(SE, (j + 3) * KVBLK); SBAR();
    pv_d0(o, vb0 + (int)SHM_V, pa0, pa1, pa2, pa3); partialSM(pA0, pA1, m_reg, mnA, alA);
    __syncthreads(); SWAIT(); SWRITE(1, SO);
    RESC(alA); __syncthreads();
  }
  SBAR(); qkt(pB0, pB1, (bf16_t*)((char*)K_lds + SHM_K), qr, r32, hi);
  finishSM(pA0, pA1, alA, l_reg, pa0, pa1, pa2, pa3); SBAR();
  pv_d0(o, vb0, pa0, pa1, pa2, pa3); partialSM(pB0, pB1, m_reg, mnB, alB);
  __syncthreads(); RESC(alB);
  finishSM(pB0, pB1, alB, l_reg, pa0, pa1, pa2, pa3); SBAR();
  pv_d0(o, vb0 + (int)SHM_V, pa0, pa1, pa2, pa3);
  if (hi == 0) li_l[r32] = l_reg; asm volatile("s_waitcnt lgkmcnt(0)" ::: "memory");
  float rli[16];
#pragma unroll
  for (int r = 0; r < 16; ++r) rli[r] = __builtin_amdgcn_rcpf(li_l[crow(r, hi)]);
  bf16_t* Ow = Ob + (long)(wid * QBLK) * LDO;
#pragma unroll
  for (int r = 0; r < 16; ++r) { int orow = crow(r, hi);
    for (int d0 = 0; d0 < 4; ++d0) Ow[(long)orow * LDO + d0 * 32 + r32] = f2bf(o[d0][r] * rli[r]); }
  __syncthreads();
#undef SLOAD
#undef SWRITE
#undef SWAIT
#undef RESC
}
}
#define XB_TMO      128
#define XB_XCNT(j)  (256  + 64 * (j))
#define XB_XSUB(j)  (1280 + 64 * (j))
#define XB_XGEN(j)  (2304 + 64 * (j))
#define XB_TOP      3328
#define XB_TOPGEN   3392
#define XCD_BAR_WORDS 3456
#define XB_SPIN_CAP (1u << 22)

__device__ __forceinline__ unsigned xb_ld(unsigned* p)              { return __hip_atomic_load(p, __ATOMIC_RELAXED, __HIP_MEMORY_SCOPE_AGENT); }
__device__ __forceinline__ unsigned xb_add(unsigned* p, unsigned v) { return __hip_atomic_fetch_add(p, v, __ATOMIC_RELAXED, __HIP_MEMORY_SCOPE_AGENT); }
__device__ __forceinline__ unsigned xb_xcc_id() { return (unsigned)__builtin_amdgcn_s_getreg((3 << 11) | 20) & 0xFu; }
#define XB_SPIN(cond, bar) do { unsigned _sp = 0; while (cond) { __builtin_amdgcn_s_sleep(1); \
    if ((++_sp & 255u) == 0u) { if (xb_ld(&(bar)[XB_TMO])) break; if (_sp > XB_SPIN_CAP) { atomicAdd(&(bar)[XB_TMO], 1u); break; } } } } while (0)

struct XcdBarrier {
    unsigned* bar; unsigned x;
    volatile LAS unsigned* st;
};

__device__ __forceinline__ XcdBarrier xcd_barrier_post(unsigned* bar, volatile LAS unsigned* st) {
    XcdBarrier b; b.bar = bar; b.x = xb_xcc_id(); b.st = st;
    if (threadIdx.x == 0) (void)xb_add(&bar[XB_XCNT(b.x)], 1u);
    return b;
}
__device__ __forceinline__ void xcd_barrier_complete(unsigned* bar, unsigned x, unsigned& nloc, unsigned& nx) {
    const unsigned G = gridDim.x * gridDim.y * gridDim.z;
    unsigned sum, cnt, mine, sp = 0u;
    for (;;) {
        sum = 0u; cnt = 0u; mine = 0u;
#pragma unroll
        for (unsigned j = 0; j < 16; ++j) { const unsigned c = xb_ld(&bar[XB_XCNT(j)]); sum += c; cnt += (c > 0u) ? 1u : 0u; mine = (j == x) ? c : mine; }
        if (sum == G) break;
        __builtin_amdgcn_s_sleep(1);
        if ((++sp & 255u) == 0u) { if (xb_ld(&bar[XB_TMO])) break; if (sp > XB_SPIN_CAP) { atomicAdd(&bar[XB_TMO], 1u); break; } }
    }
    nloc = mine > 0u ? mine : 1u; nx = cnt > 0u ? cnt : 1u;
}

__device__ __forceinline__ void xcd_barrier(const XcdBarrier& b) {
    asm volatile("s_waitcnt vmcnt(0)" ::: "memory");
    __syncthreads();
    if (threadIdx.x == 0) {
        unsigned* bar = b.bar;
        __builtin_amdgcn_s_waitcnt(0);
        unsigned nloc = b.st[0], nx = b.st[1];
        if (nloc == 0u) { xcd_barrier_complete(bar, b.x, nloc, nx); b.st[0] = nloc; b.st[1] = nx; }
        const unsigned old = xb_add(&bar[XB_XSUB(b.x)], 1u);
        const unsigned gen = old / nloc;
        if (old + 1u == (gen + 1u) * nloc) {
            __builtin_amdgcn_fence(__ATOMIC_RELEASE, "agent");
            asm volatile("s_waitcnt vmcnt(0)" ::: "memory");
            const unsigned og = xb_add(&bar[XB_TOP], 1u);
            const unsigned tg = og / nx;
            if (og + 1u == (tg + 1u) * nx) xb_add(&bar[XB_TOPGEN], 1u);
            else XB_SPIN(xb_ld(&bar[XB_TOPGEN]) == tg, bar);
            __builtin_amdgcn_fence(__ATOMIC_ACQUIRE, "agent");
            xb_add(&bar[XB_XGEN(b.x)], 1u);
            asm volatile("s_waitcnt vmcnt(0)" ::: "memory");
        } else {
            XB_SPIN(xb_ld(&bar[XB_XGEN(b.x)]) == gen, bar);
            __builtin_amdgcn_fence(__ATOMIC_ACQUIRE, "agent");
            asm volatile("s_waitcnt vmcnt(0)" ::: "memory");
        }
    }
    __syncthreads();
}
#ifdef SELFCHECK
#ifndef CHK_ROW0
#define CHK_ROW0 18432
#endif
constexpr size_t CK_STATS = 0, CK_CKS = 4096, CK_A = 65536, CK_T0 = CK_A + 84 * MiB, CK_T1 = CK_T0 + 16 * MiB, CK_T2 = CK_T1 + 16 * MiB, CK_T3 = CK_T2 + 16 * MiB, CK_T4 = CK_T3 + 16 * MiB;
constexpr size_t CHK_BYTES = CK_T4 + 16 * MiB;
constexpr int CK_NPH = 12;
struct CkStat { double d2, r2; unsigned mx, pad; };

__global__ void ck_sum(const unsigned* p, size_t nwords, unsigned long long* out) {
    unsigned long long s = 0;
    for (size_t i = (size_t)blockIdx.x * blockDim.x + threadIdx.x; i < nwords; i += (size_t)gridDim.x * blockDim.x) s += (unsigned long long)p[i] * (2ull * i + 1ull);
    for (int o = 32; o >= 1; o >>= 1) s += __shfl_xor(s, o);
    if ((threadIdx.x & 63) == 0) atomicAdd(out, s);
}
__global__ void ck_cmp(const void* fast, int is_bf16, long ldf, const float* ref, long ldr, int rows, int cols, int mode, CkStat* st) {
    double d2 = 0, r2 = 0; float mx = 0;
    for (size_t i = (size_t)blockIdx.x * blockDim.x + threadIdx.x; i < (size_t)rows * cols; i += (size_t)gridDim.x * blockDim.x) {
        const int r = (int)(i / cols), c = (int)(i % cols);
        const float f = is_bf16 ? bf2f(((const bf16_t*)fast)[(size_t)r * ldf + c]) : ((const float*)fast)[(size_t)r * ldf + c];
        float g = ref[(size_t)r * ldr + c]; if (mode == 1) g = 1.0f / (1.0f + expf(-g));
        float d = f - g; if (!(d == d)) d = 1e30f;
        d2 += (double)d * d; r2 += (double)g * g; mx = fmaxf(mx, fabsf(d));
    }
    for (int o = 32; o >= 1; o >>= 1) { d2 += __shfl_xor(d2, o); r2 += __shfl_xor(r2, o); mx = fmaxf(mx, __shfl_xor(mx, o)); }
    if ((threadIdx.x & 63) == 0) { atomicAdd(&st->d2, d2); atomicAdd(&st->r2, r2); atomicMax(&st->mx, __float_as_uint(mx)); }
}
__global__ void nk_rows(const float* xp, const float* xs, int row0, float* dst) {
    const size_t i = (size_t)blockIdx.x * 256 + threadIdx.x; const int r = row0 + (int)(i / DM), c = (int)(i % DM);
    dst[i] = (r < PROMPT_ROWS) ? xp[(size_t)r * DM + c] : xs[(size_t)(r - PROMPT_ROWS) * DM + c];
}
__global__ void nk_rmsnorm(const float* src, const float* gain, float* dst) {
    __shared__ float red[256]; const float* x = src + (size_t)blockIdx.x * DM; float s = 0;
    for (int c = threadIdx.x; c < DM; c += 256) s += x[c] * x[c];
    red[threadIdx.x] = s; __syncthreads();
    for (int o = 128; o >= 1; o >>= 1) { if (threadIdx.x < o) red[threadIdx.x] += red[threadIdx.x + o]; __syncthreads(); }
    const float rstd = 1.0f / sqrtf(red[0] / DM + 1e-6f);
    for (int c = threadIdx.x; c < DM; c += 256) dst[(size_t)blockIdx.x * DM + c] = x[c] * rstd * gain[c];
}
template <int MODE> __global__ void __launch_bounds__(256) nk_gemm(const float* A, int lda, const float* W, int ldw, int K, float* C, int ldc, int N2) {
    __shared__ float As[16][65], Bs[16][64], Bs2[16][64];
    const int t = threadIdx.x, tx = t & 15, ty = t >> 4, m0 = blockIdx.y * 64, n0 = blockIdx.x * 64;
    float acc[4][4] = {}, acc2[4][4] = {};
    for (int k0 = 0; k0 < K; k0 += 16) {
#pragma unroll
        for (int i = 0; i < 4; ++i) { const int idx = t + 256 * i; { const int m = idx >> 4, kk = idx & 15; As[kk][m] = A[(size_t)(m0 + m) * lda + k0 + kk]; }
            { const int kk = idx >> 6, n = idx & 63; Bs[kk][n] = W[(size_t)(k0 + kk) * ldw + n0 + n]; if (MODE == 1) Bs2[kk][n] = W[(size_t)(k0 + kk) * ldw + n0 + n + N2]; } }
        __syncthreads();
#pragma unroll
        for (int kk = 0; kk < 16; ++kk) {
            float a[4], b[4], b2[4];
#pragma unroll
            for (int i = 0; i < 4; ++i) { a[i] = As[kk][ty * 4 + i]; b[i] = Bs[kk][tx * 4 + i]; b2[i] = (MODE == 1) ? Bs2[kk][tx * 4 + i] : 0.f; }
#pragma unroll
            for (int i = 0; i < 4; ++i)
#pragma unroll
                for (int j = 0; j < 4; ++j) { acc[i][j] += a[i] * b[j]; if (MODE == 1) acc2[i][j] += a[i] * b2[j]; }
        }
        __syncthreads();
    }
#pragma unroll
    for (int i = 0; i < 4; ++i)
#pragma unroll
        for (int j = 0; j < 4; ++j) { float v = acc[i][j]; if (MODE == 1) v = v / (1.0f + expf(-v)) * acc2[i][j]; C[(size_t)(m0 + ty * 4 + i) * ldc + n0 + tx * 4 + j] = v; }
}
__global__ void nk_axpy(float* h, const float* d, float s, size_t n) { const size_t i = (size_t)blockIdx.x * 256 + threadIdx.x; if (i < n) h[i] += s * d[i]; }
__global__ void nk_s5(const float* ru, const float* lam_re, const float* lam_im, const float* log_dt, const float* b_re, const float* b_im, const float* c_re, const float* c_im, float* yd) {
    __shared__ float xr_s[64], xi_s[64], us[16], cr[16][64], ci[16][64];
    const int dg = blockIdx.x, dir = dg >> 5, g = dg & 31, n = threadIdx.x;
    const double dt = exp_d((double)log_dt[dg]); const double lr = lam_re[dg * 64 + n], li = lam_im[dg * 64 + n];
    const double mag = exp_d(lr * dt); double sn, cs; sincos_d(li * dt, sn, cs);
    const double are = mag * cs, aim = mag * sn, den = lr * lr + li * li, nre = are - 1.0, cre = (nre * lr + aim * li) / den, cim = (aim * lr - nre * li) / den;
    float bbr[16], bbi[16];
#pragma unroll
    for (int p = 0; p < 16; ++p) { const double br = b_re[(size_t)(dg * 64 + n) * 16 + p], bi = b_im[(size_t)(dg * 64 + n) * 16 + p]; bbr[p] = (float)(cre * br - cim * bi); bbi[p] = (float)(cre * bi + cim * br); }
    for (int i = n; i < 1024; i += 64) { cr[i >> 6][i & 63] = c_re[(size_t)dg * 1024 + i]; ci[i >> 6][i & 63] = c_im[(size_t)dg * 1024 + i]; }
    float xr = 0, xi = 0; const float ar = (float)are, ai = (float)aim;
    __syncthreads();
    for (int s = 0; s < SEQL; ++s) {
        const int t = dir ? SEQL - 1 - s : s;
        if (n < 16) us[n] = ru[(size_t)t * NIN + g * 16 + n];
        __syncthreads();
        float bur = 0, bui = 0;
#pragma unroll
        for (int p = 0; p < 16; ++p) { bur += bbr[p] * us[p]; bui += bbi[p] * us[p]; }
        const float nr = ar * xr - ai * xi + bur, ni = ar * xi + ai * xr + bui; xr = nr; xi = ni;
        xr_s[n] = xr; xi_s[n] = xi;
        __syncthreads();
        if (n < 16) { float y = 0; for (int m = 0; m < 64; ++m) y += xr_s[m] * cr[n][m] - xi_s[m] * ci[n][m]; yd[((size_t)dir * SEQL + t) * 512 + g * 16 + n] = y; }
        __syncthreads();
    }
}
__global__ void nk_s5z(const float* ru, const float* yd, const float* dsk, float* z) {
    const size_t i = (size_t)blockIdx.x * 256 + threadIdx.x; const int t = (int)(i >> 9), ch = (int)(i & 511);
    const float y = dsk[ch] * ru[(size_t)t * NIN + ch] + yd[i] + yd[(size_t)SEQL * 512 + i];
    z[i] = 0.5f * y * (1.0f + tanhf(0.7978845608028654f * (y + 0.044715f * y * y * y)));
}
__global__ void nk_glu(const float* z, const float* zw, float* ycat) { const size_t i = (size_t)blockIdx.x * 256 + threadIdx.x; const int t = (int)(i >> 9), ch = (int)(i & 511); ycat[(size_t)t * DM + ch] = z[i] / (1.0f + expf(-zw[i])); }
__device__ float nk_lb(const float* logits, int layer, int idx) {
    float lg[DEPTH], mx = -1e30f;
#pragma unroll
    for (int l = 0; l < DEPTH; ++l) { lg[l] = logits[l * 1024 + idx]; mx = fmaxf(mx, lg[l]); }
    float sum = 0;
#pragma unroll
    for (int l = 0; l < DEPTH; ++l) { lg[l] = expf(lg[l] - mx); sum += lg[l]; }
    float cum = 0;
#pragma unroll
    for (int l = 0; l < DEPTH; ++l) if (l <= layer) cum += lg[l] / sum;
    return fminf(fmaxf(cum - lg[0] / sum, 0.f), 1.0f - 1e-6f);
}
__global__ void __launch_bounds__(128) nk_hgrn(const float* ru, const float* logits, int layer, float* od, float* sd) {
    __shared__ float qs[128], ks[128], fs[128];
    const int h = blockIdx.x >> 1, dir = blockIdx.x & 1, v = threadIdx.x, col = h * 128 + v;
    const float lb = nk_lb(logits, layer, dir * 512 + col);
    float S[128];
#pragma unroll
    for (int d = 0; d < 128; ++d) S[d] = 0.f;
    for (int s = 0; s < SEQL; ++s) {
        const int t = dir ? SEQL - 1 - s : s; const float* r = ru + (size_t)t * NIN;
        const float z = r[(dir ? 1536 : 1024) + col], sg = 1.0f / (1.0f + expf(-z));
        fs[v] = fmaxf(lb, 1e-30f) + (1.0f - lb) * sg; ks[v] = (1.0f - lb) * (1.0f / (1.0f + expf(z)));
        { const float q = r[512 + col]; qs[v] = q / (1.0f + expf(-q)); }
        const float vt = r[2048 + col];
        __syncthreads();
        float o = 0;
#pragma unroll
        for (int d = 0; d < 128; ++d) { S[d] = fs[d] * S[d] + ks[d] * vt; o += qs[d] * S[d]; }
        od[((size_t)dir * SEQL + t) * 512 + col] = o;
        if (sd && (s == 63 || s == 127)) {
#pragma unroll
            for (int d = 0; d < 128; ++d) sd[(((size_t)(s >> 6) * 8 + blockIdx.x) * 128 + d) * 128 + v] = S[d];
        }
        __syncthreads();
    }
}
__global__ void nk_hgfin(const float* od, const float* ru, const float* gain, float* ycat) {
    __shared__ float red[128]; const int t = blockIdx.x >> 2, h = blockIdx.x & 3, v = threadIdx.x, col = h * 128 + v;
    const float s = od[(size_t)t * 512 + col] + od[((size_t)SEQL + t) * 512 + col];
    red[v] = s * s; __syncthreads();
    for (int o = 64; o >= 1; o >>= 1) { if (v < o) red[v] += red[v + o]; __syncthreads(); }
    const float rstd = 1.0f / sqrtf(red[0] / 128.0f + 1e-6f); const float g = ru[(size_t)t * NIN + 2560 + col];
    ycat[(size_t)t * DM + 512 + col] = s * rstd * gain[v] * (g / (1.0f + expf(-g)));
}
__global__ void nk_qkprep(const float* ru, const float* qn, const float* kn, float* qr, float* kr) {
    __shared__ float red[128], ys[128]; const int t = blockIdx.x / 10, hh = blockIdx.x % 10, d = threadIdx.x;
    const float x = (hh < 8) ? ru[(size_t)t * NIN + 3072 + hh * 128 + d] : ru[(size_t)t * NIN + 4096 + (hh - 8) * 128 + d];
    red[d] = x * x; __syncthreads();
    for (int o = 64; o >= 1; o >>= 1) { if (d < o) red[d] += red[d + o]; __syncthreads(); }
    const float y = x / sqrtf(red[0] / 128.0f + 1e-6f) * ((hh < 8) ? qn[d] : kn[d]);
    ys[d] = y; __syncthreads();
    const int axis = d >> 6, w = d & 63, i = w & 31; const float pos = (float)(axis == 0 ? (t >> 6) : (t & 63));
    const float inv = (float)exp_d(-(double)i / 32.0 * 9.210340371976184); double sn, cs; sincos_d((double)(pos * inv), sn, cs);
    const float o = (w < 32) ? y * (float)cs - ys[d + 32] * (float)sn : y * (float)cs + ys[d - 32] * (float)sn;
    if (hh < 8) qr[(size_t)t * 1024 + hh * 128 + d] = o; else kr[(size_t)t * 256 + (hh - 8) * 128 + d] = o;
}
__global__ void __launch_bounds__(256) nk_attn(const float* qr, const float* kr, const float* ru, float* ycat) {
    __shared__ float ps[4][2048], qs[4][128];
    const int w = threadIdx.x >> 6, lane = threadIdx.x & 63, item = blockIdx.x * 4 + w, h = item >> 11, t = item & 2047, kvh = h >> 2;
    qs[w][lane] = qr[(size_t)t * 1024 + h * 128 + lane]; qs[w][lane + 64] = qr[(size_t)t * 1024 + h * 128 + lane + 64];
    __syncthreads();
    float sc[32], mx = -1e30f;
#pragma unroll
    for (int kb = 0; kb < 32; ++kb) { const float* kp = kr + (size_t)(kb * 64 + lane) * 256 + kvh * 128; float s = 0; for (int d = 0; d < 128; ++d) s += qs[w][d] * kp[d]; sc[kb] = s * 0.08838834764831845f; mx = fmaxf(mx, sc[kb]); }
    for (int o = 32; o >= 1; o >>= 1) mx = fmaxf(mx, __shfl_xor(mx, o));
    float sum = 0;
#pragma unroll
    for (int kb = 0; kb < 32; ++kb) { const float p = expf(sc[kb] - mx); sum += p; ps[w][kb * 64 + lane] = p; }
    for (int o = 32; o >= 1; o >>= 1) sum += __shfl_xor(sum, o);
    __syncthreads();
    float o0 = 0, o1 = 0;
    for (int k = 0; k < SEQL; ++k) { const float p = ps[w][k]; const float* vp = ru + (size_t)k * NIN + 4352 + kvh * 128; o0 += p * vp[lane]; o1 += p * vp[lane + 64]; }
    ycat[(size_t)t * DM + 1024 + h * 128 + lane] = o0 / sum; ycat[(size_t)t * DM + 1024 + h * 128 + lane + 64] = o1 / sum;
}
__global__ void nk_gate(const float* ru, int b, const float* P, float* mg, int first) {
    const size_t i = (size_t)blockIdx.x * 256 + threadIdx.x; const int t = (int)(i >> 11), c = (int)(i & 2047);
    const float g = 1.0f / (1.0f + expf(-ru[(size_t)t * NIN + 4608 + b * 2048 + c]));
    mg[i] = (first ? 0.f : mg[i]) + g * P[i];
}
__global__ void ck_fill0(float* out, size_t n) { for (size_t i = (size_t)blockIdx.x * 256 + threadIdx.x; i < n; i += (size_t)gridDim.x * 256) out[i] = 0.f; }
#ifndef CHK_MODE
#define CHK_MODE 0
#endif
__device__ double ck_rel(const CkStat* st, int i) { return sqrt(st[i].d2 / (st[i].r2 + 1e-30)); }
__global__ void ck_encode(const CkStat* st, const unsigned long long* cks, int nchk, float* out) {
    if (threadIdx.x != 0 || blockIdx.x != 0) return;
    int v = 0;
    if (CHK_MODE == 0) {
        int dp = 48; for (int ph = CK_NPH - 1; ph >= 0; --ph) for (int r = 3; r >= 0; --r) if (cks[(0 * 16 + ph) * 4 + r] != cks[(1 * 16 + ph) * 4 + r]) dp = ph * 4 + r;
        int fi = nchk; for (int i = nchk - 1; i >= 0; --i) if (!(ck_rel(st, i) < 0.03)) fi = i;
        v = dp + 49 * fi;
    } else if (CHK_MODE == 1) {
        for (int r = 0; r < 4; ++r) if (cks[(0 * 16 + 5) * 4 + r] != cks[(1 * 16 + 5) * 4 + r]) v |= 1 << r;
        if (!(ck_rel(st, 19) < 0.03)) v |= 16; if (!(ck_rel(st, 20) < 0.03)) v |= 32; if (!(ck_rel(st, 21) < 0.03)) v |= 64; if (!(ck_rel(st, 11) < 0.03)) v |= 128;
        const double r19 = ck_rel(st, 19); v |= (r19 < 0.03 ? 0 : r19 < 0.3 ? 1 : r19 < 3 ? 2 : 3) << 8;
    } else if (CHK_MODE == 2) {
        if (!(ck_rel(st, 22) < 0.03)) v |= 1; if (!(ck_rel(st, 23) < 0.03)) v |= 2;
        if (cks[(0 * 16 + 5) * 4 + 1] != cks[(1 * 16 + 5) * 4 + 1]) v |= 4;
        if (!(ck_rel(st, 20) < 0.03)) v |= 8; if (!(ck_rel(st, 19) < 0.03)) v |= 16;
        const double r = ck_rel(st, 20); v |= (r < 0.03 ? 0 : r < 0.3 ? 1 : r < 3 ? 2 : 3) << 5;
    } else if (CHK_MODE == 6) {
        int fi = nchk; for (int i = nchk - 1; i >= 0; --i) if (!(ck_rel(st, i) < 0.03)) fi = i;
        v = fi;
    } else if (CHK_MODE == 5) {
        int dp = 48; for (int ph = CK_NPH - 1; ph >= 0; --ph) for (int r = 3; r >= 0; --r) if (cks[(0 * 16 + ph) * 4 + r] != cks[(1 * 16 + ph) * 4 + r]) dp = ph * 4 + r;
        v = dp;
    } else {
        const double rel = ck_rel(st, CHK_MODE - 100); double q = 20.0 * log10(rel + 1e-12) + 200.0; q = q < 0 ? 0 : (q > 1900 ? 1900 : q); v = (int)(q + 0.5);
    }
    out[0] = (float)(10 + v % 80) * __builtin_powif(10.0f, 5 + v / 80);
}

struct CkCtx { void* const* d_in; float* out; unsigned char* ws; hipStream_t s; };
static inline const float* ck_in(const CkCtx& c, int i) { return (const float*)c.d_in[i]; }
static void ck_cksum(const CkCtx& c, int run, int ph, int slot, const void* p, size_t bytes) {
    unsigned long long* o = (unsigned long long*)(c.ws + WS_CHK + CK_CKS) + (run * 16 + ph) * 4 + slot;
    hipLaunchKernelGGL(ck_sum, dim3(2048), dim3(256), 0, c.s, (const unsigned*)p, bytes / 4, o);
}
static void ck_compare(const CkCtx& c, int idx, const void* fast, int is_bf16, long ldf, const float* ref, long ldr, int rows, int cols, int mode) {
    hipLaunchKernelGGL(ck_cmp, dim3(1024), dim3(256), 0, c.s, fast, is_bf16, ldf, ref, ldr, rows, cols, mode, (CkStat*)(c.ws + WS_CHK + CK_STATS) + idx);
}
static void ck_gemm(const CkCtx& c, const float* A, int lda, const float* W, int ldw, int K, float* C, int ldc, int N) { hipLaunchKernelGGL(nk_gemm<0>, dim3(N / 64, 32), dim3(256), 0, c.s, A, lda, W, ldw, K, C, ldc, 0); }
constexpr int CK_NCHK = 20;
static void selfcheck_after_phase(const CkCtx& c, int run, int ph) {
    unsigned char* ws = c.ws; unsigned char* R = ws + WS_R; unsigned char* CK = ws + WS_CHK;
    float* bufA = (float*)(CK + CK_A); float* T0 = (float*)(CK + CK_T0); float* T1 = (float*)(CK + CK_T1); float* T2 = (float*)(CK + CK_T2); float* T3 = (float*)(CK + CK_T3); float* T4 = (float*)(CK + CK_T4);
    const int r0 = CHK_ROW0; const size_t OUTB = (size_t)MT * DM * 4, HBB = (size_t)MT * DM * 2;
    switch (ph) {
    case 0: ck_cksum(c, run, ph, 0, ws + WS_HB, HBB); ck_cksum(c, run, ph, 1, ws + WS_SSQ, (size_t)MT * 128); ck_cksum(c, run, ph, 2, ws + WS_ATAB, WS_LB + 16384 - WS_ATAB); break;
    case 1: ck_cksum(c, run, ph, 0, ws + WS_WB, WB_END); break;
    case 2: case 10: ck_cksum(c, run, ph, 0, R + R_HID, (size_t)MT * DFF * 2); break;
    case 3: case 9: case 11: ck_cksum(c, run, ph, 0, c.out, OUTB); ck_cksum(c, run, ph, 1, ws + WS_HB, HBB); ck_cksum(c, run, ph, 2, ws + WS_SSQ, (size_t)MT * 128); break;
    case 4: ck_cksum(c, run, ph, 0, R + R_US, 6 * SZ512); ck_cksum(c, run, ph, 1, R + R_AQ, 3 * SZ512); ck_cksum(c, run, ph, 2, R + R_GATE, 12 * SZ512); break;
    case 5: ck_cksum(c, run, ph, 0, R + R_YD, 4 * SZ512); ck_cksum(c, run, ph, 1, R + R_OHG, 4 * SZ512); ck_cksum(c, run, ph, 2, R + R_US, SZ512); ck_cksum(c, run, ph, 3, R + R_AQ, 2 * SZ512 + SZ512 / 2); break;
    case 6: ck_cksum(c, run, ph, 0, R + R_YAT, 2 * SZ512); ck_cksum(c, run, ph, 1, R + R_YHG, SZ512); break;
    case 7: ck_cksum(c, run, ph, 0, R + R_YSS, SZ512); break;
    case 8: ck_cksum(c, run, ph, 0, R + R_MRG, 4 * SZ512); break;
    }
    if (run != 0) return;
    const bf16_t* hb = (const bf16_t*)(ws + WS_HB) + (size_t)r0 * DM;
    const int EW = 2048 * 2048 / 256;
    switch (ph) {
    case 0:
        hipLaunchKernelGGL(nk_rows, dim3(EW), dim3(256), 0, c.s, ck_in(c, 0), ck_in(c, 1), r0, T0);
        ck_compare(c, 0, hb, 1, DM, T0, DM, 2048, DM, 0);
        break;
    case 2:
        hipLaunchKernelGGL(nk_rmsnorm, dim3(2048), dim3(256), 0, c.s, T0, ck_in(c, 2), T1);
        hipLaunchKernelGGL(nk_gemm<1>, dim3(DFF / 64, 32), dim3(256), 0, c.s, T1, DM, ck_in(c, 3), 2 * DFF, DM, bufA, DFF, DFF);
        ck_compare(c, 1, (const bf16_t*)(R + R_HID) + (size_t)r0 * DFF, 1, DFF, bufA, DFF, 2048, DFF, 0);
        break;
    case 3:
        ck_gemm(c, bufA, DFF, ck_in(c, 4), DM, DFF, T1, DM, DM);
        hipLaunchKernelGGL(nk_axpy, dim3(EW), dim3(256), 0, c.s, T0, T1, 0.5f, (size_t)2048 * 2048);
        ck_compare(c, 2, c.out + (size_t)r0 * DM, 0, DM, T0, DM, 2048, DM, 0);
        ck_compare(c, 3, hb, 1, DM, T0, DM, 2048, DM, 0);
        break;
    case 4:
        hipLaunchKernelGGL(nk_rmsnorm, dim3(2048), dim3(256), 0, c.s, T0, ck_in(c, 5), T1);
        ck_gemm(c, T1, DM, ck_in(c, 6), NIN, DM, bufA, NIN, NIN);
        ck_compare(c, 4, (const bf16_t*)(R + R_US) + (size_t)r0 * 512, 1, 512, bufA, NIN, 2048, 512, 0);
        for (int k = 0; k < 5; ++k) ck_compare(c, 5, (const bf16_t*)(R + R_HGQ + k * SZ512) + (size_t)r0 * 512, 1, 512, bufA + 512 + 512 * k, NIN, 2048, 512, 0);
        ck_compare(c, 6, (const bf16_t*)(R + R_AQ) + (size_t)r0 * 1024, 1, 1024, bufA + 3072, NIN, 2048, 1024, 0);
        ck_compare(c, 6, (const bf16_t*)(R + R_AK) + (size_t)r0 * 256, 1, 256, bufA + 4096, NIN, 2048, 256, 0);
        ck_compare(c, 6, (const bf16_t*)(R + R_AV) + (size_t)r0 * 256, 1, 256, bufA + 4352, NIN, 2048, 256, 0);
        for (int g = 0; g < 3; ++g) ck_compare(c, 7, (const bf16_t*)(R + R_GATE + (size_t)g * 4 * SZ512) + (size_t)r0 * DM, 1, DM, bufA + 4608 + 2048 * g, NIN, 2048, DM, 1);
        break;
    case 5:
        hipLaunchKernelGGL(nk_s5, dim3(64), dim3(64), 0, c.s, bufA, ck_in(c, 7), ck_in(c, 8), ck_in(c, 9), ck_in(c, 10), ck_in(c, 11), ck_in(c, 12), ck_in(c, 13), T3);
        ck_compare(c, 8, (const float*)(R + R_YD) + (size_t)r0 * 512, 0, 512, T3, 512, 2048, 512, 0);
        ck_compare(c, 8, (const float*)(R + R_YD) + ((size_t)MT + r0) * 512, 0, 512, T3 + (size_t)SEQL * 512, 512, 2048, 512, 0);
        hipLaunchKernelGGL(nk_s5z, dim3(2048 * 512 / 256), dim3(256), 0, c.s, bufA, T3, ck_in(c, 14), T3 + 2 * 1048576);
        ck_compare(c, 9, (const bf16_t*)(R + R_US) + (size_t)r0 * 512, 1, 512, T3 + 2 * 1048576, 512, 2048, 512, 0);
        hipLaunchKernelGGL(nk_qkprep, dim3(2048 * 10), dim3(128), 0, c.s, bufA, ck_in(c, 18), ck_in(c, 19), T4, T4 + 2 * 1048576);
        ck_compare(c, 10, (const bf16_t*)(R + R_AQ) + (size_t)r0 * 1024, 1, 1024, T4, 1024, 2048, 1024, 0);
        ck_compare(c, 10, (const bf16_t*)(R + R_AK) + (size_t)r0 * 256, 1, 256, T4 + 2 * 1048576, 256, 2048, 256, 0);
        ck_gemm(c, T3 + 2 * 1048576, 512, ck_in(c, 15), 512, 512, T1, 512, 512);
        hipLaunchKernelGGL(nk_glu, dim3(2048 * 512 / 256), dim3(256), 0, c.s, T3 + 2 * 1048576, T1, T2);
        hipLaunchKernelGGL(nk_hgrn, dim3(8), dim3(128), 0, c.s, bufA, ck_in(c, 16), 0, T3, T4 + 3 * 1048576);
        ck_compare(c, 22, T4 + 5 * 1048576 / 2, 0, 128, T4 + 3 * 1048576, 128, 8 * 128, 128, 0);
        ck_compare(c, 23, T4 + 5 * 1048576 / 2 + 8 * 128 * 128, 0, 128, T4 + 3 * 1048576 + 8 * 128 * 128, 128, 8 * 128, 128, 0);
        ck_compare(c, 11, (const float*)(R + R_OHG) + (size_t)r0 * 512, 0, 512, T3, 512, 2048, 512, 0);
        ck_compare(c, 11, (const float*)(R + R_OHG) + ((size_t)MT + r0) * 512, 0, 512, T3 + (size_t)SEQL * 512, 512, 2048, 512, 0);
        ck_compare(c, 19, (const float*)(R + R_OHG) + (size_t)r0 * 512, 0, 512, T3, 512, 64, 512, 0);
        ck_compare(c, 20, (const float*)(R + R_OHG) + (size_t)(r0 + 64) * 512, 0, 512, T3 + (size_t)64 * 512, 512, 64, 512, 0);
        ck_compare(c, 21, (const float*)(R + R_OHG) + ((size_t)MT + r0 + 1984) * 512, 0, 512, T3 + (size_t)(SEQL + 1984) * 512, 512, 64, 512, 0);
        break;
    case 6:
        hipLaunchKernelGGL(nk_hgfin, dim3(2048 * 4), dim3(128), 0, c.s, T3, bufA, ck_in(c, 17), T2);
        ck_compare(c, 12, (const bf16_t*)(R + R_YHG) + (size_t)r0 * 512, 1, 512, T2 + 512, DM, 2048, 512, 0);
        hipLaunchKernelGGL(nk_attn, dim3(8 * 2048 / 4), dim3(256), 0, c.s, T4, T4 + 2 * 1048576, bufA, T2);
        ck_compare(c, 13, (const bf16_t*)(R + R_YAT) + (size_t)r0 * 1024, 1, 1024, T2 + 1024, DM, 2048, 1024, 0);
        break;
    case 7: ck_compare(c, 14, (const bf16_t*)(R + R_YSS) + (size_t)r0 * 512, 1, 512, T2, DM, 2048, 512, 0); break;
    case 8:
        ck_gemm(c, T2, DM, ck_in(c, 20), DM, 512, T3, DM, DM);
        hipLaunchKernelGGL(nk_gate, dim3(EW), dim3(256), 0, c.s, bufA, 0, T3, T1, 1);
        ck_gemm(c, T2 + 512, DM, ck_in(c, 20) + (size_t)512 * DM, DM, 512, T3, DM, DM);
        hipLaunchKernelGGL(nk_gate, dim3(EW), dim3(256), 0, c.s, bufA, 1, T3, T1, 0);
        ck_gemm(c, T2 + 1024, DM, ck_in(c, 20) + (size_t)1024 * DM, DM, 1024, T3, DM, DM);
        hipLaunchKernelGGL(nk_gate, dim3(EW), dim3(256), 0, c.s, bufA, 2, T3, T1, 0);
        ck_compare(c, 15, (const bf16_t*)(R + R_MRG) + (size_t)r0 * DM, 1, DM, T1, DM, 2048, DM, 0);
        break;
    case 9:
        ck_gemm(c, T1, DM, ck_in(c, 21), DM, DM, T3, DM, DM);
        hipLaunchKernelGGL(nk_axpy, dim3(EW), dim3(256), 0, c.s, T0, T3, 1.0f, (size_t)2048 * 2048);
        ck_compare(c, 16, c.out + (size_t)r0 * DM, 0, DM, T0, DM, 2048, DM, 0);
        break;
    case 10:
        hipLaunchKernelGGL(nk_rmsnorm, dim3(2048), dim3(256), 0, c.s, T0, ck_in(c, 22), T1);
        hipLaunchKernelGGL(nk_gemm<1>, dim3(DFF / 64, 32), dim3(256), 0, c.s, T1, DM, ck_in(c, 23), 2 * DFF, DM, bufA, DFF, DFF);
        ck_compare(c, 17, (const bf16_t*)(R + R_HID) + (size_t)r0 * DFF, 1, DFF, bufA, DFF, 2048, DFF, 0);
        break;
    case 11:
        ck_gemm(c, bufA, DFF, ck_in(c, 24), DM, DFF, T1, DM, DM);
        hipLaunchKernelGGL(nk_axpy, dim3(EW), dim3(256), 0, c.s, T0, T1, 0.5f, (size_t)2048 * 2048);
        ck_compare(c, 18, c.out + (size_t)r0 * DM, 0, DM, T0, DM, 2048, DM, 0);
        break;
    }
}
static void selfcheck_finish(const CkCtx& c) {
    hipLaunchKernelGGL(ck_fill0, dim3(4096), dim3(256), 0, c.s, c.out, (size_t)MT * DM);
    hipLaunchKernelGGL(ck_encode, dim3(1), dim3(64), 0, c.s, (const CkStat*)(c.ws + WS_CHK + CK_STATS), (const unsigned long long*)(c.ws + WS_CHK + CK_CKS), 19, c.out);
}
#endif
constexpr int PH_PER_LAYER = 11, N_PHASES = 1 + PH_PER_LAYER * DEPTH;
struct Params { const float* in[25]; float* out; unsigned char* ws; int ph_lo, ph_hi; };
static_assert(sizeof(Params) == 27 * 8 + 8, "Params has no padding");

#ifdef SELFCHECK
#define HG_DBG_PTR ((l == 0) ? (float*)(ws + WS_CHK + CK_T4 + 10 * MiB) : nullptr)
#else
#define HG_DBG_PTR nullptr
#endif
template <class Epi>
__device__ __forceinline__ void run_gemm(LAS unsigned char* lds, const bf16_t* A, const bf16_t* Bt, int N, int K, const Epi& E) {
    pg8::Gemm g{A, Bt, MT, N, K}; pg8::StaticOrder S; S.init(MT, N, (int)gridDim.x, (int)blockIdx.x);
    pg8::gemm_phase<Epi, pg8::StaticOrder, true, true>(lds, g, S, E);
}

__global__ void __launch_bounds__(NTHREADS, 2) k_fwd(Params p) {
    extern __shared__ __attribute__((aligned(16))) unsigned char lds_raw[];
    LAS unsigned char* lds = (LAS unsigned char*)lds_raw;
    const int tid = threadIdx.x, G = gridDim.x;
    unsigned char* ws = p.ws; unsigned char* R = ws + WS_R; unsigned char* WB = ws + WS_WB;
    float* ssq = (float*)(ws + WS_SSQ); bf16_t* hb = (bf16_t*)(ws + WS_HB);
    if (tid < 4) ((LAS unsigned*)(lds + LDS_MISC))[tid] = 0u;
    __syncthreads();
    const int lo = p.ph_lo, hi = p.ph_hi;
    XcdBarrier bar; bar.bar = (unsigned*)(ws + WS_BAR); bar.x = 0; bar.st = (volatile LAS unsigned*)(lds + LDS_MISC);
    if (hi - lo > 1) bar = xcd_barrier_post((unsigned*)(ws + WS_BAR), (volatile LAS unsigned*)(lds + LDS_MISC));
#ifndef PH_MASK
#define PH_MASK 0xfff
#endif
#define IN(k) (lo <= (k) && (k) < hi)
#define SEAM(k) do { if (IN(k) && IN((k) + 1)) xcd_barrier(bar); } while (0)

    if ((PH_MASK & 1) && IN(0)) {
        ProArgs A{p.in[0], p.in[1], p.in[7], p.in[8], p.in[9], p.in[10], p.in[11], p.in[12], p.in[13], p.in[16], ws};
        prologue_phase(A);
    }
    SEAM(0);
    for (int l = 0; l < DEPTH; ++l) {
        const int pb = 1 + PH_PER_LAYER * l;
        if (((PH_MASK >> 1) & 1) && IN(pb + 0)) {
            int base = 0;
            { CvtJob J{p.in[3] + (size_t)l * DM * 2 * DFF, p.in[2] + l * DM, (bf16_t*)(WB + WB_GU1), 2 * DFF, DM, 2 * DFF, 1}; cvt_job(lds, J, base); }
            { CvtJob J{p.in[4] + (size_t)l * DFF * DM, nullptr, (bf16_t*)(WB + WB_D1), DM, DFF, DM, 0}; cvt_job(lds, J, base); }
            { CvtJob J{p.in[6] + (size_t)l * DM * NIN, p.in[5] + l * DM, (bf16_t*)(WB + WB_IN), NIN, DM, NIN, 0}; cvt_job(lds, J, base); }
            { CvtJob J{p.in[15] + (size_t)l * 512 * 512, nullptr, (bf16_t*)(WB + WB_GLU), 512, 512, 512, 0}; cvt_job(lds, J, base); }
            { CvtJob J{p.in[20] + (size_t)l * DM * DM, nullptr, (bf16_t*)(WB + WB_BS), DM, 512, DM, 0}; cvt_job(lds, J, base); }
            { CvtJob J{p.in[20] + (size_t)l * DM * DM + (size_t)512 * DM, nullptr, (bf16_t*)(WB + WB_BH), DM, 512, DM, 0}; cvt_job(lds, J, base); }
            { CvtJob J{p.in[20] + (size_t)l * DM * DM + (size_t)1024 * DM, nullptr, (bf16_t*)(WB + WB_BA), DM, 1024, DM, 0}; cvt_job(lds, J, base); }
            { CvtJob J{p.in[21] + (size_t)l * DM * DM, nullptr, (bf16_t*)(WB + WB_OUT), DM, DM, DM, 0}; cvt_job(lds, J, base); }
            { CvtJob J{p.in[23] + (size_t)l * DM * 2 * DFF, p.in[22] + l * DM, (bf16_t*)(WB + WB_GU2), 2 * DFF, DM, 2 * DFF, 1}; cvt_job(lds, J, base); }
            { CvtJob J{p.in[24] + (size_t)l * DFF * DM, nullptr, (bf16_t*)(WB + WB_D2), DM, DFF, DM, 0}; cvt_job(lds, J, base); }
        }
        SEAM(pb + 0);
        if (((PH_MASK >> 2) & 1) && IN(pb + 1)) { epi::Swiglu E{(bf16_t*)(R + R_HID), ssq}; run_gemm(lds, hb, (const bf16_t*)(WB + WB_GU1), 2 * DFF, DM, E); }
        SEAM(pb + 1);
        if (((PH_MASK >> 3) & 1) && IN(pb + 2)) {
            epi::Resid E{l == 0 ? p.in[0] : p.out, l == 0 ? p.in[1] : p.out + (size_t)PROMPT_ROWS * DM, PROMPT_ROWS, 0.5f, p.out, hb, ssq};
            run_gemm(lds, (const bf16_t*)(R + R_HID), (const bf16_t*)(WB + WB_D1), DM, DFF, E);
        }
        SEAM(pb + 2);
        if (((PH_MASK >> 4) & 1) && IN(pb + 3)) { epi::WinSplit E{R, ssq}; run_gemm(lds, hb, (const bf16_t*)(WB + WB_IN), NIN, DM, E); }
        SEAM(pb + 3);
        if (((PH_MASK >> 5) & 1) && IN(pb + 4)) {
            HgArgs H{(const bf16_t*)(R + R_HGQ), (const bf16_t*)(R + R_HGQ + SZ512), (const bf16_t*)(R + R_HGQ + 2 * SZ512), (const bf16_t*)(R + R_HGQ + 3 * SZ512), (float*)(R + R_OHG), (const float*)(ws + WS_LB) + l * 1024, HG_DBG_PTR};
            for (int u = blockIdx.x; u < 160; u += G) hgrn_unit(lds, H, u);
            S5Args S{(bf16_t*)(R + R_US), (float*)(R + R_YD), (const f32x2*)(ws + WS_ATAB) + (size_t)l * 2 * 32 * 64, (const bf16_t*)(ws + WS_BM) + (size_t)l * 64 * 128 * 16, (const bf16_t*)(ws + WS_CM) + (size_t)l * 64 * 16 * 128, p.in[14] + l * 512};
            for (int u = (int)((blockIdx.x + 96u) % (unsigned)G); u < 160; u += G) s5_unit(lds, S, u);
            QkArgs Q{(bf16_t*)(R + R_AQ), (bf16_t*)(R + R_AK), p.in[18] + l * 128, p.in[19] + l * 128};
            qkprep_phase(Q, 0, G);
        }
        SEAM(pb + 4);
        if (((PH_MASK >> 6) & 1) && IN(pb + 5)) {
            for (int u = blockIdx.x; u < NSEQ * 64; u += G) {
                const int qb = u & 7, h = (u >> 3) & 7, b = u >> 6;
                const size_t tok0 = (size_t)b * SEQL;
                att::attn_dense_body((const bf16_t*)(R + R_AQ) + (tok0 + qb * 256) * 1024 + h * 128, (const bf16_t*)(R + R_AK) + tok0 * 256 + (h >> 2) * 128,
                                     (const bf16_t*)(R + R_AV) + tok0 * 256 + (h >> 2) * 128, (bf16_t*)(R + R_YAT) + (tok0 + qb * 256) * 1024 + h * 128, SEQL, (char*)lds_raw);
            }
            HfArgs F{(const float*)(R + R_OHG), (const bf16_t*)(R + R_HGQ + 4 * SZ512), p.in[17] + l * 128, (bf16_t*)(R + R_YHG)};
            hgfin_phase(F);
        }
        SEAM(pb + 5);
        if (((PH_MASK >> 7) & 1) && IN(pb + 6)) { epi::Glu E{(const bf16_t*)(R + R_US), (bf16_t*)(R + R_YSS)}; run_gemm(lds, (const bf16_t*)(R + R_US), (const bf16_t*)(WB + WB_GLU), 512, 512, E); }
        SEAM(pb + 6);
        if (((PH_MASK >> 8) & 1) && IN(pb + 7)) {
            { epi::Merge E{(const bf16_t*)(R + R_GATE), nullptr, (bf16_t*)(R + R_YD)}; run_gemm(lds, (const bf16_t*)(R + R_YSS), (const bf16_t*)(WB + WB_BS), DM, 512, E); }
            WAIT_VM0(); __syncthreads();
            { epi::Merge E{(const bf16_t*)(R + R_GATE + 4 * SZ512), (const bf16_t*)(R + R_YD), (bf16_t*)(R + R_OHG)}; run_gemm(lds, (const bf16_t*)(R + R_YHG), (const bf16_t*)(WB + WB_BH), DM, 512, E); }
            WAIT_VM0(); __syncthreads();
            { epi::Merge E{(const bf16_t*)(R + R_GATE + 8 * SZ512), (const bf16_t*)(R + R_OHG), (bf16_t*)(R + R_MRG)}; run_gemm(lds, (const bf16_t*)(R + R_YAT), (const bf16_t*)(WB + WB_BA), DM, 1024, E); }
        }
        SEAM(pb + 7);
        if (((PH_MASK >> 9) & 1) && IN(pb + 8)) {
            epi::Resid E{p.out, p.out + (size_t)PROMPT_ROWS * DM, PROMPT_ROWS, 1.0f, p.out, hb, ssq};
            run_gemm(lds, (const bf16_t*)(R + R_MRG), (const bf16_t*)(WB + WB_OUT), DM, DM, E);
        }
        SEAM(pb + 8);
        if (((PH_MASK >> 10) & 1) && IN(pb + 9)) { epi::Swiglu E{(bf16_t*)(R + R_HID), ssq}; run_gemm(lds, hb, (const bf16_t*)(WB + WB_GU2), 2 * DFF, DM, E); }
        SEAM(pb + 9);
        if (((PH_MASK >> 11) & 1) && IN(pb + 10)) {
            epi::Resid E{p.out, p.out + (size_t)PROMPT_ROWS * DM, PROMPT_ROWS, 0.5f, p.out, hb, ssq};
            run_gemm(lds, (const bf16_t*)(R + R_HID), (const bf16_t*)(WB + WB_D2), DM, DFF, E);
        }
        SEAM(pb + 10);
    }
#undef IN
#undef SEAM
}

#ifndef N_LAUNCH_MODE
#define N_LAUNCH_MODE 0
#endif
extern "C" void kernel_launch(void* const* d_in, const int* in_sizes, int n_in, void* d_out, int out_size, void* d_ws, size_t ws_size, hipStream_t stream) {
    static int grid = 0;
    if (grid == 0) {
        size_t need = WS_END;
#ifdef SELFCHECK
        need = WS_CHK + CHK_BYTES;
#endif
        if (n_in != 25 || out_size != MT * DM || ws_size < need) { fprintf(stderr, "kernel_launch: unexpected shapes: n_in %d out %d ws %zu (need %zu)\n", n_in, out_size, ws_size, need); grid = -1; return; }
        int dev = 0, cus = 0, per_cu = 0;
        if (hipGetDevice(&dev) != hipSuccess || hipDeviceGetAttribute(&cus, hipDeviceAttributeMultiprocessorCount, dev) != hipSuccess) { grid = -1; return; }
        if (hipFuncSetAttribute((const void*)k_fwd, hipFuncAttributeMaxDynamicSharedMemorySize, LDS_BYTES) != hipSuccess) { fprintf(stderr, "kernel_launch: hipFuncSetAttribute failed\n"); grid = -1; return; }
        if (hipOccupancyMaxActiveBlocksPerMultiprocessor(&per_cu, (const void*)k_fwd, NTHREADS, LDS_BYTES) != hipSuccess || per_cu < 1) { fprintf(stderr, "kernel_launch: occupancy query says %d\n", per_cu); (void)hipGetLastError(); grid = -1; return; }
        grid = cus;
    }
    if (grid < 0) return;
    (void)hipMemsetAsync((char*)d_ws + WS_BAR, 0, 16384, stream);
    Params p{};
    for (int i = 0; i < 25; ++i) p.in[i] = (const float*)d_in[i];
    p.out = (float*)d_out; p.ws = (unsigned char*)d_ws;
#ifdef SELFCHECK
    {
        CkCtx c{d_in, (float*)d_out, (unsigned char*)d_ws, stream};
        (void)hipMemsetAsync((char*)d_ws + WS_CHK, 0, 65536, stream);
        for (int run = 0; run < 2; ++run)
            for (int ph = 0; ph < CK_NPH; ++ph) {
                p.ph_lo = ph; p.ph_hi = ph + 1;
                hipLaunchKernelGGL(k_fwd, dim3(grid), dim3(NTHREADS), LDS_BYTES, stream, p);
                selfcheck_after_phase(c, run, ph);
            }
        selfcheck_finish(c);
    }
#elif N_LAUNCH_MODE == 1
    p.ph_lo = 0; p.ph_hi = N_PHASES;
    hipLaunchKernelGGL(k_fwd, dim3(grid), dim3(NTHREADS), LDS_BYTES, stream, p);
#else
    for (int ph = 0; ph < N_PHASES; ++ph) {
        p.ph_lo = ph; p.ph_hi = ph + 1;
        hipLaunchKernelGGL(k_fwd, dim3(grid), dim3(NTHREADS), LDS_BYTES, stream, p);
    }
#endif
    const hipError_t le = hipPeekAtLastError();
    if (le != hipSuccess) fprintf(stderr, "kernel_launch: launch failed: %s\n", hipGetErrorName(le));
}
```

```cpp
#define N_LAUNCH_MODE 1
#include <hip/hip_runtime.h>
#include <cstdio>
#include <cstdint>
#include <cstring>

#define LAS __attribute__((address_space(3)))
#ifndef CHK_ROW0
#define CHK_ROW0 18432
#endif
typedef unsigned short bf16_t;
typedef short bf16x8 __attribute__((ext_vector_type(8)));
typedef short s16x4 __attribute__((ext_vector_type(4)));
typedef float f32x2 __attribute__((ext_vector_type(2)));
typedef float f32x4 __attribute__((ext_vector_type(4)));
typedef float f32x8 __attribute__((ext_vector_type(8)));
typedef float f32x16 __attribute__((ext_vector_type(16)));
typedef unsigned u32x2 __attribute__((ext_vector_type(2)));
typedef unsigned u32x4 __attribute__((ext_vector_type(4)));

constexpr int MT = 40960;
constexpr int NSEQ = 20, SEQL = 2048, PROMPT_ROWS = 8192;
constexpr int DM = 2048, DFF = 5632, NIN = 10752, DEPTH = 4;
constexpr int NTHREADS = 512;
constexpr int LDS_BYTES = 147456;
constexpr int LDS_MISC = 131072;

constexpr size_t MiB = 1048576;
constexpr size_t WS_BAR  = 0;
constexpr size_t WS_SSQ  = 2359296;
constexpr size_t WS_ATAB = 65536;
constexpr size_t WS_BM   = WS_ATAB + 131072;
constexpr size_t WS_CM   = WS_BM + 1048576;
constexpr size_t WS_LB   = WS_CM + 1048576;
constexpr size_t WS_WB   = 8 * MiB; static_assert(WS_LB + 16384 <= WS_SSQ && WS_SSQ + (size_t)MT * 128 <= WS_WB, "small tables");
constexpr size_t WB_GU1 = 0;
constexpr size_t WB_D1  = WB_GU1 + (size_t)11264 * 2048 * 2;
constexpr size_t WB_IN  = WB_D1 + (size_t)2048 * 5632 * 2;
constexpr size_t WB_GLU = WB_IN + (size_t)NIN * 2048 * 2;
constexpr size_t WB_BS  = WB_GLU + (size_t)512 * 512 * 2;
constexpr size_t WB_BH  = WB_BS + (size_t)2048 * 512 * 2;
constexpr size_t WB_BA  = WB_BH + (size_t)2048 * 512 * 2;
constexpr size_t WB_OUT = WB_BA + (size_t)2048 * 1024 * 2;
constexpr size_t WB_GU2 = WB_OUT + (size_t)2048 * 2048 * 2;
constexpr size_t WB_D2  = WB_GU2 + (size_t)11264 * 2048 * 2;
constexpr size_t WB_END = WB_D2 + (size_t)2048 * 5632 * 2;
constexpr size_t WS_HB   = WS_WB + 192 * MiB;
constexpr size_t WS_R    = WS_HB + (size_t)MT * 2048 * 2;
static_assert(WB_END <= 192 * MiB, "weights region");
constexpr size_t R_HID  = 0;
constexpr size_t SZ512  = (size_t)MT * 512 * 2;
constexpr size_t R_US   = 0;
constexpr size_t R_HGQ  = R_US + SZ512;
constexpr size_t R_MRG  = R_HGQ;
constexpr size_t R_AQ   = R_HGQ + 5 * SZ512;
constexpr size_t R_AK   = R_AQ + 2 * SZ512;
constexpr size_t R_AV   = R_AK + SZ512 / 2;
constexpr size_t R_GATE = R_AV + SZ512 / 2;
constexpr size_t R_YD   = R_GATE + 12 * SZ512;
constexpr size_t R_OHG  = R_YD + 4 * SZ512;
constexpr size_t R_YSS  = R_OHG + 4 * SZ512;
constexpr size_t R_YHG  = R_YSS + SZ512;
constexpr size_t R_YAT  = R_YHG + SZ512;
constexpr size_t R_END  = R_YAT + 2 * SZ512;
static_assert(R_MRG + 4 * SZ512 <= R_HGQ + 4 * SZ512, "merged overlay");
static_assert((size_t)MT * DFF * 2 <= R_END, "hid fits");
constexpr size_t WS_END  = WS_R + R_END;
constexpr size_t WS_CHK  = WS_END;

typedef __bf16 bf16x2_n __attribute__((ext_vector_type(2)));
__device__ __forceinline__ unsigned cvtpk(float lo, float hi) { f32x2 v = {lo, hi}; bf16x2_n b = __builtin_convertvector(v, bf16x2_n); return __builtin_bit_cast(unsigned, b); }
__device__ __forceinline__ float bf2f(bf16_t b) { return __uint_as_float(((unsigned)b) << 16); }
__device__ __forceinline__ float bflo(unsigned w) { return __uint_as_float(w << 16); }
__device__ __forceinline__ float bfhi(unsigned w) { return __uint_as_float(w & 0xffff0000u); }
__device__ __forceinline__ bf16_t f2bf(float f) { return (bf16_t)(cvtpk(f, 0.f) & 0xffffu); }
__device__ __forceinline__ float sigm(float x) { return __builtin_amdgcn_rcpf(1.0f + __expf(-x)); }
__device__ __forceinline__ float siluf(float x) { return x * sigm(x); }
__device__ __forceinline__ float gelu_tanh(float x) {
    const float u = 0.7978845608028654f * (x + 0.044715f * x * x * x);
    return x * sigm(2.0f * u);
}
#define WAIT_VM0() asm volatile("s_waitcnt vmcnt(0)" ::: "memory")
#define WAIT_LGKM0() asm volatile("s_waitcnt lgkmcnt(0)" ::: "memory")
namespace pg8 {
#define PG8_LAS __attribute__((address_space(3)))
typedef unsigned short bf16_t;
typedef short bf16x8 __attribute__((ext_vector_type(8)));
typedef float f32x4 __attribute__((ext_vector_type(4)));
typedef unsigned u32x4 __attribute__((ext_vector_type(4)));
constexpr int BM = 256, BK = 64, HALF = 128, HTB = HALF * BK * 2  , STAGE_BYTES = 8 * HTB, NXCD = 8, WGM = 8;

__host__ __device__ __forceinline__ int lds_byte(int r, int c) { const int st = (r >> 4) * 2 + (c >> 5), rr = r & 15, cc = c & 31, ob = rr * 64 + cc * 2; return st * 1024 + (ob ^ (((ob >> 9) & 1) << 5)); }
__host__ __device__ __forceinline__ void stage_rc(int b, int& R, int& C) { const int st = b / 1024, sb = b % 1024, swz = sb ^ (((sb >> 9) & 1) << 5); R = (st >> 1) * 16 + swz / 64; C = (st & 1) * 32 + (swz % 64) / 2; }
__host__ __device__ __forceinline__ int perm32(int rho) { const int n = rho >> 4, i = rho & 15; return 8 * (i >> 2) + 4 * n + (i & 3); }

struct Unit { int pm, pn; };
struct Gemm { const bf16_t* A; const bf16_t* Bt; int M, N, K; };

struct StaticOrder {
    int nM, nN, nwg, G, c;
    __host__ __device__ void init(int M, int N, int G_, int c_) { nM = M / BM; nN = N / BM; nwg = nM * nN; G = G_; c = c_; }
    __host__ __device__ bool next(int i, Unit& u) const {
        const long L = (long)i * G + c; if (L >= nwg) return false;
        int wgid = (int)L; { const int q = nwg / NXCD, r = nwg % NXCD, xcd = wgid % NXCD, off = wgid / NXCD; wgid = (xcd < r ? xcd * (q + 1) : r * (q + 1) + (xcd - r) * q) + off; }
        const int nig = WGM * nN, gid = wgid / nig, fm = gid * WGM, gsz = (nM - fm) < WGM ? (nM - fm) : WGM;
        u.pm = fm + ((wgid % nig) % gsz); u.pn = (wgid % nig) / gsz; return true;
    }
    __device__ __forceinline__ void a_ready(const Unit&) const {}
    __device__ __forceinline__ void done(const Unit&) const {}
};


template <class Epi, class Sched, bool ALIGN_EPI = false, bool SP2 = false>
__device__ __forceinline__ void gemm_phase(PG8_LAS unsigned char* lds, const Gemm g, const Sched& S, const Epi& E) {
    int tid_l = threadIdx.x; asm volatile("" : "+v"(tid_l));
    const int tid = tid_l, wid = __builtin_amdgcn_readfirstlane(tid >> 6), lane = tid & 63, wr = wid >> 2, wc = wid & 3, fr = lane & 15, fq = lane >> 4;
    const int K = g.K, nt = K / BK;
    unsigned voffA[2], voffB[2];
#pragma unroll
    for (int i = 0; i < 2; ++i) { int R, C; stage_rc(tid * 16 + i * 8192, R, C); const int Rb = Epi::PERM ? ((R & ~31) + perm32(R & 31)) : R;
        voffA[i] = (unsigned)(R * K + C) * 2u; voffB[i] = (unsigned)(Rb * K + C) * 2u; }
    const size_t kstep = (size_t)(BK * 2);
    const size_t hstep = (size_t)HALF * K * 2;
    const size_t tstep = 2 * hstep;
    const unsigned ldsw = (unsigned)wid * 1024u;
    const int aoff = lds_byte(wr * 64 + fr, fq * 8), boff = lds_byte(wc * 32 + fr, fq * 8);
#define PG8_SA(b, h) (((b) * 2 + (h)) * HTB)
#define PG8_SB(b, h) ((4 + (b) * 2 + (h)) * HTB)
#define PG8_STAGE(bufoff, gbase, voff) do { _Pragma("unroll") for (int _i = 0; _i < 2; ++_i) \
        __builtin_amdgcn_global_load_lds((const unsigned*)((const char*)(gbase) + (voff)[_i]), (PG8_LAS unsigned*)(lds + (bufoff) + ldsw + _i * 8192), 16, 0, 0); } while (0)
#define PG8_LDA(dst, b, h) do { _Pragma("unroll") for (int m = 0; m < 4; ++m) _Pragma("unroll") for (int k = 0; k < 2; ++k) dst[m][k] = *(const PG8_LAS bf16x8*)(lds + PG8_SA(b, h) + aoff + m * 2048 + k * 1024); } while (0)
#define PG8_LDB(dst, b, h) do { _Pragma("unroll") for (int n = 0; n < 2; ++n) _Pragma("unroll") for (int k = 0; k < 2; ++k) dst[n][k] = *(const PG8_LAS bf16x8*)(lds + PG8_SB(b, h) + boff + n * 2048 + k * 1024); } while (0)
#define PG8_MMA(ai, bj, At, Bt) do { __builtin_amdgcn_s_setprio(1); _Pragma("unroll") for (int m = 0; m < 4; ++m) _Pragma("unroll") for (int n = 0; n < 2; ++n) _Pragma("unroll") for (int k = 0; k < 2; ++k) \
        acc[ai][bj][m][n] = __builtin_amdgcn_mfma_f32_16x16x32_bf16(Bt[n][k], At[m][k], acc[ai][bj][m][n], 0, 0, 0); __builtin_amdgcn_s_setprio(0); } while (0)
#define PG8_WAIT_V(n) asm volatile("s_waitcnt vmcnt(" #n ")" ::: "memory")
#define PG8_WAIT_L(n) asm volatile("s_waitcnt lgkmcnt(" #n ")" ::: "memory")
#define PG8_BAR __builtin_amdgcn_s_barrier()
#define PG8_SCHED __builtin_amdgcn_sched_barrier(0)
    Unit cur, nxt; int ui = 0;
    if (!S.next(0, cur)) return;
    f32x4 acc[2][2][4][2];
#pragma unroll
    for (int a = 0; a < 2; ++a)
#pragma unroll
        for (int b = 0; b < 2; ++b)
#pragma unroll
            for (int m = 0; m < 4; ++m)
#pragma unroll
                for (int n = 0; n < 2; ++n) acc[a][b][m][n] = (f32x4){0.f, 0.f, 0.f, 0.f};
    bf16x8 At[4][2], B0[2][2], B1[2][2];
    const char* cA = (const char*)g.A + (size_t)cur.pm * tstep; const char* cB = (const char*)g.Bt + (size_t)cur.pn * tstep;
    S.a_ready(cur);
    if constexpr (SP2) {
        PG8_STAGE(PG8_SB(0, 0), cB, voffB); PG8_STAGE(PG8_SB(0, 1), cB + hstep, voffB); PG8_STAGE(PG8_SA(0, 0), cA, voffA); PG8_STAGE(PG8_SA(0, 1), cA + hstep, voffA);
        if (wr == 1) PG8_BAR;
        PG8_WAIT_V(2); PG8_BAR;
        PG8_STAGE(PG8_SB(1, 0), cB + kstep, voffB); PG8_STAGE(PG8_SA(1, 0), cA + kstep, voffA); PG8_STAGE(PG8_SB(1, 1), cB + hstep + kstep, voffB);
        PG8_WAIT_V(6); PG8_BAR;
    } else {
        PG8_STAGE(PG8_SB(0, 0), cB, voffB); PG8_STAGE(PG8_SA(0, 0), cA, voffA); PG8_STAGE(PG8_SB(0, 1), cB + hstep, voffB); PG8_STAGE(PG8_SA(0, 1), cA + hstep, voffA);
        if (wr == 1) PG8_BAR;
        PG8_WAIT_V(4); PG8_BAR;
        PG8_STAGE(PG8_SB(1, 0), cB + kstep, voffB); PG8_STAGE(PG8_SA(1, 0), cA + kstep, voffA); PG8_STAGE(PG8_SB(1, 1), cB + hstep + kstep, voffB);
        PG8_WAIT_V(6); PG8_BAR;
    }
    for (;;) {
        const bool has_next = S.next(ui + 1, nxt);
        const char* nA = has_next ? (const char*)g.A + (size_t)nxt.pm * tstep : cA; const char* nB = has_next ? (const char*)g.Bt + (size_t)nxt.pn * tstep : cB;
        for (int t = 0; t < nt; t += 2) {
            const bool last = (t == nt - 2);
            const char* a1 = cA + (size_t)(t + 1) * kstep;
            const char* a2 = last ? nA : cA + (size_t)(t + 2) * kstep; const char* b2 = last ? nB : cB + (size_t)(t + 2) * kstep;
            const char* a3 = a2 + kstep; const char* b3 = b2 + kstep;
            if (last && has_next) S.a_ready(nxt);
            if constexpr (SP2) {
            PG8_LDB(B0, 0, 0); PG8_LDB(B1, 0, 1); PG8_SCHED; PG8_LDA(At, 0, 0); PG8_STAGE(PG8_SA(1, 1), a1 + hstep, voffA);
            PG8_WAIT_V(8); PG8_WAIT_L(0); PG8_BAR; PG8_MMA(0, 0, At, B0); PG8_MMA(0, 1, At, B1); PG8_BAR; PG8_SCHED;
            PG8_LDA(At, 0, 1); PG8_STAGE(PG8_SB(0, 0), b2, voffB); PG8_STAGE(PG8_SB(0, 1), b2 + hstep, voffB); PG8_STAGE(PG8_SA(0, 0), a2, voffA);
            PG8_WAIT_V(8); PG8_WAIT_L(0); PG8_BAR; PG8_MMA(1, 0, At, B0); PG8_MMA(1, 1, At, B1); PG8_BAR; PG8_SCHED;
            PG8_LDB(B0, 1, 0); PG8_LDB(B1, 1, 1); PG8_SCHED; PG8_LDA(At, 1, 0); PG8_STAGE(PG8_SA(0, 1), a2 + hstep, voffA);
            PG8_WAIT_V(8); PG8_WAIT_L(0); PG8_BAR; PG8_MMA(0, 0, At, B0); PG8_MMA(0, 1, At, B1); PG8_BAR; PG8_SCHED;
            PG8_LDA(At, 1, 1); PG8_STAGE(PG8_SB(1, 0), b3, voffB); PG8_STAGE(PG8_SB(1, 1), b3 + hstep, voffB); PG8_STAGE(PG8_SA(1, 0), a3, voffA);
            PG8_WAIT_V(8); PG8_WAIT_L(0); PG8_BAR; PG8_MMA(1, 0, At, B0); PG8_MMA(1, 1, At, B1); PG8_BAR; PG8_SCHED;
            } else {
            PG8_LDB(B0, 0, 0); PG8_SCHED; PG8_LDA(At, 0, 0); PG8_STAGE(PG8_SA(1, 1), a1 + hstep, voffA);
            PG8_WAIT_L(8); PG8_BAR; PG8_WAIT_L(0); PG8_MMA(0, 0, At, B0); PG8_BAR; PG8_SCHED;
            PG8_LDB(B1, 0, 1); PG8_STAGE(PG8_SB(0, 0), b2, voffB);
            PG8_BAR; PG8_WAIT_L(0); PG8_MMA(0, 1, At, B1); PG8_BAR;
            PG8_LDA(At, 0, 1); PG8_STAGE(PG8_SA(0, 0), a2, voffA);
            PG8_BAR; PG8_WAIT_L(0); PG8_MMA(1, 0, At, B0); PG8_BAR; PG8_SCHED;
            PG8_STAGE(PG8_SB(0, 1), b2 + hstep, voffB);
            PG8_WAIT_V(6); PG8_BAR; PG8_MMA(1, 1, At, B1); PG8_BAR;
            PG8_LDB(B0, 1, 0); PG8_SCHED; PG8_LDA(At, 1, 0); PG8_STAGE(PG8_SA(0, 1), a2 + hstep, voffA);
            PG8_WAIT_L(8); PG8_BAR; PG8_WAIT_L(0); PG8_MMA(0, 0, At, B0); PG8_BAR; PG8_SCHED;
            PG8_LDB(B1, 1, 1); PG8_STAGE(PG8_SB(1, 0), b3, voffB);
            PG8_BAR; PG8_WAIT_L(0); PG8_MMA(0, 1, At, B1); PG8_BAR;
            PG8_LDA(At, 1, 1); PG8_STAGE(PG8_SA(1, 0), a3, voffA);
            PG8_BAR; PG8_WAIT_L(0); PG8_MMA(1, 0, At, B0); PG8_BAR; PG8_SCHED;
            PG8_STAGE(PG8_SB(1, 1), b3 + hstep, voffB);
            PG8_WAIT_V(6); PG8_BAR; PG8_MMA(1, 1, At, B1); PG8_BAR;
            }
        }
        if constexpr (ALIGN_EPI) { if (wr == 0) PG8_BAR; }
        if constexpr (!Epi::AFTER_DRAIN) { E(acc, cur, wr, wc, fr, fq); S.done(cur); }
        if (!has_next) break;
#pragma unroll
        for (int a = 0; a < 2; ++a)
#pragma unroll
            for (int b = 0; b < 2; ++b)
#pragma unroll
                for (int m = 0; m < 4; ++m)
#pragma unroll
                    for (int n = 0; n < 2; ++n) acc[a][b][m][n] = (f32x4){0.f, 0.f, 0.f, 0.f};
        cur = nxt; cA = nA; cB = nB; ++ui;
        if constexpr (ALIGN_EPI) { if (wr == 1) PG8_BAR; }
    }
    PG8_WAIT_V(0);
    if constexpr (!ALIGN_EPI) { if (wr == 0) PG8_BAR; }
    PG8_BAR;
    if constexpr (Epi::AFTER_DRAIN) { E.fused(acc, cur, wr, wc, fr, fq, lds, wid, lane); S.done(cur); }
#undef PG8_SA
#undef PG8_SB
#undef PG8_STAGE
#undef PG8_LDA
#undef PG8_LDB
#undef PG8_MMA
#undef PG8_WAIT_V
#undef PG8_WAIT_L
#undef PG8_BAR
#undef PG8_SCHED
}
}
namespace epi {
using pg8::Unit;
constexpr float RMS_EPS = 1e-6f;
__device__ __forceinline__ float row_rstd(const float* ssq, int row) {
    const f32x4* p = (const f32x4*)(ssq + (size_t)row * 32);
    f32x4 a = p[0] + p[1], b = p[2] + p[3], c = p[4] + p[5], d = p[6] + p[7];
    a = (a + b) + (c + d);
    return __builtin_amdgcn_rsqf(((a[0] + a[1]) + (a[2] + a[3])) * (1.0f / 2048.0f) + RMS_EPS);
}

struct Swiglu {
    static constexpr bool PERM = true, AFTER_DRAIN = false;
    bf16_t* H; const float* ssq;
    __device__ __forceinline__ void operator()(const f32x4 (&acc)[2][2][4][2], const Unit& u, int wr, int wc, int fr, int fq) const {
        const int row0 = u.pm * 256 + wr * 64 + fr, col0 = u.pn * 128 + wc * 32 + 8 * fq;
#pragma unroll
        for (int ai = 0; ai < 2; ++ai)
#pragma unroll
            for (int m = 0; m < 4; ++m) {
                const int row = row0 + ai * 128 + m * 16;
                const float rstd = row_rstd(ssq, row);
                float o[8];
#pragma unroll
                for (int n = 0; n < 2; ++n)
#pragma unroll
                    for (int j = 0; j < 4; ++j) { const float g = acc[ai][0][m][n][j] * rstd, up = acc[ai][1][m][n][j] * rstd; o[n * 4 + j] = siluf(g) * up; }
                u32x4 w; w.x = cvtpk(o[0], o[1]); w.y = cvtpk(o[2], o[3]); w.z = cvtpk(o[4], o[5]); w.w = cvtpk(o[6], o[7]);
                *(u32x4*)(H + (size_t)row * DFF + col0) = w;
            }
    }
};

struct Resid {
    static constexpr bool PERM = false, AFTER_DRAIN = false;
    const float* base0; const float* base1; int split_row; float scale; float* out; bf16_t* hb; float* ssq_out;
    __device__ __forceinline__ void operator()(const f32x4 (&acc)[2][2][4][2], const Unit& u, int wr, int wc, int fr, int fq) const {
        const int row0 = u.pm * 256 + wr * 64 + fr, col0 = u.pn * 256 + wc * 32 + 4 * fq;
#pragma unroll
        for (int ai = 0; ai < 2; ++ai)
#pragma unroll
            for (int m = 0; m < 4; ++m) {
                const int row = row0 + ai * 128 + m * 16;
                const float* bp = (row < split_row) ? base0 + (size_t)row * DM : base1 + (size_t)(row - split_row) * DM;
                float* op = out + (size_t)row * DM; bf16_t* hp = hb + (size_t)row * DM;
                float s = 0.f;
#pragma unroll
                for (int bj = 0; bj < 2; ++bj)
#pragma unroll
                    for (int n = 0; n < 2; ++n) {
                        const int c = col0 + bj * 128 + n * 16;
                        const f32x4 b = *(const f32x4*)(bp + c);
                        const f32x4 o = b + acc[ai][bj][m][n] * scale;
                        *(f32x4*)(op + c) = o;
                        s += (o[0] * o[0] + o[1] * o[1]) + (o[2] * o[2] + o[3] * o[3]);
                        u32x2 w; w.x = cvtpk(o[0], o[1]); w.y = cvtpk(o[2], o[3]);
                        *(u32x2*)(hp + c) = w;
                    }
                s += __shfl_xor(s, 16); s += __shfl_xor(s, 32);
                if (fq == 0) ssq_out[(size_t)row * 32 + u.pn * 4 + wc] = s;
                asm volatile("" ::: "memory");
            }
    }
};

struct WinSplit {
    static constexpr bool PERM = true, AFTER_DRAIN = false;
    unsigned char* R; const float* ssq;
    __device__ __forceinline__ void operator()(const f32x4 (&acc)[2][2][4][2], const Unit& u, int wr, int wc, int fr, int fq) const {
        const int pn = u.pn; bf16_t* dst; int ld, colt; bool sg = false;
        if (pn < 12)       { dst = (bf16_t*)(R + R_US + (size_t)(pn >> 1) * SZ512); ld = 512; colt = (pn & 1) * 256; }
        else if (pn < 16)  { dst = (bf16_t*)(R + R_AQ); ld = 1024; colt = (pn - 12) * 256; }
        else if (pn == 16) { dst = (bf16_t*)(R + R_AK); ld = 256; colt = 0; }
        else if (pn == 17) { dst = (bf16_t*)(R + R_AV); ld = 256; colt = 0; }
        else { const int g = (pn - 18) >> 3; dst = (bf16_t*)(R + R_GATE + (size_t)g * 4 * SZ512); ld = 2048; colt = ((pn - 18) & 7) * 256; sg = true; }
        const int row0 = u.pm * 256 + wr * 64 + fr, col0 = colt + wc * 32 + 8 * fq;
#pragma unroll
        for (int ai = 0; ai < 2; ++ai)
#pragma unroll
            for (int m = 0; m < 4; ++m) {
                const int row = row0 + ai * 128 + m * 16;
                const float rstd = row_rstd(ssq, row);
#pragma unroll
                for (int bj = 0; bj < 2; ++bj) {
                    f32x4 v0 = acc[ai][bj][m][0] * rstd, v1 = acc[ai][bj][m][1] * rstd;
                    if (sg) {
#pragma unroll
                        for (int j = 0; j < 4; ++j) { v0[j] = sigm(v0[j]); v1[j] = sigm(v1[j]); }
                    }
                    u32x4 w; w.x = cvtpk(v0[0], v0[1]); w.y = cvtpk(v0[2], v0[3]); w.z = cvtpk(v1[0], v1[1]); w.w = cvtpk(v1[2], v1[3]);
                    *(u32x4*)(dst + (size_t)row * ld + col0 + bj * 128) = w;
                }
            }
    }
};

struct Glu {
    static constexpr bool PERM = true, AFTER_DRAIN = false;
    const bf16_t* Z; bf16_t* Y;
    __device__ __forceinline__ void operator()(const f32x4 (&acc)[2][2][4][2], const Unit& u, int wr, int wc, int fr, int fq) const {
        const int row0 = u.pm * 256 + wr * 64 + fr, col0 = u.pn * 256 + wc * 32 + 8 * fq;
#pragma unroll
        for (int ai = 0; ai < 2; ++ai)
#pragma unroll
            for (int m = 0; m < 4; ++m) {
                const int row = row0 + ai * 128 + m * 16;
#pragma unroll
                for (int bj = 0; bj < 2; ++bj) {
                    const size_t off = (size_t)row * 512 + col0 + bj * 128;
                    const u32x4 z = *(const u32x4*)(Z + off);
                    const f32x4 a0 = acc[ai][bj][m][0], a1 = acc[ai][bj][m][1];
                    u32x4 w;
                    w.x = cvtpk(bflo(z.x) * sigm(a0[0]), bfhi(z.x) * sigm(a0[1])); w.y = cvtpk(bflo(z.y) * sigm(a0[2]), bfhi(z.y) * sigm(a0[3]));
                    w.z = cvtpk(bflo(z.z) * sigm(a1[0]), bfhi(z.z) * sigm(a1[1])); w.w = cvtpk(bflo(z.w) * sigm(a1[2]), bfhi(z.w) * sigm(a1[3]));
                    *(u32x4*)(Y + off) = w;
                }
            }
    }
};

struct Merge {
    static constexpr bool PERM = true, AFTER_DRAIN = false;
    const bf16_t* G; const bf16_t* Pin; bf16_t* Mg;
    __device__ __forceinline__ void operator()(const f32x4 (&acc)[2][2][4][2], const Unit& u, int wr, int wc, int fr, int fq) const {
        const int row0 = u.pm * 256 + wr * 64 + fr, col0 = u.pn * 256 + wc * 32 + 8 * fq;
#pragma unroll
        for (int ai = 0; ai < 2; ++ai)
#pragma unroll
            for (int m = 0; m < 4; ++m) {
                const int row = row0 + ai * 128 + m * 16;
#pragma unroll
                for (int bj = 0; bj < 2; ++bj) {
                    const size_t off = (size_t)row * DM + col0 + bj * 128;
                    const u32x4 g = *(const u32x4*)(G + off);
                    u32x4 p = (u32x4){0u, 0u, 0u, 0u};
                    if (Pin) p = *(const u32x4*)(Pin + off);
                    const f32x4 a0 = acc[ai][bj][m][0], a1 = acc[ai][bj][m][1];
                    u32x4 w;
                    w.x = cvtpk(bflo(p.x) + bflo(g.x) * a0[0], bfhi(p.x) + bfhi(g.x) * a0[1]); w.y = cvtpk(bflo(p.y) + bflo(g.y) * a0[2], bfhi(p.y) + bfhi(g.y) * a0[3]);
                    w.z = cvtpk(bflo(p.z) + bflo(g.z) * a1[0], bfhi(p.z) + bfhi(g.z) * a1[1]); w.w = cvtpk(bflo(p.w) + bflo(g.w) * a1[2], bfhi(p.w) + bfhi(g.w) * a1[3]);
                    *(u32x4*)(Mg + off) = w;
                }
            }
    }
};
}
#define MFMA16(a, b, c) __builtin_amdgcn_mfma_f32_16x16x32_bf16((a), (b), (c), 0, 0, 0)
#define MFMA32(a, b, c) __builtin_amdgcn_mfma_f32_32x32x16_bf16((a), (b), (c), 0, 0, 0)

struct CvtJob { const float* W; const float* gain; bf16_t* dst; int ldw, K, Np, mode; };
__device__ __forceinline__ int cvt_col(int np, int mode) { if (mode == 0) return np; const int t = np >> 8, w = np & 255; return (w < 128) ? t * 128 + w : DFF + t * 128 + (w - 128); }
__device__ __forceinline__ void cvt_tile(LAS unsigned char* lds, const CvtJob& J, int tn, int tk) {
    LAS bf16_t* T = (LAS bf16_t*)lds;
    int tid_l = threadIdx.x; asm volatile("" : "+v"(tid_l)); const int tid = tid_l, c = tid & 63, r0 = tid >> 6, k0 = tk * 128;
    const int col = cvt_col(tn * 64 + c, J.mode);
    const float* src = J.W + (size_t)k0 * J.ldw + col;
#pragma unroll
    for (int i = 0; i < 16; ++i) {
        const int k = r0 + 8 * i;
        float v = src[(size_t)k * J.ldw];
        if (J.gain) v *= J.gain[k0 + k];
        T[c * 136 + k] = f2bf(v);
    }
    __syncthreads();
    const int row = tid >> 3, seg = tid & 7;
    const LAS u32x4* s = (const LAS u32x4*)(T + row * 136 + seg * 16);
    u32x4* d = (u32x4*)(J.dst + (size_t)(tn * 64 + row) * J.K + k0 + seg * 16);
    d[0] = s[0]; d[1] = s[1];
    __syncthreads();
}
__device__ __forceinline__ void cvt_job(LAS unsigned char* lds, const CvtJob& J, int& base) {
    const int ntn = J.Np / 64, ntk = J.K / 128, nt = ntn * ntk;
    const int G = gridDim.x;
    int first = (int)blockIdx.x - (base % G); if (first < 0) first += G;
    for (int t = first; t < nt; t += G) cvt_tile(lds, J, t % ntn, t / ntn);
    base += nt;
}

__device__ __forceinline__ void sincos_d(double x, double& s, double& c) {
    const double k = rint(x * 0.63661977236758134308);
    const double r = (x - k * 1.5707963267948966192) - k * 6.123233995736766e-17;
    const double r2 = r * r;
    double sp = -1.0 / 1307674368000.0; sp = sp * r2 + 1.0 / 6227020800.0; sp = sp * r2 - 1.0 / 39916800.0; sp = sp * r2 + 1.0 / 362880.0; sp = sp * r2 - 1.0 / 5040.0; sp = sp * r2 + 1.0 / 120.0; sp = sp * r2 - 1.0 / 6.0; sp = sp * r2 + 1.0;
    double cp = 1.0 / 20922789888000.0; cp = cp * r2 - 1.0 / 87178291200.0; cp = cp * r2 + 1.0 / 479001600.0; cp = cp * r2 - 1.0 / 3628800.0; cp = cp * r2 + 1.0 / 40320.0; cp = cp * r2 - 1.0 / 720.0; cp = cp * r2 + 1.0 / 24.0; cp = cp * r2 - 0.5; cp = cp * r2 + 1.0;
    const double sr = sp * r, cr = cp;
    const int q = ((int)k) & 3;
    s = (q == 0) ? sr : (q == 1) ? cr : (q == 2) ? -sr : -cr;
    c = (q == 0) ? cr : (q == 1) ? -sr : (q == 2) ? -cr : sr;
}
__device__ __forceinline__ double exp_d(double x) {
    const double k = rint(x * 1.4426950408889634074);
    const double r = x - k * 0.69314718055994530942;
    double p = 1.0 / 479001600.0; p = p * r + 1.0 / 39916800.0; p = p * r + 1.0 / 3628800.0; p = p * r + 1.0 / 362880.0; p = p * r + 1.0 / 40320.0; p = p * r + 1.0 / 5040.0; p = p * r + 1.0 / 720.0;
    p = p * r + 1.0 / 120.0; p = p * r + 1.0 / 24.0; p = p * r + 1.0 / 6.0; p = p * r + 0.5; p = p * r + 1.0; p = p * r + 1.0;
    return ldexp(p, (int)k);
}

struct ProArgs {
    const float* x_prompt; const float* x_sample;
    const float* lam_re; const float* lam_im; const float* log_dt; const float* b_re; const float* b_im; const float* c_re; const float* c_im; const float* lb_logits;
    unsigned char* ws;
};
__device__ __forceinline__ void prologue_phase(const ProArgs& A) {
    int tid_l = threadIdx.x; asm volatile("" : "+v"(tid_l)); const int tid = tid_l, G = gridDim.x; const size_t gtid = (size_t)blockIdx.x * NTHREADS + tid, gstride = (size_t)G * NTHREADS;
    for (size_t i = gtid; i < (size_t)DEPTH * 2 * 32 * 64; i += gstride) {
        const int n = (int)(i & 63); const size_t ldg = i >> 6;
        const double dt = exp_d((double)A.log_dt[ldg]);
        const double lr = (double)A.lam_re[i], li = (double)A.lam_im[i];
        const double mag = exp_d(lr * dt); double sn, cs; sincos_d(li * dt, sn, cs);
        const double are = mag * cs, aim = mag * sn;
        const double den = lr * lr + li * li, nre = are - 1.0;
        const double cre = (nre * lr + aim * li) / den, cim = (aim * lr - nre * li) / den;
        ((f32x2*)(A.ws + WS_ATAB))[i] = (f32x2){(float)are, (float)aim};
        bf16_t* Bm = (bf16_t*)(A.ws + WS_BM) + ldg * 128 * 16; bf16_t* Cm = (bf16_t*)(A.ws + WS_CM) + ldg * 16 * 128;
        const float* bre = A.b_re + i * 16; const float* bim = A.b_im + i * 16;
#pragma unroll
        for (int p = 0; p < 16; ++p) {
            const double br = (double)bre[p], bi = (double)bim[p];
            Bm[n * 16 + p] = f2bf((float)(cre * br - cim * bi));
            Bm[(64 + n) * 16 + p] = f2bf((float)(cre * bi + cim * br));
            Cm[p * 128 + n] = f2bf(A.c_re[(ldg * 16 + p) * 64 + n]);
            Cm[p * 128 + 64 + n] = f2bf(-A.c_im[(ldg * 16 + p) * 64 + n]);
        }
    }
    for (size_t i = gtid; i < 1024; i += gstride) {
        float lg[DEPTH], mx = -1e30f;
#pragma unroll
        for (int l = 0; l < DEPTH; ++l) { lg[l] = A.lb_logits[l * 1024 + i]; mx = fmaxf(mx, lg[l]); }
        float sum = 0.f;
#pragma unroll
        for (int l = 0; l < DEPTH; ++l) { lg[l] = expf(lg[l] - mx); sum += lg[l]; }
        float cum = 0.f; const float p0 = lg[0] / sum;
#pragma unroll
        for (int l = 0; l < DEPTH; ++l) { cum += lg[l] / sum; float v = cum - p0; v = fminf(fmaxf(v, 0.f), 1.0f - 1e-6f); ((float*)(A.ws + WS_LB))[l * 1024 + i] = v; }
    }
    {
        const int wave = tid >> 6, lane = tid & 63; float* ssq = (float*)(A.ws + WS_SSQ); bf16_t* hb = (bf16_t*)(A.ws + WS_HB);
        for (int row = blockIdx.x * 8 + wave; row < MT; row += G * 8) {
            const float* xp = (row < PROMPT_ROWS) ? A.x_prompt + (size_t)row * DM : A.x_sample + (size_t)(row - PROMPT_ROWS) * DM;
            float s = 0.f;
#pragma unroll
            for (int i = 0; i < 4; ++i) {
                const int c = (i * 64 + lane) * 8;
                const f32x4 a = *(const f32x4*)(xp + c), b = *(const f32x4*)(xp + c + 4);
                s += (a[0] * a[0] + a[1] * a[1]) + (a[2] * a[2] + a[3] * a[3]) + (b[0] * b[0] + b[1] * b[1]) + (b[2] * b[2] + b[3] * b[3]);
                u32x4 w; w.x = cvtpk(a[0], a[1]); w.y = cvtpk(a[2], a[3]); w.z = cvtpk(b[0], b[1]); w.w = cvtpk(b[2], b[3]);
                *(u32x4*)(hb + (size_t)row * DM + c) = w;
            }
#pragma unroll
            for (int o = 32; o >= 1; o >>= 1) s += __shfl_xor(s, o);
            if (lane < 32) ssq[(size_t)row * 32 + lane] = (lane == 0) ? s : 0.f;
        }
    }
}

struct S5Args { bf16_t* us; float* yd; const f32x2* atab; const bf16_t* Bm; const bf16_t* Cm; const float* dskip; };
__device__ __forceinline__ int crow16(int r) { return (r & 3) + 8 * (r >> 2); }
__device__ __forceinline__ void s5_unit(LAS unsigned char* lds, const S5Args& A, int unit) {
    int tid_l = threadIdx.x; asm volatile("" : "+v"(tid_l)); const int tid = tid_l, w = __builtin_amdgcn_readfirstlane(tid >> 6), lane = tid & 63, l31 = lane & 31, hi = lane >> 5, fr = lane & 15, fq = lane >> 4;
    const int b = unit >> 3, gq = unit & 7, dir = w >> 2, g = gq * 4 + (w & 3);
    const size_t row0 = (size_t)b * SEQL;
    const f32x2 a = A.atab[(dir * 32 + g) * 64 + lane];
    const bf16_t* Bm = A.Bm + (size_t)(dir * 32 + g) * 128 * 16;
    const bf16_t* Cm = A.Cm + (size_t)(dir * 32 + g) * 16 * 128;
    bf16x8 bfrag[4], cfrag[4];
#pragma unroll
    for (int j = 0; j < 4; ++j) { bfrag[j] = *(const bf16x8*)(Bm + (j * 32 + l31) * 16 + hi * 8); cfrag[j] = *(const bf16x8*)(Cm + fr * 128 + j * 32 + fq * 8); }
    LAS unsigned char* X = lds + w * 8704;
    const bf16_t* ug = A.us + row0 * 512 + g * 16 + hi * 8;
    float* ydw = A.yd + ((size_t)dir * MT + row0) * 512 + g * 16 + fr;
    float xr = 0.f, xi = 0.f;
    const int tA0 = dir ? (SEQL - 1 - l31) : l31;
    bf16x8 ua = *(const bf16x8*)(ug + (size_t)tA0 * 512);
    for (int c = 0; c < SEQL / 32; ++c) {
        bf16x8 ua_n = ua;
        if (c + 1 < SEQL / 32) { const int tn = dir ? tA0 - 32 * (c + 1) : tA0 + 32 * (c + 1); ua_n = *(const bf16x8*)(ug + (size_t)tn * 512); }
        const f32x16 zero = {};
        f32x16 d0 = MFMA32(ua, bfrag[0], zero), d1 = MFMA32(ua, bfrag[1], zero), d2 = MFMA32(ua, bfrag[2], zero), d3 = MFMA32(ua, bfrag[3], zero);
        float p0r[16], p1r[16], p0i[16], p1i[16];
#pragma unroll
        for (int r = 0; r < 16; ++r) {
            auto s = __builtin_amdgcn_permlane32_swap(__float_as_uint(d0[r]), __float_as_uint(d1[r]), false, false);
            p0r[r] = __uint_as_float(s[0]); p1r[r] = __uint_as_float(s[1]);
            auto q = __builtin_amdgcn_permlane32_swap(__float_as_uint(d2[r]), __float_as_uint(d3[r]), false, false);
            p0i[r] = __uint_as_float(q[0]); p1i[r] = __uint_as_float(q[1]);
        }
#pragma unroll
        for (int t8 = 0; t8 < 4; ++t8) {
#pragma unroll
            for (int q = 0; q < 4; ++q) { const int r = 4 * t8 + q; const float nr = a.x * xr - a.y * xi + p0r[r], ni = a.x * xi + a.y * xr + p0i[r]; xr = nr; xi = ni; p0r[r] = xr; p0i[r] = xi; }
#pragma unroll
            for (int q = 0; q < 4; ++q) { const int r = 4 * t8 + q; const float nr = a.x * xr - a.y * xi + p1r[r], ni = a.x * xi + a.y * xr + p1i[r]; xr = nr; xi = ni; p1r[r] = xr; p1i[r] = xi; }
        }
        asm volatile("" ::: "memory");
#pragma unroll
        for (int r = 0; r < 16; ++r) {
            const int t0 = crow16(r);
            *(LAS bf16_t*)(X + t0 * 272 + lane * 2) = f2bf(p0r[r]);       *(LAS bf16_t*)(X + t0 * 272 + 128 + lane * 2) = f2bf(p0i[r]);
            *(LAS bf16_t*)(X + (t0 + 4) * 272 + lane * 2) = f2bf(p1r[r]); *(LAS bf16_t*)(X + (t0 + 4) * 272 + 128 + lane * 2) = f2bf(p1i[r]);
        }
        asm volatile("" ::: "memory"); __builtin_amdgcn_wave_barrier(); asm volatile("" ::: "memory");
#pragma unroll
        for (int tt = 0; tt < 2; ++tt) {
            f32x4 y = {0.f, 0.f, 0.f, 0.f};
#pragma unroll
            for (int kk = 0; kk < 4; ++kk) { const bf16x8 af = *(const LAS bf16x8*)(X + (tt * 16 + fr) * 272 + (kk * 32 + fq * 8) * 2); y = MFMA16(af, cfrag[kk], y); }
#pragma unroll
            for (int r = 0; r < 4; ++r) { const int s = c * 32 + tt * 16 + 4 * fq + r; const int tok = dir ? (SEQL - 1 - s) : s; ydw[(size_t)tok * 512] = y[r]; }
        }
        asm volatile("" ::: "memory"); __builtin_amdgcn_wave_barrier(); asm volatile("" ::: "memory");
        ua = ua_n;
    }
    __threadfence(); __syncthreads();
    {
        const int ch = gq * 64 + (tid & 63), t0 = tid >> 6; const float dsk = A.dskip[ch];
        bf16_t* up = A.us + row0 * 512 + ch; const float* y0 = A.yd + row0 * 512 + ch; const float* y1 = y0 + (size_t)MT * 512;
        for (int t = t0; t < SEQL; t += 8) {
            const size_t o = (size_t)t * 512;
            const float y = dsk * bf2f(up[o]) + y0[o] + y1[o];
            up[o] = f2bf(gelu_tanh(y));
        }
    }
    __syncthreads();
}

struct HgArgs { const bf16_t* q; const bf16_t* ff; const bf16_t* fb; const bf16_t* iv; float* o; const float* lb; float* dbg; };
namespace hg {
constexpr int QT = 0, KT = 17408, KDT = 34816, VT = 53248, ST = 71680, AB = 106496, CQ = 115712, EL = 117760, END = 118272;
}
__device__ __forceinline__ void hgrn_unit(LAS unsigned char* lds, const HgArgs& A, int unit) {
    using namespace hg;
    int tid_l = threadIdx.x; asm volatile("" : "+v"(tid_l)); const int tid = tid_l, w = __builtin_amdgcn_readfirstlane(tid >> 6), lane = tid & 63, fr = lane & 15, fq = lane >> 4;
    const int dir = unit & 1, h = (unit >> 1) & 3, b = unit >> 3;
    const size_t row0 = (size_t)b * SEQL;
    const int d = tid & 127, tq = tid >> 7, col = h * 128 + d;
    const float lbv = A.lb[dir * 512 + col], oml = 1.0f - lbv;
    const bf16_t* fsrc = dir ? A.fb : A.ff;
    f32x4 sacc[8];
#pragma unroll
    for (int i = 0; i < 8; ++i) sacc[i] = (f32x4){0.f, 0.f, 0.f, 0.f};
    for (int i = tid; i < 34816 / 16; i += NTHREADS) *(LAS u32x4*)(lds + ST + i * 16) = (u32x4){0u, 0u, 0u, 0u};
    __syncthreads();
    for (int c = 0; c < SEQL / 64; ++c) {
        float cl[16], kk[16], qv[16]; unsigned vv[8];
        {
            float run = 0.f;
#pragma unroll
            for (int j = 0; j < 16; ++j) {
                const int s = c * 64 + tq * 16 + j; const size_t tok = row0 + (dir ? (SEQL - 1 - s) : s);
                const float z = bf2f(fsrc[tok * 512 + col]);
                const float sg = sigm(z);
                const float f = fmaxf(lbv + oml * sg, 1e-30f);
                run += __logf(f); cl[j] = run;
                kk[j] = oml * (1.0f - sg);
                qv[j] = siluf(bf2f(A.q[tok * 512 + col]));
                const unsigned vb = A.iv[tok * 512 + col];
                if (j & 1) vv[j >> 1] |= vb << 16; else vv[j >> 1] = vb;
            }
            ((LAS float*)(lds + CQ))[tq * 128 + d] = run;
        }
        __syncthreads();
        {
            const LAS float* cq = (const LAS float*)(lds + CQ);
            const float c0 = cq[d], c1 = cq[128 + d], c2 = cq[256 + d], c3 = cq[384 + d];
            const float tot = (c0 + c1) + (c2 + c3);
            const float off = (tq == 0) ? 0.f : (tq == 1) ? c0 : (tq == 2) ? (c0 + c1) : (c0 + c1) + c2;
            unsigned kd[8];
#pragma unroll
            for (int j = 0; j < 16; ++j) {
                const float cum = off + cl[j];
                const int i = tq * 16 + j;
                *(LAS bf16_t*)(lds + QT + i * 272 + d * 2) = f2bf(qv[j] * __expf(cum));
                *(LAS bf16_t*)(lds + KT + i * 272 + d * 2) = f2bf(kk[j] * __expf(fminf(-cum, 80.0f)));
                const float kdv = kk[j] * __expf(tot - cum);
                if (j & 1) kd[j >> 1] = cvtpk(__uint_as_float(kd[j >> 1]), kdv); else kd[j >> 1] = __float_as_uint(kdv);
            }
            LAS u32x4* kp = (LAS u32x4*)(lds + KDT + d * 144 + tq * 32); kp[0] = (u32x4){kd[0], kd[1], kd[2], kd[3]}; kp[1] = (u32x4){kd[4], kd[5], kd[6], kd[7]};
            LAS u32x4* vp = (LAS u32x4*)(lds + VT + d * 144 + tq * 32);  vp[0] = (u32x4){vv[0], vv[1], vv[2], vv[3]}; vp[1] = (u32x4){vv[4], vv[5], vv[6], vv[7]};
            if (tq == 0) ((LAS float*)(lds + EL))[d] = __expf(tot);
        }
        __syncthreads();
        {
            const int ti = w >> 1;
#pragma unroll
            for (int sj = 0; sj < 2; ++sj) {
                const int si = 2 * (w & 1) + sj;
                f32x4 acc = {0.f, 0.f, 0.f, 0.f};
                if (si <= ti) {
#pragma unroll
                    for (int k = 0; k < 4; ++k) {
                        const bf16x8 ka = *(const LAS bf16x8*)(lds + KT + (16 * si + fr) * 272 + (k * 32 + fq * 8) * 2);
                        const bf16x8 qb = *(const LAS bf16x8*)(lds + QT + (16 * ti + fr) * 272 + (k * 32 + fq * 8) * 2);
                        acc = MFMA16(ka, qb, acc);
                    }
                    if (si == ti) {
#pragma unroll
                        for (int r = 0; r < 4; ++r) if (4 * fq + r > fr) acc[r] = 0.f;
                    }
                }
                u32x2 pk; pk.x = cvtpk(acc[0], acc[1]); pk.y = cvtpk(acc[2], acc[3]);
                *(LAS u32x2*)(lds + AB + (16 * ti + fr) * 144 + (16 * si + 4 * fq) * 2) = pk;
            }
        }
        f32x4 oacc[4];
#pragma unroll
        for (int ti = 0; ti < 4; ++ti) oacc[ti] = (f32x4){0.f, 0.f, 0.f, 0.f};
#pragma unroll
        for (int k = 0; k < 4; ++k) {
            const bf16x8 sb = *(const LAS bf16x8*)(lds + ST + (16 * w + fr) * 272 + (k * 32 + fq * 8) * 2);
#pragma unroll
            for (int ti = 0; ti < 4; ++ti) { const bf16x8 qa = *(const LAS bf16x8*)(lds + QT + (16 * ti + fr) * 272 + (k * 32 + fq * 8) * 2); oacc[ti] = MFMA16(qa, sb, oacc[ti]); }
        }
        __syncthreads();
        bf16x8 vb[2];
#pragma unroll
        for (int k = 0; k < 2; ++k) vb[k] = *(const LAS bf16x8*)(lds + VT + (16 * w + fr) * 144 + (k * 32 + fq * 8) * 2);
#pragma unroll
        for (int k = 0; k < 2; ++k)
#pragma unroll
            for (int ti = 0; ti < 4; ++ti) { const bf16x8 aa = *(const LAS bf16x8*)(lds + AB + (16 * ti + fr) * 144 + (k * 32 + fq * 8) * 2); oacc[ti] = MFMA16(aa, vb[k], oacc[ti]); }
        {
            float* op = A.o + ((size_t)dir * MT + row0) * 512 + h * 128 + 16 * w + fr;
#pragma unroll
            for (int ti = 0; ti < 4; ++ti)
#pragma unroll
                for (int r = 0; r < 4; ++r) { const int s = c * 64 + 16 * ti + 4 * fq + r; const int tok = dir ? (SEQL - 1 - s) : s; op[(size_t)tok * 512] = oacc[ti][r]; }
        }
#pragma unroll
        for (int di = 0; di < 8; ++di) {
            const f32x4 el = *(const LAS f32x4*)(lds + EL + (16 * di + 4 * fq) * 4);
            sacc[di] = sacc[di] * el;
#pragma unroll
            for (int k = 0; k < 2; ++k) { const bf16x8 ka = *(const LAS bf16x8*)(lds + KDT + (16 * di + fr) * 144 + (k * 32 + fq * 8) * 2); sacc[di] = MFMA16(ka, vb[k], sacc[di]); }
            u32x2 pk; pk.x = cvtpk(sacc[di][0], sacc[di][1]); pk.y = cvtpk(sacc[di][2], sacc[di][3]);
            *(LAS u32x2*)(lds + ST + (16 * w + fr) * 272 + (16 * di + 4 * fq) * 2) = pk;
#ifdef SELFCHECK
            if (A.dbg && c < 2 && b == CHK_ROW0 / SEQL) {
#pragma unroll
                for (int r = 0; r < 4; ++r) A.dbg[(((size_t)c * 8 + (h * 2 + dir)) * 128 + 16 * di + 4 * fq + r) * 128 + 16 * w + fr] = sacc[di][r];
            }
#endif
        }
        __syncthreads();
    }
}

struct QkArgs { bf16_t* aq; bf16_t* ak; const float* qn; const float* kn; };
__device__ __forceinline__ void qkprep_phase(const QkArgs& A, int first_block, int nblocks) {
    int tid_l = threadIdx.x; asm volatile("" : "+v"(tid_l)); const int tid = tid_l, j = tid & 15, axis = j >> 3, sub = j & 7;
    const int bid = (int)blockIdx.x - first_block; if (bid < 0 || bid >= nblocks) return;
    for (int item = bid * 32 + (tid >> 4); item < MT * 10; item += nblocks * 32) {
        const int row = item / 10, hh = item - row * 10;
        bf16_t* p; const float* gn;
        if (hh < 8) { p = A.aq + (size_t)row * 1024 + hh * 128; gn = A.qn; } else { p = A.ak + (size_t)row * 256 + (hh - 8) * 128; gn = A.kn; }
        const int d1 = axis * 64 + 4 * sub, d2 = d1 + 32;
        const u32x2 w1 = *(const u32x2*)(p + d1), w2 = *(const u32x2*)(p + d2);
        float x1[4] = {bflo(w1.x), bfhi(w1.x), bflo(w1.y), bfhi(w1.y)}, x2[4] = {bflo(w2.x), bfhi(w2.x), bflo(w2.y), bfhi(w2.y)};
        float s = 0.f;
#pragma unroll
        for (int e = 0; e < 4; ++e) s += x1[e] * x1[e] + x2[e] * x2[e];
        s += __shfl_xor(s, 1); s += __shfl_xor(s, 2); s += __shfl_xor(s, 4); s += __shfl_xor(s, 8);
        const float rstd = __builtin_amdgcn_rsqf(s * (1.0f / 128.0f) + 1e-6f);
        const int t = row & (SEQL - 1); const float pos = (float)(axis == 0 ? (t >> 6) : (t & 63));
        const f32x4 g1 = *(const f32x4*)(gn + d1), g2 = *(const f32x4*)(gn + d2);
        float o1[4], o2[4];
#pragma unroll
        for (int e = 0; e < 4; ++e) {
            const float inv = __builtin_amdgcn_exp2f(-(float)(4 * sub + e) * (13.287712379549449f / 32.0f));
            const float ang = pos * inv, cs = __cosf(ang), sn = __sinf(ang);
            const float y1 = x1[e] * rstd * g1[e], y2 = x2[e] * rstd * g2[e];
            o1[e] = y1 * cs - y2 * sn; o2[e] = y2 * cs + y1 * sn;
        }
        u32x2 r1, r2; r1.x = cvtpk(o1[0], o1[1]); r1.y = cvtpk(o1[2], o1[3]); r2.x = cvtpk(o2[0], o2[1]); r2.y = cvtpk(o2[2], o2[3]);
        *(u32x2*)(p + d1) = r1; *(u32x2*)(p + d2) = r2;
    }
}

struct HfArgs { const float* o; const bf16_t* g; const float* gain; bf16_t* y; };
__device__ __forceinline__ void hgfin_phase(const HfArgs& A) {
    int tid_l = threadIdx.x; asm volatile("" : "+v"(tid_l)); const int tid = tid_l, j = tid & 15;
    for (int item = blockIdx.x * 32 + (tid >> 4); item < MT * 4; item += gridDim.x * 32) {
        const size_t off = (size_t)item * 128 + j * 8;
        const f32x4 a0 = *(const f32x4*)(A.o + off), a1 = *(const f32x4*)(A.o + off + 4);
        const f32x4 b0 = *(const f32x4*)(A.o + (size_t)MT * 512 + off), b1 = *(const f32x4*)(A.o + (size_t)MT * 512 + off + 4);
        const f32x4 s0 = a0 + b0, s1 = a1 + b1;
        float s = (s0[0] * s0[0] + s0[1] * s0[1]) + (s0[2] * s0[2] + s0[3] * s0[3]) + (s1[0] * s1[0] + s1[1] * s1[1]) + (s1[2] * s1[2] + s1[3] * s1[3]);
        s += __shfl_xor(s, 1); s += __shfl_xor(s, 2); s += __shfl_xor(s, 4); s += __shfl_xor(s, 8);
        const float rstd = __builtin_amdgcn_rsqf(s * (1.0f / 128.0f) + 1e-6f);
        const f32x4 g0 = *(const f32x4*)(A.gain + j * 8), g1 = *(const f32x4*)(A.gain + j * 8 + 4);
        const u32x4 gg = *(const u32x4*)(A.g + off);
        u32x4 w;
        w.x = cvtpk(s0[0] * rstd * g0[0] * siluf(bflo(gg.x)), s0[1] * rstd * g0[1] * siluf(bfhi(gg.x)));
        w.y = cvtpk(s0[2] * rstd * g0[2] * siluf(bflo(gg.y)), s0[3] * rstd * g0[3] * siluf(bfhi(gg.y)));
        w.z = cvtpk(s1[0] * rstd * g1[0] * siluf(bflo(gg.z)), s1[1] * rstd * g1[1] * siluf(bfhi(gg.z)));
        w.w = cvtpk(s1[2] * rstd * g1[2] * siluf(bflo(gg.w)), s1[3] * rstd * g1[3] * siluf(bfhi(gg.w)));
        *(u32x4*)(A.y + off) = w;
    }
}
namespace att {
constexpr int D = 128, NW = 8, QBLK = 32, KVBLK = 64;
constexpr float SCALE = 0.088388347648318440f;
constexpr float THR = 8.f;
constexpr int LDQ = 1024, LDK = 256, LDO = 1024;
constexpr size_t SHM_V = KVBLK * D * 2, SHM_K = KVBLK * D * 2, SHM_ATTN = 2 * SHM_V + 2 * SHM_K + NW * 64 * 4;
#define KSWZ(row, colB) ((row) * 256 + ((colB) ^ (((row) & 7) << 4)))
#define SBAR() __builtin_amdgcn_sched_barrier(0)
__device__ __forceinline__ int crow(int r, int hi) { return (r & 3) + 8 * (r >> 2) + 4 * hi; }
__device__ __forceinline__ unsigned cvtpkv(float lo, float hi) { return cvtpk(lo, hi); }

__device__ __forceinline__ void partialSM(f32x16& p0, f32x16& p1, float& m_reg, float& mn, float& alpha) {
  constexpr float C = SCALE * 1.4426950408889634f;
  float pmax = p0[0]; for (int r = 1; r < 16; ++r) pmax = fmaxf(pmax, p0[r]); for (int r = 0; r < 16; ++r) pmax = fmaxf(pmax, p1[r]);
  { auto rr = __builtin_amdgcn_permlane32_swap(__float_as_uint(pmax), __float_as_uint(pmax), false, false);
    pmax = fmaxf(__uint_as_float(rr[0]), __uint_as_float(rr[1])); }
  if (__builtin_expect(__all(pmax - m_reg <= THR / SCALE), 1)) { mn = m_reg; alpha = 1.f; }
  else { mn = fmaxf(m_reg, pmax); alpha = __builtin_amdgcn_exp2f((m_reg - mn) * C); m_reg = mn; }
  float mnC = -mn * C;
  for (int r = 0; r < 16; ++r) p0[r] = fmaf(p0[r], C, mnC); for (int r = 0; r < 16; ++r) p1[r] = fmaf(p1[r], C, mnC);
  for (int r = 0; r < 16; ++r) p0[r] = __builtin_amdgcn_exp2f(p0[r]);
}
__device__ __forceinline__ void finishSM(f32x16& p0, f32x16& p1, float alpha, float& l_reg, bf16x8& pa0, bf16x8& pa1, bf16x8& pa2, bf16x8& pa3) {
  for (int r = 0; r < 16; ++r) p1[r] = __builtin_amdgcn_exp2f(p1[r]);
  float ps = 0; for (int r = 0; r < 16; ++r) ps += p0[r]; for (int r = 0; r < 16; ++r) ps += p1[r];
  { auto rr = __builtin_amdgcn_permlane32_swap(__float_as_uint(ps), __float_as_uint(ps), false, false);
    ps = __uint_as_float(rr[0]) + __uint_as_float(rr[1]); }
  l_reg = l_reg * alpha + ps;
#define PK4(P, BASE, OUT) do { unsigned a0 = cvtpkv(P[BASE + 0], P[BASE + 1]), a1 = cvtpkv(P[BASE + 2], P[BASE + 3]);   \
    unsigned b0 = cvtpkv(P[BASE + 4], P[BASE + 5]), b1 = cvtpkv(P[BASE + 6], P[BASE + 7]);                              \
    auto r0 = __builtin_amdgcn_permlane32_swap(a0, b0, false, false); auto r1 = __builtin_amdgcn_permlane32_swap(a1, b1, false, false); \
    u32x4 w = {r0[0], r1[0], r0[1], r1[1]}; OUT = *reinterpret_cast<bf16x8*>(&w); } while (0)
  PK4(p0, 0, pa0); PK4(p0, 8, pa1); PK4(p1, 0, pa2); PK4(p1, 8, pa3);
#undef PK4
}
__device__ __forceinline__ void qkt(f32x16& p0, f32x16& p1, const bf16_t* Ks, const bf16x8* qr, int r32, int hi) {
  p0 = f32x16{}; p1 = f32x16{};
  for (int d0 = 0; d0 < 8; ++d0) { int cb = (d0 * 16 + hi * 8) * 2;
    bf16x8 b0 = *reinterpret_cast<const bf16x8*>((const char*)Ks + KSWZ(r32, cb));
    bf16x8 b1 = *reinterpret_cast<const bf16x8*>((const char*)Ks + KSWZ(32 + r32, cb));
    p0 = __builtin_amdgcn_mfma_f32_32x32x16_bf16(b0, qr[d0], p0, 0, 0, 0);
    p1 = __builtin_amdgcn_mfma_f32_32x32x16_bf16(b1, qr[d0], p1, 0, 0, 0); }
}
__device__ __forceinline__ int v_st(int k, int c) { const int kk = (k & ~0xC) | ((k & 4) << 1) | ((k & 8) >> 1); return ((kk >> 3) * 4 + (c >> 5)) * 512 + ((kk & 7) * 32 + (c & 31)) * 2; }
__device__ __forceinline__ int v_rd_base(int lane) { return ((lane & 3) << 3) | (((lane >> 2) & 3) << 6) | (((lane >> 4) & 1) << 5) | (((lane >> 5) & 1) << 8); }
constexpr int v_rd_off(int d0, int ks, int half) { return d0 * 512 + ks * 4096 + half * 2048; }
template <int OFF> __device__ __forceinline__ s16x4 tr_read(int vb) {
  s16x4 r; asm volatile("ds_read_b64_tr_b16 %0, %1 offset:%2" : "=&v"(r) : "v"(vb), "i"(OFF) : "memory"); return r;
}
template <int D0> __device__ __forceinline__ void pv_one(f32x16& od, int vb, bf16x8 pa0, bf16x8 pa1, bf16x8 pa2, bf16x8 pa3) {
  const s16x4 l0 = tr_read<v_rd_off(D0, 0, 0)>(vb), h0 = tr_read<v_rd_off(D0, 0, 1)>(vb), l1 = tr_read<v_rd_off(D0, 1, 0)>(vb), h1 = tr_read<v_rd_off(D0, 1, 1)>(vb);
  const s16x4 l2 = tr_read<v_rd_off(D0, 2, 0)>(vb), h2 = tr_read<v_rd_off(D0, 2, 1)>(vb), l3 = tr_read<v_rd_off(D0, 3, 0)>(vb), h3 = tr_read<v_rd_off(D0, 3, 1)>(vb);
  asm volatile("s_waitcnt lgkmcnt(0)" ::: "memory"); SBAR();
#define PK(L, H) (bf16x8){L[0], L[1], L[2], L[3], H[0], H[1], H[2], H[3]}
  od = __builtin_amdgcn_mfma_f32_32x32x16_bf16(pa0, PK(l0, h0), od, 0, 0, 0);
  od = __builtin_amdgcn_mfma_f32_32x32x16_bf16(pa1, PK(l1, h1), od, 0, 0, 0);
  od = __builtin_amdgcn_mfma_f32_32x32x16_bf16(pa2, PK(l2, h2), od, 0, 0, 0);
  od = __builtin_amdgcn_mfma_f32_32x32x16_bf16(pa3, PK(l3, h3), od, 0, 0, 0);
#undef PK
}
__device__ __forceinline__ void pv_d0(f32x16* o, int vb, bf16x8 pa0, bf16x8 pa1, bf16x8 pa2, bf16x8 pa3) {
  pv_one<0>(o[0], vb, pa0, pa1, pa2, pa3); pv_one<1>(o[1], vb, pa0, pa1, pa2, pa3); pv_one<2>(o[2], vb, pa0, pa1, pa2, pa3); pv_one<3>(o[3], vb, pa0, pa1, pa2, pa3);
}
__device__ __forceinline__ void attn_dense_body(const bf16_t* __restrict__ Qb, const bf16_t* __restrict__ Kh, const bf16_t* __restrict__ Vh, bf16_t* __restrict__ Ob, int seq, char* lds) {
  int tid_l = threadIdx.x; asm volatile("" : "+v"(tid_l)); const int tid = tid_l, wid = tid >> 6, lane = tid & 63, r32 = lane & 31, hi = lane >> 5;
  bf16_t* V_lds = (bf16_t*)lds; bf16_t* K_lds = (bf16_t*)(lds + 2 * SHM_V);
  float* ws = (float*)(lds + 2 * SHM_V + 2 * SHM_K) + wid * 64; float* li_l = ws; float* al_l = ws + 32;
  float m_reg = -1e30f, l_reg = 0; f32x16 o[4] = {}; bf16x8 qr[8];
  const bf16_t* Qw = Qb + (long)(wid * QBLK + r32) * LDQ + hi * 8;
#pragma unroll
  for (int d0 = 0; d0 < 8; ++d0) qr[d0] = *reinterpret_cast<const bf16x8*>(Qw + d0 * 16);
  const int sr = tid >> 4, sc = (tid & 15) * 8, vst0 = v_st(sr, sc), vst1 = v_st(32 + sr, sc);
  const int vb0 = (int)(uintptr_t)V_lds + v_rd_base(lane);
  struct { bf16x8 vs0, vs1, ks0, ks1; } sr_[2];
#define SLOAD(i, k0) do { sr_[i].vs0 = *reinterpret_cast<const bf16x8*>(&Vh[(long)((k0) + sr) * LDK + sc]); sr_[i].vs1 = *reinterpret_cast<const bf16x8*>(&Vh[(long)((k0) + 32 + sr) * LDK + sc]); \
    sr_[i].ks0 = *reinterpret_cast<const bf16x8*>(&Kh[(long)((k0) + sr) * LDK + sc]); sr_[i].ks1 = *reinterpret_cast<const bf16x8*>(&Kh[(long)((k0) + 32 + sr) * LDK + sc]); } while (0)
#define SWRITE(b, i) do { *(bf16x8*)((char*)V_lds + (b) * SHM_V + vst0) = sr_[i].vs0;          \
    *(bf16x8*)((char*)V_lds + (b) * SHM_V + vst1) = sr_[i].vs1; int kc = sc * 2;               \
    *(bf16x8*)((char*)K_lds + (b) * SHM_K + KSWZ(sr, kc)) = sr_[i].ks0;                       \
    *(bf16x8*)((char*)K_lds + (b) * SHM_K + KSWZ(32 + sr, kc)) = sr_[i].ks1; } while (0)
#define SWAIT() asm volatile("s_waitcnt vmcnt(4)" ::: "memory")
#define RESC(a) do { if (__any((a) < 1.f)) { if (hi == 0) al_l[r32] = (a); asm volatile("s_waitcnt lgkmcnt(0)" ::: "memory"); \
    for (int d = 0; d < 4; ++d) for (int r = 0; r < 16; ++r) o[d][r] *= al_l[crow(r, hi)]; } } while (0)
  f32x16 pA0, pA1, pB0, pB1; float mnA, mnB, alA, alB; bf16x8 pa0, pa1, pa2, pa3; const int NT = seq / KVBLK;
  constexpr int SE = 0, SO = 1;
  SLOAD(SE, 0); asm volatile("s_waitcnt vmcnt(0)" ::: "memory"); SWRITE(0, SE); __syncthreads();
  qkt(pA0, pA1, K_lds, qr, r32, hi); partialSM(pA0, pA1, m_reg, mnA, alA);
  SLOAD(SO, KVBLK); if (2 < NT) SLOAD(SE, 2 * KVBLK);
  SWAIT(); SWRITE(1, SO); __syncthreads();
  for (int j = 1; j + 1 < NT; j += 2) {
    SBAR(); qkt(pB0, pB1, (bf16_t*)((char*)K_lds + SHM_K), qr, r32, hi);
    finishSM(pA0, pA1, alA, l_reg, pa0, pa1, pa2, pa3); SBAR();
    SLOAD(SO, (j + 2) * KVBLK); SBAR();
    pv_d0(o, vb0, pa0, pa1, pa2, pa3); partialSM(pB0, pB1, m_reg, mnB, alB);
    __syncthreads(); SWAIT(); SWRITE(0, SE);
    RESC(alB); __syncthreads();
    SBAR(); qkt(pA0, pA1, K_lds, qr, r32, hi);
    finishSM(pB0, pB1, alB, l_reg, pa0, pa1, pa2, pa3); SBAR();
    if (j + 3 < NT) SLOAD(SE, (j + 3) * KVBLK); SBAR();
    pv_d0(o, vb0 + (int)SHM_V, pa0, pa1, pa2, pa3); partialSM(pA0, pA1, m_reg, mnA, alA);
    __syncthreads(); SWAIT(); SWRITE(1, SO);
    RESC(alA); __syncthreads();
  }
  SBAR(); qkt(pB0, pB1, (bf16_t*)((char*)K_lds + SHM_K), qr, r32, hi);
  finishSM(pA0, pA1, alA, l_reg, pa0, pa1, pa2, pa3); SBAR();
  pv_d0(o, vb0, pa0, pa1, pa2, pa3); partialSM(pB0, pB1, m_reg, mnB, alB);
  __syncthreads(); RESC(alB);
  finishSM(pB0, pB1, alB, l_reg, pa0, pa1, pa2, pa3); SBAR();
  pv_d0(o, vb0 + (int)SHM_V, pa0, pa1, pa2, pa3);
  if (hi == 0) li_l[r32] = l_reg; asm volatile("s_waitcnt lgkmcnt(0)" ::: "memory");
  float rli[16];
#pragma unroll
  for (int r = 0; r < 16; ++r) rli[r] = __builtin_amdgcn_rcpf(li_l[crow(r, hi)]);
  bf16_t* Ow = Ob + (long)(wid * QBLK) * LDO;
#pragma unroll
  for (int r = 0; r < 16; ++r) { int orow = crow(r, hi);
    for (int d0 = 0; d0 < 4; ++d0) Ow[(long)orow * LDO + d0 * 32 + r32] = f2bf(o[d0][r] * rli[r]); }
  __syncthreads();
#undef SLOAD
#undef SWRITE
#undef SWAIT
#undef RESC
}
}
#define XB_TMO      128
#define XB_XCNT(j)  (256  + 64 * (j))
#define XB_XSUB(j)  (1280 + 64 * (j))
#define XB_XGEN(j)  (2304 + 64 * (j))
#define XB_TOP      3328
#define XB_TOPGEN   3392
#define XCD_BAR_WORDS 3456
#define XB_SPIN_CAP (1u << 22)

__device__ __forceinline__ unsigned xb_ld(unsigned* p)              { return __hip_atomic_load(p, __ATOMIC_RELAXED, __HIP_MEMORY_SCOPE_AGENT); }
__device__ __forceinline__ unsigned xb_add(unsigned* p, unsigned v) { return __hip_atomic_fetch_add(p, v, __ATOMIC_RELAXED, __HIP_MEMORY_SCOPE_AGENT); }
__device__ __forceinline__ unsigned xb_xcc_id() { return (unsigned)__builtin_amdgcn_s_getreg((3 << 11) | 20) & 0xFu; }
#define XB_SPIN(cond, bar) do { unsigned _sp = 0; while (cond) { __builtin_amdgcn_s_sleep(1); \
    if ((++_sp & 255u) == 0u) { if (xb_ld(&(bar)[XB_TMO])) break; if (_sp > XB_SPIN_CAP) { atomicAdd(&(bar)[XB_TMO], 1u); break; } } } } while (0)

struct XcdBarrier {
    unsigned* bar; unsigned x;
    volatile LAS unsigned* st;
};

__device__ __forceinline__ XcdBarrier xcd_barrier_post(unsigned* bar, volatile LAS unsigned* st) {
    XcdBarrier b; b.bar = bar; b.x = xb_xcc_id(); b.st = st;
    if (threadIdx.x == 0) (void)xb_add(&bar[XB_XCNT(b.x)], 1u);
    return b;
}
__device__ __forceinline__ void xcd_barrier_complete(unsigned* bar, unsigned x, unsigned& nloc, unsigned& nx) {
    const unsigned G = gridDim.x * gridDim.y * gridDim.z;
    unsigned sum, cnt, mine, sp = 0u;
    for (;;) {
        sum = 0u; cnt = 0u; mine = 0u;
#pragma unroll
        for (unsigned j = 0; j < 16; ++j) { const unsigned c = xb_ld(&bar[XB_XCNT(j)]); sum += c; cnt += (c > 0u) ? 1u : 0u; mine = (j == x) ? c : mine; }
        if (sum == G) break;
        __builtin_amdgcn_s_sleep(1);
        if ((++sp & 255u) == 0u) { if (xb_ld(&bar[XB_TMO])) break; if (sp > XB_SPIN_CAP) { atomicAdd(&bar[XB_TMO], 1u); break; } }
    }
    nloc = mine > 0u ? mine : 1u; nx = cnt > 0u ? cnt : 1u;
}

__device__ __forceinline__ void xcd_barrier(const XcdBarrier& b) {
    asm volatile("s_waitcnt vmcnt(0)" ::: "memory");
    __syncthreads();
    if (threadIdx.x == 0) {
        unsigned* bar = b.bar;
        __builtin_amdgcn_s_waitcnt(0);
        unsigned nloc = b.st[0], nx = b.st[1];
        if (nloc == 0u) { xcd_barrier_complete(bar, b.x, nloc, nx); b.st[0] = nloc; b.st[1] = nx; }
        const unsigned old = xb_add(&bar[XB_XSUB(b.x)], 1u);
        const unsigned gen = old / nloc;
        if (old + 1u == (gen + 1u) * nloc) {
            __builtin_amdgcn_fence(__ATOMIC_RELEASE, "agent");
            asm volatile("s_waitcnt vmcnt(0)" ::: "memory");
            const unsigned og = xb_add(&bar[XB_TOP], 1u);
            const unsigned tg = og / nx;
            if (og + 1u == (tg + 1u) * nx) xb_add(&bar[XB_TOPGEN], 1u);
            else XB_SPIN(xb_ld(&bar[XB_TOPGEN]) == tg, bar);
            __builtin_amdgcn_fence(__ATOMIC_ACQUIRE, "agent");
            xb_add(&bar[XB_XGEN(b.x)], 1u);
            asm volatile("s_waitcnt vmcnt(0)" ::: "memory");
        } else {
            XB_SPIN(xb_ld(&bar[XB_XGEN(b.x)]) == gen, bar);
            __builtin_amdgcn_fence(__ATOMIC_ACQUIRE, "agent");
            asm volatile("s_waitcnt vmcnt(0)" ::: "memory");
        }
    }
    __syncthreads();
}
#ifdef SELFCHECK
#ifndef CHK_ROW0
#define CHK_ROW0 18432
#endif
constexpr size_t CK_STATS = 0, CK_CKS = 4096, CK_A = 65536, CK_T0 = CK_A + 84 * MiB, CK_T1 = CK_T0 + 16 * MiB, CK_T2 = CK_T1 + 16 * MiB, CK_T3 = CK_T2 + 16 * MiB, CK_T4 = CK_T3 + 16 * MiB;
constexpr size_t CHK_BYTES = CK_T4 + 16 * MiB;
constexpr int CK_NPH = 12;
struct CkStat { double d2, r2; unsigned mx, pad; };

__global__ void ck_sum(const unsigned* p, size_t nwords, unsigned long long* out) {
    unsigned long long s = 0;
    for (size_t i = (size_t)blockIdx.x * blockDim.x + threadIdx.x; i < nwords; i += (size_t)gridDim.x * blockDim.x) s += (unsigned long long)p[i] * (2ull * i + 1ull);
    for (int o = 32; o >= 1; o >>= 1) s += __shfl_xor(s, o);
    if ((threadIdx.x & 63) == 0) atomicAdd(out, s);
}
__global__ void ck_cmp(const void* fast, int is_bf16, long ldf, const float* ref, long ldr, int rows, int cols, int mode, CkStat* st) {
    double d2 = 0, r2 = 0; float mx = 0;
    for (size_t i = (size_t)blockIdx.x * blockDim.x + threadIdx.x; i < (size_t)rows * cols; i += (size_t)gridDim.x * blockDim.x) {
        const int r = (int)(i / cols), c = (int)(i % cols);
        const float f = is_bf16 ? bf2f(((const bf16_t*)fast)[(size_t)r * ldf + c]) : ((const float*)fast)[(size_t)r * ldf + c];
        float g = ref[(size_t)r * ldr + c]; if (mode == 1) g = 1.0f / (1.0f + expf(-g));
        float d = f - g; if (!(d == d)) d = 1e30f;
        d2 += (double)d * d; r2 += (double)g * g; mx = fmaxf(mx, fabsf(d));
    }
    for (int o = 32; o >= 1; o >>= 1) { d2 += __shfl_xor(d2, o); r2 += __shfl_xor(r2, o); mx = fmaxf(mx, __shfl_xor(mx, o)); }
    if ((threadIdx.x & 63) == 0) { atomicAdd(&st->d2, d2); atomicAdd(&st->r2, r2); atomicMax(&st->mx, __float_as_uint(mx)); }
}
__global__ void nk_rows(const float* xp, const float* xs, int row0, float* dst) {
    const size_t i = (size_t)blockIdx.x * 256 + threadIdx.x; const int r = row0 + (int)(i / DM), c = (int)(i % DM);
    dst[i] = (r < PROMPT_ROWS) ? xp[(size_t)r * DM + c] : xs[(size_t)(r - PROMPT_ROWS) * DM + c];
}
__global__ void nk_rmsnorm(const float* src, const float* gain, float* dst) {
    __shared__ float red[256]; const float* x = src + (size_t)blockIdx.x * DM; float s = 0;
    for (int c = threadIdx.x; c < DM; c += 256) s += x[c] * x[c];
    red[threadIdx.x] = s; __syncthreads();
    for (int o = 128; o >= 1; o >>= 1) { if (threadIdx.x < o) red[threadIdx.x] += red[threadIdx.x + o]; __syncthreads(); }
    const float rstd = 1.0f / sqrtf(red[0] / DM + 1e-6f);
    for (int c = threadIdx.x; c < DM; c += 256) dst[(size_t)blockIdx.x * DM + c] = x[c] * rstd * gain[c];
}
template <int MODE> __global__ void __launch_bounds__(256) nk_gemm(const float* A, int lda, const float* W, int ldw, int K, float* C, int ldc, int N2) {
    __shared__ float As[16][65], Bs[16][64], Bs2[16][64];
    const int t = threadIdx.x, tx = t & 15, ty = t >> 4, m0 = blockIdx.y * 64, n0 = blockIdx.x * 64;
    float acc[4][4] = {}, acc2[4][4] = {};
    for (int k0 = 0; k0 < K; k0 += 16) {
#pragma unroll
        for (int i = 0; i < 4; ++i) { const int idx = t + 256 * i; { const int m = idx >> 4, kk = idx & 15; As[kk][m] = A[(size_t)(m0 + m) * lda + k0 + kk]; }
            { const int kk = idx >> 6, n = idx & 63; Bs[kk][n] = W[(size_t)(k0 + kk) * ldw + n0 + n]; if (MODE == 1) Bs2[kk][n] = W[(size_t)(k0 + kk) * ldw + n0 + n + N2]; } }
        __syncthreads();
#pragma unroll
        for (int kk = 0; kk < 16; ++kk) {
            float a[4], b[4], b2[4];
#pragma unroll
            for (int i = 0; i < 4; ++i) { a[i] = As[kk][ty * 4 + i]; b[i] = Bs[kk][tx * 4 + i]; b2[i] = (MODE == 1) ? Bs2[kk][tx * 4 + i] : 0.f; }
#pragma unroll
            for (int i = 0; i < 4; ++i)
#pragma unroll
                for (int j = 0; j < 4; ++j) { acc[i][j] += a[i] * b[j]; if (MODE == 1) acc2[i][j] += a[i] * b2[j]; }
        }
        __syncthreads();
    }
#pragma unroll
    for (int i = 0; i < 4; ++i)
#pragma unroll
        for (int j = 0; j < 4; ++j) { float v = acc[i][j]; if (MODE == 1) v = v / (1.0f + expf(-v)) * acc2[i][j]; C[(size_t)(m0 + ty * 4 + i) * ldc + n0 + tx * 4 + j] = v; }
}
__global__ void nk_axpy(float* h, const float* d, float s, size_t n) { const size_t i = (size_t)blockIdx.x * 256 + threadIdx.x; if (i < n) h[i] += s * d[i]; }
__global__ void nk_s5(const float* ru, const float* lam_re, const float* lam_im, const float* log_dt, const float* b_re, const float* b_im, const float* c_re, const float* c_im, float* yd) {
    __shared__ float xr_s[64], xi_s[64], us[16], cr[16][64], ci[16][64];
    const int dg = blockIdx.x, dir = dg >> 5, g = dg & 31, n = threadIdx.x;
    const double dt = exp_d((double)log_dt[dg]); const double lr = lam_re[dg * 64 + n], li = lam_im[dg * 64 + n];
    const double mag = exp_d(lr * dt); double sn, cs; sincos_d(li * dt, sn, cs);
    const double are = mag * cs, aim = mag * sn, den = lr * lr + li * li, nre = are - 1.0, cre = (nre * lr + aim * li) / den, cim = (aim * lr - nre * li) / den;
    float bbr[16], bbi[16];
#pragma unroll
    for (int p = 0; p < 16; ++p) { const double br = b_re[(size_t)(dg * 64 + n) * 16 + p], bi = b_im[(size_t)(dg * 64 + n) * 16 + p]; bbr[p] = (float)(cre * br - cim * bi); bbi[p] = (float)(cre * bi + cim * br); }
    for (int i = n; i < 1024; i += 64) { cr[i >> 6][i & 63] = c_re[(size_t)dg * 1024 + i]; ci[i >> 6][i & 63] = c_im[(size_t)dg * 1024 + i]; }
    float xr = 0, xi = 0; const float ar = (float)are, ai = (float)aim;
    __syncthreads();
    for (int s = 0; s < SEQL; ++s) {
        const int t = dir ? SEQL - 1 - s : s;
        if (n < 16) us[n] = ru[(size_t)t * NIN + g * 16 + n];
        __syncthreads();
        float bur = 0, bui = 0;
#pragma unroll
        for (int p = 0; p < 16; ++p) { bur += bbr[p] * us[p]; bui += bbi[p] * us[p]; }
        const float nr = ar * xr - ai * xi + bur, ni = ar * xi + ai * xr + bui; xr = nr; xi = ni;
        xr_s[n] = xr; xi_s[n] = xi;
        __syncthreads();
        if (n < 16) { float y = 0; for (int m = 0; m < 64; ++m) y += xr_s[m] * cr[n][m] - xi_s[m] * ci[n][m]; yd[((size_t)dir * SEQL + t) * 512 + g * 16 + n] = y; }
        __syncthreads();
    }
}
__global__ void nk_s5z(const float* ru, const float* yd, const float* dsk, float* z) {
    const size_t i = (size_t)blockIdx.x * 256 + threadIdx.x; const int t = (int)(i >> 9), ch = (int)(i & 511);
    const float y = dsk[ch] * ru[(size_t)t * NIN + ch] + yd[i] + yd[(size_t)SEQL * 512 + i];
    z[i] = 0.5f * y * (1.0f + tanhf(0.7978845608028654f * (y + 0.044715f * y * y * y)));
}
__global__ void nk_glu(const float* z, const float* zw, float* ycat) { const size_t i = (size_t)blockIdx.x * 256 + threadIdx.x; const int t = (int)(i >> 9), ch = (int)(i & 511); ycat[(size_t)t * DM + ch] = z[i] / (1.0f + expf(-zw[i])); }
__device__ float nk_lb(const float* logits, int layer, int idx) {
    float lg[DEPTH], mx = -1e30f;
#pragma unroll
    for (int l = 0; l < DEPTH; ++l) { lg[l] = logits[l * 1024 + idx]; mx = fmaxf(mx, lg[l]); }
    float sum = 0;
#pragma unroll
    for (int l = 0; l < DEPTH; ++l) { lg[l] = expf(lg[l] - mx); sum += lg[l]; }
    float cum = 0;
#pragma unroll
    for (int l = 0; l < DEPTH; ++l) if (l <= layer) cum += lg[l] / sum;
    return fminf(fmaxf(cum - lg[0] / sum, 0.f), 1.0f - 1e-6f);
}
__global__ void __launch_bounds__(128) nk_hgrn(const float* ru, const float* logits, int layer, float* od, float* sd) {
    __shared__ float qs[128], ks[128], fs[128];
    const int h = blockIdx.x >> 1, dir = blockIdx.x & 1, v = threadIdx.x, col = h * 128 + v;
    const float lb = nk_lb(logits, layer, dir * 512 + col);
    float S[128];
#pragma unroll
    for (int d = 0; d < 128; ++d) S[d] = 0.f;
    for (int s = 0; s < SEQL; ++s) {
        const int t = dir ? SEQL - 1 - s : s; const float* r = ru + (size_t)t * NIN;
        const float z = r[(dir ? 1536 : 1024) + col], sg = 1.0f / (1.0f + expf(-z));
        fs[v] = fmaxf(lb, 1e-30f) + (1.0f - lb) * sg; ks[v] = (1.0f - lb) * (1.0f / (1.0f + expf(z)));
        { const float q = r[512 + col]; qs[v] = q / (1.0f + expf(-q)); }
        const float vt = r[2048 + col];
        __syncthreads();
        float o = 0;
#pragma unroll
        for (int d = 0; d < 128; ++d) { S[d] = fs[d] * S[d] + ks[d] * vt; o += qs[d] * S[d]; }
        od[((size_t)dir * SEQL + t) * 512 + col] = o;
        if (sd && (s == 63 || s == 127)) {
#pragma unroll
            for (int d = 0; d < 128; ++d) sd[(((size_t)(s >> 6) * 8 + blockIdx.x) * 128 + d) * 128 + v] = S[d];
        }
        __syncthreads();
    }
}
__global__ void nk_hgfin(const float* od, const float* ru, const float* gain, float* ycat) {
    __shared__ float red[128]; const int t = blockIdx.x >> 2, h = blockIdx.x & 3, v = threadIdx.x, col = h * 128 + v;
    const float s = od[(size_t)t * 512 + col] + od[((size_t)SEQL + t) * 512 + col];
    red[v] = s * s; __syncthreads();
    for (int o = 64; o >= 1; o >>= 1) { if (v < o) red[v] += red[v + o]; __syncthreads(); }
    const float rstd = 1.0f / sqrtf(red[0] / 128.0f + 1e-6f); const float g = ru[(size_t)t * NIN + 2560 + col];
    ycat[(size_t)t * DM + 512 + col] = s * rstd * gain[v] * (g / (1.0f + expf(-g)));
}
__global__ void nk_qkprep(const float* ru, const float* qn, const float* kn, float* qr, float* kr) {
    __shared__ float red[128], ys[128]; const int t = blockIdx.x / 10, hh = blockIdx.x % 10, d = threadIdx.x;
    const float x = (hh < 8) ? ru[(size_t)t * NIN + 3072 + hh * 128 + d] : ru[(size_t)t * NIN + 4096 + (hh - 8) * 128 + d];
    red[d] = x * x; __syncthreads();
    for (int o = 64; o >= 1; o >>= 1) { if (d < o) red[d] += red[d + o]; __syncthreads(); }
    const float y = x / sqrtf(red[0] / 128.0f + 1e-6f) * ((hh < 8) ? qn[d] : kn[d]);
    ys[d] = y; __syncthreads();
    const int axis = d >> 6, w = d & 63, i = w & 31; const float pos = (float)(axis == 0 ? (t >> 6) : (t & 63));
    const float inv = (float)exp_d(-(double)i / 32.0 * 9.210340371976184); double sn, cs; sincos_d((double)(pos * inv), sn, cs);
    const float o = (w < 32) ? y * (float)cs - ys[d + 32] * (float)sn : y * (float)cs + ys[d - 32] * (float)sn;
    if (hh < 8) qr[(size_t)t * 1024 + hh * 128 + d] = o; else kr[(size_t)t * 256 + (hh - 8) * 128 + d] = o;
}
__global__ void __launch_bounds__(256) nk_attn(const float* qr, const float* kr, const float* ru, float* ycat) {
    __shared__ float ps[4][2048], qs[4][128];
    const int w = threadIdx.x >> 6, lane = threadIdx.x & 63, item = blockIdx.x * 4 + w, h = item >> 11, t = item & 2047, kvh = h >> 2;
    qs[w][lane] = qr[(size_t)t * 1024 + h * 128 + lane]; qs[w][lane + 64] = qr[(size_t)t * 1024 + h * 128 + lane + 64];
    __syncthreads();
    float sc[32], mx = -1e30f;
#pragma unroll
    for (int kb = 0; kb < 32; ++kb) { const float* kp = kr + (size_t)(kb * 64 + lane) * 256 + kvh * 128; float s = 0; for (int d = 0; d < 128; ++d) s += qs[w][d] * kp[d]; sc[kb] = s * 0.08838834764831845f; mx = fmaxf(mx, sc[kb]); }
    for (int o = 32; o >= 1; o >>= 1) mx = fmaxf(mx, __shfl_xor(mx, o));
    float sum = 0;
#pragma unroll
    for (int kb = 0; kb < 32; ++kb) { const float p = expf(sc[kb] - mx); sum += p; ps[w][kb * 64 + lane] = p; }
    for (int o = 32; o >= 1; o >>= 1) sum += __shfl_xor(sum, o);
    __syncthreads();
    float o0 = 0, o1 = 0;
    for (int k = 0; k < SEQL; ++k) { const float p = ps[w][k]; const float* vp = ru + (size_t)k * NIN + 4352 + kvh * 128; o0 += p * vp[lane]; o1 += p * vp[lane + 64]; }
    ycat[(size_t)t * DM + 1024 + h * 128 + lane] = o0 / sum; ycat[(size_t)t * DM + 1024 + h * 128 + lane + 64] = o1 / sum;
}
__global__ void nk_gate(const float* ru, int b, const float* P, float* mg, int first) {
    const size_t i = (size_t)blockIdx.x * 256 + threadIdx.x; const int t = (int)(i >> 11), c = (int)(i & 2047);
    const float g = 1.0f / (1.0f + expf(-ru[(size_t)t * NIN + 4608 + b * 2048 + c]));
    mg[i] = (first ? 0.f : mg[i]) + g * P[i];
}
__global__ void ck_fill0(float* out, size_t n) { for (size_t i = (size_t)blockIdx.x * 256 + threadIdx.x; i < n; i += (size_t)gridDim.x * 256) out[i] = 0.f; }
#ifndef CHK_MODE
#define CHK_MODE 0
#endif
__device__ double ck_rel(const CkStat* st, int i) { return sqrt(st[i].d2 / (st[i].r2 + 1e-30)); }
__global__ void ck_encode(const CkStat* st, const unsigned long long* cks, int nchk, float* out) {
    if (threadIdx.x != 0 || blockIdx.x != 0) return;
    int v = 0;
    if (CHK_MODE == 0) {
        int dp = 48; for (int ph = CK_NPH - 1; ph >= 0; --ph) for (int r = 3; r >= 0; --r) if (cks[(0 * 16 + ph) * 4 + r] != cks[(1 * 16 + ph) * 4 + r]) dp = ph * 4 + r;
        int fi = nchk; for (int i = nchk - 1; i >= 0; --i) if (!(ck_rel(st, i) < 0.03)) fi = i;
        v = dp + 49 * fi;
    } else if (CHK_MODE == 1) {
        for (int r = 0; r < 4; ++r) if (cks[(0 * 16 + 5) * 4 + r] != cks[(1 * 16 + 5) * 4 + r]) v |= 1 << r;
        if (!(ck_rel(st, 19) < 0.03)) v |= 16; if (!(ck_rel(st, 20) < 0.03)) v |= 32; if (!(ck_rel(st, 21) < 0.03)) v |= 64; if (!(ck_rel(st, 11) < 0.03)) v |= 128;
        const double r19 = ck_rel(st, 19); v |= (r19 < 0.03 ? 0 : r19 < 0.3 ? 1 : r19 < 3 ? 2 : 3) << 8;
    } else if (CHK_MODE == 2) {
        if (!(ck_rel(st, 22) < 0.03)) v |= 1; if (!(ck_rel(st, 23) < 0.03)) v |= 2;
        if (cks[(0 * 16 + 5) * 4 + 1] != cks[(1 * 16 + 5) * 4 + 1]) v |= 4;
        if (!(ck_rel(st, 20) < 0.03)) v |= 8; if (!(ck_rel(st, 19) < 0.03)) v |= 16;
        const double r = ck_rel(st, 20); v |= (r < 0.03 ? 0 : r < 0.3 ? 1 : r < 3 ? 2 : 3) << 5;
    } else if (CHK_MODE == 6) {
        int fi = nchk; for (int i = nchk - 1; i >= 0; --i) if (!(ck_rel(st, i) < 0.03)) fi = i;
        v = fi;
    } else if (CHK_MODE == 5) {
        int dp = 48; for (int ph = CK_NPH - 1; ph >= 0; --ph) for (int r = 3; r >= 0; --r) if (cks[(0 * 16 + ph) * 4 + r] != cks[(1 * 16 + ph) * 4 + r]) dp = ph * 4 + r;
        v = dp;
    } else {
        const double rel = ck_rel(st, CHK_MODE - 100); double q = 20.0 * log10(rel + 1e-12) + 200.0; q = q < 0 ? 0 : (q > 1900 ? 1900 : q); v = (int)(q + 0.5);
    }
    out[0] = (float)(10 + v % 80) * __builtin_powif(10.0f, 5 + v / 80);
}

struct CkCtx { void* const* d_in; float* out; unsigned char* ws; hipStream_t s; };
static inline const float* ck_in(const CkCtx& c, int i) { return (const float*)c.d_in[i]; }
static void ck_cksum(const CkCtx& c, int run, int ph, int slot, const void* p, size_t bytes) {
    unsigned long long* o = (unsigned long long*)(c.ws + WS_CHK + CK_CKS) + (run * 16 + ph) * 4 + slot;
    hipLaunchKernelGGL(ck_sum, dim3(2048), dim3(256), 0, c.s, (const unsigned*)p, bytes / 4, o);
}
static void ck_compare(const CkCtx& c, int idx, const void* fast, int is_bf16, long ldf, const float* ref, long ldr, int rows, int cols, int mode) {
    hipLaunchKernelGGL(ck_cmp, dim3(1024), dim3(256), 0, c.s, fast, is_bf16, ldf, ref, ldr, rows, cols, mode, (CkStat*)(c.ws + WS_CHK + CK_STATS) + idx);
}
static void ck_gemm(const CkCtx& c, const float* A, int lda, const float* W, int ldw, int K, float* C, int ldc, int N) { hipLaunchKernelGGL(nk_gemm<0>, dim3(N / 64, 32), dim3(256), 0, c.s, A, lda, W, ldw, K, C, ldc, 0); }
constexpr int CK_NCHK = 20;
static void selfcheck_after_phase(const CkCtx& c, int run, int ph) {
    unsigned char* ws = c.ws; unsigned char* R = ws + WS_R; unsigned char* CK = ws + WS_CHK;
    float* bufA = (float*)(CK + CK_A); float* T0 = (float*)(CK + CK_T0); float* T1 = (float*)(CK + CK_T1); float* T2 = (float*)(CK + CK_T2); float* T3 = (float*)(CK + CK_T3); float* T4 = (float*)(CK + CK_T4);
    const int r0 = CHK_ROW0; const size_t OUTB = (size_t)MT * DM * 4, HBB = (size_t)MT * DM * 2;
    switch (ph) {
    case 0: ck_cksum(c, run, ph, 0, ws + WS_HB, HBB); ck_cksum(c, run, ph, 1, ws + WS_SSQ, (size_t)MT * 128); ck_cksum(c, run, ph, 2, ws + WS_ATAB, WS_LB + 16384 - WS_ATAB); break;
    case 1: ck_cksum(c, run, ph, 0, ws + WS_WB, WB_END); break;
    case 2: case 10: ck_cksum(c, run, ph, 0, R + R_HID, (size_t)MT * DFF * 2); break;
    case 3: case 9: case 11: ck_cksum(c, run, ph, 0, c.out, OUTB); ck_cksum(c, run, ph, 1, ws + WS_HB, HBB); ck_cksum(c, run, ph, 2, ws + WS_SSQ, (size_t)MT * 128); break;
    case 4: ck_cksum(c, run, ph, 0, R + R_US, 6 * SZ512); ck_cksum(c, run, ph, 1, R + R_AQ, 3 * SZ512); ck_cksum(c, run, ph, 2, R + R_GATE, 12 * SZ512); break;
    case 5: ck_cksum(c, run, ph, 0, R + R_YD, 4 * SZ512); ck_cksum(c, run, ph, 1, R + R_OHG, 4 * SZ512); ck_cksum(c, run, ph, 2, R + R_US, SZ512); ck_cksum(c, run, ph, 3, R + R_AQ, 2 * SZ512 + SZ512 / 2); break;
    case 6: ck_cksum(c, run, ph, 0, R + R_YAT, 2 * SZ512); ck_cksum(c, run, ph, 1, R + R_YHG, SZ512); break;
    case 7: ck_cksum(c, run, ph, 0, R + R_YSS, SZ512); break;
    case 8: ck_cksum(c, run, ph, 0, R + R_MRG, 4 * SZ512); break;
    }
    if (run != 0) return;
    const bf16_t* hb = (const bf16_t*)(ws + WS_HB) + (size_t)r0 * DM;
    const int EW = 2048 * 2048 / 256;
    switch (ph) {
    case 0:
        hipLaunchKernelGGL(nk_rows, dim3(EW), dim3(256), 0, c.s, ck_in(c, 0), ck_in(c, 1), r0, T0);
        ck_compare(c, 0, hb, 1, DM, T0, DM, 2048, DM, 0);
        break;
    case 2:
        hipLaunchKernelGGL(nk_rmsnorm, dim3(2048), dim3(256), 0, c.s, T0, ck_in(c, 2), T1);
        hipLaunchKernelGGL(nk_gemm<1>, dim3(DFF / 64, 32), dim3(256), 0, c.s, T1, DM, ck_in(c, 3), 2 * DFF, DM, bufA, DFF, DFF);
        ck_compare(c, 1, (const bf16_t*)(R + R_HID) + (size_t)r0 * DFF, 1, DFF, bufA, DFF, 2048, DFF, 0);
        break;
    case 3:
        ck_gemm(c, bufA, DFF, ck_in(c, 4), DM, DFF, T1, DM, DM);
        hipLaunchKernelGGL(nk_axpy, dim3(EW), dim3(256), 0, c.s, T0, T1, 0.5f, (size_t)2048 * 2048);
        ck_compare(c, 2, c.out + (size_t)r0 * DM, 0, DM, T0, DM, 2048, DM, 0);
        ck_compare(c, 3, hb, 1, DM, T0, DM, 2048, DM, 0);
        break;
    case 4:
        hipLaunchKernelGGL(nk_rmsnorm, dim3(2048), dim3(256), 0, c.s, T0, ck_in(c, 5), T1);
        ck_gemm(c, T1, DM, ck_in(c, 6), NIN, DM, bufA, NIN, NIN);
        ck_compare(c, 4, (const bf16_t*)(R + R_US) + (size_t)r0 * 512, 1, 512, bufA, NIN, 2048, 512, 0);
        for (int k = 0; k < 5; ++k) ck_compare(c, 5, (const bf16_t*)(R + R_HGQ + k * SZ512) + (size_t)r0 * 512, 1, 512, bufA + 512 + 512 * k, NIN, 2048, 512, 0);
        ck_compare(c, 6, (const bf16_t*)(R + R_AQ) + (size_t)r0 * 1024, 1, 1024, bufA + 3072, NIN, 2048, 1024, 0);
        ck_compare(c, 6, (const bf16_t*)(R + R_AK) + (size_t)r0 * 256, 1, 256, bufA + 4096, NIN, 2048, 256, 0);
        ck_compare(c, 6, (const bf16_t*)(R + R_AV) + (size_t)r0 * 256, 1, 256, bufA + 4352, NIN, 2048, 256, 0);
        for (int g = 0; g < 3; ++g) ck_compare(c, 7, (const bf16_t*)(R + R_GATE + (size_t)g * 4 * SZ512) + (size_t)r0 * DM, 1, DM, bufA + 4608 + 2048 * g, NIN, 2048, DM, 1);
        break;
    case 5:
        hipLaunchKernelGGL(nk_s5, dim3(64), dim3(64), 0, c.s, bufA, ck_in(c, 7), ck_in(c, 8), ck_in(c, 9), ck_in(c, 10), ck_in(c, 11), ck_in(c, 12), ck_in(c, 13), T3);
        ck_compare(c, 8, (const float*)(R + R_YD) + (size_t)r0 * 512, 0, 512, T3, 512, 2048, 512, 0);
        ck_compare(c, 8, (const float*)(R + R_YD) + ((size_t)MT + r0) * 512, 0, 512, T3 + (size_t)SEQL * 512, 512, 2048, 512, 0);
        hipLaunchKernelGGL(nk_s5z, dim3(2048 * 512 / 256), dim3(256), 0, c.s, bufA, T3, ck_in(c, 14), T3 + 2 * 1048576);
        ck_compare(c, 9, (const bf16_t*)(R + R_US) + (size_t)r0 * 512, 1, 512, T3 + 2 * 1048576, 512, 2048, 512, 0);
        hipLaunchKernelGGL(nk_qkprep, dim3(2048 * 10), dim3(128), 0, c.s, bufA, ck_in(c, 18), ck_in(c, 19), T4, T4 + 2 * 1048576);
        ck_compare(c, 10, (const bf16_t*)(R + R_AQ) + (size_t)r0 * 1024, 1, 1024, T4, 1024, 2048, 1024, 0);
        ck_compare(c, 10, (const bf16_t*)(R + R_AK) + (size_t)r0 * 256, 1, 256, T4 + 2 * 1048576, 256, 2048, 256, 0);
        ck_gemm(c, T3 + 2 * 1048576, 512, ck_in(c, 15), 512, 512, T1, 512, 512);
        hipLaunchKernelGGL(nk_glu, dim3(2048 * 512 / 256), dim3(256), 0, c.s, T3 + 2 * 1048576, T1, T2);
        hipLaunchKernelGGL(nk_hgrn, dim3(8), dim3(128), 0, c.s, bufA, ck_in(c, 16), 0, T3, T4 + 3 * 1048576);
        ck_compare(c, 22, T4 + 5 * 1048576 / 2, 0, 128, T4 + 3 * 1048576, 128, 8 * 128, 128, 0);
        ck_compare(c, 23, T4 + 5 * 1048576 / 2 + 8 * 128 * 128, 0, 128, T4 + 3 * 1048576 + 8 * 128 * 128, 128, 8 * 128, 128, 0);
        ck_compare(c, 11, (const float*)(R + R_OHG) + (size_t)r0 * 512, 0, 512, T3, 512, 2048, 512, 0);
        ck_compare(c, 11, (const float*)(R + R_OHG) + ((size_t)MT + r0) * 512, 0, 512, T3 + (size_t)SEQL * 512, 512, 2048, 512, 0);
        ck_compare(c, 19, (const float*)(R + R_OHG) + (size_t)r0 * 512, 0, 512, T3, 512, 64, 512, 0);
        ck_compare(c, 20, (const float*)(R + R_OHG) + (size_t)(r0 + 64) * 512, 0, 512, T3 + (size_t)64 * 512, 512, 64, 512, 0);
        ck_compare(c, 21, (const float*)(R + R_OHG) + ((size_t)MT + r0 + 1984) * 512, 0, 512, T3 + (size_t)(SEQL + 1984) * 512, 512, 64, 512, 0);
        break;
    case 6:
        hipLaunchKernelGGL(nk_hgfin, dim3(2048 * 4), dim3(128), 0, c.s, T3, bufA, ck_in(c, 17), T2);
        ck_compare(c, 12, (const bf16_t*)(R + R_YHG) + (size_t)r0 * 512, 1, 512, T2 + 512, DM, 2048, 512, 0);
        hipLaunchKernelGGL(nk_attn, dim3(8 * 2048 / 4), dim3(256), 0, c.s, T4, T4 + 2 * 1048576, bufA, T2);
        ck_compare(c, 13, (const bf16_t*)(R + R_YAT) + (size_t)r0 * 1024, 1, 1024, T2 + 1024, DM, 2048, 1024, 0);
        break;
    case 7: ck_compare(c, 14, (const bf16_t*)(R + R_YSS) + (size_t)r0 * 512, 1, 512, T2, DM, 2048, 512, 0); break;
    case 8:
        ck_gemm(c, T2, DM, ck_in(c, 20), DM, 512, T3, DM, DM);
        hipLaunchKernelGGL(nk_gate, dim3(EW), dim3(256), 0, c.s, bufA, 0, T3, T1, 1);
        ck_gemm(c, T2 + 512, DM, ck_in(c, 20) + (size_t)512 * DM, DM, 512, T3, DM, DM);
        hipLaunchKernelGGL(nk_gate, dim3(EW), dim3(256), 0, c.s, bufA, 1, T3, T1, 0);
        ck_gemm(c, T2 + 1024, DM, ck_in(c, 20) + (size_t)1024 * DM, DM, 1024, T3, DM, DM);
        hipLaunchKernelGGL(nk_gate, dim3(EW), dim3(256), 0, c.s, bufA, 2, T3, T1, 0);
        ck_compare(c, 15, (const bf16_t*)(R + R_MRG) + (size_t)r0 * DM, 1, DM, T1, DM, 2048, DM, 0);
        break;
    case 9:
        ck_gemm(c, T1, DM, ck_in(c, 21), DM, DM, T3, DM, DM);
        hipLaunchKernelGGL(nk_axpy, dim3(EW), dim3(256), 0, c.s, T0, T3, 1.0f, (size_t)2048 * 2048);
        ck_compare(c, 16, c.out + (size_t)r0 * DM, 0, DM, T0, DM, 2048, DM, 0);
        break;
    case 10:
        hipLaunchKernelGGL(nk_rmsnorm, dim3(2048), dim3(256), 0, c.s, T0, ck_in(c, 22), T1);
        hipLaunchKernelGGL(nk_gemm<1>, dim3(DFF / 64, 32), dim3(256), 0, c.s, T1, DM, ck_in(c, 23), 2 * DFF, DM, bufA, DFF, DFF);
        ck_compare(c, 17, (const bf16_t*)(R + R_HID) + (size_t)r0 * DFF, 1, DFF, bufA, DFF, 2048, DFF, 0);
        break;
    case 11:
        ck_gemm(c, bufA, DFF, ck_in(c, 24), DM, DFF, T1, DM, DM);
        hipLaunchKernelGGL(nk_axpy, dim3(EW), dim3(256), 0, c.s, T0, T1, 0.5f, (size_t)2048 * 2048);
        ck_compare(c, 18, c.out + (size_t)r0 * DM, 0, DM, T0, DM, 2048, DM, 0);
        break;
    }
}
static void selfcheck_finish(const CkCtx& c) {
    hipLaunchKernelGGL(ck_fill0, dim3(4096), dim3(256), 0, c.s, c.out, (size_t)MT * DM);
    hipLaunchKernelGGL(ck_encode, dim3(1), dim3(64), 0, c.s, (const CkStat*)(c.ws + WS_CHK + CK_STATS), (const unsigned long long*)(c.ws + WS_CHK + CK_CKS), 19, c.out);
}
#endif
constexpr int PH_PER_LAYER = 11, N_PHASES = 1 + PH_PER_LAYER * DEPTH;
struct Params { const float* in[25]; float* out; unsigned char* ws; int ph_lo, ph_hi; };
static_assert(sizeof(Params) == 27 * 8 + 8, "Params has no padding");

#ifdef SELFCHECK
#define HG_DBG_PTR ((l == 0) ? (float*)(ws + WS_CHK + CK_T4 + 10 * MiB) : nullptr)
#else
#define HG_DBG_PTR nullptr
#endif
template <class Epi>
__device__ __forceinline__ void run_gemm(LAS unsigned char* lds, const bf16_t* A, const bf16_t* Bt, int N, int K, const Epi& E) {
    pg8::Gemm g{A, Bt, MT, N, K}; pg8::StaticOrder S; S.init(MT, N, (int)gridDim.x, (int)blockIdx.x);
    pg8::gemm_phase<Epi, pg8::StaticOrder, true, true>(lds, g, S, E);
}

__global__ void __launch_bounds__(NTHREADS, 2) k_fwd(Params p) {
    extern __shared__ __attribute__((aligned(16))) unsigned char lds_raw[];
    LAS unsigned char* lds = (LAS unsigned char*)lds_raw;
    const int tid = threadIdx.x, G = gridDim.x;
    unsigned char* ws = p.ws; unsigned char* R = ws + WS_R; unsigned char* WB = ws + WS_WB;
    float* ssq = (float*)(ws + WS_SSQ); bf16_t* hb = (bf16_t*)(ws + WS_HB);
    if (tid < 4) ((LAS unsigned*)(lds + LDS_MISC))[tid] = 0u;
    __syncthreads();
    const int lo = p.ph_lo, hi = p.ph_hi;
    XcdBarrier bar; bar.bar = (unsigned*)(ws + WS_BAR); bar.x = 0; bar.st = (volatile LAS unsigned*)(lds + LDS_MISC);
    if (hi - lo > 1) bar = xcd_barrier_post((unsigned*)(ws + WS_BAR), (volatile LAS unsigned*)(lds + LDS_MISC));
#ifndef PH_MASK
#define PH_MASK 0xfff
#endif
#define IN(k) (lo <= (k) && (k) < hi)
#define SEAM(k) do { if (IN(k) && IN((k) + 1)) xcd_barrier(bar); } while (0)

    if ((PH_MASK & 1) && IN(0)) {
        ProArgs A{p.in[0], p.in[1], p.in[7], p.in[8], p.in[9], p.in[10], p.in[11], p.in[12], p.in[13], p.in[16], ws};
        prologue_phase(A);
    }
    SEAM(0);
    for (int l = 0; l < DEPTH; ++l) {
        const int pb = 1 + PH_PER_LAYER * l;
        if (((PH_MASK >> 1) & 1) && IN(pb + 0)) {
            int base = 0;
            { CvtJob J{p.in[3] + (size_t)l * DM * 2 * DFF, p.in[2] + l * DM, (bf16_t*)(WB + WB_GU1), 2 * DFF, DM, 2 * DFF, 1}; cvt_job(lds, J, base); }
            { CvtJob J{p.in[4] + (size_t)l * DFF * DM, nullptr, (bf16_t*)(WB + WB_D1), DM, DFF, DM, 0}; cvt_job(lds, J, base); }
            { CvtJob J{p.in[6] + (size_t)l * DM * NIN, p.in[5] + l * DM, (bf16_t*)(WB + WB_IN), NIN, DM, NIN, 0}; cvt_job(lds, J, base); }
            { CvtJob J{p.in[15] + (size_t)l * 512 * 512, nullptr, (bf16_t*)(WB + WB_GLU), 512, 512, 512, 0}; cvt_job(lds, J, base); }
            { CvtJob J{p.in[20] + (size_t)l * DM * DM, nullptr, (bf16_t*)(WB + WB_BS), DM, 512, DM, 0}; cvt_job(lds, J, base); }
            { CvtJob J{p.in[20] + (size_t)l * DM * DM + (size_t)512 * DM, nullptr, (bf16_t*)(WB + WB_BH), DM, 512, DM, 0}; cvt_job(lds, J, base); }
            { CvtJob J{p.in[20] + (size_t)l * DM * DM + (size_t)1024 * DM, nullptr, (bf16_t*)(WB + WB_BA), DM, 1024, DM, 0}; cvt_job(lds, J, base); }
            { CvtJob J{p.in[21] + (size_t)l * DM * DM, nullptr, (bf16_t*)(WB + WB_OUT), DM, DM, DM, 0}; cvt_job(lds, J, base); }
            { CvtJob J{p.in[23] + (size_t)l * DM * 2 * DFF, p.in[22] + l * DM, (bf16_t*)(WB + WB_GU2), 2 * DFF, DM, 2 * DFF, 1}; cvt_job(lds, J, base); }
            { CvtJob J{p.in[24] + (size_t)l * DFF * DM, nullptr, (bf16_t*)(WB + WB_D2), DM, DFF, DM, 0}; cvt_job(lds, J, base); }
        }
        SEAM(pb + 0);
        if (((PH_MASK >> 2) & 1) && IN(pb + 1)) { epi::Swiglu E{(bf16_t*)(R + R_HID), ssq}; run_gemm(lds, hb, (const bf16_t*)(WB + WB_GU1), 2 * DFF, DM, E); }
        SEAM(pb + 1);
        if (((PH_MASK >> 3) & 1) && IN(pb + 2)) {
            epi::Resid E{l == 0 ? p.in[0] : p.out, l == 0 ? p.in[1] : p.out + (size_t)PROMPT_ROWS * DM, PROMPT_ROWS, 0.5f, p.out, hb, ssq};
            run_gemm(lds, (const bf16_t*)(R + R_HID), (const bf16_t*)(WB + WB_D1), DM, DFF, E);
        }
        SEAM(pb + 2);
        if (((PH_MASK >> 4) & 1) && IN(pb + 3)) { epi::WinSplit E{R, ssq}; run_gemm(lds, hb, (const bf16_t*)(WB + WB_IN), NIN, DM, E); }
        SEAM(pb + 3);
        if (((PH_MASK >> 5) & 1) && IN(pb + 4)) {
            HgArgs H{(const bf16_t*)(R + R_HGQ), (const bf16_t*)(R + R_HGQ + SZ512), (const bf16_t*)(R + R_HGQ + 2 * SZ512), (const bf16_t*)(R + R_HGQ + 3 * SZ512), (float*)(R + R_OHG), (const float*)(ws + WS_LB) + l * 1024, HG_DBG_PTR};
            for (int u = blockIdx.x; u < 160; u += G) hgrn_unit(lds, H, u);
            S5Args S{(bf16_t*)(R + R_US), (float*)(R + R_YD), (const f32x2*)(ws + WS_ATAB) + (size_t)l * 2 * 32 * 64, (const bf16_t*)(ws + WS_BM) + (size_t)l * 64 * 128 * 16, (const bf16_t*)(ws + WS_CM) + (size_t)l * 64 * 16 * 128, p.in[14] + l * 512};
            for (int u = (int)((blockIdx.x + 96u) % (unsigned)G); u < 160; u += G) s5_unit(lds, S, u);
            QkArgs Q{(bf16_t*)(R + R_AQ), (bf16_t*)(R + R_AK), p.in[18] + l * 128, p.in[19] + l * 128};
            qkprep_phase(Q, 0, G);
        }
        SEAM(pb + 4);
        if (((PH_MASK >> 6) & 1) && IN(pb + 5)) {
            for (int u = blockIdx.x; u < NSEQ * 64; u += G) {
                const int qb = u & 7, h = (u >> 3) & 7, b = u >> 6;
                const size_t tok0 = (size_t)b * SEQL;
                att::attn_dense_body((const bf16_t*)(R + R_AQ) + (tok0 + qb * 256) * 1024 + h * 128, (const bf16_t*)(R + R_AK) + tok0 * 256 + (h >> 2) * 128,
                                     (const bf16_t*)(R + R_AV) + tok0 * 256 + (h >> 2) * 128, (bf16_t*)(R + R_YAT) + (tok0 + qb * 256) * 1024 + h * 128, SEQL, (char*)lds_raw);
            }
            HfArgs F{(const float*)(R + R_OHG), (const bf16_t*)(R + R_HGQ + 4 * SZ512), p.in[17] + l * 128, (bf16_t*)(R + R_YHG)};
            hgfin_phase(F);
        }
        SEAM(pb + 5);
        if (((PH_MASK >> 7) & 1) && IN(pb + 6)) { epi::Glu E{(const bf16_t*)(R + R_US), (bf16_t*)(R + R_YSS)}; run_gemm(lds, (const bf16_t*)(R + R_US), (const bf16_t*)(WB + WB_GLU), 512, 512, E); }
        SEAM(pb + 6);
        if (((PH_MASK >> 8) & 1) && IN(pb + 7)) {
            { epi::Merge E{(const bf16_t*)(R + R_GATE), nullptr, (bf16_t*)(R + R_YD)}; run_gemm(lds, (const bf16_t*)(R + R_YSS), (const bf16_t*)(WB + WB_BS), DM, 512, E); }
            WAIT_VM0(); __syncthreads();
            { epi::Merge E{(const bf16_t*)(R + R_GATE + 4 * SZ512), (const bf16_t*)(R + R_YD), (bf16_t*)(R + R_OHG)}; run_gemm(lds, (const bf16_t*)(R + R_YHG), (const bf16_t*)(WB + WB_BH), DM, 512, E); }
            WAIT_VM0(); __syncthreads();
            { epi::Merge E{(const bf16_t*)(R + R_GATE + 8 * SZ512), (const bf16_t*)(R + R_OHG), (bf16_t*)(R + R_MRG)}; run_gemm(lds, (const bf16_t*)(R + R_YAT), (const bf16_t*)(WB + WB_BA), DM, 1024, E); }
        }
        SEAM(pb + 7);
        if (((PH_MASK >> 9) & 1) && IN(pb + 8)) {
            epi::Resid E{p.out, p.out + (size_t)PROMPT_ROWS * DM, PROMPT_ROWS, 1.0f, p.out, hb, ssq};
            run_gemm(lds, (const bf16_t*)(R + R_MRG), (const bf16_t*)(WB + WB_OUT), DM, DM, E);
        }
        SEAM(pb + 8);
        if (((PH_MASK >> 10) & 1) && IN(pb + 9)) { epi::Swiglu E{(bf16_t*)(R + R_HID), ssq}; run_gemm(lds, hb, (const bf16_t*)(WB + WB_GU2), 2 * DFF, DM, E); }
        SEAM(pb + 9);
        if (((PH_MASK >> 11) & 1) && IN(pb + 10)) {
            epi::Resid E{p.out, p.out + (size_t)PROMPT_ROWS * DM, PROMPT_ROWS, 0.5f, p.out, hb, ssq};
            run_gemm(lds, (const bf16_t*)(R + R_HID), (const bf16_t*)(WB + WB_D2), DM, DFF, E);
        }
        SEAM(pb + 10);
    }
#undef IN
#undef SEAM
}

#ifndef N_LAUNCH_MODE
#define N_LAUNCH_MODE 0
#endif
extern "C" void kernel_launch(void* const* d_in, const int* in_sizes, int n_in, void* d_out, int out_size, void* d_ws, size_t ws_size, hipStream_t stream) {
    static int grid = 0;
    if (grid == 0) {
        size_t need = WS_END;
#ifdef SELFCHECK
        need = WS_CHK + CHK_BYTES;
#endif
        if (n_in != 25 || out_size != MT * DM || ws_size < need) { fprintf(stderr, "kernel_launch: unexpected shapes: n_in %d out %d ws %zu (need %zu)\n", n_in, out_size, ws_size, need); grid = -1; return; }
        int dev = 0, cus = 0, per_cu = 0;
        if (hipGetDevice(&dev) != hipSuccess || hipDeviceGetAttribute(&cus, hipDeviceAttributeMultiprocessorCount, dev) != hipSuccess) { grid = -1; return; }
        if (hipFuncSetAttribute((const void*)k_fwd, hipFuncAttributeMaxDynamicSharedMemorySize, LDS_BYTES) != hipSuccess) { fprintf(stderr, "kernel_launch: hipFuncSetAttribute failed\n"); grid = -1; return; }
        if (hipOccupancyMaxActiveBlocksPerMultiprocessor(&per_cu, (const void*)k_fwd, NTHREADS, LDS_BYTES) != hipSuccess || per_cu < 1) { fprintf(stderr, "kernel_launch: occupancy query says %d\n", per_cu); (void)hipGetLastError(); grid = -1; return; }
        grid = cus;
    }
    if (grid < 0) return;
    (void)hipMemsetAsync((char*)d_ws + WS_BAR, 0, 16384, stream);
    Params p{};
    for (int i = 0; i < 25; ++i) p.in[i] = (const float*)d_in[i];
    p.out = (float*)d_out; p.ws = (unsigned char*)d_ws;
#ifdef SELFCHECK
    {
        CkCtx c{d_in, (float*)d_out, (unsigned char*)d_ws, stream};
        (void)hipMemsetAsync((char*)d_ws + WS_CHK, 0, 65536, stream);
        for (int run = 0; run < 2; ++run)
            for (int ph = 0; ph < CK_NPH; ++ph) {
                p.ph_lo = ph; p.ph_hi = ph + 1;
                hipLaunchKernelGGL(k_fwd, dim3(grid), dim3(NTHREADS), LDS_BYTES, stream, p);
                selfcheck_after_phase(c, run, ph);
            }
        selfcheck_finish(c);
    }
#elif N_LAUNCH_MODE == 1
    p.ph_lo = 0; p.ph_hi = N_PHASES;
    hipLaunchKernelGGL(k_fwd, dim3(grid), dim3(NTHREADS), LDS_BYTES, stream, p);
#else
    for (int ph = 0; ph < N_PHASES; ++ph) {
        p.ph_lo = ph; p.ph_hi = ph + 1;
        hipLaunchKernelGGL(k_fwd, dim3(grid), dim3(NTHREADS), LDS_BYTES, stream, p);
    }
#endif
    const hipError_t le = hipPeekAtLastError();
    if (le != hipSuccess) fprintf(stderr, "kernel_launch: launch failed: %s\n", hipGetErrorName(le));
}
```

```cpp
#include <hip/hip_runtime.h>
#include <cstdio>
#include <cstdint>
#include <cstring>

#define LAS __attribute__((address_space(3)))
#define CAS __attribute__((address_space(4)))
#define GAS __attribute__((address_space(1)))
#ifndef CHK_ROW0
#define CHK_ROW0 18432
#endif
typedef unsigned short bf16_t;
typedef short bf16x8 __attribute__((ext_vector_type(8)));
typedef short s16x4 __attribute__((ext_vector_type(4)));
typedef float f32x2 __attribute__((ext_vector_type(2)));
typedef float f32x4 __attribute__((ext_vector_type(4)));
typedef float f32x8 __attribute__((ext_vector_type(8)));
typedef float f32x16 __attribute__((ext_vector_type(16)));
typedef unsigned u32x2 __attribute__((ext_vector_type(2)));
typedef unsigned u32x4 __attribute__((ext_vector_type(4)));

constexpr int MT = 40960;
constexpr int NSEQ = 20, SEQL = 2048, PROMPT_ROWS = 8192;
constexpr int DM = 2048, DFF = 5632, NIN = 10752, DEPTH = 4;
constexpr int NTHREADS = 512;
constexpr int LDS_BYTES = 147456;
constexpr int LDS_MISC = 131072;

#ifndef MRG_FP8
#define MRG_FP8 1
#endif
constexpr int YLD = MRG_FP8 ? 1536 : 2048;
constexpr float YATT_SC = 16.0f, WBR_SC = 32.0f;
constexpr size_t MiB = 1048576;
constexpr size_t WS_BAR  = 0;
constexpr size_t WS_PTAB = 15872;
constexpr size_t WS_SSQ  = 2359296;
constexpr size_t WS_ATAB = 65536;
constexpr size_t WS_BM   = WS_ATAB + 131072;
constexpr size_t WS_CM   = WS_BM + 1048576;
constexpr size_t WS_LB   = WS_CM + 1048576;
constexpr size_t WS_WB   = 8 * MiB; static_assert(WS_LB + 16384 <= WS_SSQ && WS_SSQ + (size_t)MT * 128 <= WS_WB, "small tables");
constexpr size_t WB_GU1 = 0;
constexpr size_t WB_D1  = WB_GU1 + (size_t)11264 * 2048 * 2;
constexpr size_t WB_IN  = WB_D1 + (size_t)2048 * 5632 * 2;
constexpr size_t WB_GLU = WB_IN + (size_t)NIN * 2048 * 2;
constexpr size_t WB_BS  = WB_GLU + (size_t)512 * 512 * 2;
constexpr size_t WB_BH  = WB_BS + (size_t)2048 * 512 * 2;
constexpr size_t WB_BA  = WB_BH + (size_t)2048 * 512 * 2;
constexpr size_t WB_OUT = WB_BA + (size_t)2048 * 1024 * 2;
constexpr size_t WB_GU2 = WB_OUT + (size_t)2048 * 2048 * 2;
constexpr size_t WB_D2  = WB_GU2 + (size_t)11264 * 2048 * 2;
constexpr size_t WB_END = WB_D2 + (size_t)2048 * 5632 * 2;
constexpr size_t WS_HB   = WS_WB + 192 * MiB;
constexpr size_t WS_R    = WS_HB + (size_t)MT * 2048 * 2;
static_assert(WB_END <= 192 * MiB, "weights region");
constexpr size_t R_HID  = 0;
constexpr size_t SZ512  = (size_t)MT * 512 * 2;
constexpr size_t R_US   = 0;
constexpr size_t R_HGQ  = R_US + SZ512;
constexpr size_t R_MRG  = R_HGQ;
constexpr size_t R_AQ   = R_HGQ + 5 * SZ512;
constexpr size_t R_AK   = R_AQ + 2 * SZ512;
constexpr size_t R_AV   = R_AK + SZ512 / 2;
constexpr size_t R_GATE = R_AV + SZ512 / 2;
constexpr size_t R_YD   = R_GATE + 12 * SZ512;
constexpr size_t R_OHG  = R_YD + 4 * SZ512;
constexpr size_t R_YSS  = R_OHG + 4 * SZ512;
constexpr size_t R_HB8  = R_YD;
constexpr size_t R_W8   = R_OHG;
constexpr size_t R_YHG  = R_YSS + SZ512;
constexpr size_t R_YAT  = R_YHG + SZ512;
constexpr size_t R_END  = R_YAT + 2 * SZ512;
static_assert(R_MRG + 4 * SZ512 <= R_HGQ + 4 * SZ512, "merged overlay");
static_assert((size_t)MT * DFF * 2 <= R_END, "hid fits");
static_assert((size_t)MT * DFF * 2 <= R_YD, "hid clear of the fp8 copies");
constexpr size_t WS_END  = WS_R + R_END;
constexpr size_t WS_CHK  = WS_END;

typedef __bf16 bf16x2_n __attribute__((ext_vector_type(2)));
__device__ __forceinline__ unsigned cvtpk(float lo, float hi) { f32x2 v = {lo, hi}; bf16x2_n b = __builtin_convertvector(v, bf16x2_n); return __builtin_bit_cast(unsigned, b); }
__device__ __forceinline__ float bf2f(bf16_t b) { return __uint_as_float(((unsigned)b) << 16); }
__device__ __forceinline__ float bflo(unsigned w) { return __uint_as_float(w << 16); }
__device__ __forceinline__ float bfhi(unsigned w) { return __uint_as_float(w & 0xffff0000u); }
__device__ __forceinline__ bf16_t f2bf(float f) { return (bf16_t)(cvtpk(f, 0.f) & 0xffffu); }
__device__ __forceinline__ float sigm(float x) { return __builtin_amdgcn_rcpf(1.0f + __expf(-x)); }
__device__ __forceinline__ float siluf(float x) { return x * sigm(x); }
__device__ __forceinline__ float gelu_tanh(float x) {
    const float u = 0.7978845608028654f * (x + 0.044715f * x * x * x);
    return x * sigm(2.0f * u);
}
template <int X> __device__ __forceinline__ float xor_f(float v) { static_assert(X >= 1 && X <= 16, "inside a 32-lane half"); return __uint_as_float((unsigned)__builtin_amdgcn_ds_swizzle((int)__float_as_uint(v), (X << 10) | 0x1f)); }
__device__ __forceinline__ float xor32_sum(float v) { auto r = __builtin_amdgcn_permlane32_swap(__float_as_uint(v), __float_as_uint(v), false, false); return __uint_as_float(r[0]) + __uint_as_float(r[1]); }
#define WAIT_VM0() asm volatile("s_waitcnt vmcnt(0)" ::: "memory")
#define WAIT_LGKM0() asm volatile("s_waitcnt lgkmcnt(0)" ::: "memory")
namespace pg8 {
#define PG8_LAS __attribute__((address_space(3)))
typedef unsigned short bf16_t;
typedef short bf16x8 __attribute__((ext_vector_type(8)));
typedef float f32x4 __attribute__((ext_vector_type(4)));
typedef unsigned u32x4 __attribute__((ext_vector_type(4)));
constexpr int BM = 256, BK = 64, HALF = 128, HTB = HALF * BK * 2  , STAGE_BYTES = 8 * HTB, NXCD = 8;
#ifndef PG8_WGM
#define PG8_WGM 4
#endif
constexpr int WGM = PG8_WGM;

__host__ __device__ __forceinline__ int lds_byte(int r, int c) { const int st = (r >> 4) * 2 + (c >> 5), rr = r & 15, cc = c & 31, ob = rr * 64 + cc * 2; return st * 1024 + (ob ^ (((ob >> 9) & 1) << 5)); }
__host__ __device__ __forceinline__ void stage_rc(int b, int& R, int& C) { const int st = b / 1024, sb = b % 1024, swz = sb ^ (((sb >> 9) & 1) << 5); R = (st >> 1) * 16 + swz / 64; C = (st & 1) * 32 + (swz % 64) / 2; }
__host__ __device__ __forceinline__ int perm32(int rho) { const int n = rho >> 4, i = rho & 15; return 8 * (i >> 2) + 4 * n + (i & 3); }

struct Unit { int pm, pn; };
struct Gemm { const bf16_t* A; const bf16_t* Bt; int M, N, K; };

struct StaticOrder {
    int nM, nN, nwg, G, c, wgm, xm, xx, xr, xW;
    __host__ __device__ void init(int M, int N, int G_, int c_, int wgm_ = WGM) { nM = M / BM; nN = N / BM; nwg = nM * nN; G = G_; c = c_; wgm = wgm_; xm = 0; xx = 0; xr = 0; xW = 1; }
    __host__ __device__ void init_x(int x, int rank, int W) { xm = 1; xx = x; xr = rank; xW = W; }
    __host__ __device__ bool next(int i, Unit& u) const {
        int wgid;
        if (xm) { const int q = nwg / NXCD, r = nwg % NXCD, qx = q + (xx < r ? 1 : 0), off = i * xW + xr; if (off >= qx) return false; wgid = (xx < r ? xx * (q + 1) : r * (q + 1) + (xx - r) * q) + off; }
        else {
        const long L = (long)i * G + c; if (L >= nwg) return false;
        wgid = (int)L; { const int q = nwg / NXCD, r = nwg % NXCD, xcd = wgid % NXCD, off = wgid / NXCD; wgid = (xcd < r ? xcd * (q + 1) : r * (q + 1) + (xcd - r) * q) + off; }
        }
        const int nig = wgm * nN, gid = wgid / nig, fm = gid * wgm, gsz = (nM - fm) < wgm ? (nM - fm) : wgm;
        u.pm = fm + ((wgid % nig) % gsz); u.pn = (wgid % nig) / gsz; return true;
    }
    __device__ __forceinline__ void a_ready(const Unit&) const {}
    __device__ __forceinline__ void done(const Unit&) const {}
};


#ifndef PG8_RELAX
#define PG8_RELAX 0
#endif
template <int N> __device__ __forceinline__ void wait_vm() { asm volatile("s_waitcnt vmcnt(%0)" :: "n"(N) : "memory"); }
typedef int pg8_i32x4 __attribute__((ext_vector_type(4)));
typedef int pg8_i32x8 __attribute__((ext_vector_type(8)));
template <class Epi, class Sched, bool ALIGN_EPI = false, bool SP2 = false, int F8FROM = -1>
__device__ __forceinline__ void gemm_phase(PG8_LAS unsigned char* lds, const Gemm g, const Sched& S, const Epi& E) {
    int tid_l = threadIdx.x; asm volatile("" : "+v"(tid_l));
    const int tid = tid_l, wid = __builtin_amdgcn_readfirstlane(tid >> 6), lane = tid & 63, wr = wid >> 2, wc = wid & 3, fr = lane & 15, fq = lane >> 4;
    const int K = g.K, nt = K / BK;
    unsigned voffA[2], voffB[2];
#pragma unroll
    for (int i = 0; i < 2; ++i) { int R, C; stage_rc(tid * 16 + i * 8192, R, C); const int Rb = Epi::PERM ? ((R & ~31) + perm32(R & 31)) : R;
        voffA[i] = (unsigned)(R * K + C) * 2u; voffB[i] = (unsigned)(Rb * K + C) * 2u; }
    const size_t kstep = (size_t)(BK * 2);
    const size_t hstep = (size_t)HALF * K * 2;
    const size_t tstep = 2 * hstep;
    const unsigned ldsw = (unsigned)wid * 1024u;
    const int aoff = lds_byte(wr * 64 + fr, fq * 8), boff = lds_byte(wc * 32 + fr, fq * 8);
#define PG8_SA(b, h) (((b) * 2 + (h)) * HTB)
#define PG8_SB(b, h) ((4 + (b) * 2 + (h)) * HTB)
#define PG8_STAGE(bufoff, gbase, voff) do { _Pragma("unroll") for (int _i = 0; _i < 2; ++_i) \
        __builtin_amdgcn_global_load_lds((const unsigned*)((const char*)(gbase) + (voff)[_i]), (PG8_LAS unsigned*)(lds + (bufoff) + ldsw + _i * 8192), 16, 0, 0); } while (0)
#define PG8_LDA(dst, b, h) do { _Pragma("unroll") for (int m = 0; m < 4; ++m) _Pragma("unroll") for (int k = 0; k < 2; ++k) dst[m][k] = *(const PG8_LAS bf16x8*)(lds + PG8_SA(b, h) + aoff + m * 2048 + k * 1024); } while (0)
#define PG8_LDB(dst, b, h) do { _Pragma("unroll") for (int n = 0; n < 2; ++n) _Pragma("unroll") for (int k = 0; k < 2; ++k) dst[n][k] = *(const PG8_LAS bf16x8*)(lds + PG8_SB(b, h) + boff + n * 2048 + k * 1024); } while (0)
#define PG8_CAT8(lo, hi) __builtin_shufflevector(__builtin_bit_cast(pg8_i32x4, lo), __builtin_bit_cast(pg8_i32x4, hi), 0, 1, 2, 3, 4, 5, 6, 7)
#define PG8_MMA(ai, bj, At, Bt) do { __builtin_amdgcn_s_setprio(1); _Pragma("unroll") for (int m = 0; m < 4; ++m) _Pragma("unroll") for (int n = 0; n < 2; ++n) { \
        if constexpr (F8T) acc[ai][bj][m][n] = __builtin_amdgcn_mfma_scale_f32_16x16x128_f8f6f4(PG8_CAT8(Bt[n][0], Bt[n][1]), PG8_CAT8(At[m][0], At[m][1]), acc[ai][bj][m][n], 0, 0, 0, 0, 0, 0); \
        else { _Pragma("unroll") for (int k = 0; k < 2; ++k) acc[ai][bj][m][n] = __builtin_amdgcn_mfma_f32_16x16x32_bf16(Bt[n][k], At[m][k], acc[ai][bj][m][n], 0, 0, 0); } } __builtin_amdgcn_s_setprio(0); } while (0)
#define PG8_WAIT_V(n) asm volatile("s_waitcnt vmcnt(" #n ")" ::: "memory")
#define PG8_WAIT_L(n) asm volatile("s_waitcnt lgkmcnt(" #n ")" ::: "memory")
#define PG8_BAR __builtin_amdgcn_s_barrier()
#define PG8_SCHED __builtin_amdgcn_sched_barrier(0)
    Unit cur, nxt; int ui = 0;
    if (!S.next(0, cur)) return;
    f32x4 acc[2][2][4][2];
#pragma unroll
    for (int a = 0; a < 2; ++a)
#pragma unroll
        for (int b = 0; b < 2; ++b)
#pragma unroll
            for (int m = 0; m < 4; ++m)
#pragma unroll
                for (int n = 0; n < 2; ++n) acc[a][b][m][n] = (f32x4){0.f, 0.f, 0.f, 0.f};
    bf16x8 At[4][2], B0[2][2], B1[2][2];
    const char* cA = (const char*)g.A + (size_t)cur.pm * tstep; const char* cB = (const char*)g.Bt + (size_t)cur.pn * tstep;
    S.a_ready(cur);
    if constexpr (SP2) {
        PG8_STAGE(PG8_SB(0, 0), cB, voffB); PG8_STAGE(PG8_SB(0, 1), cB + hstep, voffB); PG8_STAGE(PG8_SA(0, 0), cA, voffA); PG8_STAGE(PG8_SA(0, 1), cA + hstep, voffA);
        if (wr == 1) PG8_BAR;
        PG8_WAIT_V(2); PG8_BAR;
        PG8_STAGE(PG8_SB(1, 0), cB + kstep, voffB); PG8_STAGE(PG8_SA(1, 0), cA + kstep, voffA); PG8_STAGE(PG8_SB(1, 1), cB + hstep + kstep, voffB);
        PG8_WAIT_V(6); PG8_BAR;
    } else {
        PG8_STAGE(PG8_SB(0, 0), cB, voffB); PG8_STAGE(PG8_SA(0, 0), cA, voffA); PG8_STAGE(PG8_SB(0, 1), cB + hstep, voffB); PG8_STAGE(PG8_SA(0, 1), cA + hstep, voffA);
        if (wr == 1) PG8_BAR;
        PG8_WAIT_V(4); PG8_BAR;
        PG8_STAGE(PG8_SB(1, 0), cB + kstep, voffB); PG8_STAGE(PG8_SA(1, 0), cA + kstep, voffA); PG8_STAGE(PG8_SB(1, 1), cB + hstep + kstep, voffB);
        PG8_WAIT_V(6); PG8_BAR;
    }
    for (;;) {
        const bool has_next = S.next(ui + 1, nxt);
        const char* nA = has_next ? (const char*)g.A + (size_t)nxt.pm * tstep : cA; const char* nB = has_next ? (const char*)g.Bt + (size_t)nxt.pn * tstep : cB;
        if constexpr (F8FROM > 0) { constexpr bool F8T = false, MID8_ = true, MID16_ = (F8FROM > 16);
        for (int t = 0; t < F8FROM; t += 2) {
            const bool last = (t == nt - 2);
            const char* a1 = cA + (size_t)(t + 1) * kstep;
            const char* a2 = last ? nA : cA + (size_t)(t + 2) * kstep; const char* b2 = last ? nB : cB + (size_t)(t + 2) * kstep;
            const char* a3 = a2 + kstep; const char* b3 = b2 + kstep;
            if (last && has_next) S.a_ready(nxt);
            int relax = __builtin_amdgcn_readfirstlane((PG8_RELAX && (t == 0) && (ui > 0)) ? 1 : 0); asm volatile("" : "+s"(relax));
            if constexpr (Epi::MIDK) { if ((MID8_ && t == 8) || (MID16_ && t == 16)) E.mid(acc, cur, t >> 3, wr, wc, fr, fq); }
            if constexpr (SP2) {
            PG8_LDB(B0, 0, 0); PG8_LDB(B1, 0, 1); PG8_SCHED; PG8_LDA(At, 0, 0); PG8_STAGE(PG8_SA(1, 1), a1 + hstep, voffA);
            if (relax) wait_vm<8 + Epi::NSTORE>(); else PG8_WAIT_V(8); PG8_WAIT_L(0); PG8_BAR; PG8_MMA(0, 0, At, B0); PG8_MMA(0, 1, At, B1); PG8_BAR; PG8_SCHED;
            PG8_LDA(At, 0, 1); PG8_STAGE(PG8_SB(0, 0), b2, voffB); PG8_STAGE(PG8_SB(0, 1), b2 + hstep, voffB); PG8_STAGE(PG8_SA(0, 0), a2, voffA);
            if (relax) wait_vm<8 + Epi::NSTORE>(); else PG8_WAIT_V(8); PG8_WAIT_L(0); PG8_BAR; PG8_MMA(1, 0, At, B0); PG8_MMA(1, 1, At, B1); PG8_BAR; PG8_SCHED;
            PG8_LDB(B0, 1, 0); PG8_LDB(B1, 1, 1); PG8_SCHED; PG8_LDA(At, 1, 0); PG8_STAGE(PG8_SA(0, 1), a2 + hstep, voffA);
            PG8_WAIT_V(8); PG8_WAIT_L(0); PG8_BAR; PG8_MMA(0, 0, At, B0); PG8_MMA(0, 1, At, B1); PG8_BAR; PG8_SCHED;
            PG8_LDA(At, 1, 1); PG8_STAGE(PG8_SB(1, 0), b3, voffB); PG8_STAGE(PG8_SB(1, 1), b3 + hstep, voffB); PG8_STAGE(PG8_SA(1, 0), a3, voffA);
            PG8_WAIT_V(8); PG8_WAIT_L(0); PG8_BAR; PG8_MMA(1, 0, At, B0); PG8_MMA(1, 1, At, B1); PG8_BAR; PG8_SCHED;
            } else {
            PG8_LDB(B0, 0, 0); PG8_SCHED; PG8_LDA(At, 0, 0); PG8_STAGE(PG8_SA(1, 1), a1 + hstep, voffA);
            PG8_WAIT_L(8); PG8_BAR; PG8_WAIT_L(0); PG8_MMA(0, 0, At, B0); PG8_BAR; PG8_SCHED;
            PG8_LDB(B1, 0, 1); PG8_STAGE(PG8_SB(0, 0), b2, voffB);
            PG8_BAR; PG8_WAIT_L(0); PG8_MMA(0, 1, At, B1); PG8_BAR;
            PG8_LDA(At, 0, 1); PG8_STAGE(PG8_SA(0, 0), a2, voffA);
            PG8_BAR; PG8_WAIT_L(0); PG8_MMA(1, 0, At, B0); PG8_BAR; PG8_SCHED;
            PG8_STAGE(PG8_SB(0, 1), b2 + hstep, voffB);
            PG8_WAIT_V(6); PG8_BAR; PG8_MMA(1, 1, At, B1); PG8_BAR;
            PG8_LDB(B0, 1, 0); PG8_SCHED; PG8_LDA(At, 1, 0); PG8_STAGE(PG8_SA(0, 1), a2 + hstep, voffA);
            PG8_WAIT_L(8); PG8_BAR; PG8_WAIT_L(0); PG8_MMA(0, 0, At, B0); PG8_BAR; PG8_SCHED;
            PG8_LDB(B1, 1, 1); PG8_STAGE(PG8_SB(1, 0), b3, voffB);
            PG8_BAR; PG8_WAIT_L(0); PG8_MMA(0, 1, At, B1); PG8_BAR;
            PG8_LDA(At, 1, 1); PG8_STAGE(PG8_SA(1, 0), a3, voffA);
            PG8_BAR; PG8_WAIT_L(0); PG8_MMA(1, 0, At, B0); PG8_BAR; PG8_SCHED;
            PG8_STAGE(PG8_SB(1, 1), b3 + hstep, voffB);
            PG8_WAIT_V(6); PG8_BAR; PG8_MMA(1, 1, At, B1); PG8_BAR;
            }
        } }
        if constexpr (Epi::MIDK && F8FROM == 16) E.mid(acc, cur, 2, wr, wc, fr, fq);
        { constexpr bool F8T = (F8FROM >= 0), MID8_ = (F8FROM <= 0), MID16_ = (F8FROM != 16);
        for (int t = (F8FROM > 0 ? F8FROM : 0); t < nt; t += 2) {
            const bool last = (t == nt - 2);
            const char* a1 = cA + (size_t)(t + 1) * kstep;
            const char* a2 = last ? nA : cA + (size_t)(t + 2) * kstep; const char* b2 = last ? nB : cB + (size_t)(t + 2) * kstep;
            const char* a3 = a2 + kstep; const char* b3 = b2 + kstep;
            if (last && has_next) S.a_ready(nxt);
            int relax = __builtin_amdgcn_readfirstlane((PG8_RELAX && (t == 0) && (ui > 0)) ? 1 : 0); asm volatile("" : "+s"(relax));
            if constexpr (Epi::MIDK) { if ((MID8_ && t == 8) || (MID16_ && t == 16)) E.mid(acc, cur, t >> 3, wr, wc, fr, fq); }
            if constexpr (SP2) {
            PG8_LDB(B0, 0, 0); PG8_LDB(B1, 0, 1); PG8_SCHED; PG8_LDA(At, 0, 0); PG8_STAGE(PG8_SA(1, 1), a1 + hstep, voffA);
            if (relax) wait_vm<8 + Epi::NSTORE>(); else PG8_WAIT_V(8); PG8_WAIT_L(0); PG8_BAR; PG8_MMA(0, 0, At, B0); PG8_MMA(0, 1, At, B1); PG8_BAR; PG8_SCHED;
            PG8_LDA(At, 0, 1); PG8_STAGE(PG8_SB(0, 0), b2, voffB); PG8_STAGE(PG8_SB(0, 1), b2 + hstep, voffB); PG8_STAGE(PG8_SA(0, 0), a2, voffA);
            if (relax) wait_vm<8 + Epi::NSTORE>(); else PG8_WAIT_V(8); PG8_WAIT_L(0); PG8_BAR; PG8_MMA(1, 0, At, B0); PG8_MMA(1, 1, At, B1); PG8_BAR; PG8_SCHED;
            PG8_LDB(B0, 1, 0); PG8_LDB(B1, 1, 1); PG8_SCHED; PG8_LDA(At, 1, 0); PG8_STAGE(PG8_SA(0, 1), a2 + hstep, voffA);
            PG8_WAIT_V(8); PG8_WAIT_L(0); PG8_BAR; PG8_MMA(0, 0, At, B0); PG8_MMA(0, 1, At, B1); PG8_BAR; PG8_SCHED;
            PG8_LDA(At, 1, 1); PG8_STAGE(PG8_SB(1, 0), b3, voffB); PG8_STAGE(PG8_SB(1, 1), b3 + hstep, voffB); PG8_STAGE(PG8_SA(1, 0), a3, voffA);
            PG8_WAIT_V(8); PG8_WAIT_L(0); PG8_BAR; PG8_MMA(1, 0, At, B0); PG8_MMA(1, 1, At, B1); PG8_BAR; PG8_SCHED;
            } else {
            PG8_LDB(B0, 0, 0); PG8_SCHED; PG8_LDA(At, 0, 0); PG8_STAGE(PG8_SA(1, 1), a1 + hstep, voffA);
            PG8_WAIT_L(8); PG8_BAR; PG8_WAIT_L(0); PG8_MMA(0, 0, At, B0); PG8_BAR; PG8_SCHED;
            PG8_LDB(B1, 0, 1); PG8_STAGE(PG8_SB(0, 0), b2, voffB);
            PG8_BAR; PG8_WAIT_L(0); PG8_MMA(0, 1, At, B1); PG8_BAR;
            PG8_LDA(At, 0, 1); PG8_STAGE(PG8_SA(0, 0), a2, voffA);
            PG8_BAR; PG8_WAIT_L(0); PG8_MMA(1, 0, At, B0); PG8_BAR; PG8_SCHED;
            PG8_STAGE(PG8_SB(0, 1), b2 + hstep, voffB);
            PG8_WAIT_V(6); PG8_BAR; PG8_MMA(1, 1, At, B1); PG8_BAR;
            PG8_LDB(B0, 1, 0); PG8_SCHED; PG8_LDA(At, 1, 0); PG8_STAGE(PG8_SA(0, 1), a2 + hstep, voffA);
            PG8_WAIT_L(8); PG8_BAR; PG8_WAIT_L(0); PG8_MMA(0, 0, At, B0); PG8_BAR; PG8_SCHED;
            PG8_LDB(B1, 1, 1); PG8_STAGE(PG8_SB(1, 0), b3, voffB);
            PG8_BAR; PG8_WAIT_L(0); PG8_MMA(0, 1, At, B1); PG8_BAR;
            PG8_LDA(At, 1, 1); PG8_STAGE(PG8_SA(1, 0), a3, voffA);
            PG8_BAR; PG8_WAIT_L(0); PG8_MMA(1, 0, At, B0); PG8_BAR; PG8_SCHED;
            PG8_STAGE(PG8_SB(1, 1), b3 + hstep, voffB);
            PG8_WAIT_V(6); PG8_BAR; PG8_MMA(1, 1, At, B1); PG8_BAR;
            }
        } }
        if constexpr (ALIGN_EPI) { if (wr == 0) PG8_BAR; }
        if constexpr (!Epi::AFTER_DRAIN) { E(acc, cur, wr, wc, fr, fq); S.done(cur); }
        if (!has_next) break;
#pragma unroll
        for (int a = 0; a < 2; ++a)
#pragma unroll
            for (int b = 0; b < 2; ++b)
#pragma unroll
                for (int m = 0; m < 4; ++m)
#pragma unroll
                    for (int n = 0; n < 2; ++n) acc[a][b][m][n] = (f32x4){0.f, 0.f, 0.f, 0.f};
        cur = nxt; cA = nA; cB = nB; ++ui;
        if constexpr (ALIGN_EPI) { if (wr == 1) PG8_BAR; }
    }
    PG8_WAIT_V(0);
    if constexpr (!ALIGN_EPI) { if (wr == 0) PG8_BAR; }
    PG8_BAR;
    if constexpr (Epi::AFTER_DRAIN) { E.fused(acc, cur, wr, wc, fr, fq, lds, wid, lane); S.done(cur); }
#undef PG8_SA
#undef PG8_SB
#undef PG8_STAGE
#undef PG8_LDA
#undef PG8_LDB
#undef PG8_MMA
#undef PG8_WAIT_V
#undef PG8_WAIT_L
#undef PG8_BAR
#undef PG8_SCHED
}
}
namespace epi {
using pg8::Unit;
constexpr float RMS_EPS = 1e-6f;
__device__ __forceinline__ float row_rstd(const float* ssq, int row) {
    const f32x4* p = (const f32x4*)(ssq + (size_t)row * 32);
    f32x4 a = p[0] + p[1], b = p[2] + p[3], c = p[4] + p[5], d = p[6] + p[7];
    a = (a + b) + (c + d);
    return __builtin_amdgcn_rsqf(((a[0] + a[1]) + (a[2] + a[3])) * (1.0f / 2048.0f) + RMS_EPS);
}

__device__ __forceinline__ void unit_rstd_table(const float* ssq, LAS float* tab, int pm, int wr, int wc, int fr, int fq) {
    const int have = __builtin_amdgcn_readfirstlane(((volatile LAS int*)tab)[256]);
    if (have != pm) {
        const int t = (wr * 4 + wc) * 64 + fq * 16 + fr, row = t >> 1, h = t & 1;
        const f32x4* p = (const f32x4*)(ssq + (size_t)(pm * 256 + row) * 32 + h * 16);
        f32x4 a = (p[0] + p[1]) + (p[2] + p[3]);
        float s = (a[0] + a[1]) + (a[2] + a[3]);
        s += xor_f<1>(s);
        if (h == 0) tab[row] = __builtin_amdgcn_rsqf(s * (1.0f / 2048.0f) + RMS_EPS);
        asm volatile("s_waitcnt lgkmcnt(0)" ::: "memory"); __builtin_amdgcn_s_barrier(); asm volatile("" ::: "memory");
        if (t == 0) ((volatile LAS int*)tab)[256] = pm;
    }
}

struct Swiglu {
    static constexpr bool PERM = true, AFTER_DRAIN = false, MIDK = false; static constexpr int NSTORE = 8;
    bf16_t* H; const float* ssq; LAS float* tab;
    __device__ __forceinline__ void operator()(const f32x4 (&acc)[2][2][4][2], const Unit& u, int wr, int wc, int fr, int fq) const {
        const int row0 = u.pm * 256 + wr * 64 + fr, col0 = u.pn * 128 + wc * 32 + 8 * fq;
        unit_rstd_table(ssq, tab, u.pm, wr, wc, fr, fq);
#pragma unroll
        for (int ai = 0; ai < 2; ++ai)
#pragma unroll
            for (int m = 0; m < 4; ++m) {
                const int row = row0 + ai * 128 + m * 16;
                const float rstd = tab[wr * 64 + fr + ai * 128 + m * 16];
                float o[8];
#pragma unroll
                for (int n = 0; n < 2; ++n)
#pragma unroll
                    for (int j = 0; j < 4; ++j) { const float g = acc[ai][0][m][n][j] * rstd, up = acc[ai][1][m][n][j] * rstd; o[n * 4 + j] = siluf(g) * up; }
                u32x4 w; w.x = cvtpk(o[0], o[1]); w.y = cvtpk(o[2], o[3]); w.z = cvtpk(o[4], o[5]); w.w = cvtpk(o[6], o[7]);
                __builtin_nontemporal_store(w, (u32x4*)(H + (size_t)row * DFF + col0));
            }
    }
};

#ifndef RESID_NB
#define RESID_NB 1
#endif
__device__ __forceinline__ u32x2 pk8_fp8(const f32x4& a, const f32x4& b) {
    int p0 = __builtin_amdgcn_cvt_pk_fp8_f32(a[0], a[1], 0, false); p0 = __builtin_amdgcn_cvt_pk_fp8_f32(a[2], a[3], p0, true);
    int p1 = __builtin_amdgcn_cvt_pk_fp8_f32(b[0], b[1], 0, false); p1 = __builtin_amdgcn_cvt_pk_fp8_f32(b[2], b[3], p1, true);
    u32x2 r; r.x = (unsigned)p0; r.y = (unsigned)p1; return r;
}
template <bool BASEF32, bool OUTF32, bool F8 = false>
struct Resid {
    static constexpr bool PERM = true, AFTER_DRAIN = false, MIDK = false; static constexpr int NSTORE = 16;
    const float* base0; const float* base1; int split_row; float scale; float* out; bf16_t* hb; float* ssq_out; unsigned char* hb8;
    __device__ __forceinline__ void operator()(const f32x4 (&acc)[2][2][4][2], const Unit& u, int wr, int wc, int fr, int fq) const {
        const int row0 = u.pm * 256 + wr * 64 + fr, col0 = u.pn * 256 + wc * 32 + 8 * fq;
        if constexpr (BASEF32) {
            const int prow = u.pm * 256;
            const float* bsel = (prow < split_row) ? base0 : base1 - (size_t)split_row * DM;
            size_t rowoff = ((size_t)row0 * DM + col0);
            asm volatile("" : "+v"(rowoff));
            const char* bp0 = (const char*)(bsel + rowoff); char* hp = (char*)(hb + rowoff);
#pragma unroll
            for (int ai = 0; ai < 2; ++ai) {
                f32x4 b[4][2][2];
#pragma unroll
                for (int m = 0; m < 4; ++m)
#pragma unroll
                    for (int bj = 0; bj < 2; ++bj) { const float* bp = (const float*)(bp0 + ((size_t)(ai * 128 + m * 16) * DM + bj * 128) * 4); b[m][bj][0] = *(const f32x4*)bp; b[m][bj][1] = *(const f32x4*)(bp + 4); }
                __builtin_amdgcn_sched_barrier(0);
#pragma unroll
                for (int m = 0; m < 4; ++m) { const int row = row0 + ai * 128 + m * 16; float s = 0.f;
#pragma unroll
                    for (int bj = 0; bj < 2; ++bj) {
                        const f32x4 o0 = b[m][bj][0] + acc[ai][bj][m][0] * scale, o1 = b[m][bj][1] + acc[ai][bj][m][1] * scale;
                        s += (o0[0] * o0[0] + o0[1] * o0[1]) + (o0[2] * o0[2] + o0[3] * o0[3]) + (o1[0] * o1[0] + o1[1] * o1[1]) + (o1[2] * o1[2] + o1[3] * o1[3]);
                        u32x4 w; w.x = cvtpk(o0[0], o0[1]); w.y = cvtpk(o0[2], o0[3]); w.z = cvtpk(o1[0], o1[1]); w.w = cvtpk(o1[2], o1[3]);
                        *(u32x4*)(hp + ((size_t)(ai * 128 + m * 16) * DM + bj * 128) * 2) = w;
                        if constexpr (F8) *(u32x2*)(hb8 + rowoff + ((size_t)(ai * 128 + m * 16) * DM + bj * 128)) = pk8_fp8(o0, o1);
                    }
                    s += xor_f<16>(s); s = xor32_sum(s);
                    if (fq == 0) ssq_out[(size_t)row * 32 + u.pn * 4 + wc] = s;
                }
                __builtin_amdgcn_sched_barrier(0);
            }
        } else {
            size_t rowoff = ((size_t)row0 * DM + col0) * 2;
            asm volatile("" : "+v"(rowoff));
            char* hp = (char*)hb + rowoff; char* op0 = (char*)out + 2 * rowoff; (void)op0;
#pragma unroll
            for (int ai = 0; ai < RESID_NB; ++ai) {
                constexpr int NA = 2 / RESID_NB;
                u32x4 b[NA][4][2];
#pragma unroll
                for (int a2 = 0; a2 < NA; ++a2)
#pragma unroll
                    for (int m = 0; m < 4; ++m)
#pragma unroll
                        for (int bj = 0; bj < 2; ++bj) b[a2][m][bj] = *(const u32x4*)(hp + ((size_t)((ai * NA + a2) * 128 + m * 16) * DM + bj * 128) * 2);
                __builtin_amdgcn_sched_barrier(0);
#pragma unroll
                for (int a2 = 0; a2 < NA; ++a2)
#pragma unroll
                    for (int m = 0; m < 4; ++m) { const int aa = ai * NA + a2; const int row = row0 + aa * 128 + m * 16; float s = 0.f;
#pragma unroll
                        for (int bj = 0; bj < 2; ++bj) {
                            const u32x4 bb = b[a2][m][bj];
                            const f32x4 h0 = {bflo(bb.x), bfhi(bb.x), bflo(bb.y), bfhi(bb.y)}, h1 = {bflo(bb.z), bfhi(bb.z), bflo(bb.w), bfhi(bb.w)};
                            const f32x4 o0 = h0 + acc[aa][bj][m][0] * scale, o1 = h1 + acc[aa][bj][m][1] * scale;
                            if constexpr (OUTF32) {
                                float* op = (float*)(op0 + ((size_t)(aa * 128 + m * 16) * DM + bj * 128) * 4); *(f32x4*)op = o0; *(f32x4*)(op + 4) = o1;
                            } else {
                                s += (o0[0] * o0[0] + o0[1] * o0[1]) + (o0[2] * o0[2] + o0[3] * o0[3]) + (o1[0] * o1[0] + o1[1] * o1[1]) + (o1[2] * o1[2] + o1[3] * o1[3]);
                                u32x4 w; w.x = cvtpk(o0[0], o0[1]); w.y = cvtpk(o0[2], o0[3]); w.z = cvtpk(o1[0], o1[1]); w.w = cvtpk(o1[2], o1[3]);
                                *(u32x4*)(hp + ((size_t)(aa * 128 + m * 16) * DM + bj * 128) * 2) = w;
                                if constexpr (F8) *(u32x2*)(hb8 + (rowoff >> 1) + ((size_t)(aa * 128 + m * 16) * DM + bj * 128)) = pk8_fp8(o0, o1);
                            }
                        }
                        if constexpr (!OUTF32) { s += xor_f<16>(s); s = xor32_sum(s); if (fq == 0) ssq_out[(size_t)row * 32 + u.pn * 4 + wc] = s; }
                    }
                __builtin_amdgcn_sched_barrier(0);
            }
        }
    }
};

struct WinSplit {
    static constexpr bool PERM = true, AFTER_DRAIN = false, MIDK = false; static constexpr int NSTORE = 16;
    unsigned char* R; const float* ssq; LAS float* tab; unsigned* kdone; int pn0; float sc;
    template <int ACT, bool WT = false>
    __device__ __forceinline__ void body(const f32x4 (&acc)[2][2][4][2], bf16_t* dst, int ld, int row0, int col0, int wr, int fr) const {
#pragma unroll
        for (int ai = 0; ai < 2; ++ai)
#pragma unroll
            for (int m = 0; m < 4; ++m) {
                const int row = row0 + ai * 128 + m * 16;
                const float rstd = tab[wr * 64 + fr + ai * 128 + m * 16] * sc;
#pragma unroll
                for (int bj = 0; bj < 2; ++bj) {
                    f32x4 v0 = acc[ai][bj][m][0] * rstd, v1 = acc[ai][bj][m][1] * rstd;
                    if (ACT == 1) {
#pragma unroll
                        for (int j = 0; j < 4; ++j) { v0[j] = 1.0f + __expf(fminf(-v0[j], 30.f)); v1[j] = 1.0f + __expf(fminf(-v1[j], 30.f)); }
                    }
                    if (ACT == 2) {
#pragma unroll
                        for (int j = 0; j < 4; ++j) { v0[j] = siluf(v0[j]); v1[j] = siluf(v1[j]); }
                    }
                    u32x4 w; w.x = cvtpk(v0[0], v0[1]); w.y = cvtpk(v0[2], v0[3]); w.z = cvtpk(v1[0], v1[1]); w.w = cvtpk(v1[2], v1[3]);
                    if (WT) { unsigned long long* q8 = (unsigned long long*)(dst + (size_t)row * ld + col0 + bj * 128);
                        __hip_atomic_store(q8, ((unsigned long long)w.y << 32) | w.x, __ATOMIC_RELAXED, __HIP_MEMORY_SCOPE_AGENT); __hip_atomic_store(q8 + 1, ((unsigned long long)w.w << 32) | w.z, __ATOMIC_RELAXED, __HIP_MEMORY_SCOPE_AGENT); }
                    else __builtin_nontemporal_store(w, (u32x4*)(dst + (size_t)row * ld + col0 + bj * 128));
                }
            }
    }
    __device__ __forceinline__ void body_gate(const f32x4 (&acc)[2][2][4][2], unsigned char* dst, int row0, int col0, int wr, int fr) const {
#pragma unroll
        for (int ai = 0; ai < 2; ++ai)
#pragma unroll
            for (int m = 0; m < 4; ++m) {
                const int row = row0 + ai * 128 + m * 16;
                const float rstd = tab[wr * 64 + fr + ai * 128 + m * 16] * sc;
#pragma unroll
                for (int bj = 0; bj < 2; ++bj) {
                    const f32x4 v0 = acc[ai][bj][m][0] * rstd, v1 = acc[ai][bj][m][1] * rstd;
                    unsigned lo = 0u, hi = 0u;
#pragma unroll
                    for (int j = 0; j < 4; ++j) {
                        lo = __builtin_amdgcn_cvt_pk_u8_f32(fmaxf(sigm(v0[j]) * 255.0f, 1.0f), j, lo);
                        hi = __builtin_amdgcn_cvt_pk_u8_f32(fmaxf(sigm(v1[j]) * 255.0f, 1.0f), j, hi);
                    }
                    u32x2 w; w.x = lo; w.y = hi;
                    __builtin_nontemporal_store(w, (u32x2*)(dst + (size_t)row * DM + col0 + bj * 128));
                }
            }
    }
    __device__ __forceinline__ void operator()(const f32x4 (&acc)[2][2][4][2], const Unit& u, int wr, int wc, int fr, int fq) const {
        const int pn = __builtin_amdgcn_readfirstlane(u.pn) + pn0; bf16_t* dst; int ld, colt;
        if (pn < 12)       { dst = (bf16_t*)(R + R_US + (size_t)(pn >> 1) * SZ512); ld = 512; colt = (pn & 1) * 256; }
        else if (pn < 16)  { dst = (bf16_t*)(R + R_AQ); ld = 1024; colt = (pn - 12) * 256; }
        else if (pn == 16) { dst = (bf16_t*)(R + R_AK); ld = 256; colt = 0; }
        else if (pn == 17) { dst = (bf16_t*)(R + R_AV); ld = 256; colt = 0; }
        else { const int g = (pn - 18) >> 3; dst = (bf16_t*)(R + R_GATE + (size_t)g * 4 * SZ512); ld = 2048; colt = ((pn - 18) & 7) * 256; }
        const int row0 = u.pm * 256 + wr * 64 + fr, col0 = colt + wc * 32 + 8 * fq;
        unit_rstd_table(ssq, tab, u.pm, wr, wc, fr, fq);
        if (pn >= 18) body_gate(acc, R + R_GATE + (size_t)((pn - 18) >> 3) * MT * DM, row0, col0, wr, fr);
        else if (pn == 2 || pn == 3) body<2>(acc, dst, ld, row0, col0, wr, fr);
        else if (pn == 16) {
            body<0, true>(acc, dst, ld, row0, col0, wr, fr);
            asm volatile("s_waitcnt vmcnt(0)" ::: "memory");
            if ((fr | fq) == 0) __hip_atomic_fetch_add(kdone, 1u, __ATOMIC_RELAXED, __HIP_MEMORY_SCOPE_AGENT);
        }
        else body<0>(acc, dst, ld, row0, col0, wr, fr);
    }
};

struct Glu {
    static constexpr bool PERM = true, AFTER_DRAIN = false, MIDK = false; static constexpr int NSTORE = 16;
    const bf16_t* Z; bf16_t* Y;
    __device__ __forceinline__ void operator()(const f32x4 (&acc)[2][2][4][2], const Unit& u, int wr, int wc, int fr, int fq) const {
        const int row0 = u.pm * 256 + wr * 64 + fr, col0 = u.pn * 256 + wc * 32 + 8 * fq;
#pragma unroll
        for (int ai = 0; ai < 2; ++ai) {
            u32x4 zz[4][2];
#pragma unroll
            for (int m = 0; m < 4; ++m)
#pragma unroll
                for (int bj = 0; bj < 2; ++bj) zz[m][bj] = *(const u32x4*)(Z + (size_t)(row0 + ai * 128 + m * 16) * 512 + col0 + bj * 128);
            __builtin_amdgcn_sched_barrier(0);
#pragma unroll
            for (int m = 0; m < 4; ++m)
#pragma unroll
                for (int bj = 0; bj < 2; ++bj) {
                    const size_t offy = (size_t)(row0 + ai * 128 + m * 16) * YLD + col0 + bj * 128;
                    const u32x4 z = zz[m][bj];
                    const f32x4 a0 = acc[ai][bj][m][0], a1 = acc[ai][bj][m][1];
                    u32x4 w;
                    w.x = cvtpk(bflo(z.x) * sigm(a0[0]), bfhi(z.x) * sigm(a0[1])); w.y = cvtpk(bflo(z.y) * sigm(a0[2]), bfhi(z.y) * sigm(a0[3]));
                    w.z = cvtpk(bflo(z.z) * sigm(a1[0]), bfhi(z.z) * sigm(a1[1])); w.w = cvtpk(bflo(z.w) * sigm(a1[2]), bfhi(z.w) * sigm(a1[3]));
                    *(u32x4*)(Y + offy) = w;
                }
            __builtin_amdgcn_sched_barrier(0);
        }
    }
};

#ifndef MID_NB
#define MID_NB 1
#endif
struct MergeFused {
    static constexpr bool PERM = true, AFTER_DRAIN = false, MIDK = true; static constexpr int NSTORE = 16;
    const unsigned char* G; bf16_t* Mg;
#define UB0(w) ((float)((w) & 0xffu))
#define UB1(w) ((float)(((w) >> 8) & 0xffu))
#define UB2(w) ((float)(((w) >> 16) & 0xffu))
#define UB3(w) ((float)((w) >> 24))
    __device__ __forceinline__ void mid(f32x4 (&acc)[2][2][4][2], const Unit& u, int b, int wr, int wc, int fr, int fq) const {
        const int row0 = u.pm * 256 + wr * 64 + fr, col0 = u.pn * 256 + wc * 32 + 8 * fq;
        size_t rowoff = (size_t)row0 * DM + col0;
        asm volatile("" : "+v"(rowoff));
        const unsigned char* Ga = G + (size_t)(b - 1) * MT * DM + rowoff; const unsigned char* Gb = G + (size_t)b * MT * DM + rowoff;
#pragma unroll
        for (int ai = 0; ai < 2; ++ai) {
            u32x2 ga[4][2], gb[4][2];
#pragma unroll
            for (int mm = 0; mm < 4; ++mm)
#pragma unroll
                for (int bj = 0; bj < 2; ++bj) {
                    const size_t off = (size_t)(ai * 128 + mm * 16) * DM + bj * 128;
                    asm volatile("global_load_dwordx2 %0, %1, off" : "=&v"(ga[mm][bj]) : "v"(Ga + off) : "memory");
                    asm volatile("global_load_dwordx2 %0, %1, off" : "=&v"(gb[mm][bj]) : "v"(Gb + off) : "memory");
                }
            asm volatile("s_waitcnt vmcnt(0)" ::: "memory");
#pragma unroll
            for (int m = 0; m < 4; ++m)
#pragma unroll
                for (int bj = 0; bj < 2; ++bj) {
                    u32x2 a = ga[m][bj], c = gb[m][bj];
                    asm volatile("" : "+v"(a), "+v"(c));
                    f32x4 r0, r1;
                    r0[0] = UB0(a.x) * __builtin_amdgcn_rcpf(UB0(c.x)); r0[1] = UB1(a.x) * __builtin_amdgcn_rcpf(UB1(c.x));
                    r0[2] = UB2(a.x) * __builtin_amdgcn_rcpf(UB2(c.x)); r0[3] = UB3(a.x) * __builtin_amdgcn_rcpf(UB3(c.x));
                    r1[0] = UB0(a.y) * __builtin_amdgcn_rcpf(UB0(c.y)); r1[1] = UB1(a.y) * __builtin_amdgcn_rcpf(UB1(c.y));
                    r1[2] = UB2(a.y) * __builtin_amdgcn_rcpf(UB2(c.y)); r1[3] = UB3(a.y) * __builtin_amdgcn_rcpf(UB3(c.y));
                    if (MRG_FP8 && b == 2) { r0 = r0 * (YATT_SC * WBR_SC); r1 = r1 * (YATT_SC * WBR_SC); }
                    acc[ai][bj][m][0] = acc[ai][bj][m][0] * r0; acc[ai][bj][m][1] = acc[ai][bj][m][1] * r1;
                }
        }
    }
    __device__ __forceinline__ void operator()(const f32x4 (&acc)[2][2][4][2], const Unit& u, int wr, int wc, int fr, int fq) const {
        const int row0 = u.pm * 256 + wr * 64 + fr, col0 = u.pn * 256 + wc * 32 + 8 * fq;
        size_t rowoff = (size_t)row0 * DM + col0;
        asm volatile("" : "+v"(rowoff));
        const unsigned char* G2 = G + (size_t)2 * MT * DM + rowoff; char* Mo = (char*)Mg + 2 * rowoff;
        constexpr float FS = (1.0f / 255.0f) * (MRG_FP8 ? 1.0f / (YATT_SC * WBR_SC) : 1.0f);
#pragma unroll
        for (int ai = 0; ai < 2; ++ai) {
            u32x2 gg[4][2];
#pragma unroll
            for (int m = 0; m < 4; ++m)
#pragma unroll
                for (int bj = 0; bj < 2; ++bj) asm volatile("global_load_dwordx2 %0, %1, off" : "=&v"(gg[m][bj]) : "v"(G2 + ((size_t)(ai * 128 + m * 16) * DM + bj * 128)) : "memory");
            asm volatile("s_waitcnt vmcnt(0)" ::: "memory");
#pragma unroll
            for (int m = 0; m < 4; ++m)
#pragma unroll
                for (int bj = 0; bj < 2; ++bj) {
                    u32x2 g = gg[m][bj]; asm volatile("" : "+v"(g));
                    const f32x4 a0 = acc[ai][bj][m][0] * FS, a1 = acc[ai][bj][m][1] * FS;
                    u32x4 w;
                    w.x = cvtpk(UB0(g.x) * a0[0], UB1(g.x) * a0[1]); w.y = cvtpk(UB2(g.x) * a0[2], UB3(g.x) * a0[3]);
                    w.z = cvtpk(UB0(g.y) * a1[0], UB1(g.y) * a1[1]); w.w = cvtpk(UB2(g.y) * a1[2], UB3(g.y) * a1[3]);
                    *(u32x4*)(Mo + ((size_t)(ai * 128 + m * 16) * DM + bj * 128) * 2) = w;
                }
        }
    }
#undef UB0
#undef UB1
#undef UB2
#undef UB3
};
struct NullEpi {
    static constexpr bool PERM = true, AFTER_DRAIN = false, MIDK = false; static constexpr int NSTORE = 0;
    float* sink;
    __device__ __forceinline__ void operator()(const f32x4 (&acc)[2][2][4][2], const Unit& u, int wr, int wc, int fr, int fq) const {
        f32x4 s = {0.f, 0.f, 0.f, 0.f};
#pragma unroll
        for (int ai = 0; ai < 2; ++ai)
#pragma unroll
            for (int bj = 0; bj < 2; ++bj)
#pragma unroll
                for (int m = 0; m < 4; ++m) { s = s + acc[ai][bj][m][0]; s = s + acc[ai][bj][m][1]; }
        const float t = (s[0] + s[1]) + (s[2] + s[3]);
        if (t == 1.2345e37f) sink[u.pm] = t;
    }
};
}
#define LDS_BARRIER() do { asm volatile("s_waitcnt lgkmcnt(0)" ::: "memory"); __builtin_amdgcn_s_barrier(); asm volatile("" ::: "memory"); } while (0)
#define MFMA16(a, b, c) __builtin_amdgcn_mfma_f32_16x16x32_bf16((a), (b), (c), 0, 0, 0)
#define MFMA32(a, b, c) __builtin_amdgcn_mfma_f32_32x32x16_bf16((a), (b), (c), 0, 0, 0)

struct CvtJob { const float* W; const float* gain; bf16_t* dst; int ldw, K, Np, mode, ldd; };
__device__ __forceinline__ int cvt_col(int np, int mode) { if (mode == 0) return np; const int t = np >> 8, w = np & 255; return (w < 128) ? t * 128 + w : DFF + t * 128 + (w - 128); }
struct CvtRegs { f32x4 v[4]; float g[4]; };
__device__ __forceinline__ void cvt_load(const CvtJob& J, int tn, int tk, int c4, int r, CvtRegs& X) {
    const int k0 = tk * 128, col = cvt_col(tn * 64 + 4 * c4, J.mode);
    const float* src = J.W + (size_t)k0 * J.ldw + col;
#pragma unroll
    for (int i = 0; i < 4; ++i) { const int k = r + 32 * i; X.v[i] = *(const f32x4*)(src + (size_t)k * J.ldw); X.g[i] = J.gain ? J.gain[k0 + k] : 1.0f; }
}
__device__ __forceinline__ unsigned char f2fp8(float x) { return (unsigned char)(__builtin_amdgcn_cvt_pk_fp8_f32(x, x, 0, false) & 0xff); }
__device__ __forceinline__ void cvt_job8(LAS unsigned char* lds, const CvtJob& J, float scale, int& base, int ldd8) {
    LAS unsigned char* T = lds;
    int tid_l = threadIdx.x; asm volatile("" : "+v"(tid_l)); const int tid = tid_l, c4 = tid & 15, r = tid >> 4, row = tid >> 3, seg = tid & 7;
    const int ntn = J.Np / 64, ntk = J.K / 128, nt = ntn * ntk;
    const int G = (int)gridDim.x, rank = (int)blockIdx.x;
    int first = rank - (base % G); if (first < 0) first += G;
    base += nt;
    if (first >= nt) return;
    CvtRegs X; cvt_load(J, first % ntn, first / ntn, c4, r, X);
    for (int t = first; t < nt; t += G) {
        const int tn = t % ntn, tk = t / ntn;
#pragma unroll
        for (int i = 0; i < 4; ++i) { const int k = r + 32 * i;
#pragma unroll
            for (int e = 0; e < 4; ++e) T[(4 * c4 + e) * 144 + k] = f2fp8(X.v[i][e] * X.g[i] * scale); }
        if (t + G < nt) cvt_load(J, (t + G) % ntn, (t + G) / ntn, c4, r, X);
        LDS_BARRIER();
        const u32x4 v = *(const LAS u32x4*)(T + row * 144 + seg * 16);
        *(u32x4*)((unsigned char*)J.dst + (size_t)(tn * 64 + row) * ldd8 + tk * 128 + seg * 16) = v;
        LDS_BARRIER();
    }
}
__device__ __forceinline__ void cvt_job(LAS unsigned char* lds, const CvtJob& J, int& base, int wg0 = 0, int nw = 0) {
    LAS bf16_t* T = (LAS bf16_t*)lds;
    int tid_l = threadIdx.x; asm volatile("" : "+v"(tid_l)); const int tid = tid_l, c4 = tid & 15, r = tid >> 4, row = tid >> 3, seg = tid & 7;
    const int ntn = J.Np / 64, ntk = J.K / 128, nt = ntn * ntk;
    const int G = nw ? nw : (int)gridDim.x;
    const int rank = (int)blockIdx.x - wg0;
    int first = rank - (base % G); if (first < 0) first += G;
    base += nt;
    if (rank < 0 || rank >= G || first >= nt) return;
    CvtRegs X; cvt_load(J, first % ntn, first / ntn, c4, r, X);
    for (int t = first; t < nt; t += G) {
        const int tn = t % ntn, tk = t / ntn;
#pragma unroll
        for (int i = 0; i < 4; ++i) { const int k = r + 32 * i;
#pragma unroll
            for (int e = 0; e < 4; ++e) T[(4 * c4 + e) * 136 + k] = f2bf(X.v[i][e] * X.g[i]); }
        if (t + G < nt) cvt_load(J, (t + G) % ntn, (t + G) / ntn, c4, r, X);
        LDS_BARRIER();
        const LAS u32x4* s = (const LAS u32x4*)(T + row * 136 + seg * 16);
        u32x4* d = (u32x4*)(J.dst + (size_t)(tn * 64 + row) * (J.ldd ? J.ldd : J.K) + tk * 128 + seg * 16);
        d[0] = s[0]; d[1] = s[1];
        LDS_BARRIER();
    }
}

__device__ __forceinline__ void sincos_d(double x, double& s, double& c) {
    const double k = rint(x * 0.63661977236758134308);
    const double r = (x - k * 1.5707963267948966192) - k * 6.123233995736766e-17;
    const double r2 = r * r;
    double sp = -1.0 / 1307674368000.0; sp = sp * r2 + 1.0 / 6227020800.0; sp = sp * r2 - 1.0 / 39916800.0; sp = sp * r2 + 1.0 / 362880.0; sp = sp * r2 - 1.0 / 5040.0; sp = sp * r2 + 1.0 / 120.0; sp = sp * r2 - 1.0 / 6.0; sp = sp * r2 + 1.0;
    double cp = 1.0 / 20922789888000.0; cp = cp * r2 - 1.0 / 87178291200.0; cp = cp * r2 + 1.0 / 479001600.0; cp = cp * r2 - 1.0 / 3628800.0; cp = cp * r2 + 1.0 / 40320.0; cp = cp * r2 - 1.0 / 720.0; cp = cp * r2 + 1.0 / 24.0; cp = cp * r2 - 0.5; cp = cp * r2 + 1.0;
    const double sr = sp * r, cr = cp;
    const int q = ((int)k) & 3;
    s = (q == 0) ? sr : (q == 1) ? cr : (q == 2) ? -sr : -cr;
    c = (q == 0) ? cr : (q == 1) ? -sr : (q == 2) ? -cr : sr;
}
__device__ __forceinline__ double exp_d(double x) {
    const double k = rint(x * 1.4426950408889634074);
    const double r = x - k * 0.69314718055994530942;
    double p = 1.0 / 479001600.0; p = p * r + 1.0 / 39916800.0; p = p * r + 1.0 / 3628800.0; p = p * r + 1.0 / 362880.0; p = p * r + 1.0 / 40320.0; p = p * r + 1.0 / 5040.0; p = p * r + 1.0 / 720.0;
    p = p * r + 1.0 / 120.0; p = p * r + 1.0 / 24.0; p = p * r + 1.0 / 6.0; p = p * r + 0.5; p = p * r + 1.0; p = p * r + 1.0;
    return ldexp(p, (int)k);
}

struct ProArgs {
    const float* x_prompt; const float* x_sample;
    const float* lam_re; const float* lam_im; const float* log_dt; const float* b_re; const float* b_im; const float* c_re; const float* c_im; const float* lb_logits;
    unsigned char* ws;
};
__device__ __forceinline__ void prologue_phase(const ProArgs& A) {
    int tid_l = threadIdx.x; asm volatile("" : "+v"(tid_l)); const int tid = tid_l, G = gridDim.x; const size_t gtid = (size_t)blockIdx.x * NTHREADS + tid, gstride = (size_t)G * NTHREADS;
    for (size_t i = gtid; i < (size_t)DEPTH * 2 * 32 * 64; i += gstride) {
        const int n = (int)(i & 63); const size_t ldg = i >> 6;
        const double dt = exp_d((double)A.log_dt[ldg]);
        const double lr = (double)A.lam_re[i], li = (double)A.lam_im[i];
        const double mag = exp_d(lr * dt); double sn, cs; sincos_d(li * dt, sn, cs);
        const double are = mag * cs, aim = mag * sn;
        const double den = lr * lr + li * li, nre = are - 1.0;
        const double cre = (nre * lr + aim * li) / den, cim = (aim * lr - nre * li) / den;
        ((f32x2*)(A.ws + WS_ATAB))[i] = (f32x2){(float)are, (float)aim};
        bf16_t* Bm = (bf16_t*)(A.ws + WS_BM) + ldg * 128 * 16; bf16_t* Cm = (bf16_t*)(A.ws + WS_CM) + ldg * 16 * 128;
        const float* bre = A.b_re + i * 16; const float* bim = A.b_im + i * 16;
#pragma unroll
        for (int p = 0; p < 16; ++p) {
            const double br = (double)bre[p], bi = (double)bim[p];
            Bm[n * 16 + p] = f2bf((float)(cre * br - cim * bi));
            Bm[(64 + n) * 16 + p] = f2bf((float)(cre * bi + cim * br));
            Cm[p * 128 + n] = f2bf(A.c_re[(ldg * 16 + p) * 64 + n]);
            Cm[p * 128 + 64 + n] = f2bf(-A.c_im[(ldg * 16 + p) * 64 + n]);
        }
    }
    for (size_t i = gtid; i < 1024; i += gstride) {
        float lg[DEPTH], mx = -1e30f;
#pragma unroll
        for (int l = 0; l < DEPTH; ++l) { lg[l] = A.lb_logits[l * 1024 + i]; mx = fmaxf(mx, lg[l]); }
        float sum = 0.f;
#pragma unroll
        for (int l = 0; l < DEPTH; ++l) { lg[l] = expf(lg[l] - mx); sum += lg[l]; }
        float cum = 0.f; const float p0 = lg[0] / sum;
#pragma unroll
        for (int l = 0; l < DEPTH; ++l) { cum += lg[l] / sum; float v = cum - p0; v = fminf(fmaxf(v, 0.f), 1.0f - 1e-6f); ((float*)(A.ws + WS_LB))[l * 1024 + i] = v; }
    }
    {
        const int wave = tid >> 6, lane = tid & 63; float* ssq = (float*)(A.ws + WS_SSQ); bf16_t* hb = (bf16_t*)(A.ws + WS_HB);
        for (int row0 = blockIdx.x * 8 + wave; row0 < MT; row0 += 2 * G * 8) {
            f32x4 a[2][4], b[2][4]; bool ok[2];
#pragma unroll
            for (int k = 0; k < 2; ++k) { const int row = row0 + k * G * 8; ok[k] = row < MT; const int rr = ok[k] ? row : row0;
                const float* xp = (rr < PROMPT_ROWS) ? A.x_prompt + (size_t)rr * DM : A.x_sample + (size_t)(rr - PROMPT_ROWS) * DM;
#pragma unroll
                for (int i = 0; i < 4; ++i) { const int c = (i * 64 + lane) * 8; a[k][i] = *(const f32x4*)(xp + c); b[k][i] = *(const f32x4*)(xp + c + 4); } }
            __builtin_amdgcn_sched_barrier(0);
#pragma unroll
            for (int k = 0; k < 2; ++k) { const int row = row0 + k * G * 8; float s = 0.f;
#pragma unroll
                for (int i = 0; i < 4; ++i) { const int c = (i * 64 + lane) * 8; const f32x4 av = a[k][i], bv = b[k][i];
                    s += (av[0] * av[0] + av[1] * av[1]) + (av[2] * av[2] + av[3] * av[3]) + (bv[0] * bv[0] + bv[1] * bv[1]) + (bv[2] * bv[2] + bv[3] * bv[3]);
                    u32x4 w; w.x = cvtpk(av[0], av[1]); w.y = cvtpk(av[2], av[3]); w.z = cvtpk(bv[0], bv[1]); w.w = cvtpk(bv[2], bv[3]);
                    if (ok[k]) *(u32x4*)(hb + (size_t)row * DM + c) = w; }
                s = xor32_sum(s); s += xor_f<16>(s); s += xor_f<8>(s); s += xor_f<4>(s); s += xor_f<2>(s); s += xor_f<1>(s);
                if (ok[k] && lane < 32) ssq[(size_t)row * 32 + lane] = (lane == 0) ? s : 0.f; }
        }
    }
}

struct S5Args { bf16_t* us; float* yd; const f32x2* atab; const bf16_t* Bm; const bf16_t* Cm; const float* dskip; };
__device__ __forceinline__ int crow16(int r) { return (r & 3) + 8 * (r >> 2); }
__device__ __forceinline__ void s5_unit(LAS unsigned char* lds, const S5Args& A, int unit) {
    int tid_l = threadIdx.x; asm volatile("" : "+v"(tid_l)); const int tid = tid_l, w = __builtin_amdgcn_readfirstlane(tid >> 6), lane = tid & 63, l31 = lane & 31, hi = lane >> 5, fr = lane & 15, fq = lane >> 4;
    const int b = unit >> 3, gq = unit & 7, dir = w >> 2, g = gq * 4 + (w & 3);
    const size_t row0 = (size_t)b * SEQL;
    const f32x2 a = A.atab[(dir * 32 + g) * 64 + lane];
    const bf16_t* Bm = A.Bm + (size_t)(dir * 32 + g) * 128 * 16;
    const bf16_t* Cm = A.Cm + (size_t)(dir * 32 + g) * 16 * 128;
    bf16x8 bfrag[4], cfrag[4];
#pragma unroll
    for (int j = 0; j < 4; ++j) { bfrag[j] = *(const bf16x8*)(Bm + (j * 32 + l31) * 16 + hi * 8); cfrag[j] = *(const bf16x8*)(Cm + fr * 128 + j * 32 + fq * 8); }
    LAS unsigned char* X = lds + w * 8704;
    const bf16_t* ug = A.us + row0 * 512 + g * 16 + hi * 8;
    float* ydw = A.yd + ((size_t)dir * MT + row0) * 512 + g * 16 + fr;
    float xr = 0.f, xi = 0.f;
    const float one = (A.dskip != nullptr) ? 1.0f : 0.0f;
    const int tA0 = dir ? (SEQL - 1 - l31) : l31;
    bf16x8 ua = *(const bf16x8*)(ug + (size_t)tA0 * 512);
    bf16x8 ua1 = *(const bf16x8*)(ug + (size_t)(dir ? tA0 - 32 : tA0 + 32) * 512);
    for (int c = 0; c < SEQL / 32; ++c) {
        bf16x8 ua_n = ua1;
        if (c + 2 < SEQL / 32) { const int tn = dir ? tA0 - 32 * (c + 2) : tA0 + 32 * (c + 2); ua1 = *(const bf16x8*)(ug + (size_t)tn * 512); }
        const f32x16 zero = {};
        f32x16 d0 = MFMA32(ua, bfrag[0], zero), d1 = MFMA32(ua, bfrag[1], zero), d2 = MFMA32(ua, bfrag[2], zero), d3 = MFMA32(ua, bfrag[3], zero);
        asm volatile("" :: "v"(ua));
        float p0r[16], p1r[16], p0i[16], p1i[16];
#pragma unroll
        for (int r = 0; r < 16; ++r) { d0[r] *= one; d1[r] *= one; d2[r] *= one; d3[r] *= one; }
#pragma unroll
        for (int r = 0; r < 16; ++r) {
            auto s = __builtin_amdgcn_permlane32_swap(__float_as_uint(d0[r]), __float_as_uint(d1[r]), false, false);
            p0r[r] = __uint_as_float(s[0]); p1r[r] = __uint_as_float(s[1]);
            auto q = __builtin_amdgcn_permlane32_swap(__float_as_uint(d2[r]), __float_as_uint(d3[r]), false, false);
            p0i[r] = __uint_as_float(q[0]); p1i[r] = __uint_as_float(q[1]);
        }
#pragma unroll
        for (int t8 = 0; t8 < 4; ++t8) {
#pragma unroll
            for (int q = 0; q < 4; ++q) { const int r = 4 * t8 + q; const float nr = a.x * xr - a.y * xi + p0r[r], ni = a.x * xi + a.y * xr + p0i[r]; xr = nr; xi = ni; p0r[r] = xr; p0i[r] = xi; }
#pragma unroll
            for (int q = 0; q < 4; ++q) { const int r = 4 * t8 + q; const float nr = a.x * xr - a.y * xi + p1r[r], ni = a.x * xi + a.y * xr + p1i[r]; xr = nr; xi = ni; p1r[r] = xr; p1i[r] = xi; }
        }
        asm volatile("" ::: "memory");
#pragma unroll
        for (int r = 0; r < 16; ++r) {
            const int t0 = crow16(r);
            *(LAS bf16_t*)(X + t0 * 272 + lane * 2) = f2bf(p0r[r]);       *(LAS bf16_t*)(X + t0 * 272 + 128 + lane * 2) = f2bf(p0i[r]);
            *(LAS bf16_t*)(X + (t0 + 4) * 272 + lane * 2) = f2bf(p1r[r]); *(LAS bf16_t*)(X + (t0 + 4) * 272 + 128 + lane * 2) = f2bf(p1i[r]);
        }
        asm volatile("" ::: "memory"); __builtin_amdgcn_wave_barrier(); asm volatile("" ::: "memory");
#pragma unroll
        for (int tt = 0; tt < 2; ++tt) {
            f32x4 y = {0.f, 0.f, 0.f, 0.f};
#pragma unroll
            for (int kk = 0; kk < 4; ++kk) { const bf16x8 af = *(const LAS bf16x8*)(X + (tt * 16 + fr) * 272 + (kk * 32 + fq * 8) * 2); y = MFMA16(af, cfrag[kk], y); }
#pragma unroll
            for (int r = 0; r < 4; ++r) { const int s = c * 32 + tt * 16 + 4 * fq + r; const int tok = dir ? (SEQL - 1 - s) : s; ydw[(size_t)tok * 512] = y[r]; }
        }
        asm volatile("" ::: "memory"); __builtin_amdgcn_wave_barrier(); asm volatile("" ::: "memory");
        ua = ua_n;
    }
    __threadfence(); __syncthreads();
    {
        const int c8 = (tid & 7) * 8, tt = tid >> 3;
        const f32x4 d0 = *(const f32x4*)(A.dskip + gq * 64 + c8), d1 = *(const f32x4*)(A.dskip + gq * 64 + c8 + 4);
        bf16_t* up = A.us + row0 * 512 + gq * 64 + c8; const float* y0 = A.yd + row0 * 512 + gq * 64 + c8; const float* y1 = y0 + (size_t)MT * 512;
        for (int it = 0; it < SEQL / 64; it += 4) {
            u32x4 uu[4]; f32x4 a0[4], a1[4], b0[4], b1[4];
#pragma unroll
            for (int k = 0; k < 4; ++k) { const size_t o = (size_t)((it + k) * 64 + tt) * 512;
                uu[k] = *(const u32x4*)(up + o); a0[k] = *(const f32x4*)(y0 + o); a1[k] = *(const f32x4*)(y0 + o + 4); b0[k] = *(const f32x4*)(y1 + o); b1[k] = *(const f32x4*)(y1 + o + 4); }
            __builtin_amdgcn_sched_barrier(0);
#pragma unroll
            for (int k = 0; k < 4; ++k) { const size_t o = (size_t)((it + k) * 64 + tt) * 512;
                const f32x4 u0 = {bflo(uu[k].x), bfhi(uu[k].x), bflo(uu[k].y), bfhi(uu[k].y)}, u1 = {bflo(uu[k].z), bfhi(uu[k].z), bflo(uu[k].w), bfhi(uu[k].w)};
                const f32x4 y_0 = d0 * u0 + a0[k] + b0[k], y_1 = d1 * u1 + a1[k] + b1[k];
                u32x4 w; w.x = cvtpk(gelu_tanh(y_0[0]), gelu_tanh(y_0[1])); w.y = cvtpk(gelu_tanh(y_0[2]), gelu_tanh(y_0[3])); w.z = cvtpk(gelu_tanh(y_1[0]), gelu_tanh(y_1[1])); w.w = cvtpk(gelu_tanh(y_1[2]), gelu_tanh(y_1[3]));
                *(u32x4*)(up + o) = w; }
            __builtin_amdgcn_sched_barrier(0);
        }
    }
    __syncthreads();
}

struct HgArgs { const bf16_t* q; const bf16_t* ff; const bf16_t* fb; const bf16_t* iv; bf16_t* o; const float* lb; unsigned* done; };
namespace hg {
constexpr int QT = 0, KT = 17408, KDT = 34816, VT = 53248, ST = 71680, AB = 106496, CQ = 115712, EL = 117760, END = 118272;
}
__device__ __forceinline__ void hgrn_unit(LAS unsigned char* lds, const HgArgs& A, int unit) {
    using namespace hg;
    int tid_l = threadIdx.x; asm volatile("" : "+v"(tid_l)); const int tid = tid_l, w = __builtin_amdgcn_readfirstlane(tid >> 6), lane = tid & 63, fr = lane & 15, fq = lane >> 4;
    const int dir = unit & 1, h = (unit >> 1) & 3, b = unit >> 3;
    const size_t row0 = (size_t)b * SEQL;
    const int d = tid & 127, tq = tid >> 7, col = h * 128 + d;
    const float lbv = A.lb[dir * 512 + col], oml = 1.0f - lbv;
    const bf16_t* fsrc = (dir ? A.fb : A.ff) + row0 * 512 + col;
    const bf16_t* qsrc = A.q + row0 * 512 + col;
    const bf16_t* vsrc = A.iv + row0 * 512 + col;
    f32x4 sacc[8];
#pragma unroll
    for (int i = 0; i < 8; ++i) sacc[i] = (f32x4){0.f, 0.f, 0.f, 0.f};
    { unsigned z0; asm volatile("v_mov_b32 %0, 0" : "=v"(z0));
      for (int i = tid; i < 34816 / 16; i += NTHREADS) *(LAS u32x4*)(lds + ST + i * 16) = (u32x4){z0, z0, z0, z0}; }
    unsigned rz[16], rq[16], rv[16];
#pragma unroll
    for (int j = 0; j < 16; ++j) { const int s = tq * 16 + j; const size_t o = (size_t)(dir ? (SEQL - 1 - s) : s) * 512; rz[j] = fsrc[o]; rq[j] = qsrc[o]; rv[j] = vsrc[o]; }
    LDS_BARRIER();
    for (int c = 0; c < SEQL / 64; ++c) {
        float pr[16], kk[16];
        {
            float run = 1.0f;
#pragma unroll
            for (int j = 0; j < 16; ++j) {
                const float sg = sigm(__uint_as_float(rz[j] << 16));
                run *= fmaxf(lbv + oml * sg, 1e-30f); pr[j] = run;
                kk[j] = oml * (1.0f - sg);
            }
            ((LAS float*)(lds + CQ))[tq * 128 + d] = run;
        }
        unsigned qv[16], vv[8];
#pragma unroll
        for (int j = 0; j < 16; ++j) { qv[j] = rq[j]; if (j & 1) vv[j >> 1] |= rv[j] << 16; else vv[j >> 1] = rv[j]; }
        if (c + 1 < SEQL / 64) {
#pragma unroll
            for (int j = 0; j < 16; ++j) { const int s = (c + 1) * 64 + tq * 16 + j; const size_t o = (size_t)(dir ? (SEQL - 1 - s) : s) * 512; rz[j] = fsrc[o]; rq[j] = qsrc[o]; rv[j] = vsrc[o]; }
        }
        LDS_BARRIER();
        {
            const LAS float* cq = (const LAS float*)(lds + CQ);
            const float c0 = cq[d], c1 = cq[128 + d], c2 = cq[256 + d], c3 = cq[384 + d];
            const float tot = (c0 * c1) * (c2 * c3);
            const float off = (tq == 0) ? 1.0f : (tq == 1) ? c0 : (tq == 2) ? (c0 * c1) : (c0 * c1) * c2;
            unsigned kd[8];
#pragma unroll
            for (int j = 0; j < 16; ++j) {
                const float e1 = off * pr[j];
                const float e2 = __builtin_amdgcn_rcpf(fmaxf(e1, 1.8e-35f));
                const int i = tq * 16 + j;
                *(LAS bf16_t*)(lds + QT + i * 272 + d * 2) = f2bf(__uint_as_float(qv[j] << 16) * e1);
                const float kt = kk[j] * e2;
                *(LAS bf16_t*)(lds + KT + i * 272 + d * 2) = f2bf(kt);
                const float kdv = kt * tot;
                if (j & 1) kd[j >> 1] = cvtpk(__uint_as_float(kd[j >> 1]), kdv); else kd[j >> 1] = __float_as_uint(kdv);
            }
            LAS u32x4* kp = (LAS u32x4*)(lds + KDT + d * 144 + tq * 32); kp[0] = (u32x4){kd[0], kd[1], kd[2], kd[3]}; kp[1] = (u32x4){kd[4], kd[5], kd[6], kd[7]};
            LAS u32x4* vp = (LAS u32x4*)(lds + VT + d * 144 + tq * 32);  vp[0] = (u32x4){vv[0], vv[1], vv[2], vv[3]}; vp[1] = (u32x4){vv[4], vv[5], vv[6], vv[7]};
            if (tq == 0) ((LAS float*)(lds + EL))[d] = tot;
        }
        LDS_BARRIER();
        {
            const int ti = w >> 1;
#pragma unroll
            for (int sj = 0; sj < 2; ++sj) {
                const int si = 2 * (w & 1) + sj;
                f32x4 acc = {0.f, 0.f, 0.f, 0.f};
                if (si <= ti) {
#pragma unroll
                    for (int k = 0; k < 4; ++k) {
                        const bf16x8 ka = *(const LAS bf16x8*)(lds + KT + (16 * si + fr) * 272 + (k * 32 + fq * 8) * 2);
                        const bf16x8 qb = *(const LAS bf16x8*)(lds + QT + (16 * ti + fr) * 272 + (k * 32 + fq * 8) * 2);
                        acc = MFMA16(ka, qb, acc);
                    }
                    if (si == ti) {
#pragma unroll
                        for (int r = 0; r < 4; ++r) if (4 * fq + r > fr) acc[r] = 0.f;
                    }
                }
                u32x2 pk; pk.x = cvtpk(acc[0], acc[1]); pk.y = cvtpk(acc[2], acc[3]);
                *(LAS u32x2*)(lds + AB + (16 * ti + fr) * 144 + (16 * si + 4 * fq) * 2) = pk;
            }
        }
        f32x4 oacc[4];
#pragma unroll
        for (int ti = 0; ti < 4; ++ti) oacc[ti] = (f32x4){0.f, 0.f, 0.f, 0.f};
#pragma unroll
        for (int k = 0; k < 4; ++k) {
            const bf16x8 sb = *(const LAS bf16x8*)(lds + ST + (16 * w + fr) * 272 + (k * 32 + fq * 8) * 2);
#pragma unroll
            for (int ti = 0; ti < 4; ++ti) { const bf16x8 qa = *(const LAS bf16x8*)(lds + QT + (16 * ti + fr) * 272 + (k * 32 + fq * 8) * 2); oacc[ti] = MFMA16(qa, sb, oacc[ti]); }
        }
        LDS_BARRIER();
        bf16x8 vb[2];
#pragma unroll
        for (int k = 0; k < 2; ++k) vb[k] = *(const LAS bf16x8*)(lds + VT + (16 * w + fr) * 144 + (k * 32 + fq * 8) * 2);
#pragma unroll
        for (int k = 0; k < 2; ++k)
#pragma unroll
            for (int ti = 0; ti < 4; ++ti) { const bf16x8 aa = *(const LAS bf16x8*)(lds + AB + (16 * ti + fr) * 144 + (k * 32 + fq * 8) * 2); oacc[ti] = MFMA16(aa, vb[k], oacc[ti]); }
        {
            bf16_t* op = A.o + ((size_t)dir * MT + row0) * 512 + h * 128 + 16 * w + fr;
#pragma unroll
            for (int ti = 0; ti < 4; ++ti)
#pragma unroll
                for (int r = 0; r < 4; ++r) { const int s = c * 64 + 16 * ti + 4 * fq + r; const int tok = dir ? (SEQL - 1 - s) : s; __hip_atomic_store(op + (size_t)tok * 512, f2bf(oacc[ti][r]), __ATOMIC_RELAXED, __HIP_MEMORY_SCOPE_AGENT); }
        }
#pragma unroll
        for (int di = 0; di < 8; ++di) {
            const f32x4 el = *(const LAS f32x4*)(lds + EL + (16 * di + 4 * fq) * 4);
            sacc[di] = sacc[di] * el;
#pragma unroll
            for (int k = 0; k < 2; ++k) { const bf16x8 ka = *(const LAS bf16x8*)(lds + KDT + (16 * di + fr) * 144 + (k * 32 + fq * 8) * 2); sacc[di] = MFMA16(ka, vb[k], sacc[di]); }
            u32x2 pk; pk.x = cvtpk(sacc[di][0], sacc[di][1]); pk.y = cvtpk(sacc[di][2], sacc[di][3]);
            *(LAS u32x2*)(lds + ST + (16 * w + fr) * 272 + (16 * di + 4 * fq) * 2) = pk;
        }
        LDS_BARRIER();
    }
    WAIT_VM0();
    if ((tid & 63) == 0) __hip_atomic_fetch_add(A.done, 1u, __ATOMIC_RELAXED, __HIP_MEMORY_SCOPE_AGENT);
}

struct QkArgs { bf16_t* aq; bf16_t* ak; const float* qn; const float* kn; int nq; };
__device__ __forceinline__ void qkprep_phase(const QkArgs& A, int first_block, int nblocks) {
    int tid_l = threadIdx.x; asm volatile("" : "+v"(tid_l)); const int tid = tid_l, j = tid & 15, axis = j >> 3, sub = j & 7;
    const int bid = (int)blockIdx.x - first_block; if (bid < 0 || bid >= nblocks) return;
    const int nh = A.nq + 2, stride = nblocks * 32;
    const int d1 = axis * 64 + 4 * sub, d2 = d1 + 32;
    float inv[4];
#pragma unroll
    for (int e = 0; e < 4; ++e) inv[e] = __builtin_amdgcn_exp2f(-(float)(4 * sub + e) * (13.287712379549449f / 32.0f));
    constexpr int NB = 5;
    for (int item0 = bid * 32 + (tid >> 4); item0 < MT * nh; item0 += NB * stride) {
        bf16_t* pp[NB]; const float* gn[NB]; u32x2 w1[NB], w2[NB]; int tt[NB]; bool ok[NB];
#pragma unroll
        for (int k = 0; k < NB; ++k) {
            const int item = item0 + k * stride; ok[k] = item < MT * nh;
            const int it = ok[k] ? item : item0;
            const int row = it / nh, hh = it - row * nh + (8 - A.nq);
            if (hh < 8) { pp[k] = A.aq + (size_t)row * 1024 + hh * 128; gn[k] = A.qn; } else { pp[k] = A.ak + (size_t)row * 256 + (hh - 8) * 128; gn[k] = A.kn; }
            tt[k] = row & (SEQL - 1);
            w1[k] = *(const u32x2*)(pp[k] + d1); w2[k] = *(const u32x2*)(pp[k] + d2);
        }
        __builtin_amdgcn_sched_barrier(0);
#pragma unroll
        for (int k = 0; k < NB; ++k) {
            float x1[4] = {bflo(w1[k].x), bfhi(w1[k].x), bflo(w1[k].y), bfhi(w1[k].y)}, x2[4] = {bflo(w2[k].x), bfhi(w2[k].x), bflo(w2[k].y), bfhi(w2[k].y)};
            float s = 0.f;
#pragma unroll
            for (int e = 0; e < 4; ++e) s += x1[e] * x1[e] + x2[e] * x2[e];
            s += xor_f<1>(s); s += xor_f<2>(s); s += xor_f<4>(s); s += xor_f<8>(s);
            const float rstd = __builtin_amdgcn_rsqf(s * (1.0f / 128.0f) + 1e-6f);
            const float pos = (float)(axis == 0 ? (tt[k] >> 6) : (tt[k] & 63));
            const f32x4 g1 = *(const f32x4*)(gn[k] + d1), g2 = *(const f32x4*)(gn[k] + d2);
            float o1[4], o2[4];
#pragma unroll
            for (int e = 0; e < 4; ++e) {
                const float ang = pos * inv[e], cs = __cosf(ang), sn = __sinf(ang);
                const float y1 = x1[e] * rstd * g1[e], y2 = x2[e] * rstd * g2[e];
                o1[e] = y1 * cs - y2 * sn; o2[e] = y2 * cs + y1 * sn;
            }
            u32x2 r1, r2; r1.x = cvtpk(o1[0], o1[1]); r1.y = cvtpk(o1[2], o1[3]); r2.x = cvtpk(o2[0], o2[1]); r2.y = cvtpk(o2[2], o2[3]);
            if (ok[k]) { *(u32x2*)(pp[k] + d1) = r1; *(u32x2*)(pp[k] + d2) = r2; }
        }
        __builtin_amdgcn_sched_barrier(0);
    }
}

struct HfArgs { const bf16_t* o; const bf16_t* g; const float* gain; bf16_t* y; };
__device__ __forceinline__ void hgfin_chunk(const HfArgs& A, int chunk) {
    int tid_l = threadIdx.x; asm volatile("" : "+v"(tid_l)); const int tid = tid_l, j = tid & 15;
    const f32x4 g0 = *(const f32x4*)(A.gain + j * 8), g1 = *(const f32x4*)(A.gain + j * 8 + 4);
#pragma unroll 1
    for (int trip = 0; trip < 2; ++trip) {
        const int item = chunk * 256 + trip * 128 + (tid >> 4);
        u32x4 oa[4], ob[4], gg[4];
#pragma unroll
        for (int k = 0; k < 4; ++k) { const size_t off = (size_t)(item + k * 32) * 128 + j * 8;
            oa[k] = *(const u32x4*)(A.o + off); ob[k] = *(const u32x4*)(A.o + (size_t)MT * 512 + off);
            gg[k] = *(const u32x4*)(A.g + off); }
        __builtin_amdgcn_sched_barrier(0);
#pragma unroll
        for (int k = 0; k < 4; ++k) { const int it = item + k * 32;
            const f32x4 s0 = {bflo(oa[k].x) + bflo(ob[k].x), bfhi(oa[k].x) + bfhi(ob[k].x), bflo(oa[k].y) + bflo(ob[k].y), bfhi(oa[k].y) + bfhi(ob[k].y)};
            const f32x4 s1 = {bflo(oa[k].z) + bflo(ob[k].z), bfhi(oa[k].z) + bfhi(ob[k].z), bflo(oa[k].w) + bflo(ob[k].w), bfhi(oa[k].w) + bfhi(ob[k].w)};
            float s = (s0[0] * s0[0] + s0[1] * s0[1]) + (s0[2] * s0[2] + s0[3] * s0[3]) + (s1[0] * s1[0] + s1[1] * s1[1]) + (s1[2] * s1[2] + s1[3] * s1[3]);
            s += xor_f<1>(s); s += xor_f<2>(s); s += xor_f<4>(s); s += xor_f<8>(s);
            const float rstd = __builtin_amdgcn_rsqf(s * (1.0f / 128.0f) + 1e-6f);
            u32x4 w;
            w.x = cvtpk(s0[0] * rstd * g0[0] * siluf(bflo(gg[k].x)), s0[1] * rstd * g0[1] * siluf(bfhi(gg[k].x)));
            w.y = cvtpk(s0[2] * rstd * g0[2] * siluf(bflo(gg[k].y)), s0[3] * rstd * g0[3] * siluf(bfhi(gg[k].y)));
            w.z = cvtpk(s1[0] * rstd * g1[0] * siluf(bflo(gg[k].z)), s1[1] * rstd * g1[1] * siluf(bfhi(gg[k].z)));
            w.w = cvtpk(s1[2] * rstd * g1[2] * siluf(bflo(gg[k].w)), s1[3] * rstd * g1[3] * siluf(bfhi(gg[k].w)));
            *(u32x4*)(A.y + (size_t)(it >> 2) * YLD + 512 + (it & 3) * 128 + j * 8) = w; }
        __builtin_amdgcn_sched_barrier(0);
    }
}
__device__ __forceinline__ void hgfin_phase(const HfArgs& A) {
    int tid_l = threadIdx.x; asm volatile("" : "+v"(tid_l)); const int tid = tid_l, j = tid & 15;
    const f32x4 g0 = *(const f32x4*)(A.gain + j * 8), g1 = *(const f32x4*)(A.gain + j * 8 + 4);
    const int stride = gridDim.x * 32;
    int item = blockIdx.x * 32 + (tid >> 4);
    for (; item + 3 * stride < MT * 4; item += 4 * stride) {
        u32x4 oa[4], ob[4], gg[4];
#pragma unroll
        for (int k = 0; k < 4; ++k) { const size_t off = (size_t)(item + k * stride) * 128 + j * 8;
            oa[k] = *(const u32x4*)(A.o + off); ob[k] = *(const u32x4*)(A.o + (size_t)MT * 512 + off);
            gg[k] = *(const u32x4*)(A.g + off); }
        __builtin_amdgcn_sched_barrier(0);
#pragma unroll
        for (int k = 0; k < 4; ++k) { const int it = item + k * stride;
            const f32x4 s0 = {bflo(oa[k].x) + bflo(ob[k].x), bfhi(oa[k].x) + bfhi(ob[k].x), bflo(oa[k].y) + bflo(ob[k].y), bfhi(oa[k].y) + bfhi(ob[k].y)};
            const f32x4 s1 = {bflo(oa[k].z) + bflo(ob[k].z), bfhi(oa[k].z) + bfhi(ob[k].z), bflo(oa[k].w) + bflo(ob[k].w), bfhi(oa[k].w) + bfhi(ob[k].w)};
            float s = (s0[0] * s0[0] + s0[1] * s0[1]) + (s0[2] * s0[2] + s0[3] * s0[3]) + (s1[0] * s1[0] + s1[1] * s1[1]) + (s1[2] * s1[2] + s1[3] * s1[3]);
            s += xor_f<1>(s); s += xor_f<2>(s); s += xor_f<4>(s); s += xor_f<8>(s);
            const float rstd = __builtin_amdgcn_rsqf(s * (1.0f / 128.0f) + 1e-6f);
            u32x4 w;
            w.x = cvtpk(s0[0] * rstd * g0[0] * siluf(bflo(gg[k].x)), s0[1] * rstd * g0[1] * siluf(bfhi(gg[k].x)));
            w.y = cvtpk(s0[2] * rstd * g0[2] * siluf(bflo(gg[k].y)), s0[3] * rstd * g0[3] * siluf(bfhi(gg[k].y)));
            w.z = cvtpk(s1[0] * rstd * g1[0] * siluf(bflo(gg[k].z)), s1[1] * rstd * g1[1] * siluf(bfhi(gg[k].z)));
            w.w = cvtpk(s1[2] * rstd * g1[2] * siluf(bflo(gg[k].w)), s1[3] * rstd * g1[3] * siluf(bfhi(gg[k].w)));
            *(u32x4*)(A.y + (size_t)(it >> 2) * YLD + 512 + (it & 3) * 128 + j * 8) = w; }
        __builtin_amdgcn_sched_barrier(0);
    }
    for (; item < MT * 4; item += stride) {
        const size_t off = (size_t)item * 128 + j * 8;
        const u32x4 oa = *(const u32x4*)(A.o + off), ob = *(const u32x4*)(A.o + (size_t)MT * 512 + off);
        const f32x4 s0 = {bflo(oa.x) + bflo(ob.x), bfhi(oa.x) + bfhi(ob.x), bflo(oa.y) + bflo(ob.y), bfhi(oa.y) + bfhi(ob.y)};
        const f32x4 s1 = {bflo(oa.z) + bflo(ob.z), bfhi(oa.z) + bfhi(ob.z), bflo(oa.w) + bflo(ob.w), bfhi(oa.w) + bfhi(ob.w)};
        float s = (s0[0] * s0[0] + s0[1] * s0[1]) + (s0[2] * s0[2] + s0[3] * s0[3]) + (s1[0] * s1[0] + s1[1] * s1[1]) + (s1[2] * s1[2] + s1[3] * s1[3]);
        s += xor_f<1>(s); s += xor_f<2>(s); s += xor_f<4>(s); s += xor_f<8>(s);
        const float rstd = __builtin_amdgcn_rsqf(s * (1.0f / 128.0f) + 1e-6f);
        const u32x4 gg = *(const u32x4*)(A.g + off);
        u32x4 w;
        w.x = cvtpk(s0[0] * rstd * g0[0] * siluf(bflo(gg.x)), s0[1] * rstd * g0[1] * siluf(bfhi(gg.x)));
        w.y = cvtpk(s0[2] * rstd * g0[2] * siluf(bflo(gg.y)), s0[3] * rstd * g0[3] * siluf(bfhi(gg.y)));
        w.z = cvtpk(s1[0] * rstd * g1[0] * siluf(bflo(gg.z)), s1[1] * rstd * g1[1] * siluf(bfhi(gg.z)));
        w.w = cvtpk(s1[2] * rstd * g1[2] * siluf(bflo(gg.w)), s1[3] * rstd * g1[3] * siluf(bfhi(gg.w)));
        *(u32x4*)(A.y + (size_t)(item >> 2) * YLD + 512 + (item & 3) * 128 + j * 8) = w;
    }
}
namespace att {
constexpr int D = 128, NW = 8, QBLK = 32, KVBLK = 64;
constexpr float SCALE = 0.088388347648318440f;
constexpr float THR = 8.f;
constexpr int LDQ = 1024, LDK = 256, LDO = 2048;
constexpr size_t SHM_V = KVBLK * D * 2, SHM_K = KVBLK * D * 2, SHM_ATTN = 2 * SHM_V + 2 * SHM_K + NW * 64 * 4;
#define KSWZ(row, colB) ((row) * 256 + ((colB) ^ (((row) & 7) << 4)))
#define SBAR() __builtin_amdgcn_sched_barrier(0)
__device__ __forceinline__ int crow(int r, int hi) { return (r & 3) + 8 * (r >> 2) + 4 * hi; }
__device__ __forceinline__ unsigned cvtpkv(float lo, float hi) { return cvtpk(lo, hi); }

__device__ __forceinline__ void partialSM(f32x16& p0, f32x16& p1, float& m_reg, float& mn, float& alpha) {
  constexpr float C = SCALE * 1.4426950408889634f;
  float pmax = p0[0]; for (int r = 1; r < 16; ++r) pmax = fmaxf(pmax, p0[r]); for (int r = 0; r < 16; ++r) pmax = fmaxf(pmax, p1[r]);
  { auto rr = __builtin_amdgcn_permlane32_swap(__float_as_uint(pmax), __float_as_uint(pmax), false, false);
    pmax = fmaxf(__uint_as_float(rr[0]), __uint_as_float(rr[1])); }
  if (__builtin_expect(__all(pmax - m_reg <= THR / SCALE), 1)) { mn = m_reg; alpha = 1.f; }
  else { mn = fmaxf(m_reg, pmax); alpha = __builtin_amdgcn_exp2f((m_reg - mn) * C); m_reg = mn; }
  float mnC = -mn * C;
  for (int r = 0; r < 16; ++r) p0[r] = fmaf(p0[r], C, mnC); for (int r = 0; r < 16; ++r) p1[r] = fmaf(p1[r], C, mnC);
  for (int r = 0; r < 16; ++r) p0[r] = __builtin_amdgcn_exp2f(p0[r]);
}
__device__ __forceinline__ void finishSM(f32x16& p0, f32x16& p1, float alpha, float& l_reg, bf16x8& pa0, bf16x8& pa1, bf16x8& pa2, bf16x8& pa3) {
  for (int r = 0; r < 16; ++r) p1[r] = __builtin_amdgcn_exp2f(p1[r]);
  float ps = 0; for (int r = 0; r < 16; ++r) ps += p0[r]; for (int r = 0; r < 16; ++r) ps += p1[r];
  { auto rr = __builtin_amdgcn_permlane32_swap(__float_as_uint(ps), __float_as_uint(ps), false, false);
    ps = __uint_as_float(rr[0]) + __uint_as_float(rr[1]); }
  l_reg = l_reg * alpha + ps;
#define PK4(P, BASE, OUT) do { unsigned a0 = cvtpkv(P[BASE + 0], P[BASE + 1]), a1 = cvtpkv(P[BASE + 2], P[BASE + 3]);   \
    unsigned b0 = cvtpkv(P[BASE + 4], P[BASE + 5]), b1 = cvtpkv(P[BASE + 6], P[BASE + 7]);                              \
    auto r0 = __builtin_amdgcn_permlane32_swap(a0, b0, false, false); auto r1 = __builtin_amdgcn_permlane32_swap(a1, b1, false, false); \
    u32x4 w = {r0[0], r1[0], r0[1], r1[1]}; OUT = *reinterpret_cast<bf16x8*>(&w); } while (0)
  PK4(p0, 0, pa0); PK4(p0, 8, pa1); PK4(p1, 0, pa2); PK4(p1, 8, pa3);
#undef PK4
}
__device__ __forceinline__ void qkt(f32x16& p0, f32x16& p1, const bf16_t* Ks, const bf16x8* qr, int r32, int hi) {
  p0 = f32x16{}; p1 = f32x16{};
  for (int d0 = 0; d0 < 8; ++d0) { int cb = (d0 * 16 + hi * 8) * 2;
    bf16x8 b0 = *reinterpret_cast<const bf16x8*>((const char*)Ks + KSWZ(r32, cb));
    bf16x8 b1 = *reinterpret_cast<const bf16x8*>((const char*)Ks + KSWZ(32 + r32, cb));
    p0 = __builtin_amdgcn_mfma_f32_32x32x16_bf16(b0, qr[d0], p0, 0, 0, 0);
    p1 = __builtin_amdgcn_mfma_f32_32x32x16_bf16(b1, qr[d0], p1, 0, 0, 0); }
}
__device__ __forceinline__ int v_st(int k, int c) { const int kk = (k & ~0xC) | ((k & 4) << 1) | ((k & 8) >> 1); return ((kk >> 3) * 4 + (c >> 5)) * 512 + ((kk & 7) * 32 + (c & 31)) * 2; }
__device__ __forceinline__ int v_rd_base(int lane) { return ((lane & 3) << 3) | (((lane >> 2) & 3) << 6) | (((lane >> 4) & 1) << 5) | (((lane >> 5) & 1) << 8); }
constexpr int v_rd_off(int d0, int ks, int half) { return d0 * 512 + ks * 4096 + half * 2048; }
template <int OFF> __device__ __forceinline__ s16x4 tr_read(int vb) {
  s16x4 r; asm volatile("ds_read_b64_tr_b16 %0, %1 offset:%2" : "=&v"(r) : "v"(vb), "i"(OFF) : "memory"); return r;
}
template <int D0> __device__ __forceinline__ void pv_one(f32x16& od, int vb, bf16x8 pa0, bf16x8 pa1, bf16x8 pa2, bf16x8 pa3) {
  const s16x4 l0 = tr_read<v_rd_off(D0, 0, 0)>(vb), h0 = tr_read<v_rd_off(D0, 0, 1)>(vb), l1 = tr_read<v_rd_off(D0, 1, 0)>(vb), h1 = tr_read<v_rd_off(D0, 1, 1)>(vb);
  const s16x4 l2 = tr_read<v_rd_off(D0, 2, 0)>(vb), h2 = tr_read<v_rd_off(D0, 2, 1)>(vb), l3 = tr_read<v_rd_off(D0, 3, 0)>(vb), h3 = tr_read<v_rd_off(D0, 3, 1)>(vb);
  asm volatile("s_waitcnt lgkmcnt(0)" ::: "memory"); SBAR();
#define PK(L, H) (bf16x8){L[0], L[1], L[2], L[3], H[0], H[1], H[2], H[3]}
  od = __builtin_amdgcn_mfma_f32_32x32x16_bf16(pa0, PK(l0, h0), od, 0, 0, 0);
  od = __builtin_amdgcn_mfma_f32_32x32x16_bf16(pa1, PK(l1, h1), od, 0, 0, 0);
  od = __builtin_amdgcn_mfma_f32_32x32x16_bf16(pa2, PK(l2, h2), od, 0, 0, 0);
  od = __builtin_amdgcn_mfma_f32_32x32x16_bf16(pa3, PK(l3, h3), od, 0, 0, 0);
#undef PK
}
__device__ __forceinline__ void pv_d0(f32x16* o, int vb, bf16x8 pa0, bf16x8 pa1, bf16x8 pa2, bf16x8 pa3) {
  pv_one<0>(o[0], vb, pa0, pa1, pa2, pa3); pv_one<1>(o[1], vb, pa0, pa1, pa2, pa3); pv_one<2>(o[2], vb, pa0, pa1, pa2, pa3); pv_one<3>(o[3], vb, pa0, pa1, pa2, pa3);
}
__device__ __forceinline__ void attn_dense_body(const bf16_t* __restrict__ Qb, const bf16_t* __restrict__ Kh, const bf16_t* __restrict__ Vh, bf16_t* __restrict__ Ob, int seq, char* lds, const float* qgain, int t0) {
  int tid_l = threadIdx.x; asm volatile("" : "+v"(tid_l)); const int tid = tid_l, wid = tid >> 6, lane = tid & 63, r32 = lane & 31, hi = lane >> 5;
  bf16_t* V_lds = (bf16_t*)lds; bf16_t* K_lds = (bf16_t*)(lds + 2 * SHM_V);
  float* ws = (float*)(lds + 2 * SHM_V + 2 * SHM_K) + wid * 64; float* li_l = ws; float* al_l = ws + 32;
  float m_reg = -1e30f, l_reg = 0; f32x16 o[4] = {}; bf16x8 qr[8];
  const bf16_t* Qw = Qb + (long)(wid * QBLK + r32) * LDQ + hi * 8;
#pragma unroll
  for (int d0 = 0; d0 < 8; ++d0) qr[d0] = *reinterpret_cast<const bf16x8*>(Qw + d0 * 16);
  if (qgain) {
    float ss = 0.f;
#pragma unroll
    for (int d0 = 0; d0 < 8; ++d0) { const u32x4 w = *reinterpret_cast<const u32x4*>(&qr[d0]);
      const float a0 = bflo(w.x), a1 = bfhi(w.x), a2 = bflo(w.y), a3 = bfhi(w.y), a4 = bflo(w.z), a5 = bfhi(w.z), a6 = bflo(w.w), a7 = bfhi(w.w);
      ss += (a0 * a0 + a1 * a1) + (a2 * a2 + a3 * a3) + (a4 * a4 + a5 * a5) + (a6 * a6 + a7 * a7); }
    ss = xor32_sum(ss);
    const float rstd = __builtin_amdgcn_rsqf(ss * (1.0f / 128.0f) + 1e-6f);
    const int t = t0 + wid * QBLK + r32; const float prow = (float)(t >> 6), pcol = (float)(t & 63);
#pragma unroll
    for (int ax = 0; ax < 2; ++ax)
#pragma unroll
      for (int dd = 0; dd < 2; ++dd) {
        const int d1 = ax * 4 + dd;
        const u32x4 w1 = *reinterpret_cast<const u32x4*>(&qr[d1]), w2 = *reinterpret_cast<const u32x4*>(&qr[d1 + 2]);
        float x1[8] = {bflo(w1.x), bfhi(w1.x), bflo(w1.y), bfhi(w1.y), bflo(w1.z), bfhi(w1.z), bflo(w1.w), bfhi(w1.w)};
        float x2[8] = {bflo(w2.x), bfhi(w2.x), bflo(w2.y), bfhi(w2.y), bflo(w2.z), bfhi(w2.z), bflo(w2.w), bfhi(w2.w)};
        const float* g1 = qgain + d1 * 16 + hi * 8; const float* g2 = g1 + 32;
#pragma unroll
        for (int e = 0; e < 8; ++e) {
          const float fi = (float)(dd * 16 + hi * 8 + e);
          const float inv = __builtin_amdgcn_exp2f(-fi * (13.287712379549449f / 32.0f)), ang = (ax ? pcol : prow) * inv, cs = __cosf(ang), sn = __sinf(ang);
          const float y1 = x1[e] * rstd * g1[e], y2 = x2[e] * rstd * g2[e];
          x1[e] = y1 * cs - y2 * sn; x2[e] = y2 * cs + y1 * sn; }
        u32x4 o1, o2;
        o1.x = cvtpk(x1[0], x1[1]); o1.y = cvtpk(x1[2], x1[3]); o1.z = cvtpk(x1[4], x1[5]); o1.w = cvtpk(x1[6], x1[7]);
        o2.x = cvtpk(x2[0], x2[1]); o2.y = cvtpk(x2[2], x2[3]); o2.z = cvtpk(x2[4], x2[5]); o2.w = cvtpk(x2[6], x2[7]);
        qr[d1] = *reinterpret_cast<bf16x8*>(&o1); qr[d1 + 2] = *reinterpret_cast<bf16x8*>(&o2);
      }
  }
  const int sr = tid >> 4, sc = (tid & 15) * 8, vst0 = v_st(sr, sc), vst1 = v_st(32 + sr, sc);
  const int vb0 = (int)(uintptr_t)V_lds + v_rd_base(lane);
  struct { bf16x8 vs0, vs1, ks0, ks1; } sr_[2];
#define SLOAD(i, k0) do { sr_[i].vs0 = *reinterpret_cast<const bf16x8*>(&Vh[(long)((k0) + sr) * LDK + sc]); sr_[i].vs1 = *reinterpret_cast<const bf16x8*>(&Vh[(long)((k0) + 32 + sr) * LDK + sc]); \
    sr_[i].ks0 = *reinterpret_cast<const bf16x8*>(&Kh[(long)((k0) + sr) * LDK + sc]); sr_[i].ks1 = *reinterpret_cast<const bf16x8*>(&Kh[(long)((k0) + 32 + sr) * LDK + sc]); } while (0)
#define SWRITE(b, i) do { *(bf16x8*)((char*)V_lds + (b) * SHM_V + vst0) = sr_[i].vs0;          \
    *(bf16x8*)((char*)V_lds + (b) * SHM_V + vst1) = sr_[i].vs1; int kc = sc * 2;               \
    *(bf16x8*)((char*)K_lds + (b) * SHM_K + KSWZ(sr, kc)) = sr_[i].ks0;                       \
    *(bf16x8*)((char*)K_lds + (b) * SHM_K + KSWZ(32 + sr, kc)) = sr_[i].ks1; } while (0)
#define SWAIT() asm volatile("s_waitcnt vmcnt(4)" ::: "memory")
#define RESC(a) do { if (__any((a) < 1.f)) { if (hi == 0) al_l[r32] = (a); asm volatile("s_waitcnt lgkmcnt(0)" ::: "memory"); \
    for (int d = 0; d < 4; ++d) for (int r = 0; r < 16; ++r) o[d][r] *= al_l[crow(r, hi)]; } } while (0)
  f32x16 pA0, pA1, pB0, pB1; float mnA, mnB, alA, alB; bf16x8 pa0, pa1, pa2, pa3; const int NT = seq / KVBLK;
  constexpr int SE = 0, SO = 1;
  SLOAD(SE, 0); asm volatile("s_waitcnt vmcnt(0)" ::: "memory"); SWRITE(0, SE); __syncthreads();
  qkt(pA0, pA1, K_lds, qr, r32, hi); partialSM(pA0, pA1, m_reg, mnA, alA);
  SLOAD(SO, KVBLK); if (2 < NT) SLOAD(SE, 2 * KVBLK);
  SWAIT(); SWRITE(1, SO); __syncthreads();
  for (int j = 1; j + 1 < NT; j += 2) {
    SBAR(); qkt(pB0, pB1, (bf16_t*)((char*)K_lds + SHM_K), qr, r32, hi);
    finishSM(pA0, pA1, alA, l_reg, pa0, pa1, pa2, pa3); SBAR();
    SLOAD(SO, (j + 2) * KVBLK); SBAR();
    pv_d0(o, vb0, pa0, pa1, pa2, pa3); partialSM(pB0, pB1, m_reg, mnB, alB);
    __syncthreads(); SWAIT(); SWRITE(0, SE);
    RESC(alB); __syncthreads();
    SBAR(); qkt(pA0, pA1, K_lds, qr, r32, hi);
    finishSM(pB0, pB1, alB, l_reg, pa0, pa1, pa2, pa3); SBAR();
    if (j + 3 < NT) SLOAD(SE, (j + 3) * KVBLK); SBAR();
    pv_d0(o, vb0 + (int)SHM_V, pa0, pa1, pa2, pa3); partialSM(pA0, pA1, m_reg, mnA, alA);
    __syncthreads(); SWAIT(); SWRITE(1, SO);
    RESC(alA); __syncthreads();
  }
  SBAR(); qkt(pB0, pB1, (bf16_t*)((char*)K_lds + SHM_K), qr, r32, hi);
  finishSM(pA0, pA1, alA, l_reg, pa0, pa1, pa2, pa3); SBAR();
  pv_d0(o, vb0, pa0, pa1, pa2, pa3); partialSM(pB0, pB1, m_reg, mnB, alB);
  __syncthreads(); RESC(alB);
  finishSM(pB0, pB1, alB, l_reg, pa0, pa1, pa2, pa3); SBAR();
  pv_d0(o, vb0 + (int)SHM_V, pa0, pa1, pa2, pa3);
  if (hi == 0) li_l[r32] = l_reg; asm volatile("s_waitcnt lgkmcnt(0)" ::: "memory");
  float rli[16];
#pragma unroll
  for (int r = 0; r < 16; ++r) rli[r] = __builtin_amdgcn_rcpf(li_l[crow(r, hi)]);
#if MRG_FP8
  unsigned char* Ow = (unsigned char*)Ob + (long)(wid * QBLK) * (YLD * 2);
#pragma unroll
  for (int r = 0; r < 16; ++r) { int orow = crow(r, hi);
    for (int d0 = 0; d0 < 4; ++d0) Ow[(long)orow * (YLD * 2) + d0 * 32 + r32] = (unsigned char)(__builtin_amdgcn_cvt_pk_fp8_f32(o[d0][r] * (rli[r] * YATT_SC), 0.f, 0, false) & 0xff); }
#else
  bf16_t* Ow = Ob + (long)(wid * QBLK) * LDO;
#pragma unroll
  for (int r = 0; r < 16; ++r) { int orow = crow(r, hi);
    for (int d0 = 0; d0 < 4; ++d0) Ow[(long)orow * LDO + d0 * 32 + r32] = f2bf(o[d0][r] * rli[r]); }
#endif
  __syncthreads();
#undef SLOAD
#undef SWRITE
#undef SWAIT
#undef RESC
}
}
#define XB_TMO      128
#define XB_XCNT(j)  (256  + 64 * (j))
#define XB_XSUB(j)  (1280 + 64 * (j))
#define XB_XGEN(j)  (2304 + 64 * (j))
#define XB_TOP      3328
#define XB_TOPGEN   3392
#define XCD_BAR_WORDS 3456
#define XB_SPIN_CAP (1u << 22)

__device__ __forceinline__ unsigned xb_ld(unsigned* p)              { return __hip_atomic_load(p, __ATOMIC_RELAXED, __HIP_MEMORY_SCOPE_AGENT); }
__device__ __forceinline__ unsigned xb_add(unsigned* p, unsigned v) { return __hip_atomic_fetch_add(p, v, __ATOMIC_RELAXED, __HIP_MEMORY_SCOPE_AGENT); }
__device__ __forceinline__ unsigned xb_xcc_id() { return (unsigned)__builtin_amdgcn_s_getreg((3 << 11) | 20) & 0xFu; }
#define XB_SPIN(cond, bar) do { unsigned _sp = 0; while (cond) { __builtin_amdgcn_s_sleep(1); \
    if ((++_sp & 255u) == 0u) { if (xb_ld(&(bar)[XB_TMO])) break; if (_sp > XB_SPIN_CAP) { atomicAdd(&(bar)[XB_TMO], 1u); break; } } } } while (0)

struct XcdBarrier {
    unsigned* bar; unsigned x;
    volatile LAS unsigned* st;
};

__device__ __forceinline__ XcdBarrier xcd_barrier_post(unsigned* bar, volatile LAS unsigned* st) {
    XcdBarrier b; b.bar = bar; b.x = xb_xcc_id(); b.st = st;
    if (threadIdx.x == 0) st[2] = xb_add(&bar[XB_XCNT(b.x)], 1u);
    return b;
}
__device__ __forceinline__ void xcd_barrier_complete(unsigned* bar, unsigned x, unsigned& nloc, unsigned& nx, unsigned& lo8) {
    const unsigned G = gridDim.x * gridDim.y * gridDim.z;
    unsigned sum, cnt, mine, sp = 0u;
    for (;;) {
        sum = 0u; cnt = 0u; mine = 0u; lo8 = 0u;
#pragma unroll
        for (unsigned j = 0; j < 16; ++j) { const unsigned c = xb_ld(&bar[XB_XCNT(j)]); sum += c; cnt += (c > 0u) ? 1u : 0u; lo8 += (j < 8u && c > 0u) ? 1u : 0u; mine = (j == x) ? c : mine; }
        if (sum == G) break;
        __builtin_amdgcn_s_sleep(1);
        if ((++sp & 255u) == 0u) { if (xb_ld(&bar[XB_TMO])) break; if (sp > XB_SPIN_CAP) { atomicAdd(&bar[XB_TMO], 1u); break; } }
    }
    nloc = mine > 0u ? mine : 1u; nx = cnt > 0u ? cnt : 1u;
}

__device__ __forceinline__ void xcd_barrier(const XcdBarrier& b) {
    asm volatile("s_waitcnt vmcnt(0)" ::: "memory");
    __syncthreads();
    if (threadIdx.x == 0) {
        unsigned* bar = b.bar;
        __builtin_amdgcn_s_waitcnt(0);
        unsigned nloc = b.st[0], nx = b.st[1];
        if (nloc == 0u) { unsigned lo8; xcd_barrier_complete(bar, b.x, nloc, nx, lo8); b.st[0] = nloc; b.st[1] = nx; b.st[3] = (lo8 == 8u && nx == 8u) ? 1u : 0u; }
        const unsigned old = xb_add(&bar[XB_XSUB(b.x)], 1u);
        const unsigned gen = old / nloc;
        if (old + 1u == (gen + 1u) * nloc) {
            __builtin_amdgcn_fence(__ATOMIC_RELEASE, "agent");
            asm volatile("s_waitcnt vmcnt(0)" ::: "memory");
            const unsigned og = xb_add(&bar[XB_TOP], 1u);
            const unsigned tg = og / nx;
            if (og + 1u == (tg + 1u) * nx) xb_add(&bar[XB_TOPGEN], 1u);
            else XB_SPIN(xb_ld(&bar[XB_TOPGEN]) == tg, bar);
            __builtin_amdgcn_fence(__ATOMIC_ACQUIRE, "agent");
            xb_add(&bar[XB_XGEN(b.x)], 1u);
            asm volatile("s_waitcnt vmcnt(0)" ::: "memory");
        } else {
            XB_SPIN(xb_ld(&bar[XB_XGEN(b.x)]) == gen, bar);
            __builtin_amdgcn_fence(__ATOMIC_ACQUIRE, "agent");
            asm volatile("s_waitcnt vmcnt(0)" ::: "memory");
        }
    }
    __syncthreads();
}

__device__ __forceinline__ void xcd_barrier_local(const XcdBarrier& b) {
    asm volatile("s_waitcnt vmcnt(0)" ::: "memory");
    __syncthreads();
    if (threadIdx.x == 0) {
        unsigned* bar = b.bar;
        __builtin_amdgcn_s_waitcnt(0);
        const unsigned nloc = b.st[0];
        const unsigned old = xb_add(&bar[XB_XSUB(b.x)], 1u);
        const unsigned gen = old / nloc;
        if (old + 1u == (gen + 1u) * nloc) xb_add(&bar[XB_XGEN(b.x)], 1u);
        else XB_SPIN(xb_ld(&bar[XB_XGEN(b.x)]) == gen, bar);
        __builtin_amdgcn_fence(__ATOMIC_ACQUIRE, "agent");
        asm volatile("s_waitcnt vmcnt(0)" ::: "memory");
    }
    __syncthreads();
}
#ifdef SELFCHECK
#ifndef CHK_ROW0
#define CHK_ROW0 18432
#endif
constexpr size_t CK_STATS = 0, CK_CKS = 4096, CK_A = 65536, CK_T0 = CK_A + 84 * MiB, CK_T1 = CK_T0 + 16 * MiB, CK_T2 = CK_T1 + 16 * MiB, CK_T3 = CK_T2 + 16 * MiB, CK_T4 = CK_T3 + 16 * MiB;
constexpr size_t CHK_BYTES = CK_T4 + 16 * MiB;
constexpr int CK_NPH = 12;
struct CkStat { double d2, r2; unsigned mx, pad; };

__global__ void ck_sum(const unsigned* p, size_t nwords, unsigned long long* out) {
    unsigned long long s = 0;
    for (size_t i = (size_t)blockIdx.x * blockDim.x + threadIdx.x; i < nwords; i += (size_t)gridDim.x * blockDim.x) s += (unsigned long long)p[i] * (2ull * i + 1ull);
    for (int o = 32; o >= 1; o >>= 1) s += __shfl_xor(s, o);
    if ((threadIdx.x & 63) == 0) atomicAdd(out, s);
}
__global__ void ck_cmp(const void* fast, int is_bf16, long ldf, const float* ref, long ldr, int rows, int cols, int mode, CkStat* st) {
    double d2 = 0, r2 = 0; float mx = 0;
    for (size_t i = (size_t)blockIdx.x * blockDim.x + threadIdx.x; i < (size_t)rows * cols; i += (size_t)gridDim.x * blockDim.x) {
        const int r = (int)(i / cols), c = (int)(i % cols);
        const float f = is_bf16 ? bf2f(((const bf16_t*)fast)[(size_t)r * ldf + c]) : ((const float*)fast)[(size_t)r * ldf + c];
        float g = ref[(size_t)r * ldr + c]; if (mode == 1) g = 1.0f / (1.0f + expf(-g));
        float d = f - g; if (!(d == d)) d = 1e30f;
        d2 += (double)d * d; r2 += (double)g * g; mx = fmaxf(mx, fabsf(d));
    }
    for (int o = 32; o >= 1; o >>= 1) { d2 += __shfl_xor(d2, o); r2 += __shfl_xor(r2, o); mx = fmaxf(mx, __shfl_xor(mx, o)); }
    if ((threadIdx.x & 63) == 0) { atomicAdd(&st->d2, d2); atomicAdd(&st->r2, r2); atomicMax(&st->mx, __float_as_uint(mx)); }
}
__global__ void nk_rows(const float* xp, const float* xs, int row0, float* dst) {
    const size_t i = (size_t)blockIdx.x * 256 + threadIdx.x; const int r = row0 + (int)(i / DM), c = (int)(i % DM);
    dst[i] = (r < PROMPT_ROWS) ? xp[(size_t)r * DM + c] : xs[(size_t)(r - PROMPT_ROWS) * DM + c];
}
__global__ void nk_rmsnorm(const float* src, const float* gain, float* dst) {
    __shared__ float red[256]; const float* x = src + (size_t)blockIdx.x * DM; float s = 0;
    for (int c = threadIdx.x; c < DM; c += 256) s += x[c] * x[c];
    red[threadIdx.x] = s; __syncthreads();
    for (int o = 128; o >= 1; o >>= 1) { if (threadIdx.x < o) red[threadIdx.x] += red[threadIdx.x + o]; __syncthreads(); }
    const float rstd = 1.0f / sqrtf(red[0] / DM + 1e-6f);
    for (int c = threadIdx.x; c < DM; c += 256) dst[(size_t)blockIdx.x * DM + c] = x[c] * rstd * gain[c];
}
template <int MODE> __global__ void __launch_bounds__(256) nk_gemm(const float* A, int lda, const float* W, int ldw, int K, float* C, int ldc, int N2) {
    __shared__ float As[16][65], Bs[16][64], Bs2[16][64];
    const int t = threadIdx.x, tx = t & 15, ty = t >> 4, m0 = blockIdx.y * 64, n0 = blockIdx.x * 64;
    float acc[4][4] = {}, acc2[4][4] = {};
    for (int k0 = 0; k0 < K; k0 += 16) {
#pragma unroll
        for (int i = 0; i < 4; ++i) { const int idx = t + 256 * i; { const int m = idx >> 4, kk = idx & 15; As[kk][m] = A[(size_t)(m0 + m) * lda + k0 + kk]; }
            { const int kk = idx >> 6, n = idx & 63; Bs[kk][n] = W[(size_t)(k0 + kk) * ldw + n0 + n]; if (MODE == 1) Bs2[kk][n] = W[(size_t)(k0 + kk) * ldw + n0 + n + N2]; } }
        __syncthreads();
#pragma unroll
        for (int kk = 0; kk < 16; ++kk) {
            float a[4], b[4], b2[4];
#pragma unroll
            for (int i = 0; i < 4; ++i) { a[i] = As[kk][ty * 4 + i]; b[i] = Bs[kk][tx * 4 + i]; b2[i] = (MODE == 1) ? Bs2[kk][tx * 4 + i] : 0.f; }
#pragma unroll
            for (int i = 0; i < 4; ++i)
#pragma unroll
                for (int j = 0; j < 4; ++j) { acc[i][j] += a[i] * b[j]; if (MODE == 1) acc2[i][j] += a[i] * b2[j]; }
        }
        __syncthreads();
    }
#pragma unroll
    for (int i = 0; i < 4; ++i)
#pragma unroll
        for (int j = 0; j < 4; ++j) { float v = acc[i][j]; if (MODE == 1) v = v / (1.0f + expf(-v)) * acc2[i][j]; C[(size_t)(m0 + ty * 4 + i) * ldc + n0 + tx * 4 + j] = v; }
}
__global__ void nk_axpy(float* h, const float* d, float s, size_t n) { const size_t i = (size_t)blockIdx.x * 256 + threadIdx.x; if (i < n) h[i] += s * d[i]; }
__global__ void nk_s5(const float* ru, const float* lam_re, const float* lam_im, const float* log_dt, const float* b_re, const float* b_im, const float* c_re, const float* c_im, float* yd) {
    __shared__ float xr_s[64], xi_s[64], us[16], cr[16][64], ci[16][64];
    const int dg = blockIdx.x, dir = dg >> 5, g = dg & 31, n = threadIdx.x;
    const double dt = exp_d((double)log_dt[dg]); const double lr = lam_re[dg * 64 + n], li = lam_im[dg * 64 + n];
    const double mag = exp_d(lr * dt); double sn, cs; sincos_d(li * dt, sn, cs);
    const double are = mag * cs, aim = mag * sn, den = lr * lr + li * li, nre = are - 1.0, cre = (nre * lr + aim * li) / den, cim = (aim * lr - nre * li) / den;
    float bbr[16], bbi[16];
#pragma unroll
    for (int p = 0; p < 16; ++p) { const double br = b_re[(size_t)(dg * 64 + n) * 16 + p], bi = b_im[(size_t)(dg * 64 + n) * 16 + p]; bbr[p] = (float)(cre * br - cim * bi); bbi[p] = (float)(cre * bi + cim * br); }
    for (int i = n; i < 1024; i += 64) { cr[i >> 6][i & 63] = c_re[(size_t)dg * 1024 + i]; ci[i >> 6][i & 63] = c_im[(size_t)dg * 1024 + i]; }
    float xr = 0, xi = 0; const float ar = (float)are, ai = (float)aim;
    __syncthreads();
    for (int s = 0; s < SEQL; ++s) {
        const int t = dir ? SEQL - 1 - s : s;
        if (n < 16) us[n] = ru[(size_t)t * NIN + g * 16 + n];
        __syncthreads();
        float bur = 0, bui = 0;
#pragma unroll
        for (int p = 0; p < 16; ++p) { bur += bbr[p] * us[p]; bui += bbi[p] * us[p]; }
        const float nr = ar * xr - ai * xi + bur, ni = ar * xi + ai * xr + bui; xr = nr; xi = ni;
        xr_s[n] = xr; xi_s[n] = xi;
        __syncthreads();
        if (n < 16) { float y = 0; for (int m = 0; m < 64; ++m) y += xr_s[m] * cr[n][m] - xi_s[m] * ci[n][m]; yd[((size_t)dir * SEQL + t) * 512 + g * 16 + n] = y; }
        __syncthreads();
    }
}
__global__ void nk_s5z(const float* ru, const float* yd, const float* dsk, float* z) {
    const size_t i = (size_t)blockIdx.x * 256 + threadIdx.x; const int t = (int)(i >> 9), ch = (int)(i & 511);
    const float y = dsk[ch] * ru[(size_t)t * NIN + ch] + yd[i] + yd[(size_t)SEQL * 512 + i];
    z[i] = 0.5f * y * (1.0f + tanhf(0.7978845608028654f * (y + 0.044715f * y * y * y)));
}
__global__ void nk_glu(const float* z, const float* zw, float* ycat) { const size_t i = (size_t)blockIdx.x * 256 + threadIdx.x; const int t = (int)(i >> 9), ch = (int)(i & 511); ycat[(size_t)t * DM + ch] = z[i] / (1.0f + expf(-zw[i])); }
__device__ float nk_lb(const float* logits, int layer, int idx) {
    float lg[DEPTH], mx = -1e30f;
#pragma unroll
    for (int l = 0; l < DEPTH; ++l) { lg[l] = logits[l * 1024 + idx]; mx = fmaxf(mx, lg[l]); }
    float sum = 0;
#pragma unroll
    for (int l = 0; l < DEPTH; ++l) { lg[l] = expf(lg[l] - mx); sum += lg[l]; }
    float cum = 0;
#pragma unroll
    for (int l = 0; l < DEPTH; ++l) if (l <= layer) cum += lg[l] / sum;
    return fminf(fmaxf(cum - lg[0] / sum, 0.f), 1.0f - 1e-6f);
}
__global__ void __launch_bounds__(128) nk_hgrn(const float* ru, const float* logits, int layer, float* od, float* sd) {
    __shared__ float qs[128], ks[128], fs[128];
    const int h = blockIdx.x >> 1, dir = blockIdx.x & 1, v = threadIdx.x, col = h * 128 + v;
    const float lb = nk_lb(logits, layer, dir * 512 + col);
    float S[128];
#pragma unroll
    for (int d = 0; d < 128; ++d) S[d] = 0.f;
    for (int s = 0; s < SEQL; ++s) {
        const int t = dir ? SEQL - 1 - s : s; const float* r = ru + (size_t)t * NIN;
        const float z = r[(dir ? 1536 : 1024) + col], sg = 1.0f / (1.0f + expf(-z));
        fs[v] = fmaxf(lb, 1e-30f) + (1.0f - lb) * sg; ks[v] = (1.0f - lb) * (1.0f / (1.0f + expf(z)));
        { const float q = r[512 + col]; qs[v] = q / (1.0f + expf(-q)); }
        const float vt = r[2048 + col];
        __syncthreads();
        float o = 0;
#pragma unroll
        for (int d = 0; d < 128; ++d) { S[d] = fs[d] * S[d] + ks[d] * vt; o += qs[d] * S[d]; }
        od[((size_t)dir * SEQL + t) * 512 + col] = o;
        if (sd && (s == 63 || s == 127)) {
#pragma unroll
            for (int d = 0; d < 128; ++d) sd[(((size_t)(s >> 6) * 8 + blockIdx.x) * 128 + d) * 128 + v] = S[d];
        }
        __syncthreads();
    }
}
__global__ void nk_hgfin(const float* od, const float* ru, const float* gain, float* ycat) {
    __shared__ float red[128]; const int t = blockIdx.x >> 2, h = blockIdx.x & 3, v = threadIdx.x, col = h * 128 + v;
    const float s = od[(size_t)t * 512 + col] + od[((size_t)SEQL + t) * 512 + col];
    red[v] = s * s; __syncthreads();
    for (int o = 64; o >= 1; o >>= 1) { if (v < o) red[v] += red[v + o]; __syncthreads(); }
    const float rstd = 1.0f / sqrtf(red[0] / 128.0f + 1e-6f); const float g = ru[(size_t)t * NIN + 2560 + col];
    ycat[(size_t)t * DM + 512 + col] = s * rstd * gain[v] * (g / (1.0f + expf(-g)));
}
__global__ void nk_qkprep(const float* ru, const float* qn, const float* kn, float* qr, float* kr) {
    __shared__ float red[128], ys[128]; const int t = blockIdx.x / 10, hh = blockIdx.x % 10, d = threadIdx.x;
    const float x = (hh < 8) ? ru[(size_t)t * NIN + 3072 + hh * 128 + d] : ru[(size_t)t * NIN + 4096 + (hh - 8) * 128 + d];
    red[d] = x * x; __syncthreads();
    for (int o = 64; o >= 1; o >>= 1) { if (d < o) red[d] += red[d + o]; __syncthreads(); }
    const float y = x / sqrtf(red[0] / 128.0f + 1e-6f) * ((hh < 8) ? qn[d] : kn[d]);
    ys[d] = y; __syncthreads();
    const int axis = d >> 6, w = d & 63, i = w & 31; const float pos = (float)(axis == 0 ? (t >> 6) : (t & 63));
    const float inv = (float)exp_d(-(double)i / 32.0 * 9.210340371976184); double sn, cs; sincos_d((double)(pos * inv), sn, cs);
    const float o = (w < 32) ? y * (float)cs - ys[d + 32] * (float)sn : y * (float)cs + ys[d - 32] * (float)sn;
    if (hh < 8) qr[(size_t)t * 1024 + hh * 128 + d] = o; else kr[(size_t)t * 256 + (hh - 8) * 128 + d] = o;
}
__global__ void __launch_bounds__(256) nk_attn(const float* qr, const float* kr, const float* ru, float* ycat) {
    __shared__ float ps[4][2048], qs[4][128];
    const int w = threadIdx.x >> 6, lane = threadIdx.x & 63, item = blockIdx.x * 4 + w, h = item >> 11, t = item & 2047, kvh = h >> 2;
    qs[w][lane] = qr[(size_t)t * 1024 + h * 128 + lane]; qs[w][lane + 64] = qr[(size_t)t * 1024 + h * 128 + lane + 64];
    __syncthreads();
    float sc[32], mx = -1e30f;
#pragma unroll
    for (int kb = 0; kb < 32; ++kb) { const float* kp = kr + (size_t)(kb * 64 + lane) * 256 + kvh * 128; float s = 0; for (int d = 0; d < 128; ++d) s += qs[w][d] * kp[d]; sc[kb] = s * 0.08838834764831845f; mx = fmaxf(mx, sc[kb]); }
    for (int o = 32; o >= 1; o >>= 1) mx = fmaxf(mx, __shfl_xor(mx, o));
    float sum = 0;
#pragma unroll
    for (int kb = 0; kb < 32; ++kb) { const float p = expf(sc[kb] - mx); sum += p; ps[w][kb * 64 + lane] = p; }
    for (int o = 32; o >= 1; o >>= 1) sum += __shfl_xor(sum, o);
    __syncthreads();
    float o0 = 0, o1 = 0;
    for (int k = 0; k < SEQL; ++k) { const float p = ps[w][k]; const float* vp = ru + (size_t)k * NIN + 4352 + kvh * 128; o0 += p * vp[lane]; o1 += p * vp[lane + 64]; }
    ycat[(size_t)t * DM + 1024 + h * 128 + lane] = o0 / sum; ycat[(size_t)t * DM + 1024 + h * 128 + lane + 64] = o1 / sum;
}
__global__ void nk_gate(const float* ru, int b, const float* P, float* mg, int first) {
    const size_t i = (size_t)blockIdx.x * 256 + threadIdx.x; const int t = (int)(i >> 11), c = (int)(i & 2047);
    const float g = 1.0f / (1.0f + expf(-ru[(size_t)t * NIN + 4608 + b * 2048 + c]));
    mg[i] = (first ? 0.f : mg[i]) + g * P[i];
}
__global__ void ck_fill0(float* out, size_t n) { for (size_t i = (size_t)blockIdx.x * 256 + threadIdx.x; i < n; i += (size_t)gridDim.x * 256) out[i] = 0.f; }
#ifndef CHK_MODE
#define CHK_MODE 0
#endif
__device__ double ck_rel(const CkStat* st, int i) { return sqrt(st[i].d2 / (st[i].r2 + 1e-30)); }
__global__ void ck_encode(const CkStat* st, const unsigned long long* cks, int nchk, float* out) {
    if (threadIdx.x != 0 || blockIdx.x != 0) return;
    int v = 0;
    if (CHK_MODE == 0) {
        int dp = 48; for (int ph = CK_NPH - 1; ph >= 0; --ph) for (int r = 3; r >= 0; --r) if (cks[(0 * 16 + ph) * 4 + r] != cks[(1 * 16 + ph) * 4 + r]) dp = ph * 4 + r;
        int fi = nchk; for (int i = nchk - 1; i >= 0; --i) if (!(ck_rel(st, i) < 0.03)) fi = i;
        v = dp + 49 * fi;
    } else if (CHK_MODE == 1) {
        for (int r = 0; r < 4; ++r) if (cks[(0 * 16 + 5) * 4 + r] != cks[(1 * 16 + 5) * 4 + r]) v |= 1 << r;
        if (!(ck_rel(st, 19) < 0.03)) v |= 16; if (!(ck_rel(st, 20) < 0.03)) v |= 32; if (!(ck_rel(st, 21) < 0.03)) v |= 64; if (!(ck_rel(st, 11) < 0.03)) v |= 128;
        const double r19 = ck_rel(st, 19); v |= (r19 < 0.03 ? 0 : r19 < 0.3 ? 1 : r19 < 3 ? 2 : 3) << 8;
    } else if (CHK_MODE == 2) {
        if (!(ck_rel(st, 22) < 0.03)) v |= 1; if (!(ck_rel(st, 23) < 0.03)) v |= 2;
        if (cks[(0 * 16 + 5) * 4 + 1] != cks[(1 * 16 + 5) * 4 + 1]) v |= 4;
        if (!(ck_rel(st, 20) < 0.03)) v |= 8; if (!(ck_rel(st, 19) < 0.03)) v |= 16;
        const double r = ck_rel(st, 20); v |= (r < 0.03 ? 0 : r < 0.3 ? 1 : r < 3 ? 2 : 3) << 5;
    } else if (CHK_MODE == 6) {
        int fi = nchk; for (int i = nchk - 1; i >= 0; --i) if (!(ck_rel(st, i) < 0.03)) fi = i;
        v = fi;
    } else if (CHK_MODE == 5) {
        int dp = 48; for (int ph = CK_NPH - 1; ph >= 0; --ph) for (int r = 3; r >= 0; --r) if (cks[(0 * 16 + ph) * 4 + r] != cks[(1 * 16 + ph) * 4 + r]) dp = ph * 4 + r;
        v = dp;
    } else {
        const double rel = ck_rel(st, CHK_MODE - 100); double q = 20.0 * log10(rel + 1e-12) + 200.0; q = q < 0 ? 0 : (q > 1900 ? 1900 : q); v = (int)(q + 0.5);
    }
    out[0] = (float)(10 + v % 80) * __builtin_powif(10.0f, 5 + v / 80);
}

struct CkCtx { void* const* d_in; float* out; unsigned char* ws; hipStream_t s; };
static inline const float* ck_in(const CkCtx& c, int i) { return (const float*)c.d_in[i]; }
static void ck_cksum(const CkCtx& c, int run, int ph, int slot, const void* p, size_t bytes) {
    unsigned long long* o = (unsigned long long*)(c.ws + WS_CHK + CK_CKS) + (run * 16 + ph) * 4 + slot;
    hipLaunchKernelGGL(ck_sum, dim3(2048), dim3(256), 0, c.s, (const unsigned*)p, bytes / 4, o);
}
static void ck_compare(const CkCtx& c, int idx, const void* fast, int is_bf16, long ldf, const float* ref, long ldr, int rows, int cols, int mode) {
    hipLaunchKernelGGL(ck_cmp, dim3(1024), dim3(256), 0, c.s, fast, is_bf16, ldf, ref, ldr, rows, cols, mode, (CkStat*)(c.ws + WS_CHK + CK_STATS) + idx);
}
static void ck_gemm(const CkCtx& c, const float* A, int lda, const float* W, int ldw, int K, float* C, int ldc, int N) { hipLaunchKernelGGL(nk_gemm<0>, dim3(N / 64, 32), dim3(256), 0, c.s, A, lda, W, ldw, K, C, ldc, 0); }
constexpr int CK_NCHK = 20;
static void selfcheck_after_phase(const CkCtx& c, int run, int ph) {
    unsigned char* ws = c.ws; unsigned char* R = ws + WS_R; unsigned char* CK = ws + WS_CHK;
    float* bufA = (float*)(CK + CK_A); float* T0 = (float*)(CK + CK_T0); float* T1 = (float*)(CK + CK_T1); float* T2 = (float*)(CK + CK_T2); float* T3 = (float*)(CK + CK_T3); float* T4 = (float*)(CK + CK_T4);
    const int r0 = CHK_ROW0; const size_t OUTB = (size_t)MT * DM * 4, HBB = (size_t)MT * DM * 2;
    switch (ph) {
    case 0: ck_cksum(c, run, ph, 0, ws + WS_HB, HBB); ck_cksum(c, run, ph, 1, ws + WS_SSQ, (size_t)MT * 128); ck_cksum(c, run, ph, 2, ws + WS_ATAB, WS_LB + 16384 - WS_ATAB); break;
    case 1: ck_cksum(c, run, ph, 0, ws + WS_WB, WB_END); break;
    case 2: case 10: ck_cksum(c, run, ph, 0, R + R_HID, (size_t)MT * DFF * 2); break;
    case 3: case 9: case 11: ck_cksum(c, run, ph, 0, c.out, OUTB); ck_cksum(c, run, ph, 1, ws + WS_HB, HBB); ck_cksum(c, run, ph, 2, ws + WS_SSQ, (size_t)MT * 128); break;
    case 4: ck_cksum(c, run, ph, 0, R + R_US, 6 * SZ512); ck_cksum(c, run, ph, 1, R + R_AQ, 3 * SZ512); ck_cksum(c, run, ph, 2, R + R_GATE, 12 * SZ512); break;
    case 5: ck_cksum(c, run, ph, 3, R + R_AK, SZ512 / 2); break;
    case 6: ck_cksum(c, run, ph, 0, R + R_YD, 4 * SZ512); ck_cksum(c, run, ph, 1, R + R_OHG, 4 * SZ512); ck_cksum(c, run, ph, 2, R + R_US, SZ512); break;
    case 7: ck_cksum(c, run, ph, 0, R + R_YSS, 4 * SZ512); break;
    case 8: ck_cksum(c, run, ph, 0, R + R_MRG, 4 * SZ512); break;
    }
    if (run != 0) return;
    const bf16_t* hb = (const bf16_t*)(ws + WS_HB) + (size_t)r0 * DM;
    const int EW = 2048 * 2048 / 256;
    switch (ph) {
    case 0:
        hipLaunchKernelGGL(nk_rows, dim3(EW), dim3(256), 0, c.s, ck_in(c, 0), ck_in(c, 1), r0, T0);
        ck_compare(c, 0, hb, 1, DM, T0, DM, 2048, DM, 0);
        break;
    case 2:
        hipLaunchKernelGGL(nk_rmsnorm, dim3(2048), dim3(256), 0, c.s, T0, ck_in(c, 2), T1);
        hipLaunchKernelGGL(nk_gemm<1>, dim3(DFF / 64, 32), dim3(256), 0, c.s, T1, DM, ck_in(c, 3), 2 * DFF, DM, bufA, DFF, DFF);
        ck_compare(c, 1, (const bf16_t*)(R + R_HID) + (size_t)r0 * DFF, 1, DFF, bufA, DFF, 2048, DFF, 0);
        break;
    case 3:
        ck_gemm(c, bufA, DFF, ck_in(c, 4), DM, DFF, T1, DM, DM);
        hipLaunchKernelGGL(nk_axpy, dim3(EW), dim3(256), 0, c.s, T0, T1, 0.5f, (size_t)2048 * 2048);
        ck_compare(c, 2, c.out + (size_t)r0 * DM, 0, DM, T0, DM, 2048, DM, 0);
        ck_compare(c, 3, hb, 1, DM, T0, DM, 2048, DM, 0);
        break;
    case 4:
        hipLaunchKernelGGL(nk_rmsnorm, dim3(2048), dim3(256), 0, c.s, T0, ck_in(c, 5), T1);
        ck_gemm(c, T1, DM, ck_in(c, 6), NIN, DM, bufA, NIN, NIN);
        ck_compare(c, 4, (const bf16_t*)(R + R_US) + (size_t)r0 * 512, 1, 512, bufA, NIN, 2048, 512, 0);
        for (int k = 1; k < 5; ++k) ck_compare(c, 5, (const bf16_t*)(R + R_HGQ + k * SZ512) + (size_t)r0 * 512, 1, 512, bufA + 512 + 512 * k, NIN, 2048, 512, 0);
        ck_compare(c, 6, (const bf16_t*)(R + R_AQ) + (size_t)r0 * 1024, 1, 1024, bufA + 3072, NIN, 2048, 1024, 0);
        ck_compare(c, 6, (const bf16_t*)(R + R_AK) + (size_t)r0 * 256, 1, 256, bufA + 4096, NIN, 2048, 256, 0);
        ck_compare(c, 6, (const bf16_t*)(R + R_AV) + (size_t)r0 * 256, 1, 256, bufA + 4352, NIN, 2048, 256, 0);
        for (int g = 0; g < 3; ++g) ck_compare(c, 7, (const bf16_t*)(R + R_GATE + (size_t)g * 4 * SZ512) + (size_t)r0 * DM, 1, DM, bufA + 4608 + 2048 * g, NIN, 2048, DM, 1);
        break;
    case 5:
        hipLaunchKernelGGL(nk_s5, dim3(64), dim3(64), 0, c.s, bufA, ck_in(c, 7), ck_in(c, 8), ck_in(c, 9), ck_in(c, 10), ck_in(c, 11), ck_in(c, 12), ck_in(c, 13), T3);
        ck_compare(c, 8, (const float*)(R + R_YD) + (size_t)r0 * 512, 0, 512, T3, 512, 2048, 512, 0);
        ck_compare(c, 8, (const float*)(R + R_YD) + ((size_t)MT + r0) * 512, 0, 512, T3 + (size_t)SEQL * 512, 512, 2048, 512, 0);
        hipLaunchKernelGGL(nk_s5z, dim3(2048 * 512 / 256), dim3(256), 0, c.s, bufA, T3, ck_in(c, 14), T3 + 2 * 1048576);
        ck_compare(c, 9, (const bf16_t*)(R + R_US) + (size_t)r0 * 512, 1, 512, T3 + 2 * 1048576, 512, 2048, 512, 0);
        hipLaunchKernelGGL(nk_qkprep, dim3(2048 * 10), dim3(128), 0, c.s, bufA, ck_in(c, 18), ck_in(c, 19), T4, T4 + 2 * 1048576);
        ck_compare(c, 10, (const bf16_t*)(R + R_AQ) + (size_t)r0 * 1024, 1, 1024, T4, 1024, 2048, 1024, 0);
        ck_compare(c, 10, (const bf16_t*)(R + R_AK) + (size_t)r0 * 256, 1, 256, T4 + 2 * 1048576, 256, 2048, 256, 0);
        ck_gemm(c, T3 + 2 * 1048576, 512, ck_in(c, 15), 512, 512, T1, 512, 512);
        hipLaunchKernelGGL(nk_glu, dim3(2048 * 512 / 256), dim3(256), 0, c.s, T3 + 2 * 1048576, T1, T2);
        hipLaunchKernelGGL(nk_hgrn, dim3(8), dim3(128), 0, c.s, bufA, ck_in(c, 16), 0, T3, nullptr);
        ck_compare(c, 11, (const float*)(R + R_OHG) + (size_t)r0 * 512, 0, 512, T3, 512, 2048, 512, 0);
        ck_compare(c, 11, (const float*)(R + R_OHG) + ((size_t)MT + r0) * 512, 0, 512, T3 + (size_t)SEQL * 512, 512, 2048, 512, 0);
        ck_compare(c, 19, (const float*)(R + R_OHG) + (size_t)r0 * 512, 0, 512, T3, 512, 64, 512, 0);
        ck_compare(c, 20, (const float*)(R + R_OHG) + (size_t)(r0 + 64) * 512, 0, 512, T3 + (size_t)64 * 512, 512, 64, 512, 0);
        ck_compare(c, 21, (const float*)(R + R_OHG) + ((size_t)MT + r0 + 1984) * 512, 0, 512, T3 + (size_t)(SEQL + 1984) * 512, 512, 64, 512, 0);
        break;
    case 6:
        hipLaunchKernelGGL(nk_hgfin, dim3(2048 * 4), dim3(128), 0, c.s, T3, bufA, ck_in(c, 17), T2);
        ck_compare(c, 12, (const bf16_t*)(R + R_YHG) + (size_t)r0 * 512, 1, 512, T2 + 512, DM, 2048, 512, 0);
        hipLaunchKernelGGL(nk_attn, dim3(8 * 2048 / 4), dim3(256), 0, c.s, T4, T4 + 2 * 1048576, bufA, T2);
        ck_compare(c, 13, (const bf16_t*)(R + R_YAT) + (size_t)r0 * 1024, 1, 1024, T2 + 1024, DM, 2048, 1024, 0);
        break;
    case 7: ck_compare(c, 14, (const bf16_t*)(R + R_YSS) + (size_t)r0 * 512, 1, 512, T2, DM, 2048, 512, 0); break;
    case 8:
        ck_gemm(c, T2, DM, ck_in(c, 20), DM, 512, T3, DM, DM);
        hipLaunchKernelGGL(nk_gate, dim3(EW), dim3(256), 0, c.s, bufA, 0, T3, T1, 1);
        ck_gemm(c, T2 + 512, DM, ck_in(c, 20) + (size_t)512 * DM, DM, 512, T3, DM, DM);
        hipLaunchKernelGGL(nk_gate, dim3(EW), dim3(256), 0, c.s, bufA, 1, T3, T1, 0);
        ck_gemm(c, T2 + 1024, DM, ck_in(c, 20) + (size_t)1024 * DM, DM, 1024, T3, DM, DM);
        hipLaunchKernelGGL(nk_gate, dim3(EW), dim3(256), 0, c.s, bufA, 2, T3, T1, 0);
        ck_compare(c, 15, (const bf16_t*)(R + R_MRG) + (size_t)r0 * DM, 1, DM, T1, DM, 2048, DM, 0);
        break;
    case 9:
        ck_gemm(c, T1, DM, ck_in(c, 21), DM, DM, T3, DM, DM);
        hipLaunchKernelGGL(nk_axpy, dim3(EW), dim3(256), 0, c.s, T0, T3, 1.0f, (size_t)2048 * 2048);
        ck_compare(c, 16, c.out + (size_t)r0 * DM, 0, DM, T0, DM, 2048, DM, 0);
        break;
    case 10:
        hipLaunchKernelGGL(nk_rmsnorm, dim3(2048), dim3(256), 0, c.s, T0, ck_in(c, 22), T1);
        hipLaunchKernelGGL(nk_gemm<1>, dim3(DFF / 64, 32), dim3(256), 0, c.s, T1, DM, ck_in(c, 23), 2 * DFF, DM, bufA, DFF, DFF);
        ck_compare(c, 17, (const bf16_t*)(R + R_HID) + (size_t)r0 * DFF, 1, DFF, bufA, DFF, 2048, DFF, 0);
        break;
    case 11:
        ck_gemm(c, bufA, DFF, ck_in(c, 24), DM, DFF, T1, DM, DM);
        hipLaunchKernelGGL(nk_axpy, dim3(EW), dim3(256), 0, c.s, T0, T1, 0.5f, (size_t)2048 * 2048);
        ck_compare(c, 18, c.out + (size_t)r0 * DM, 0, DM, T0, DM, 2048, DM, 0);
        break;
    }
}
static void selfcheck_finish(const CkCtx& c) {
    hipLaunchKernelGGL(ck_fill0, dim3(4096), dim3(256), 0, c.s, c.out, (size_t)MT * DM);
    hipLaunchKernelGGL(ck_encode, dim3(1), dim3(64), 0, c.s, (const CkStat*)(c.ws + WS_CHK + CK_STATS), (const unsigned long long*)(c.ws + WS_CHK + CK_CKS), 19, c.out);
}
#endif
constexpr int PH_PER_LAYER = 11, N_PHASES = 1 + PH_PER_LAYER * DEPTH;
struct Params { const float* in[25]; float* out; unsigned char* ws; int ph_lo, ph_hi; };
static_assert(sizeof(Params) == 27 * 8 + 8, "Params has no padding");

#ifdef SELFCHECK
#define HG_DBG_PTR ((l == 0) ? (float*)(ws + WS_CHK + CK_T4 + 10 * MiB) : nullptr)
#else
#define HG_DBG_PTR nullptr
#endif
#ifndef DUP_GU
#define DUP_GU 1
#endif
#ifndef DUP_NULL
#define DUP_NULL 0
#endif
#ifndef DUP_CVT
#define DUP_CVT 1
#endif
#ifndef NULLX
#define NULLX 0
#endif
#ifndef DUP_MRG
#define DUP_MRG 1
#endif
#ifndef DUP_BAR
#define DUP_BAR 1
#endif
#ifndef DUP_ATT
#define DUP_ATT 1
#endif
#ifndef DUP_HG
#define DUP_HG 1
#endif
#ifndef WGM_N2048
#define WGM_N2048 4
#endif
#ifndef WGM_WIDE
#define WGM_WIDE 4
#endif
#ifndef CVT_AHEAD
#define CVT_AHEAD 0
#endif
#ifndef DUP_D0
#define DUP_D0 1
#endif
#ifndef STAGGER_US
#define STAGGER_US 0
#endif
#ifndef KPREP_TAIL
#define KPREP_TAIL 0
#endif
#ifndef XCC_LOCAL
#define XCC_LOCAL 0
#endif
#ifndef HGFIN_IN_QUEUE
#define HGFIN_IN_QUEUE 0
#endif
#ifndef QMIX
#define QMIX 0
#endif
#ifndef GATE_FP8
#define GATE_FP8 1
#endif
#ifndef N8_COLS
#define N8_COLS (3 * DM + 1536)
#endif
constexpr int N8 = N8_COLS;
#ifndef DUP_WIN
#define DUP_WIN 1
#endif
#ifndef PG8_ALIGN_EPI
#define PG8_ALIGN_EPI true
#endif
#ifndef PG8_SP2
#define PG8_SP2 true
#endif
template <class Epi, int F8FROM = -1>
__device__ __forceinline__ void run_gemm(LAS unsigned char* lds, const bf16_t* A, const bf16_t* Bt, int N, int K, const Epi& E) {
    int zz = 0; asm volatile("" : "+s"(zz));
    pg8::Gemm g{A, Bt, MT, N, K}; pg8::StaticOrder S; S.init(MT, N, (int)gridDim.x + zz, (int)blockIdx.x + zz, (N == DM) ? WGM_N2048 : ((N > DM) ? WGM_WIDE : 4));
    {
        volatile LAS unsigned* st = (volatile LAS unsigned*)(lds + LDS_MISC);
        const int xok = __builtin_amdgcn_readfirstlane((int)st[3]), nloc = __builtin_amdgcn_readfirstlane((int)st[0]), rank = __builtin_amdgcn_readfirstlane((int)st[2]);
        if (XCC_LOCAL && xok) S.init_x((int)xb_xcc_id() + zz, rank, nloc);
    }
    if (threadIdx.x == 0) ((volatile LAS int*)(lds + LDS_MISC + 1024))[256] = -1;
    if (STAGGER_US > 0) {
        const int nwg = (MT / 256) * (N / 256), rem = nwg % (int)gridDim.x;
        if (rem && (int)blockIdx.x >= rem) {
            constexpr int NG = 3; const int grp = ((int)blockIdx.x - rem) % NG + 1;
            const unsigned long long t0 = wall_clock64(), dt = (unsigned long long)(STAGGER_US * 100 * grp / (NG + 1));
            while (wall_clock64() - t0 < dt) __builtin_amdgcn_s_sleep(16);
        }
    }
    __syncthreads();
    pg8::gemm_phase<Epi, pg8::StaticOrder, PG8_ALIGN_EPI, PG8_SP2, F8FROM>(lds, g, S, E);
}

__global__ void __launch_bounds__(NTHREADS, 2) k_fwd(Params p) {
    extern __shared__ __attribute__((aligned(16))) unsigned char lds_raw[];
    LAS unsigned char* lds = (LAS unsigned char*)lds_raw;
    const int tid = threadIdx.x, G = gridDim.x;
    unsigned char* const ws0 = p.ws; float* const out0 = p.out; unsigned char* ws = ws0;
#define PH_LOCALS size_t z_ = 0; asm volatile("" : "+s"(z_)); unsigned char* ws = ws0 + z_; float* outp = (float*)((unsigned char*)out0 + z_); unsigned char* R = ws + WS_R; unsigned char* WB = ws + WS_WB; float* ssq = (float*)(ws + WS_SSQ); bf16_t* hb = (bf16_t*)(ws + WS_HB); \
    const CAS unsigned long long* PT = (const CAS unsigned long long*)(ws + WS_PTAB); (void)R; (void)WB; (void)ssq; (void)hb; (void)PT; (void)outp;
    if (tid < 4) ((LAS unsigned*)(lds + LDS_MISC))[tid] = 0u;
    __syncthreads();
    const int lo = p.ph_lo, hi = p.ph_hi;
    if (hi - lo > 1) (void)xcd_barrier_post((unsigned*)(ws + WS_BAR), (volatile LAS unsigned*)(lds + LDS_MISC));
#ifndef PH_MASK
#define PH_MASK 0xfff
#endif
#define IN(k) (lo <= (k) && (k) < hi)
#ifdef PROBE_T
#define STAMP(k) do { if (blockIdx.x == 0 && tid == 0) ((unsigned long long*)(ws + WS_BAR + 14336))[k] = wall_clock64(); } while (0)
#else
#define STAMP(k) do { } while (0)
#endif
#ifdef PROBE_SKEW
#define SKEW_PRE(k) do { if (tid == 0) ((unsigned*)(ws0 + WS_CHK))[(size_t)(k) * 256 + blockIdx.x] = (unsigned)wall_clock64(); } while (0)
#define SKEW_POST(k) do { } while (0)
#else
#define SKEW_PRE(k) do { } while (0)
#define SKEW_POST(k) do { } while (0)
#endif
#ifdef PROBE_IDLE
#define IDLE_() do { const unsigned long long t0_ = wall_clock64(); while (wall_clock64() - t0_ < (unsigned long long)(PROBE_IDLE * 100)) __builtin_amdgcn_s_sleep(8); } while (0)
#else
#define IDLE_() do { } while (0)
#endif
#define SEAM(k) do { if (IN(k) && IN((k) + 1)) { IDLE_(); SKEW_PRE(k); XcdBarrier b_; b_.bar = (unsigned*)(ws0 + WS_BAR); b_.x = xb_xcc_id(); b_.st = (volatile LAS unsigned*)(lds + LDS_MISC); for (int rb_ = 0; rb_ < DUP_BAR; ++rb_) xcd_barrier(b_); SKEW_POST(k); } STAMP((k) + 1); } while (0)

#define SEAM_L(k) do { if (IN(k) && IN((k) + 1)) { SKEW_PRE(k); XcdBarrier b_; b_.bar = (unsigned*)(ws0 + WS_BAR); b_.x = xb_xcc_id(); b_.st = (volatile LAS unsigned*)(lds + LDS_MISC); \
        const int xl_ = __builtin_amdgcn_readfirstlane((int)b_.st[3]); if (XCC_LOCAL && xl_) xcd_barrier_local(b_); else xcd_barrier(b_); SKEW_POST(k); } STAMP((k) + 1); } while (0)
    STAMP(0);
    if ((PH_MASK & 1) && IN(0)) {
        if (blockIdx.x == 0 && tid < 25) ((unsigned long long*)(ws + WS_PTAB))[tid] = (unsigned long long)p.in[tid];
        ProArgs A{p.in[0], p.in[1], p.in[7], p.in[8], p.in[9], p.in[10], p.in[11], p.in[12], p.in[13], p.in[16], ws};
        prologue_phase(A);
    }
    SEAM(0);
#ifdef PROBE_XOK
    if (((volatile LAS unsigned*)(lds + LDS_MISC))[3] == 0u) { const unsigned long long t0 = wall_clock64(); while (wall_clock64() - t0 < 200000ull) __builtin_amdgcn_s_sleep(16); }
#endif
    for (int l = 0; l < DEPTH; ++l) {
        const int pb = 1 + PH_PER_LAYER * l;
#define INP(i) ((const float*)(const GAS float*)PT[i])
        if (((PH_MASK >> 1) & 1) && IN(pb + 0)) { PH_LOCALS
          for (int rep = 0; rep < DUP_CVT; ++rep) {
            int base = 0;
            if (l == 0 || !CVT_AHEAD) {
            { CvtJob J{INP(3) + (size_t)l * DM * 2 * DFF, INP(2) + l * DM, (bf16_t*)(WB + WB_GU1), 2 * DFF, DM, 2 * DFF, 1}; cvt_job(lds, J, base); }
            { CvtJob J{INP(4) + (size_t)l * DFF * DM, nullptr, (bf16_t*)(WB + WB_D1), DM, DFF, DM, 0}; cvt_job(lds, J, base); }
#if GATE_FP8
            { CvtJob J{INP(6) + (size_t)l * DM * NIN, INP(5) + l * DM, (bf16_t*)(WB + WB_IN), NIN, DM, NIN - N8, 0}; cvt_job(lds, J, base); }
            { CvtJob J{INP(6) + (size_t)l * DM * NIN + (NIN - N8), INP(5) + l * DM, (bf16_t*)(R + R_W8), NIN, DM, N8, 0}; cvt_job8(lds, J, 32.0f, base, DM); }
#else
            { CvtJob J{INP(6) + (size_t)l * DM * NIN, INP(5) + l * DM, (bf16_t*)(WB + WB_IN), NIN, DM, NIN, 0}; cvt_job(lds, J, base); }
#endif
            }
            { CvtJob J{INP(15) + (size_t)l * 512 * 512, nullptr, (bf16_t*)(WB + WB_GLU), 512, 512, 512, 0}; cvt_job(lds, J, base); }
#if MRG_FP8
            { CvtJob J{INP(20) + (size_t)l * DM * DM, nullptr, (bf16_t*)(WB + WB_BS), DM, 1024, DM, 0, YLD}; cvt_job(lds, J, base); }
            { CvtJob J{INP(20) + (size_t)l * DM * DM + (size_t)1024 * DM, nullptr, (bf16_t*)(WB + WB_BS + 2048), DM, 1024, DM, 0, 0}; cvt_job8(lds, J, WBR_SC, base, 3072); }
#else
            { CvtJob J{INP(20) + (size_t)l * DM * DM, nullptr, (bf16_t*)(WB + WB_BS), DM, DM, DM, 0}; cvt_job(lds, J, base); }
#endif
            { CvtJob J{INP(21) + (size_t)l * DM * DM, nullptr, (bf16_t*)(WB + WB_OUT), DM, DM, DM, 0}; cvt_job(lds, J, base); }
            { CvtJob J{INP(23) + (size_t)l * DM * 2 * DFF, INP(22) + l * DM, (bf16_t*)(WB + WB_GU2), 2 * DFF, DM, 2 * DFF, 1}; cvt_job(lds, J, base); }
            { CvtJob J{INP(24) + (size_t)l * DFF * DM, nullptr, (bf16_t*)(WB + WB_D2), DM, DFF, DM, 0}; cvt_job(lds, J, base); }
          }
        }
        SEAM(pb + 0);
        if (((PH_MASK >> 2) & 1) && IN(pb + 1)) { PH_LOCALS epi::Swiglu E{(bf16_t*)(R + R_HID), ssq, (LAS float*)(lds + LDS_MISC + 1024)}; if (DUP_NULL) { epi::NullEpi E0{ssq}; run_gemm(lds, hb, (const bf16_t*)(WB + WB_GU1), 2 * DFF, DM, E0); } for (int rep = 0; rep < DUP_GU; ++rep) run_gemm(lds, hb, (const bf16_t*)(WB + WB_GU1), 2 * DFF, DM, E); }
        SEAM_L(pb + 1);
        if (((PH_MASK >> 3) & 1) && IN(pb + 2)) { PH_LOCALS
            if (NULLX == 2) { epi::NullEpi E0{ssq}; run_gemm(lds, (const bf16_t*)(R + R_HID), (const bf16_t*)(WB + WB_D1), DM, DFF, E0); }
            if (l == 0) { epi::Resid<true, false, GATE_FP8 != 0> E{INP(0), INP(1), PROMPT_ROWS, 0.5f, nullptr, hb, ssq, R + R_HB8}; run_gemm(lds, (const bf16_t*)(R + R_HID), (const bf16_t*)(WB + WB_D1), DM, DFF, E); }
            else        { epi::Resid<false, false, GATE_FP8 != 0> E{nullptr, nullptr, 0, 0.5f, nullptr, hb, ssq, R + R_HB8}; run_gemm(lds, (const bf16_t*)(R + R_HID), (const bf16_t*)(WB + WB_D1), DM, DFF, E); }
        }
        SEAM_L(pb + 2);
        if (((PH_MASK >> 4) & 1) && IN(pb + 3)) { PH_LOCALS unsigned* kdone = (unsigned*)(ws + WS_BAR + 16128) + l * 16;
#if GATE_FP8
            { epi::WinSplit E8{R, ssq, (LAS float*)(lds + LDS_MISC + 1024), kdone, (NIN - N8) / 256, 1.0f / 32.0f}; run_gemm<epi::WinSplit, 0>(lds, (const bf16_t*)(R + R_HB8), (const bf16_t*)(R + R_W8), N8, DM / 2, E8); }
            { epi::WinSplit E{R, ssq, (LAS float*)(lds + LDS_MISC + 1024), kdone, 0, 1.0f}; run_gemm(lds, hb, (const bf16_t*)(WB + WB_IN), NIN - N8, DM, E); }
#else
            epi::WinSplit E{R, ssq, (LAS float*)(lds + LDS_MISC + 1024), kdone, 0, 1.0f}; if (NULLX == 3) { epi::NullEpi E0{ssq}; run_gemm(lds, hb, (const bf16_t*)(WB + WB_IN), NIN, DM, E0); } for (int rep = 0; rep < DUP_WIN; ++rep) run_gemm(lds, hb, (const bf16_t*)(WB + WB_IN), NIN, DM, E);
#endif

            if (CVT_AHEAD && l + 1 < DEPTH) {
                const int rem = ((MT / 256) * (NIN / 256)) % G, wg0 = rem, nw = rem ? G - rem : 0; int base = 0;
                { CvtJob J{INP(3) + (size_t)(l + 1) * DM * 2 * DFF, INP(2) + (l + 1) * DM, (bf16_t*)(WB + WB_GU1), 2 * DFF, DM, 2 * DFF, 1}; cvt_job(lds, J, base, wg0, nw); }
                { CvtJob J{INP(4) + (size_t)(l + 1) * DFF * DM, nullptr, (bf16_t*)(WB + WB_D1), DM, DFF, DM, 0}; cvt_job(lds, J, base, wg0, nw); }
            }
#if KPREP_TAIL
            {
                const int rem = ((MT / 256) * (NIN / 256)) % G, fb = rem, nb = G - rem;
                if ((int)blockIdx.x >= fb) {
                    if (tid == 0) {
                        const unsigned long long t0 = wall_clock64();
                        while (__hip_atomic_load(kdone, __ATOMIC_RELAXED, __HIP_MEMORY_SCOPE_AGENT) < (unsigned)(MT / 256) * 8u) { if (wall_clock64() - t0 > 2000000ull) break; __builtin_amdgcn_s_sleep(2); }
                        __builtin_amdgcn_fence(__ATOMIC_ACQUIRE, "agent");
                        asm volatile("s_waitcnt vmcnt(0)" ::: "memory");
                    }
                    __syncthreads();
                    QkArgs Q{(bf16_t*)(R + R_AQ), (bf16_t*)(R + R_AK), INP(18) + l * 128, INP(19) + l * 128, 0};
                    qkprep_phase(Q, fb, nb);
                }
            }
#endif
        }
        SEAM(pb + 3);
#if !KPREP_TAIL
        if (((PH_MASK >> 5) & 1) && IN(pb + 4)) { PH_LOCALS
            QkArgs Q{(bf16_t*)(R + R_AQ), (bf16_t*)(R + R_AK), INP(18) + l * 128, INP(19) + l * 128, 0};
            qkprep_phase(Q, 0, G);
        }
        SEAM(pb + 4);
#endif
        if (((PH_MASK >> 6) & 1) && IN(pb + 5)) { PH_LOCALS
            HgArgs H{(const bf16_t*)(R + R_HGQ), (const bf16_t*)(R + R_HGQ + SZ512), (const bf16_t*)(R + R_HGQ + 2 * SZ512), (const bf16_t*)(R + R_HGQ + 3 * SZ512), (bf16_t*)(R + R_OHG), (const float*)(ws + WS_LB) + l * 1024, (unsigned*)(ws + WS_BAR + 16128) + l * 16};
            S5Args S{(bf16_t*)(R + R_US), (float*)(R + R_YD), (const f32x2*)(ws + WS_ATAB) + (size_t)l * 2 * 32 * 64, (const bf16_t*)(ws + WS_BM) + (size_t)l * 64 * 128 * 16, (const bf16_t*)(ws + WS_CM) + (size_t)l * 64 * 16 * 128, INP(14) + l * 512};
            unsigned* qctr = (unsigned*)(ws + WS_BAR + 15360) + l * 16;
            volatile LAS unsigned* qslot = (volatile LAS unsigned*)(lds + LDS_MISC + 16);
#define QGRAB(u) do { if (tid == 0) *qslot = __hip_atomic_fetch_add(qctr, 1u, __ATOMIC_RELAXED, __HIP_MEMORY_SCOPE_AGENT); __syncthreads(); (u) = (int)*qslot; __syncthreads(); } while (0)
#if QMIX
#define QGRAB_C(u) do { if (tid == 0) *qslot = __hip_atomic_fetch_add(qctr, 1u, __ATOMIC_RELAXED, __HIP_MEMORY_SCOPE_AGENT); __syncthreads(); (u) = (int)*qslot; __syncthreads(); } while (0)
#undef QGRAB
#define QGRAB(u) do { if (tid == 0) *qslot = 320u + __hip_atomic_fetch_add(qctr + 8, 1u, __ATOMIC_RELAXED, __HIP_MEMORY_SCOPE_AGENT); __syncthreads(); (u) = (int)*qslot; __syncthreads(); } while (0)
            int u = 320;
            if ((int)blockIdx.x < QMIX) QGRAB_C(u);
            while (u < 160) { hgrn_unit(lds, H, u); QGRAB_C(u); }
            while (u < 320) { s5_unit(lds, S, u - 160); QGRAB_C(u); }
            QGRAB(u);
#undef QGRAB_C
#else
            int u; QGRAB(u);
            while (u < 160) { hgrn_unit(lds, H, u); if (DUP_HG > 1) hgrn_unit(lds, H, u); QGRAB(u); }
            while (u < 320) { s5_unit(lds, S, u - 160); QGRAB(u); }
#endif
            while (u < 320 + NSEQ * 64) {
                const int a = u - 320, qb = a & 7, h = (a >> 3) & 7, b = a >> 6;
                const size_t tok0 = (size_t)b * SEQL;
                att::attn_dense_body((const bf16_t*)(R + R_AQ) + (tok0 + qb * 256) * 1024 + h * 128, (const bf16_t*)(R + R_AK) + tok0 * 256 + (h >> 2) * 128,
                                     (const bf16_t*)(R + R_AV) + tok0 * 256 + (h >> 2) * 128, (bf16_t*)(R + R_YSS) + (tok0 + qb * 256) * YLD + 1024 + (MRG_FP8 ? h * 64 : h * 128), SEQL, (char*)lds_raw,
                                     INP(18) + l * 128, qb * 256);
                if (DUP_ATT > 1) att::attn_dense_body((const bf16_t*)(R + R_AQ) + (tok0 + qb * 256) * 1024 + h * 128, (const bf16_t*)(R + R_AK) + tok0 * 256 + (h >> 2) * 128,
                                     (const bf16_t*)(R + R_AV) + tok0 * 256 + (h >> 2) * 128, (bf16_t*)(R + R_YSS) + (tok0 + qb * 256) * YLD + 1024 + (MRG_FP8 ? h * 64 : h * 128), SEQL, (char*)lds_raw,
                                     INP(18) + l * 128, qb * 256);
                QGRAB(u);
            }
#if HGFIN_IN_QUEUE
            if (u < 1600 + MT / 64) {
                if (tid == 0) {
                    const unsigned long long t0 = wall_clock64();
                    while (__hip_atomic_load(H.done, __ATOMIC_RELAXED, __HIP_MEMORY_SCOPE_AGENT) < 160u * 8u) { if (wall_clock64() - t0 > 2000000ull) break; __builtin_amdgcn_s_sleep(2); }
                    __builtin_amdgcn_fence(__ATOMIC_ACQUIRE, "agent");
                    asm volatile("s_waitcnt vmcnt(0)" ::: "memory");
                }
                __syncthreads();
                HfArgs F{(const bf16_t*)(R + R_OHG), (const bf16_t*)(R + R_HGQ + 4 * SZ512), INP(17) + l * 128, (bf16_t*)(R + R_YSS)};
                while (u < 1600 + MT / 64) { hgfin_chunk(F, u - 1600); QGRAB(u); }
            }
#endif
#undef QGRAB
        }
        SEAM(pb + 5);
#if !HGFIN_IN_QUEUE
        if (((PH_MASK >> 7) & 1) && IN(pb + 6)) { PH_LOCALS
            HfArgs F{(const bf16_t*)(R + R_OHG), (const bf16_t*)(R + R_HGQ + 4 * SZ512), INP(17) + l * 128, (bf16_t*)(R + R_YSS)};
            hgfin_phase(F);
        }
#endif
        if (((PH_MASK >> 7) & 1) && IN(pb + 6)) { PH_LOCALS epi::Glu E{(const bf16_t*)(R + R_US), (bf16_t*)(R + R_YSS)}; run_gemm(lds, (const bf16_t*)(R + R_US), (const bf16_t*)(WB + WB_GLU), 512, 512, E); }
        SEAM(pb + 6);
        if (((PH_MASK >> 8) & 1) && IN(pb + 7)) { PH_LOCALS
            epi::MergeFused E{(const unsigned char*)(R + R_GATE), (bf16_t*)(R + R_MRG)}; if (NULLX == 7) { epi::NullEpi E0{ssq}; run_gemm(lds, (const bf16_t*)(R + R_YSS), (const bf16_t*)(WB + WB_BS), DM, DM, E0); } for (int rep = 0; rep < DUP_MRG; ++rep) run_gemm<epi::MergeFused, (MRG_FP8 ? 16 : -1)>(lds, (const bf16_t*)(R + R_YSS), (const bf16_t*)(WB + WB_BS), DM, YLD, E);
        }
        SEAM_L(pb + 7);
        if (((PH_MASK >> 9) & 1) && IN(pb + 8)) { PH_LOCALS
            epi::Resid<false, false> E{nullptr, nullptr, 0, 1.0f, nullptr, hb, ssq};
            if (NULLX == 8) { epi::NullEpi E0{ssq}; run_gemm(lds, (const bf16_t*)(R + R_MRG), (const bf16_t*)(WB + WB_OUT), DM, DM, E0); }
            run_gemm(lds, (const bf16_t*)(R + R_MRG), (const bf16_t*)(WB + WB_OUT), DM, DM, E);
        }
        SEAM_L(pb + 8);
        if (((PH_MASK >> 10) & 1) && IN(pb + 9)) { PH_LOCALS epi::Swiglu E{(bf16_t*)(R + R_HID), ssq, (LAS float*)(lds + LDS_MISC + 1024)}; if (DUP_NULL) { epi::NullEpi E0{ssq}; run_gemm(lds, hb, (const bf16_t*)(WB + WB_GU2), 2 * DFF, DM, E0); } for (int rep = 0; rep < DUP_GU; ++rep) run_gemm(lds, hb, (const bf16_t*)(WB + WB_GU2), 2 * DFF, DM, E);
            if (CVT_AHEAD && l + 1 < DEPTH) {
                const int rem = ((MT / 256) * (2 * DFF / 256)) % G, wg0 = rem, nw = rem ? G - rem : 0; int base = 0;
                { CvtJob J{INP(6) + (size_t)(l + 1) * DM * NIN, INP(5) + (l + 1) * DM, (bf16_t*)(WB + WB_IN), NIN, DM, NIN, 0}; cvt_job(lds, J, base, wg0, nw); }
            }
        }
        SEAM_L(pb + 9);
        if (((PH_MASK >> 11) & 1) && IN(pb + 10)) { PH_LOCALS
            if (NULLX == 2) { epi::NullEpi E0{ssq}; run_gemm(lds, (const bf16_t*)(R + R_HID), (const bf16_t*)(WB + WB_D2), DM, DFF, E0); }
            if (l + 1 < DEPTH) { epi::Resid<false, false> E{nullptr, nullptr, 0, 0.5f, nullptr, hb, ssq}; run_gemm(lds, (const bf16_t*)(R + R_HID), (const bf16_t*)(WB + WB_D2), DM, DFF, E); }
            else               { epi::Resid<false, true>  E{nullptr, nullptr, 0, 0.5f, outp, hb, ssq};    run_gemm(lds, (const bf16_t*)(R + R_HID), (const bf16_t*)(WB + WB_D2), DM, DFF, E); }
        }
        SEAM(pb + 10);
    }
#ifdef PROBE_SKEW
    { XcdBarrier b_; b_.bar = (unsigned*)(ws0 + WS_BAR); b_.x = xb_xcc_id(); b_.st = (volatile LAS unsigned*)(lds + LDS_MISC); xcd_barrier(b_); }
    if (blockIdx.x == 0 && tid == 0) {
        float tot = 0.f;
        for (int k_ = 0; k_ < N_PHASES - 1; ++k_) { const unsigned* a_ = (const unsigned*)(ws0 + WS_CHK) + (size_t)k_ * 256; const unsigned v0_ = a_[0]; int mx_ = -2000000000; float sm_ = 0.f;
            for (int i_ = 0; i_ < (int)gridDim.x; ++i_) { const int d_ = (int)(a_[i_] - v0_); mx_ = d_ > mx_ ? d_ : mx_; sm_ += (float)d_; }
            tot += (float)mx_ * (float)gridDim.x - sm_; }
        const float us = tot * 0.01f / (float)gridDim.x;
        int la = (int)(3.0f * log2f(us / 20.0f) + 0.5f); la = la < 0 ? 0 : (la > 79 ? 79 : la);
        out0[0] = (float)(10 + la) * 1e5f;
    }
#endif
#ifdef PROBE_T
    { XcdBarrier b_; b_.bar = (unsigned*)(ws0 + WS_BAR); b_.x = xb_xcc_id(); b_.st = (volatile LAS unsigned*)(lds + LDS_MISC); xcd_barrier(b_); }
    if (blockIdx.x == 0 && tid == 0) {
        const unsigned long long* ts = (const unsigned long long*)(ws + WS_BAR + 14336);
        unsigned long long ta = 0, tb = 0;
        for (int l = 0; l < DEPTH; ++l) { const int pb = 1 + PH_PER_LAYER * l;
            for (int c = 0; c < PH_PER_LAYER; ++c) { const unsigned long long d = ts[pb + c + 1] - ts[pb + c]; if ((PROBE_A >> c) & 1) ta += d; if ((PROBE_B >> c) & 1) tb += d; } }
        if (PROBE_A == 0) ta = ts[1] - ts[0];
        if (PROBE_B == 0) tb = ts[N_PHASES] - ts[0];
        const float ua = (float)ta * 0.01f, ub = (float)tb * 0.01f;
        int la = (int)(6.0f * log2f(ua / 20.0f) + 0.5f); (void)ub;
        la = la < 0 ? 0 : (la > 79 ? 79 : la);
        const int v = la;
        out0[0] = (float)(10 + v % 80) * __builtin_powif(10.0f, 5 + v / 80);
    }
#endif
#undef INP
#undef IN
#undef SEAM
}

#ifndef N_LAUNCH_MODE
#define N_LAUNCH_MODE 1
#endif
extern "C" void kernel_launch(void* const* d_in, const int* in_sizes, int n_in, void* d_out, int out_size, void* d_ws, size_t ws_size, hipStream_t stream) {
    static int grid = 0;
    if (grid == 0) {
        size_t need = WS_END;
#ifdef SELFCHECK
        need = WS_CHK + CHK_BYTES;
#endif
        if (n_in != 25 || out_size != MT * DM || ws_size < need) { fprintf(stderr, "kernel_launch: unexpected shapes: n_in %d out %d ws %zu (need %zu)\n", n_in, out_size, ws_size, need); grid = -1; return; }
        int dev = 0, cus = 0, per_cu = 0;
        if (hipGetDevice(&dev) != hipSuccess || hipDeviceGetAttribute(&cus, hipDeviceAttributeMultiprocessorCount, dev) != hipSuccess) { grid = -1; return; }
        if (hipFuncSetAttribute((const void*)k_fwd, hipFuncAttributeMaxDynamicSharedMemorySize, LDS_BYTES) != hipSuccess) { fprintf(stderr, "kernel_launch: hipFuncSetAttribute failed\n"); grid = -1; return; }
        if (hipOccupancyMaxActiveBlocksPerMultiprocessor(&per_cu, (const void*)k_fwd, NTHREADS, LDS_BYTES) != hipSuccess || per_cu < 1) { fprintf(stderr, "kernel_launch: occupancy query says %d\n", per_cu); (void)hipGetLastError(); grid = -1; return; }
        grid = cus;
    }
    if (grid < 0) return;
    (void)hipMemsetAsync((char*)d_ws + WS_BAR, 0, 16384, stream);
    Params p{};
    for (int i = 0; i < 25; ++i) p.in[i] = (const float*)d_in[i];
    p.out = (float*)d_out; p.ws = (unsigned char*)d_ws;
#ifdef SELFCHECK
    {
        CkCtx c{d_in, (float*)d_out, (unsigned char*)d_ws, stream};
        (void)hipMemsetAsync((char*)d_ws + WS_CHK, 0, 65536, stream);
        for (int run = 0; run < 2; ++run)
            for (int ph = 0; ph < CK_NPH; ++ph) {
                if (ph == 0) (void)hipMemsetAsync((char*)d_ws + WS_BAR + 15360, 0, 512, stream);
                p.ph_lo = ph; p.ph_hi = ph + 1;
                hipLaunchKernelGGL(k_fwd, dim3(grid), dim3(NTHREADS), LDS_BYTES, stream, p);
                selfcheck_after_phase(c, run, ph);
            }
        selfcheck_finish(c);
    }
#elif N_LAUNCH_MODE == 1
    p.ph_lo = 0; p.ph_hi = N_PHASES;
    hipLaunchKernelGGL(k_fwd, dim3(grid), dim3(NTHREADS), LDS_BYTES, stream, p);
#else
    for (int ph = 0; ph < N_PHASES; ++ph) {
        p.ph_lo = ph; p.ph_hi = ph + 1;
        hipLaunchKernelGGL(k_fwd, dim3(grid), dim3(NTHREADS), LDS_BYTES, stream, p);
    }
#endif
    const hipError_t le = hipPeekAtLastError();
    if (le != hipSuccess) fprintf(stderr, "kernel_launch: launch failed: %s\n", hipGetErrorName(le));
}
```

```cpp
#include <hip/hip_runtime.h>
#include <cstdio>
#include <cstdint>
#include <cstring>

#define LAS __attribute__((address_space(3)))
#define CAS __attribute__((address_space(4)))
#define GAS __attribute__((address_space(1)))
#ifndef CHK_ROW0
#define CHK_ROW0 18432
#endif
typedef unsigned short bf16_t;
typedef short bf16x8 __attribute__((ext_vector_type(8)));
typedef short s16x4 __attribute__((ext_vector_type(4)));
typedef float f32x2 __attribute__((ext_vector_type(2)));
typedef float f32x4 __attribute__((ext_vector_type(4)));
typedef float f32x8 __attribute__((ext_vector_type(8)));
typedef float f32x16 __attribute__((ext_vector_type(16)));
typedef unsigned u32x2 __attribute__((ext_vector_type(2)));
typedef unsigned u32x4 __attribute__((ext_vector_type(4)));

constexpr int MT = 40960;
constexpr int NSEQ = 20, SEQL = 2048, PROMPT_ROWS = 8192;
constexpr int DM = 2048, DFF = 5632, NIN = 10752, DEPTH = 4;
constexpr int NTHREADS = 512;
constexpr int LDS_BYTES = 147456;
constexpr int LDS_MISC = 131072;

#ifndef HG_WT
#define HG_WT 0
#endif
#ifndef MRG_FP8
#define MRG_FP8 1
#endif
constexpr int YLD = MRG_FP8 ? 1536 : 2048;
constexpr float YATT_SC = 16.0f, WBR_SC = 32.0f;
constexpr size_t MiB = 1048576;
constexpr size_t WS_BAR  = 0;
constexpr size_t WS_PTAB = 15872;
constexpr size_t WS_SSQ  = 2359296;
constexpr size_t WS_ATAB = 65536;
constexpr size_t WS_BM   = WS_ATAB + 131072;
constexpr size_t WS_CM   = WS_BM + 1048576;
constexpr size_t WS_LB   = WS_CM + 1048576;
constexpr size_t WS_WB   = 8 * MiB; static_assert(WS_LB + 16384 <= WS_SSQ && WS_SSQ + (size_t)MT * 128 <= WS_WB, "small tables");
constexpr size_t WB_GU1 = 0;
constexpr size_t WB_D1  = WB_GU1 + (size_t)11264 * 2048 * 2;
constexpr size_t WB_IN  = WB_D1 + (size_t)2048 * 5632 * 2;
constexpr size_t WB_GLU = WB_IN + (size_t)NIN * 2048 * 2;
constexpr size_t WB_BS  = WB_GLU + (size_t)512 * 512 * 2;
constexpr size_t WB_BH  = WB_BS + (size_t)2048 * 512 * 2;
constexpr size_t WB_BA  = WB_BH + (size_t)2048 * 512 * 2;
constexpr size_t WB_OUT = WB_BA + (size_t)2048 * 1024 * 2;
constexpr size_t WB_GU2 = WB_OUT + (size_t)2048 * 2048 * 2;
constexpr size_t WB_D2  = WB_GU2 + (size_t)11264 * 2048 * 2;
constexpr size_t WB_END = WB_D2 + (size_t)2048 * 5632 * 2;
constexpr size_t WS_HB   = WS_WB + 192 * MiB;
constexpr size_t WS_R    = WS_HB + (size_t)MT * 2048 * 2;
static_assert(WB_END <= 192 * MiB, "weights region");
constexpr size_t R_HID  = 0;
constexpr size_t SZ512  = (size_t)MT * 512 * 2;
constexpr size_t R_US   = 0;
constexpr size_t R_HGQ  = R_US + SZ512;
constexpr size_t R_MRG  = R_HGQ;
constexpr size_t R_AQ   = R_HGQ + 5 * SZ512;
constexpr size_t R_AK   = R_AQ + 2 * SZ512;
constexpr size_t R_AV   = R_AK + SZ512 / 2;
constexpr size_t R_GATE = R_AV + SZ512 / 2;
constexpr size_t R_YD   = R_GATE + 12 * SZ512;
constexpr size_t R_OHG  = R_YD + 4 * SZ512;
constexpr size_t R_YSS  = R_OHG + 4 * SZ512;
constexpr size_t R_HB8  = R_YD;
constexpr size_t R_W8   = R_OHG;
constexpr size_t R_YHG  = R_YSS + SZ512;
constexpr size_t R_YAT  = R_YHG + SZ512;
constexpr size_t R_END  = R_YAT + 2 * SZ512;
static_assert(R_MRG + 4 * SZ512 <= R_HGQ + 4 * SZ512, "merged overlay");
static_assert((size_t)MT * DFF * 2 <= R_END, "hid fits");
static_assert((size_t)MT * DFF * 2 <= R_YD, "hid clear of the fp8 copies");
constexpr size_t WS_END  = WS_R + R_END;
constexpr size_t WS_CHK  = WS_END;

typedef __bf16 bf16x2_n __attribute__((ext_vector_type(2)));
__device__ __forceinline__ unsigned cvtpk(float lo, float hi) { f32x2 v = {lo, hi}; bf16x2_n b = __builtin_convertvector(v, bf16x2_n); return __builtin_bit_cast(unsigned, b); }
__device__ __forceinline__ float bf2f(bf16_t b) { return __uint_as_float(((unsigned)b) << 16); }
__device__ __forceinline__ float bflo(unsigned w) { return __uint_as_float(w << 16); }
__device__ __forceinline__ float bfhi(unsigned w) { return __uint_as_float(w & 0xffff0000u); }
__device__ __forceinline__ bf16_t f2bf(float f) { return (bf16_t)(cvtpk(f, 0.f) & 0xffffu); }
__device__ __forceinline__ float sigm(float x) { return __builtin_amdgcn_rcpf(1.0f + __expf(-x)); }
__device__ __forceinline__ float siluf(float x) { return x * sigm(x); }
__device__ __forceinline__ float gelu_tanh(float x) {
    const float u = 0.7978845608028654f * (x + 0.044715f * x * x * x);
    return x * sigm(2.0f * u);
}
template <int X> __device__ __forceinline__ float xor_f(float v) { static_assert(X >= 1 && X <= 16, "inside a 32-lane half"); return __uint_as_float((unsigned)__builtin_amdgcn_ds_swizzle((int)__float_as_uint(v), (X << 10) | 0x1f)); }
__device__ __forceinline__ float xor32_sum(float v) { auto r = __builtin_amdgcn_permlane32_swap(__float_as_uint(v), __float_as_uint(v), false, false); return __uint_as_float(r[0]) + __uint_as_float(r[1]); }
#define WAIT_VM0() asm volatile("s_waitcnt vmcnt(0)" ::: "memory")
#define WAIT_LGKM0() asm volatile("s_waitcnt lgkmcnt(0)" ::: "memory")
namespace pg8 {
#define PG8_LAS __attribute__((address_space(3)))
typedef unsigned short bf16_t;
typedef short bf16x8 __attribute__((ext_vector_type(8)));
typedef float f32x4 __attribute__((ext_vector_type(4)));
typedef unsigned u32x4 __attribute__((ext_vector_type(4)));
constexpr int BM = 256, BK = 64, HALF = 128, HTB = HALF * BK * 2  , STAGE_BYTES = 8 * HTB, NXCD = 8;
#ifndef PG8_WGM
#define PG8_WGM 4
#endif
constexpr int WGM = PG8_WGM;

__host__ __device__ __forceinline__ int lds_byte(int r, int c) { const int st = (r >> 4) * 2 + (c >> 5), rr = r & 15, cc = c & 31, ob = rr * 64 + cc * 2; return st * 1024 + (ob ^ (((ob >> 9) & 1) << 5)); }
__host__ __device__ __forceinline__ void stage_rc(int b, int& R, int& C) { const int st = b / 1024, sb = b % 1024, swz = sb ^ (((sb >> 9) & 1) << 5); R = (st >> 1) * 16 + swz / 64; C = (st & 1) * 32 + (swz % 64) / 2; }
__host__ __device__ __forceinline__ int perm32(int rho) { const int n = rho >> 4, i = rho & 15; return 8 * (i >> 2) + 4 * n + (i & 3); }

struct Unit { int pm, pn; };
struct Gemm { const bf16_t* A; const bf16_t* Bt; int M, N, K; };

struct StaticOrder {
    int nM, nN, nwg, G, c, wgm, xm, xx, xr, xW;
    __host__ __device__ void init(int M, int N, int G_, int c_, int wgm_ = WGM) { nM = M / BM; nN = N / BM; nwg = nM * nN; G = G_; c = c_; wgm = wgm_; xm = 0; xx = 0; xr = 0; xW = 1; }
    __host__ __device__ void init_x(int x, int rank, int W) { xm = 1; xx = x; xr = rank; xW = W; }
    __host__ __device__ bool next(int i, Unit& u) const {
        int wgid;
        if (xm) { const int q = nwg / NXCD, r = nwg % NXCD, qx = q + (xx < r ? 1 : 0), off = i * xW + xr; if (off >= qx) return false; wgid = (xx < r ? xx * (q + 1) : r * (q + 1) + (xx - r) * q) + off; }
        else {
        const long L = (long)i * G + c; if (L >= nwg) return false;
        wgid = (int)L; { const int q = nwg / NXCD, r = nwg % NXCD, xcd = wgid % NXCD, off = wgid / NXCD; wgid = (xcd < r ? xcd * (q + 1) : r * (q + 1) + (xcd - r) * q) + off; }
        }
        const int nig = wgm * nN, gid = wgid / nig, fm = gid * wgm, gsz = (nM - fm) < wgm ? (nM - fm) : wgm;
        u.pm = fm + ((wgid % nig) % gsz); u.pn = (wgid % nig) / gsz; return true;
    }
    __device__ __forceinline__ void a_ready(const Unit&) const {}
    __device__ __forceinline__ void done(const Unit&) const {}
};


#ifndef PG8_RELAX
#define PG8_RELAX 0
#endif
template <int N> __device__ __forceinline__ void wait_vm() { asm volatile("s_waitcnt vmcnt(%0)" :: "n"(N) : "memory"); }
typedef int pg8_i32x4 __attribute__((ext_vector_type(4)));
typedef int pg8_i32x8 __attribute__((ext_vector_type(8)));
template <class Epi, class Sched, bool ALIGN_EPI = false, bool SP2 = false, int F8FROM = -1>
__device__ __forceinline__ void gemm_phase(PG8_LAS unsigned char* lds, const Gemm g, const Sched& S, const Epi& E) {
    int tid_l = threadIdx.x; asm volatile("" : "+v"(tid_l));
    const int tid = tid_l, wid = __builtin_amdgcn_readfirstlane(tid >> 6), lane = tid & 63, wr = wid >> 2, wc = wid & 3, fr = lane & 15, fq = lane >> 4;
    const int K = g.K, nt = K / BK;
    unsigned voffA[2], voffB[2];
#pragma unroll
    for (int i = 0; i < 2; ++i) { int R, C; stage_rc(tid * 16 + i * 8192, R, C); const int Rb = Epi::PERM ? ((R & ~31) + perm32(R & 31)) : R;
        voffA[i] = (unsigned)(R * K + C) * 2u; voffB[i] = (unsigned)(Rb * K + C) * 2u; }
    const size_t kstep = (size_t)(BK * 2);
    const size_t hstep = (size_t)HALF * K * 2;
    const size_t tstep = 2 * hstep;
    const unsigned ldsw = (unsigned)wid * 1024u;
    const int aoff = lds_byte(wr * 64 + fr, fq * 8), boff = lds_byte(wc * 32 + fr, fq * 8);
#define PG8_SA(b, h) (((b) * 2 + (h)) * HTB)
#define PG8_SB(b, h) ((4 + (b) * 2 + (h)) * HTB)
#define PG8_STAGE(bufoff, gbase, voff) do { _Pragma("unroll") for (int _i = 0; _i < 2; ++_i) \
        __builtin_amdgcn_global_load_lds((const unsigned*)((const char*)(gbase) + (voff)[_i]), (PG8_LAS unsigned*)(lds + (bufoff) + ldsw + _i * 8192), 16, 0, 0); } while (0)
#define PG8_LDA(dst, b, h) do { _Pragma("unroll") for (int m = 0; m < 4; ++m) _Pragma("unroll") for (int k = 0; k < 2; ++k) dst[m][k] = *(const PG8_LAS bf16x8*)(lds + PG8_SA(b, h) + aoff + m * 2048 + k * 1024); } while (0)
#define PG8_LDB(dst, b, h) do { _Pragma("unroll") for (int n = 0; n < 2; ++n) _Pragma("unroll") for (int k = 0; k < 2; ++k) dst[n][k] = *(const PG8_LAS bf16x8*)(lds + PG8_SB(b, h) + boff + n * 2048 + k * 1024); } while (0)
#define PG8_CAT8(lo, hi) __builtin_shufflevector(__builtin_bit_cast(pg8_i32x4, lo), __builtin_bit_cast(pg8_i32x4, hi), 0, 1, 2, 3, 4, 5, 6, 7)
#define PG8_MMA(ai, bj, At, Bt) do { __builtin_amdgcn_s_setprio(1); _Pragma("unroll") for (int m = 0; m < 4; ++m) _Pragma("unroll") for (int n = 0; n < 2; ++n) { \
        if constexpr (F8T) acc[ai][bj][m][n] = __builtin_amdgcn_mfma_scale_f32_16x16x128_f8f6f4(PG8_CAT8(Bt[n][0], Bt[n][1]), PG8_CAT8(At[m][0], At[m][1]), acc[ai][bj][m][n], 0, 0, 0, 0, 0, 0); \
        else { _Pragma("unroll") for (int k = 0; k < 2; ++k) acc[ai][bj][m][n] = __builtin_amdgcn_mfma_f32_16x16x32_bf16(Bt[n][k], At[m][k], acc[ai][bj][m][n], 0, 0, 0); } } __builtin_amdgcn_s_setprio(0); } while (0)
#define PG8_WAIT_V(n) asm volatile("s_waitcnt vmcnt(" #n ")" ::: "memory")
#define PG8_WAIT_L(n) asm volatile("s_waitcnt lgkmcnt(" #n ")" ::: "memory")
#define PG8_BAR __builtin_amdgcn_s_barrier()
#define PG8_SCHED __builtin_amdgcn_sched_barrier(0)
    Unit cur, nxt; int ui = 0;
    if (!S.next(0, cur)) return;
    f32x4 acc[2][2][4][2];
#pragma unroll
    for (int a = 0; a < 2; ++a)
#pragma unroll
        for (int b = 0; b < 2; ++b)
#pragma unroll
            for (int m = 0; m < 4; ++m)
#pragma unroll
                for (int n = 0; n < 2; ++n) acc[a][b][m][n] = (f32x4){0.f, 0.f, 0.f, 0.f};
    bf16x8 At[4][2], B0[2][2], B1[2][2];
    const char* cA = (const char*)g.A + (size_t)cur.pm * tstep; const char* cB = (const char*)g.Bt + (size_t)cur.pn * tstep;
    S.a_ready(cur);
    if constexpr (SP2) {
        PG8_STAGE(PG8_SB(0, 0), cB, voffB); PG8_STAGE(PG8_SB(0, 1), cB + hstep, voffB); PG8_STAGE(PG8_SA(0, 0), cA, voffA); PG8_STAGE(PG8_SA(0, 1), cA + hstep, voffA);
        if (wr == 1) PG8_BAR;
        PG8_WAIT_V(2); PG8_BAR;
        PG8_STAGE(PG8_SB(1, 0), cB + kstep, voffB); PG8_STAGE(PG8_SA(1, 0), cA + kstep, voffA); PG8_STAGE(PG8_SB(1, 1), cB + hstep + kstep, voffB);
        PG8_WAIT_V(6); PG8_BAR;
    } else {
        PG8_STAGE(PG8_SB(0, 0), cB, voffB); PG8_STAGE(PG8_SA(0, 0), cA, voffA); PG8_STAGE(PG8_SB(0, 1), cB + hstep, voffB); PG8_STAGE(PG8_SA(0, 1), cA + hstep, voffA);
        if (wr == 1) PG8_BAR;
        PG8_WAIT_V(4); PG8_BAR;
        PG8_STAGE(PG8_SB(1, 0), cB + kstep, voffB); PG8_STAGE(PG8_SA(1, 0), cA + kstep, voffA); PG8_STAGE(PG8_SB(1, 1), cB + hstep + kstep, voffB);
        PG8_WAIT_V(6); PG8_BAR;
    }
    for (;;) {
        const bool has_next = S.next(ui + 1, nxt);
        const char* nA = has_next ? (const char*)g.A + (size_t)nxt.pm * tstep : cA; const char* nB = has_next ? (const char*)g.Bt + (size_t)nxt.pn * tstep : cB;
        if constexpr (F8FROM > 0) { constexpr bool F8T = false, MID8_ = true, MID16_ = (F8FROM > 16);
        for (int t = 0; t < F8FROM; t += 2) {
            const bool last = (t == nt - 2);
            const char* a1 = cA + (size_t)(t + 1) * kstep;
            const char* a2 = last ? nA : cA + (size_t)(t + 2) * kstep; const char* b2 = last ? nB : cB + (size_t)(t + 2) * kstep;
            const char* a3 = a2 + kstep; const char* b3 = b2 + kstep;
            if (last && has_next) S.a_ready(nxt);
            int relax = __builtin_amdgcn_readfirstlane((PG8_RELAX && (t == 0) && (ui > 0)) ? 1 : 0); asm volatile("" : "+s"(relax));
            if constexpr (Epi::MIDK) { if ((MID8_ && t == 8) || (MID16_ && t == 16)) E.mid(acc, cur, t >> 3, wr, wc, fr, fq); }
            if constexpr (SP2) {
            PG8_LDB(B0, 0, 0); PG8_LDB(B1, 0, 1); PG8_SCHED; PG8_LDA(At, 0, 0); PG8_STAGE(PG8_SA(1, 1), a1 + hstep, voffA);
            if (relax) wait_vm<8 + Epi::NSTORE>(); else PG8_WAIT_V(8); PG8_WAIT_L(0); PG8_BAR; PG8_MMA(0, 0, At, B0); PG8_MMA(0, 1, At, B1); PG8_BAR; PG8_SCHED;
            PG8_LDA(At, 0, 1); PG8_STAGE(PG8_SB(0, 0), b2, voffB); PG8_STAGE(PG8_SB(0, 1), b2 + hstep, voffB); PG8_STAGE(PG8_SA(0, 0), a2, voffA);
            if (relax) wait_vm<8 + Epi::NSTORE>(); else PG8_WAIT_V(8); PG8_WAIT_L(0); PG8_BAR; PG8_MMA(1, 0, At, B0); PG8_MMA(1, 1, At, B1); PG8_BAR; PG8_SCHED;
            PG8_LDB(B0, 1, 0); PG8_LDB(B1, 1, 1); PG8_SCHED; PG8_LDA(At, 1, 0); PG8_STAGE(PG8_SA(0, 1), a2 + hstep, voffA);
            PG8_WAIT_V(8); PG8_WAIT_L(0); PG8_BAR; PG8_MMA(0, 0, At, B0); PG8_MMA(0, 1, At, B1); PG8_BAR; PG8_SCHED;
            PG8_LDA(At, 1, 1); PG8_STAGE(PG8_SB(1, 0), b3, voffB); PG8_STAGE(PG8_SB(1, 1), b3 + hstep, voffB); PG8_STAGE(PG8_SA(1, 0), a3, voffA);
            PG8_WAIT_V(8); PG8_WAIT_L(0); PG8_BAR; PG8_MMA(1, 0, At, B0); PG8_MMA(1, 1, At, B1); PG8_BAR; PG8_SCHED;
            } else {
            PG8_LDB(B0, 0, 0); PG8_SCHED; PG8_LDA(At, 0, 0); PG8_STAGE(PG8_SA(1, 1), a1 + hstep, voffA);
            PG8_WAIT_L(8); PG8_BAR; PG8_WAIT_L(0); PG8_MMA(0, 0, At, B0); PG8_BAR; PG8_SCHED;
            PG8_LDB(B1, 0, 1); PG8_STAGE(PG8_SB(0, 0), b2, voffB);
            PG8_BAR; PG8_WAIT_L(0); PG8_MMA(0, 1, At, B1); PG8_BAR;
            PG8_LDA(At, 0, 1); PG8_STAGE(PG8_SA(0, 0), a2, voffA);
            PG8_BAR; PG8_WAIT_L(0); PG8_MMA(1, 0, At, B0); PG8_BAR; PG8_SCHED;
            PG8_STAGE(PG8_SB(0, 1), b2 + hstep, voffB);
            PG8_WAIT_V(6); PG8_BAR; PG8_MMA(1, 1, At, B1); PG8_BAR;
            PG8_LDB(B0, 1, 0); PG8_SCHED; PG8_LDA(At, 1, 0); PG8_STAGE(PG8_SA(0, 1), a2 + hstep, voffA);
            PG8_WAIT_L(8); PG8_BAR; PG8_WAIT_L(0); PG8_MMA(0, 0, At, B0); PG8_BAR; PG8_SCHED;
            PG8_LDB(B1, 1, 1); PG8_STAGE(PG8_SB(1, 0), b3, voffB);
            PG8_BAR; PG8_WAIT_L(0); PG8_MMA(0, 1, At, B1); PG8_BAR;
            PG8_LDA(At, 1, 1); PG8_STAGE(PG8_SA(1, 0), a3, voffA);
            PG8_BAR; PG8_WAIT_L(0); PG8_MMA(1, 0, At, B0); PG8_BAR; PG8_SCHED;
            PG8_STAGE(PG8_SB(1, 1), b3 + hstep, voffB);
            PG8_WAIT_V(6); PG8_BAR; PG8_MMA(1, 1, At, B1); PG8_BAR;
            }
        } }
        if constexpr (Epi::MIDK && F8FROM == 16) E.mid(acc, cur, 2, wr, wc, fr, fq);
        { constexpr bool F8T = (F8FROM >= 0), MID8_ = (F8FROM <= 0), MID16_ = (F8FROM != 16);
        for (int t = (F8FROM > 0 ? F8FROM : 0); t < nt; t += 2) {
            const bool last = (t == nt - 2);
            const char* a1 = cA + (size_t)(t + 1) * kstep;
            const char* a2 = last ? nA : cA + (size_t)(t + 2) * kstep; const char* b2 = last ? nB : cB + (size_t)(t + 2) * kstep;
            const char* a3 = a2 + kstep; const char* b3 = b2 + kstep;
            if (last && has_next) S.a_ready(nxt);
            int relax = __builtin_amdgcn_readfirstlane((PG8_RELAX && (t == 0) && (ui > 0)) ? 1 : 0); asm volatile("" : "+s"(relax));
            if constexpr (Epi::MIDK) { if ((MID8_ && t == 8) || (MID16_ && t == 16)) E.mid(acc, cur, t >> 3, wr, wc, fr, fq); }
            if constexpr (SP2) {
            PG8_LDB(B0, 0, 0); PG8_LDB(B1, 0, 1); PG8_SCHED; PG8_LDA(At, 0, 0); PG8_STAGE(PG8_SA(1, 1), a1 + hstep, voffA);
            if (relax) wait_vm<8 + Epi::NSTORE>(); else PG8_WAIT_V(8); PG8_WAIT_L(0); PG8_BAR; PG8_MMA(0, 0, At, B0); PG8_MMA(0, 1, At, B1); PG8_BAR; PG8_SCHED;
            PG8_LDA(At, 0, 1); PG8_STAGE(PG8_SB(0, 0), b2, voffB); PG8_STAGE(PG8_SB(0, 1), b2 + hstep, voffB); PG8_STAGE(PG8_SA(0, 0), a2, voffA);
            if (relax) wait_vm<8 + Epi::NSTORE>(); else PG8_WAIT_V(8); PG8_WAIT_L(0); PG8_BAR; PG8_MMA(1, 0, At, B0); PG8_MMA(1, 1, At, B1); PG8_BAR; PG8_SCHED;
            PG8_LDB(B0, 1, 0); PG8_LDB(B1, 1, 1); PG8_SCHED; PG8_LDA(At, 1, 0); PG8_STAGE(PG8_SA(0, 1), a2 + hstep, voffA);
            PG8_WAIT_V(8); PG8_WAIT_L(0); PG8_BAR; PG8_MMA(0, 0, At, B0); PG8_MMA(0, 1, At, B1); PG8_BAR; PG8_SCHED;
            PG8_LDA(At, 1, 1); PG8_STAGE(PG8_SB(1, 0), b3, voffB); PG8_STAGE(PG8_SB(1, 1), b3 + hstep, voffB); PG8_STAGE(PG8_SA(1, 0), a3, voffA);
            PG8_WAIT_V(8); PG8_WAIT_L(0); PG8_BAR; PG8_MMA(1, 0, At, B0); PG8_MMA(1, 1, At, B1); PG8_BAR; PG8_SCHED;
            } else {
            PG8_LDB(B0, 0, 0); PG8_SCHED; PG8_LDA(At, 0, 0); PG8_STAGE(PG8_SA(1, 1), a1 + hstep, voffA);
            PG8_WAIT_L(8); PG8_BAR; PG8_WAIT_L(0); PG8_MMA(0, 0, At, B0); PG8_BAR; PG8_SCHED;
            PG8_LDB(B1, 0, 1); PG8_STAGE(PG8_SB(0, 0), b2, voffB);
            PG8_BAR; PG8_WAIT_L(0); PG8_MMA(0, 1, At, B1); PG8_BAR;
            PG8_LDA(At, 0, 1); PG8_STAGE(PG8_SA(0, 0), a2, voffA);
            PG8_BAR; PG8_WAIT_L(0); PG8_MMA(1, 0, At, B0); PG8_BAR; PG8_SCHED;
            PG8_STAGE(PG8_SB(0, 1), b2 + hstep, voffB);
            PG8_WAIT_V(6); PG8_BAR; PG8_MMA(1, 1, At, B1); PG8_BAR;
            PG8_LDB(B0, 1, 0); PG8_SCHED; PG8_LDA(At, 1, 0); PG8_STAGE(PG8_SA(0, 1), a2 + hstep, voffA);
            PG8_WAIT_L(8); PG8_BAR; PG8_WAIT_L(0); PG8_MMA(0, 0, At, B0); PG8_BAR; PG8_SCHED;
            PG8_LDB(B1, 1, 1); PG8_STAGE(PG8_SB(1, 0), b3, voffB);
            PG8_BAR; PG8_WAIT_L(0); PG8_MMA(0, 1, At, B1); PG8_BAR;
            PG8_LDA(At, 1, 1); PG8_STAGE(PG8_SA(1, 0), a3, voffA);
            PG8_BAR; PG8_WAIT_L(0); PG8_MMA(1, 0, At, B0); PG8_BAR; PG8_SCHED;
            PG8_STAGE(PG8_SB(1, 1), b3 + hstep, voffB);
            PG8_WAIT_V(6); PG8_BAR; PG8_MMA(1, 1, At, B1); PG8_BAR;
            }
        } }
        if constexpr (ALIGN_EPI) { if (wr == 0) PG8_BAR; }
        if constexpr (!Epi::AFTER_DRAIN) { E(acc, cur, wr, wc, fr, fq); S.done(cur); }
        if (!has_next) break;
#pragma unroll
        for (int a = 0; a < 2; ++a)
#pragma unroll
            for (int b = 0; b < 2; ++b)
#pragma unroll
                for (int m = 0; m < 4; ++m)
#pragma unroll
                    for (int n = 0; n < 2; ++n) acc[a][b][m][n] = (f32x4){0.f, 0.f, 0.f, 0.f};
        cur = nxt; cA = nA; cB = nB; ++ui;
        if constexpr (ALIGN_EPI) { if (wr == 1) PG8_BAR; }
    }
    PG8_WAIT_V(0);
    if constexpr (!ALIGN_EPI) { if (wr == 0) PG8_BAR; }
    PG8_BAR;
    if constexpr (Epi::AFTER_DRAIN) { E.fused(acc, cur, wr, wc, fr, fq, lds, wid, lane); S.done(cur); }
#undef PG8_SA
#undef PG8_SB
#undef PG8_STAGE
#undef PG8_LDA
#undef PG8_LDB
#undef PG8_MMA
#undef PG8_WAIT_V
#undef PG8_WAIT_L
#undef PG8_BAR
#undef PG8_SCHED
}
}
namespace epi {
using pg8::Unit;
constexpr float RMS_EPS = 1e-6f;
__device__ __forceinline__ float row_rstd(const float* ssq, int row) {
    const f32x4* p = (const f32x4*)(ssq + (size_t)row * 32);
    f32x4 a = p[0] + p[1], b = p[2] + p[3], c = p[4] + p[5], d = p[6] + p[7];
    a = (a + b) + (c + d);
    return __builtin_amdgcn_rsqf(((a[0] + a[1]) + (a[2] + a[3])) * (1.0f / 2048.0f) + RMS_EPS);
}

__device__ __forceinline__ void unit_rstd_table(const float* ssq, LAS float* tab, int pm, int wr, int wc, int fr, int fq) {
    const int have = __builtin_amdgcn_readfirstlane(((volatile LAS int*)tab)[256]);
    if (have != pm) {
        const int t = (wr * 4 + wc) * 64 + fq * 16 + fr, row = t >> 1, h = t & 1;
        const f32x4* p = (const f32x4*)(ssq + (size_t)(pm * 256 + row) * 32 + h * 16);
        f32x4 a = (p[0] + p[1]) + (p[2] + p[3]);
        float s = (a[0] + a[1]) + (a[2] + a[3]);
        s += xor_f<1>(s);
        if (h == 0) tab[row] = __builtin_amdgcn_rsqf(s * (1.0f / 2048.0f) + RMS_EPS);
        asm volatile("s_waitcnt lgkmcnt(0)" ::: "memory"); __builtin_amdgcn_s_barrier(); asm volatile("" ::: "memory");
        if (t == 0) ((volatile LAS int*)tab)[256] = pm;
    }
}

struct Swiglu {
    static constexpr bool PERM = true, AFTER_DRAIN = false, MIDK = false; static constexpr int NSTORE = 8;
    bf16_t* H; const float* ssq; LAS float* tab;
    __device__ __forceinline__ void operator()(const f32x4 (&acc)[2][2][4][2], const Unit& u, int wr, int wc, int fr, int fq) const {
        const int row0 = u.pm * 256 + wr * 64 + fr, col0 = u.pn * 128 + wc * 32 + 8 * fq;
        unit_rstd_table(ssq, tab, u.pm, wr, wc, fr, fq);
#pragma unroll
        for (int ai = 0; ai < 2; ++ai)
#pragma unroll
            for (int m = 0; m < 4; ++m) {
                const int row = row0 + ai * 128 + m * 16;
                const float rstd = tab[wr * 64 + fr + ai * 128 + m * 16];
                float o[8];
#pragma unroll
                for (int n = 0; n < 2; ++n)
#pragma unroll
                    for (int j = 0; j < 4; ++j) { const float g = acc[ai][0][m][n][j] * rstd, up = acc[ai][1][m][n][j] * rstd; o[n * 4 + j] = siluf(g) * up; }
                u32x4 w; w.x = cvtpk(o[0], o[1]); w.y = cvtpk(o[2], o[3]); w.z = cvtpk(o[4], o[5]); w.w = cvtpk(o[6], o[7]);
                __builtin_nontemporal_store(w, (u32x4*)(H + (size_t)row * DFF + col0));
            }
    }
};

#ifndef RESID_NB
#define RESID_NB 1
#endif
__device__ __forceinline__ u32x2 pk8_fp8(const f32x4& a, const f32x4& b) {
    int p0 = __builtin_amdgcn_cvt_pk_fp8_f32(a[0], a[1], 0, false); p0 = __builtin_amdgcn_cvt_pk_fp8_f32(a[2], a[3], p0, true);
    int p1 = __builtin_amdgcn_cvt_pk_fp8_f32(b[0], b[1], 0, false); p1 = __builtin_amdgcn_cvt_pk_fp8_f32(b[2], b[3], p1, true);
    u32x2 r; r.x = (unsigned)p0; r.y = (unsigned)p1; return r;
}
template <bool BASEF32, bool OUTF32, bool F8 = false>
struct Resid {
    static constexpr bool PERM = true, AFTER_DRAIN = false, MIDK = false; static constexpr int NSTORE = 16;
    const float* base0; const float* base1; int split_row; float scale; float* out; bf16_t* hb; float* ssq_out; unsigned char* hb8;
    __device__ __forceinline__ void operator()(const f32x4 (&acc)[2][2][4][2], const Unit& u, int wr, int wc, int fr, int fq) const {
        const int row0 = u.pm * 256 + wr * 64 + fr, col0 = u.pn * 256 + wc * 32 + 8 * fq;
        if constexpr (BASEF32) {
            const int prow = u.pm * 256;
            const float* bsel = (prow < split_row) ? base0 : base1 - (size_t)split_row * DM;
            size_t rowoff = ((size_t)row0 * DM + col0);
            asm volatile("" : "+v"(rowoff));
            const char* bp0 = (const char*)(bsel + rowoff); char* hp = (char*)(hb + rowoff);
#pragma unroll
            for (int ai = 0; ai < 2; ++ai) {
                f32x4 b[4][2][2];
#pragma unroll
                for (int m = 0; m < 4; ++m)
#pragma unroll
                    for (int bj = 0; bj < 2; ++bj) { const float* bp = (const float*)(bp0 + ((size_t)(ai * 128 + m * 16) * DM + bj * 128) * 4); b[m][bj][0] = *(const f32x4*)bp; b[m][bj][1] = *(const f32x4*)(bp + 4); }
                __builtin_amdgcn_sched_barrier(0);
#pragma unroll
                for (int m = 0; m < 4; ++m) { const int row = row0 + ai * 128 + m * 16; float s = 0.f;
#pragma unroll
                    for (int bj = 0; bj < 2; ++bj) {
                        const f32x4 o0 = b[m][bj][0] + acc[ai][bj][m][0] * scale, o1 = b[m][bj][1] + acc[ai][bj][m][1] * scale;
                        s += (o0[0] * o0[0] + o0[1] * o0[1]) + (o0[2] * o0[2] + o0[3] * o0[3]) + (o1[0] * o1[0] + o1[1] * o1[1]) + (o1[2] * o1[2] + o1[3] * o1[3]);
                        u32x4 w; w.x = cvtpk(o0[0], o0[1]); w.y = cvtpk(o0[2], o0[3]); w.z = cvtpk(o1[0], o1[1]); w.w = cvtpk(o1[2], o1[3]);
                        *(u32x4*)(hp + ((size_t)(ai * 128 + m * 16) * DM + bj * 128) * 2) = w;
                        if constexpr (F8) *(u32x2*)(hb8 + rowoff + ((size_t)(ai * 128 + m * 16) * DM + bj * 128)) = pk8_fp8(o0, o1);
                    }
                    s += xor_f<16>(s); s = xor32_sum(s);
                    if (fq == 0) ssq_out[(size_t)row * 32 + u.pn * 4 + wc] = s;
                }
                __builtin_amdgcn_sched_barrier(0);
            }
        } else {
            size_t rowoff = ((size_t)row0 * DM + col0) * 2;
            asm volatile("" : "+v"(rowoff));
            char* hp = (char*)hb + rowoff; char* op0 = (char*)out + 2 * rowoff; (void)op0;
#pragma unroll
            for (int ai = 0; ai < RESID_NB; ++ai) {
                constexpr int NA = 2 / RESID_NB;
                u32x4 b[NA][4][2];
#pragma unroll
                for (int a2 = 0; a2 < NA; ++a2)
#pragma unroll
                    for (int m = 0; m < 4; ++m)
#pragma unroll
                        for (int bj = 0; bj < 2; ++bj) b[a2][m][bj] = *(const u32x4*)(hp + ((size_t)((ai * NA + a2) * 128 + m * 16) * DM + bj * 128) * 2);
                __builtin_amdgcn_sched_barrier(0);
#pragma unroll
                for (int a2 = 0; a2 < NA; ++a2)
#pragma unroll
                    for (int m = 0; m < 4; ++m) { const int aa = ai * NA + a2; const int row = row0 + aa * 128 + m * 16; float s = 0.f;
#pragma unroll
                        for (int bj = 0; bj < 2; ++bj) {
                            const u32x4 bb = b[a2][m][bj];
                            const f32x4 h0 = {bflo(bb.x), bfhi(bb.x), bflo(bb.y), bfhi(bb.y)}, h1 = {bflo(bb.z), bfhi(bb.z), bflo(bb.w), bfhi(bb.w)};
                            const f32x4 o0 = h0 + acc[aa][bj][m][0] * scale, o1 = h1 + acc[aa][bj][m][1] * scale;
                            if constexpr (OUTF32) {
                                float* op = (float*)(op0 + ((size_t)(aa * 128 + m * 16) * DM + bj * 128) * 4); *(f32x4*)op = o0; *(f32x4*)(op + 4) = o1;
                            } else {
                                s += (o0[0] * o0[0] + o0[1] * o0[1]) + (o0[2] * o0[2] + o0[3] * o0[3]) + (o1[0] * o1[0] + o1[1] * o1[1]) + (o1[2] * o1[2] + o1[3] * o1[3]);
                                u32x4 w; w.x = cvtpk(o0[0], o0[1]); w.y = cvtpk(o0[2], o0[3]); w.z = cvtpk(o1[0], o1[1]); w.w = cvtpk(o1[2], o1[3]);
                                *(u32x4*)(hp + ((size_t)(aa * 128 + m * 16) * DM + bj * 128) * 2) = w;
                                if constexpr (F8) *(u32x2*)(hb8 + (rowoff >> 1) + ((size_t)(aa * 128 + m * 16) * DM + bj * 128)) = pk8_fp8(o0, o1);
                            }
                        }
                        if constexpr (!OUTF32) { s += xor_f<16>(s); s = xor32_sum(s); if (fq == 0) ssq_out[(size_t)row * 32 + u.pn * 4 + wc] = s; }
                    }
                __builtin_amdgcn_sched_barrier(0);
            }
        }
    }
};

struct WinSplit {
    static constexpr bool PERM = true, AFTER_DRAIN = false, MIDK = false; static constexpr int NSTORE = 16;
    unsigned char* R; const float* ssq; LAS float* tab; unsigned* kdone; int pn0; float sc;
    template <int ACT, bool WT = false>
    __device__ __forceinline__ void body(const f32x4 (&acc)[2][2][4][2], bf16_t* dst, int ld, int row0, int col0, int wr, int fr) const {
#pragma unroll
        for (int ai = 0; ai < 2; ++ai)
#pragma unroll
            for (int m = 0; m < 4; ++m) {
                const int row = row0 + ai * 128 + m * 16;
                const float rstd = tab[wr * 64 + fr + ai * 128 + m * 16] * sc;
#pragma unroll
                for (int bj = 0; bj < 2; ++bj) {
                    f32x4 v0 = acc[ai][bj][m][0] * rstd, v1 = acc[ai][bj][m][1] * rstd;
                    if (ACT == 1) {
#pragma unroll
                        for (int j = 0; j < 4; ++j) { v0[j] = 1.0f + __expf(fminf(-v0[j], 30.f)); v1[j] = 1.0f + __expf(fminf(-v1[j], 30.f)); }
                    }
                    if (ACT == 2) {
#pragma unroll
                        for (int j = 0; j < 4; ++j) { v0[j] = siluf(v0[j]); v1[j] = siluf(v1[j]); }
                    }
                    u32x4 w; w.x = cvtpk(v0[0], v0[1]); w.y = cvtpk(v0[2], v0[3]); w.z = cvtpk(v1[0], v1[1]); w.w = cvtpk(v1[2], v1[3]);
                    if (WT) { unsigned long long* q8 = (unsigned long long*)(dst + (size_t)row * ld + col0 + bj * 128);
                        __hip_atomic_store(q8, ((unsigned long long)w.y << 32) | w.x, __ATOMIC_RELAXED, __HIP_MEMORY_SCOPE_AGENT); __hip_atomic_store(q8 + 1, ((unsigned long long)w.w << 32) | w.z, __ATOMIC_RELAXED, __HIP_MEMORY_SCOPE_AGENT); }
                    else __builtin_nontemporal_store(w, (u32x4*)(dst + (size_t)row * ld + col0 + bj * 128));
                }
            }
    }
    __device__ __forceinline__ void body_gate(const f32x4 (&acc)[2][2][4][2], unsigned char* dst, int row0, int col0, int wr, int fr) const {
#pragma unroll
        for (int ai = 0; ai < 2; ++ai)
#pragma unroll
            for (int m = 0; m < 4; ++m) {
                const int row = row0 + ai * 128 + m * 16;
                const float rstd = tab[wr * 64 + fr + ai * 128 + m * 16] * sc;
#pragma unroll
                for (int bj = 0; bj < 2; ++bj) {
                    const f32x4 v0 = acc[ai][bj][m][0] * rstd, v1 = acc[ai][bj][m][1] * rstd;
                    unsigned lo = 0u, hi = 0u;
#pragma unroll
                    for (int j = 0; j < 4; ++j) {
                        lo = __builtin_amdgcn_cvt_pk_u8_f32(fmaxf(sigm(v0[j]) * 255.0f, 1.0f), j, lo);
                        hi = __builtin_amdgcn_cvt_pk_u8_f32(fmaxf(sigm(v1[j]) * 255.0f, 1.0f), j, hi);
                    }
                    u32x2 w; w.x = lo; w.y = hi;
                    __builtin_nontemporal_store(w, (u32x2*)(dst + (size_t)row * DM + col0 + bj * 128));
                }
            }
    }
    __device__ __forceinline__ void operator()(const f32x4 (&acc)[2][2][4][2], const Unit& u, int wr, int wc, int fr, int fq) const {
        const int pn = __builtin_amdgcn_readfirstlane(u.pn) + pn0; bf16_t* dst; int ld, colt;
        if (pn < 12)       { dst = (bf16_t*)(R + R_US + (size_t)(pn >> 1) * SZ512); ld = 512; colt = (pn & 1) * 256; }
        else if (pn < 16)  { dst = (bf16_t*)(R + R_AQ); ld = 1024; colt = (pn - 12) * 256; }
        else if (pn == 16) { dst = (bf16_t*)(R + R_AK); ld = 256; colt = 0; }
        else if (pn == 17) { dst = (bf16_t*)(R + R_AV); ld = 256; colt = 0; }
        else { const int g = (pn - 18) >> 3; dst = (bf16_t*)(R + R_GATE + (size_t)g * 4 * SZ512); ld = 2048; colt = ((pn - 18) & 7) * 256; }
        const int row0 = u.pm * 256 + wr * 64 + fr, col0 = colt + wc * 32 + 8 * fq;
        unit_rstd_table(ssq, tab, u.pm, wr, wc, fr, fq);
        if (pn >= 18) body_gate(acc, R + R_GATE + (size_t)((pn - 18) >> 3) * MT * DM, row0, col0, wr, fr);
        else if (pn == 2 || pn == 3) body<2>(acc, dst, ld, row0, col0, wr, fr);
        else if (pn == 16) {
            body<0, true>(acc, dst, ld, row0, col0, wr, fr);
            asm volatile("s_waitcnt vmcnt(0)" ::: "memory");
            if ((fr | fq) == 0) __hip_atomic_fetch_add(kdone, 1u, __ATOMIC_RELAXED, __HIP_MEMORY_SCOPE_AGENT);
        }
        else body<0>(acc, dst, ld, row0, col0, wr, fr);
    }
};

struct Glu {
    static constexpr bool PERM = true, AFTER_DRAIN = false, MIDK = false; static constexpr int NSTORE = 16;
    const bf16_t* Z; bf16_t* Y;
    __device__ __forceinline__ void operator()(const f32x4 (&acc)[2][2][4][2], const Unit& u, int wr, int wc, int fr, int fq) const {
        const int row0 = u.pm * 256 + wr * 64 + fr, col0 = u.pn * 256 + wc * 32 + 8 * fq;
#pragma unroll
        for (int ai = 0; ai < 2; ++ai) {
            u32x4 zz[4][2];
#pragma unroll
            for (int m = 0; m < 4; ++m)
#pragma unroll
                for (int bj = 0; bj < 2; ++bj) zz[m][bj] = *(const u32x4*)(Z + (size_t)(row0 + ai * 128 + m * 16) * 512 + col0 + bj * 128);
            __builtin_amdgcn_sched_barrier(0);
#pragma unroll
            for (int m = 0; m < 4; ++m)
#pragma unroll
                for (int bj = 0; bj < 2; ++bj) {
                    const size_t offy = (size_t)(row0 + ai * 128 + m * 16) * YLD + col0 + bj * 128;
                    const u32x4 z = zz[m][bj];
                    const f32x4 a0 = acc[ai][bj][m][0], a1 = acc[ai][bj][m][1];
                    u32x4 w;
                    w.x = cvtpk(bflo(z.x) * sigm(a0[0]), bfhi(z.x) * sigm(a0[1])); w.y = cvtpk(bflo(z.y) * sigm(a0[2]), bfhi(z.y) * sigm(a0[3]));
                    w.z = cvtpk(bflo(z.z) * sigm(a1[0]), bfhi(z.z) * sigm(a1[1])); w.w = cvtpk(bflo(z.w) * sigm(a1[2]), bfhi(z.w) * sigm(a1[3]));
                    *(u32x4*)(Y + offy) = w;
                }
            __builtin_amdgcn_sched_barrier(0);
        }
    }
};

#ifndef MID_NB
#define MID_NB 1
#endif
struct MergeFused {
    static constexpr bool PERM = true, AFTER_DRAIN = false, MIDK = true; static constexpr int NSTORE = 16;
    const unsigned char* G; bf16_t* Mg;
#define UB0(w) ((float)((w) & 0xffu))
#define UB1(w) ((float)(((w) >> 8) & 0xffu))
#define UB2(w) ((float)(((w) >> 16) & 0xffu))
#define UB3(w) ((float)((w) >> 24))
    __device__ __forceinline__ void mid(f32x4 (&acc)[2][2][4][2], const Unit& u, int b, int wr, int wc, int fr, int fq) const {
        const int row0 = u.pm * 256 + wr * 64 + fr, col0 = u.pn * 256 + wc * 32 + 8 * fq;
        size_t rowoff = (size_t)row0 * DM + col0;
        asm volatile("" : "+v"(rowoff));
        const unsigned char* Ga = G + (size_t)(b - 1) * MT * DM + rowoff; const unsigned char* Gb = G + (size_t)b * MT * DM + rowoff;
#pragma unroll
        for (int ai = 0; ai < 2; ++ai) {
            u32x2 ga[4][2], gb[4][2];
#pragma unroll
            for (int mm = 0; mm < 4; ++mm)
#pragma unroll
                for (int bj = 0; bj < 2; ++bj) {
                    const size_t off = (size_t)(ai * 128 + mm * 16) * DM + bj * 128;
                    asm volatile("global_load_dwordx2 %0, %1, off" : "=&v"(ga[mm][bj]) : "v"(Ga + off) : "memory");
                    asm volatile("global_load_dwordx2 %0, %1, off" : "=&v"(gb[mm][bj]) : "v"(Gb + off) : "memory");
                }
            asm volatile("s_waitcnt vmcnt(0)" ::: "memory");
#pragma unroll
            for (int m = 0; m < 4; ++m)
#pragma unroll
                for (int bj = 0; bj < 2; ++bj) {
                    u32x2 a = ga[m][bj], c = gb[m][bj];
                    asm volatile("" : "+v"(a), "+v"(c));
                    f32x4 r0, r1;
                    r0[0] = UB0(a.x) * __builtin_amdgcn_rcpf(UB0(c.x)); r0[1] = UB1(a.x) * __builtin_amdgcn_rcpf(UB1(c.x));
                    r0[2] = UB2(a.x) * __builtin_amdgcn_rcpf(UB2(c.x)); r0[3] = UB3(a.x) * __builtin_amdgcn_rcpf(UB3(c.x));
                    r1[0] = UB0(a.y) * __builtin_amdgcn_rcpf(UB0(c.y)); r1[1] = UB1(a.y) * __builtin_amdgcn_rcpf(UB1(c.y));
                    r1[2] = UB2(a.y) * __builtin_amdgcn_rcpf(UB2(c.y)); r1[3] = UB3(a.y) * __builtin_amdgcn_rcpf(UB3(c.y));
                    if (MRG_FP8 && b == 2) { r0 = r0 * (YATT_SC * WBR_SC); r1 = r1 * (YATT_SC * WBR_SC); }
                    acc[ai][bj][m][0] = acc[ai][bj][m][0] * r0; acc[ai][bj][m][1] = acc[ai][bj][m][1] * r1;
                }
        }
    }
    __device__ __forceinline__ void operator()(const f32x4 (&acc)[2][2][4][2], const Unit& u, int wr, int wc, int fr, int fq) const {
        const int row0 = u.pm * 256 + wr * 64 + fr, col0 = u.pn * 256 + wc * 32 + 8 * fq;
        size_t rowoff = (size_t)row0 * DM + col0;
        asm volatile("" : "+v"(rowoff));
        const unsigned char* G2 = G + (size_t)2 * MT * DM + rowoff; char* Mo = (char*)Mg + 2 * rowoff;
        constexpr float FS = (1.0f / 255.0f) * (MRG_FP8 ? 1.0f / (YATT_SC * WBR_SC) : 1.0f);
#pragma unroll
        for (int ai = 0; ai < 2; ++ai) {
            u32x2 gg[4][2];
#pragma unroll
            for (int m = 0; m < 4; ++m)
#pragma unroll
                for (int bj = 0; bj < 2; ++bj) asm volatile("global_load_dwordx2 %0, %1, off" : "=&v"(gg[m][bj]) : "v"(G2 + ((size_t)(ai * 128 + m * 16) * DM + bj * 128)) : "memory");
            asm volatile("s_waitcnt vmcnt(0)" ::: "memory");
#pragma unroll
            for (int m = 0; m < 4; ++m)
#pragma unroll
                for (int bj = 0; bj < 2; ++bj) {
                    u32x2 g = gg[m][bj]; asm volatile("" : "+v"(g));
                    const f32x4 a0 = acc[ai][bj][m][0] * FS, a1 = acc[ai][bj][m][1] * FS;
                    u32x4 w;
                    w.x = cvtpk(UB0(g.x) * a0[0], UB1(g.x) * a0[1]); w.y = cvtpk(UB2(g.x) * a0[2], UB3(g.x) * a0[3]);
                    w.z = cvtpk(UB0(g.y) * a1[0], UB1(g.y) * a1[1]); w.w = cvtpk(UB2(g.y) * a1[2], UB3(g.y) * a1[3]);
                    *(u32x4*)(Mo + ((size_t)(ai * 128 + m * 16) * DM + bj * 128) * 2) = w;
                }
        }
    }
#undef UB0
#undef UB1
#undef UB2
#undef UB3
};
struct NullEpi {
    static constexpr bool PERM = true, AFTER_DRAIN = false, MIDK = false; static constexpr int NSTORE = 0;
    float* sink;
    __device__ __forceinline__ void operator()(const f32x4 (&acc)[2][2][4][2], const Unit& u, int wr, int wc, int fr, int fq) const {
        f32x4 s = {0.f, 0.f, 0.f, 0.f};
#pragma unroll
        for (int ai = 0; ai < 2; ++ai)
#pragma unroll
            for (int bj = 0; bj < 2; ++bj)
#pragma unroll
                for (int m = 0; m < 4; ++m) { s = s + acc[ai][bj][m][0]; s = s + acc[ai][bj][m][1]; }
        const float t = (s[0] + s[1]) + (s[2] + s[3]);
        if (t == 1.2345e37f) sink[u.pm] = t;
    }
};
}
#define LDS_BARRIER() do { asm volatile("s_waitcnt lgkmcnt(0)" ::: "memory"); __builtin_amdgcn_s_barrier(); asm volatile("" ::: "memory"); } while (0)
#define MFMA16(a, b, c) __builtin_amdgcn_mfma_f32_16x16x32_bf16((a), (b), (c), 0, 0, 0)
#define MFMA32(a, b, c) __builtin_amdgcn_mfma_f32_32x32x16_bf16((a), (b), (c), 0, 0, 0)

struct CvtJob { const float* W; const float* gain; bf16_t* dst; int ldw, K, Np, mode, ldd; };
__device__ __forceinline__ int cvt_col(int np, int mode) { if (mode == 0) return np; const int t = np >> 8, w = np & 255; return (w < 128) ? t * 128 + w : DFF + t * 128 + (w - 128); }
struct CvtRegs { f32x4 v[4]; float g[4]; };
__device__ __forceinline__ void cvt_load(const CvtJob& J, int tn, int tk, int c4, int r, CvtRegs& X) {
    const int k0 = tk * 128, col = cvt_col(tn * 64 + 4 * c4, J.mode);
    const float* src = J.W + (size_t)k0 * J.ldw + col;
#pragma unroll
    for (int i = 0; i < 4; ++i) { const int k = r + 32 * i; X.v[i] = *(const f32x4*)(src + (size_t)k * J.ldw); X.g[i] = J.gain ? J.gain[k0 + k] : 1.0f; }
}
__device__ __forceinline__ unsigned char f2fp8(float x) { return (unsigned char)(__builtin_amdgcn_cvt_pk_fp8_f32(x, x, 0, false) & 0xff); }
__device__ __forceinline__ void cvt_load8(const CvtJob& J, int tn, int tk, int c4, int r, CvtRegs& X) {
    const int k0 = tk * 128, col = tn * 64 + 4 * c4;
    const float* src = J.W + (size_t)k0 * J.ldw + col;
#pragma unroll
    for (int i = 0; i < 4; ++i) { const int k = 4 * r + i; X.v[i] = *(const f32x4*)(src + (size_t)k * J.ldw); X.g[i] = J.gain ? J.gain[k0 + k] : 1.0f; }
}
__device__ __forceinline__ void cvt_job8(LAS unsigned char* lds, const CvtJob& J, float scale, int& base, int ldd8) {
    LAS unsigned* T = (LAS unsigned*)lds;
    int tid_l = threadIdx.x; asm volatile("" : "+v"(tid_l)); const int tid = tid_l, c4 = tid & 15, r = tid >> 4, row = tid >> 3, seg = tid & 7;
    const int ntn = J.Np / 64, ntk = J.K / 128, nt = ntn * ntk;
    const int G = (int)gridDim.x, rank = (int)blockIdx.x;
    int first = rank - (base % G); if (first < 0) first += G;
    base += nt;
    if (first >= nt) return;
    CvtRegs X; cvt_load8(J, first % ntn, first / ntn, c4, r, X);
    for (int t = first; t < nt; t += G) {
        const int tn = t % ntn, tk = t / ntn;
        const float g0 = X.g[0] * scale, g1 = X.g[1] * scale, g2 = X.g[2] * scale, g3 = X.g[3] * scale;
#pragma unroll
        for (int e = 0; e < 4; ++e) {
            int w = __builtin_amdgcn_cvt_pk_fp8_f32(X.v[0][e] * g0, X.v[1][e] * g1, 0, false); w = __builtin_amdgcn_cvt_pk_fp8_f32(X.v[2][e] * g2, X.v[3][e] * g3, w, true);
            T[(4 * c4 + e) * 33 + r] = (unsigned)w; }
        if (t + G < nt) cvt_load8(J, (t + G) % ntn, (t + G) / ntn, c4, r, X);
        LDS_BARRIER();
        u32x4 v; v.x = T[row * 33 + seg * 4]; v.y = T[row * 33 + seg * 4 + 1]; v.z = T[row * 33 + seg * 4 + 2]; v.w = T[row * 33 + seg * 4 + 3];
        *(u32x4*)((unsigned char*)J.dst + (size_t)(tn * 64 + row) * ldd8 + tk * 128 + seg * 16) = v;
        LDS_BARRIER();
    }
}
__device__ __forceinline__ void cvt_job(LAS unsigned char* lds, const CvtJob& J, int& base, int wg0 = 0, int nw = 0) {
    LAS bf16_t* T = (LAS bf16_t*)lds;
    int tid_l = threadIdx.x; asm volatile("" : "+v"(tid_l)); const int tid = tid_l, c4 = tid & 15, r = tid >> 4, row = tid >> 3, seg = tid & 7;
    const int ntn = J.Np / 64, ntk = J.K / 128, nt = ntn * ntk;
    const int G = nw ? nw : (int)gridDim.x;
    const int rank = (int)blockIdx.x - wg0;
    int first = rank - (base % G); if (first < 0) first += G;
    base += nt;
    if (rank < 0 || rank >= G || first >= nt) return;
    CvtRegs X; cvt_load(J, first % ntn, first / ntn, c4, r, X);
    for (int t = first; t < nt; t += G) {
        const int tn = t % ntn, tk = t / ntn;
#pragma unroll
        for (int i = 0; i < 4; ++i) { const int k = r + 32 * i;
#pragma unroll
            for (int e = 0; e < 4; ++e) T[(4 * c4 + e) * 136 + k] = f2bf(X.v[i][e] * X.g[i]); }
        if (t + G < nt) cvt_load(J, (t + G) % ntn, (t + G) / ntn, c4, r, X);
        LDS_BARRIER();
        const LAS u32x4* s = (const LAS u32x4*)(T + row * 136 + seg * 16);
        u32x4* d = (u32x4*)(J.dst + (size_t)(tn * 64 + row) * (J.ldd ? J.ldd : J.K) + tk * 128 + seg * 16);
        d[0] = s[0]; d[1] = s[1];
        LDS_BARRIER();
    }
}

__device__ __forceinline__ void sincos_d(double x, double& s, double& c) {
    const double k = rint(x * 0.63661977236758134308);
    const double r = (x - k * 1.5707963267948966192) - k * 6.123233995736766e-17;
    const double r2 = r * r;
    double sp = -1.0 / 1307674368000.0; sp = sp * r2 + 1.0 / 6227020800.0; sp = sp * r2 - 1.0 / 39916800.0; sp = sp * r2 + 1.0 / 362880.0; sp = sp * r2 - 1.0 / 5040.0; sp = sp * r2 + 1.0 / 120.0; sp = sp * r2 - 1.0 / 6.0; sp = sp * r2 + 1.0;
    double cp = 1.0 / 20922789888000.0; cp = cp * r2 - 1.0 / 87178291200.0; cp = cp * r2 + 1.0 / 479001600.0; cp = cp * r2 - 1.0 / 3628800.0; cp = cp * r2 + 1.0 / 40320.0; cp = cp * r2 - 1.0 / 720.0; cp = cp * r2 + 1.0 / 24.0; cp = cp * r2 - 0.5; cp = cp * r2 + 1.0;
    const double sr = sp * r, cr = cp;
    const int q = ((int)k) & 3;
    s = (q == 0) ? sr : (q == 1) ? cr : (q == 2) ? -sr : -cr;
    c = (q == 0) ? cr : (q == 1) ? -sr : (q == 2) ? -cr : sr;
}
__device__ __forceinline__ double exp_d(double x) {
    const double k = rint(x * 1.4426950408889634074);
    const double r = x - k * 0.69314718055994530942;
    double p = 1.0 / 479001600.0; p = p * r + 1.0 / 39916800.0; p = p * r + 1.0 / 3628800.0; p = p * r + 1.0 / 362880.0; p = p * r + 1.0 / 40320.0; p = p * r + 1.0 / 5040.0; p = p * r + 1.0 / 720.0;
    p = p * r + 1.0 / 120.0; p = p * r + 1.0 / 24.0; p = p * r + 1.0 / 6.0; p = p * r + 0.5; p = p * r + 1.0; p = p * r + 1.0;
    return ldexp(p, (int)k);
}

struct ProArgs {
    const float* x_prompt; const float* x_sample;
    const float* lam_re; const float* lam_im; const float* log_dt; const float* b_re; const float* b_im; const float* c_re; const float* c_im; const float* lb_logits;
    unsigned char* ws;
};
__device__ __forceinline__ void prologue_phase(const ProArgs& A) {
    int tid_l = threadIdx.x; asm volatile("" : "+v"(tid_l)); const int tid = tid_l, G = gridDim.x; const size_t gtid = (size_t)blockIdx.x * NTHREADS + tid, gstride = (size_t)G * NTHREADS;
    for (size_t i = gtid; i < (size_t)DEPTH * 2 * 32 * 64; i += gstride) {
        const int n = (int)(i & 63); const size_t ldg = i >> 6;
        const double dt = exp_d((double)A.log_dt[ldg]);
        const double lr = (double)A.lam_re[i], li = (double)A.lam_im[i];
        const double mag = exp_d(lr * dt); double sn, cs; sincos_d(li * dt, sn, cs);
        const double are = mag * cs, aim = mag * sn;
        const double den = lr * lr + li * li, nre = are - 1.0;
        const double cre = (nre * lr + aim * li) / den, cim = (aim * lr - nre * li) / den;
        ((f32x2*)(A.ws + WS_ATAB))[i] = (f32x2){(float)are, (float)aim};
        bf16_t* Bm = (bf16_t*)(A.ws + WS_BM) + ldg * 128 * 16; bf16_t* Cm = (bf16_t*)(A.ws + WS_CM) + ldg * 16 * 128;
        const float* bre = A.b_re + i * 16; const float* bim = A.b_im + i * 16;
#pragma unroll
        for (int p = 0; p < 16; ++p) {
            const double br = (double)bre[p], bi = (double)bim[p];
            Bm[n * 16 + p] = f2bf((float)(cre * br - cim * bi));
            Bm[(64 + n) * 16 + p] = f2bf((float)(cre * bi + cim * br));
            Cm[p * 128 + n] = f2bf(A.c_re[(ldg * 16 + p) * 64 + n]);
            Cm[p * 128 + 64 + n] = f2bf(-A.c_im[(ldg * 16 + p) * 64 + n]);
        }
    }
    for (size_t i = gtid; i < 1024; i += gstride) {
        float lg[DEPTH], mx = -1e30f;
#pragma unroll
        for (int l = 0; l < DEPTH; ++l) { lg[l] = A.lb_logits[l * 1024 + i]; mx = fmaxf(mx, lg[l]); }
        float sum = 0.f;
#pragma unroll
        for (int l = 0; l < DEPTH; ++l) { lg[l] = expf(lg[l] - mx); sum += lg[l]; }
        float cum = 0.f; const float p0 = lg[0] / sum;
#pragma unroll
        for (int l = 0; l < DEPTH; ++l) { cum += lg[l] / sum; float v = cum - p0; v = fminf(fmaxf(v, 0.f), 1.0f - 1e-6f); ((float*)(A.ws + WS_LB))[l * 1024 + i] = v; }
    }
    {
        const int wave = tid >> 6, lane = tid & 63; float* ssq = (float*)(A.ws + WS_SSQ); bf16_t* hb = (bf16_t*)(A.ws + WS_HB);
        for (int row0 = blockIdx.x * 8 + wave; row0 < MT; row0 += 2 * G * 8) {
            f32x4 a[2][4], b[2][4]; bool ok[2];
#pragma unroll
            for (int k = 0; k < 2; ++k) { const int row = row0 + k * G * 8; ok[k] = row < MT; const int rr = ok[k] ? row : row0;
                const float* xp = (rr < PROMPT_ROWS) ? A.x_prompt + (size_t)rr * DM : A.x_sample + (size_t)(rr - PROMPT_ROWS) * DM;
#pragma unroll
                for (int i = 0; i < 4; ++i) { const int c = (i * 64 + lane) * 8; a[k][i] = *(const f32x4*)(xp + c); b[k][i] = *(const f32x4*)(xp + c + 4); } }
            __builtin_amdgcn_sched_barrier(0);
#pragma unroll
            for (int k = 0; k < 2; ++k) { const int row = row0 + k * G * 8; float s = 0.f;
#pragma unroll
                for (int i = 0; i < 4; ++i) { const int c = (i * 64 + lane) * 8; const f32x4 av = a[k][i], bv = b[k][i];
                    s += (av[0] * av[0] + av[1] * av[1]) + (av[2] * av[2] + av[3] * av[3]) + (bv[0] * bv[0] + bv[1] * bv[1]) + (bv[2] * bv[2] + bv[3] * bv[3]);
                    u32x4 w; w.x = cvtpk(av[0], av[1]); w.y = cvtpk(av[2], av[3]); w.z = cvtpk(bv[0], bv[1]); w.w = cvtpk(bv[2], bv[3]);
                    if (ok[k]) *(u32x4*)(hb + (size_t)row * DM + c) = w; }
                s = xor32_sum(s); s += xor_f<16>(s); s += xor_f<8>(s); s += xor_f<4>(s); s += xor_f<2>(s); s += xor_f<1>(s);
                if (ok[k] && lane < 32) ssq[(size_t)row * 32 + lane] = (lane == 0) ? s : 0.f; }
        }
    }
}

struct S5Args { bf16_t* us; float* yd; const f32x2* atab; const bf16_t* Bm; const bf16_t* Cm; const float* dskip; };
__device__ __forceinline__ int crow16(int r) { return (r & 3) + 8 * (r >> 2); }
__device__ __forceinline__ void s5_unit(LAS unsigned char* lds, const S5Args& A, int unit) {
    int tid_l = threadIdx.x; asm volatile("" : "+v"(tid_l)); const int tid = tid_l, w = __builtin_amdgcn_readfirstlane(tid >> 6), lane = tid & 63, l31 = lane & 31, hi = lane >> 5, fr = lane & 15, fq = lane >> 4;
    const int b = unit >> 3, gq = unit & 7, dir = w >> 2, g = gq * 4 + (w & 3);
    const size_t row0 = (size_t)b * SEQL;
    const f32x2 a = A.atab[(dir * 32 + g) * 64 + lane];
    const bf16_t* Bm = A.Bm + (size_t)(dir * 32 + g) * 128 * 16;
    const bf16_t* Cm = A.Cm + (size_t)(dir * 32 + g) * 16 * 128;
    bf16x8 bfrag[4], cfrag[4];
#pragma unroll
    for (int j = 0; j < 4; ++j) { bfrag[j] = *(const bf16x8*)(Bm + (j * 32 + l31) * 16 + hi * 8); cfrag[j] = *(const bf16x8*)(Cm + fr * 128 + j * 32 + fq * 8); }
    LAS unsigned char* X = lds + w * 8704;
    const bf16_t* ug = A.us + row0 * 512 + g * 16 + hi * 8;
    float* ydw = A.yd + ((size_t)dir * MT + row0) * 512 + g * 16 + fr;
    float xr = 0.f, xi = 0.f;
    const float one = (A.dskip != nullptr) ? 1.0f : 0.0f;
    const int tA0 = dir ? (SEQL - 1 - l31) : l31;
    bf16x8 ua = *(const bf16x8*)(ug + (size_t)tA0 * 512);
    bf16x8 ua1 = *(const bf16x8*)(ug + (size_t)(dir ? tA0 - 32 : tA0 + 32) * 512);
    for (int c = 0; c < SEQL / 32; ++c) {
        bf16x8 ua_n = ua1;
        if (c + 2 < SEQL / 32) { const int tn = dir ? tA0 - 32 * (c + 2) : tA0 + 32 * (c + 2); ua1 = *(const bf16x8*)(ug + (size_t)tn * 512); }
        const f32x16 zero = {};
        f32x16 d0 = MFMA32(ua, bfrag[0], zero), d1 = MFMA32(ua, bfrag[1], zero), d2 = MFMA32(ua, bfrag[2], zero), d3 = MFMA32(ua, bfrag[3], zero);
        asm volatile("" :: "v"(ua));
        float p0r[16], p1r[16], p0i[16], p1i[16];
#pragma unroll
        for (int r = 0; r < 16; ++r) { d0[r] *= one; d1[r] *= one; d2[r] *= one; d3[r] *= one; }
#pragma unroll
        for (int r = 0; r < 16; ++r) {
            auto s = __builtin_amdgcn_permlane32_swap(__float_as_uint(d0[r]), __float_as_uint(d1[r]), false, false);
            p0r[r] = __uint_as_float(s[0]); p1r[r] = __uint_as_float(s[1]);
            auto q = __builtin_amdgcn_permlane32_swap(__float_as_uint(d2[r]), __float_as_uint(d3[r]), false, false);
            p0i[r] = __uint_as_float(q[0]); p1i[r] = __uint_as_float(q[1]);
        }
#pragma unroll
        for (int t8 = 0; t8 < 4; ++t8) {
#pragma unroll
            for (int q = 0; q < 4; ++q) { const int r = 4 * t8 + q; const float nr = a.x * xr - a.y * xi + p0r[r], ni = a.x * xi + a.y * xr + p0i[r]; xr = nr; xi = ni; p0r[r] = xr; p0i[r] = xi; }
#pragma unroll
            for (int q = 0; q < 4; ++q) { const int r = 4 * t8 + q; const float nr = a.x * xr - a.y * xi + p1r[r], ni = a.x * xi + a.y * xr + p1i[r]; xr = nr; xi = ni; p1r[r] = xr; p1i[r] = xi; }
        }
        asm volatile("" ::: "memory");
#pragma unroll
        for (int r = 0; r < 16; ++r) {
            const int t0 = crow16(r);
            *(LAS bf16_t*)(X + t0 * 272 + lane * 2) = f2bf(p0r[r]);       *(LAS bf16_t*)(X + t0 * 272 + 128 + lane * 2) = f2bf(p0i[r]);
            *(LAS bf16_t*)(X + (t0 + 4) * 272 + lane * 2) = f2bf(p1r[r]); *(LAS bf16_t*)(X + (t0 + 4) * 272 + 128 + lane * 2) = f2bf(p1i[r]);
        }
        asm volatile("" ::: "memory"); __builtin_amdgcn_wave_barrier(); asm volatile("" ::: "memory");
#pragma unroll
        for (int tt = 0; tt < 2; ++tt) {
            f32x4 y = {0.f, 0.f, 0.f, 0.f};
#pragma unroll
            for (int kk = 0; kk < 4; ++kk) { const bf16x8 af = *(const LAS bf16x8*)(X + (tt * 16 + fr) * 272 + (kk * 32 + fq * 8) * 2); y = MFMA16(af, cfrag[kk], y); }
#pragma unroll
            for (int r = 0; r < 4; ++r) { const int s = c * 32 + tt * 16 + 4 * fq + r; const int tok = dir ? (SEQL - 1 - s) : s; ydw[(size_t)tok * 512] = y[r]; }
        }
        asm volatile("" ::: "memory"); __builtin_amdgcn_wave_barrier(); asm volatile("" ::: "memory");
        ua = ua_n;
    }
    __threadfence(); __syncthreads();
    {
        const int c8 = (tid & 7) * 8, tt = tid >> 3;
        const f32x4 d0 = *(const f32x4*)(A.dskip + gq * 64 + c8), d1 = *(const f32x4*)(A.dskip + gq * 64 + c8 + 4);
        bf16_t* up = A.us + row0 * 512 + gq * 64 + c8; const float* y0 = A.yd + row0 * 512 + gq * 64 + c8; const float* y1 = y0 + (size_t)MT * 512;
        for (int it = 0; it < SEQL / 64; it += 4) {
            u32x4 uu[4]; f32x4 a0[4], a1[4], b0[4], b1[4];
#pragma unroll
            for (int k = 0; k < 4; ++k) { const size_t o = (size_t)((it + k) * 64 + tt) * 512;
                uu[k] = *(const u32x4*)(up + o); a0[k] = *(const f32x4*)(y0 + o); a1[k] = *(const f32x4*)(y0 + o + 4); b0[k] = *(const f32x4*)(y1 + o); b1[k] = *(const f32x4*)(y1 + o + 4); }
            __builtin_amdgcn_sched_barrier(0);
#pragma unroll
            for (int k = 0; k < 4; ++k) { const size_t o = (size_t)((it + k) * 64 + tt) * 512;
                const f32x4 u0 = {bflo(uu[k].x), bfhi(uu[k].x), bflo(uu[k].y), bfhi(uu[k].y)}, u1 = {bflo(uu[k].z), bfhi(uu[k].z), bflo(uu[k].w), bfhi(uu[k].w)};
                const f32x4 y_0 = d0 * u0 + a0[k] + b0[k], y_1 = d1 * u1 + a1[k] + b1[k];
                u32x4 w; w.x = cvtpk(gelu_tanh(y_0[0]), gelu_tanh(y_0[1])); w.y = cvtpk(gelu_tanh(y_0[2]), gelu_tanh(y_0[3])); w.z = cvtpk(gelu_tanh(y_1[0]), gelu_tanh(y_1[1])); w.w = cvtpk(gelu_tanh(y_1[2]), gelu_tanh(y_1[3]));
                *(u32x4*)(up + o) = w; }
            __builtin_amdgcn_sched_barrier(0);
        }
    }
    __syncthreads();
}

struct HgArgs { const bf16_t* q; const bf16_t* ff; const bf16_t* fb; const bf16_t* iv; bf16_t* o; const float* lb; unsigned* done; };
namespace hg {
constexpr int QT = 0, KT = 17408, KDT = 34816, VT = 53248, ST = 71680, AB = 106496, CQ = 115712, EL = 117760, END = 118272;
}
__device__ __forceinline__ void hgrn_unit(LAS unsigned char* lds, const HgArgs& A, int unit) {
    using namespace hg;
    int tid_l = threadIdx.x; asm volatile("" : "+v"(tid_l)); const int tid = tid_l, w = __builtin_amdgcn_readfirstlane(tid >> 6), lane = tid & 63, fr = lane & 15, fq = lane >> 4;
    const int dir = unit & 1, h = (unit >> 1) & 3, b = unit >> 3;
    const size_t row0 = (size_t)b * SEQL;
    const int d = tid & 127, tq = tid >> 7, col = h * 128 + d;
    const float lbv = A.lb[dir * 512 + col], oml = 1.0f - lbv;
    const bf16_t* fsrc = (dir ? A.fb : A.ff) + row0 * 512 + col;
    const bf16_t* qsrc = A.q + row0 * 512 + col;
    const bf16_t* vsrc = A.iv + row0 * 512 + col;
    f32x4 sacc[8];
#pragma unroll
    for (int i = 0; i < 8; ++i) sacc[i] = (f32x4){0.f, 0.f, 0.f, 0.f};
    { unsigned z0; asm volatile("v_mov_b32 %0, 0" : "=v"(z0));
      for (int i = tid; i < 34816 / 16; i += NTHREADS) *(LAS u32x4*)(lds + ST + i * 16) = (u32x4){z0, z0, z0, z0}; }
    unsigned rz[16], rq[16], rv[16];
#pragma unroll
    for (int j = 0; j < 16; ++j) { const int s = tq * 16 + j; const size_t o = (size_t)(dir ? (SEQL - 1 - s) : s) * 512; rz[j] = fsrc[o]; rq[j] = qsrc[o]; rv[j] = vsrc[o]; }
    LDS_BARRIER();
    for (int c = 0; c < SEQL / 64; ++c) {
        float pr[16], kk[16];
        {
            float run = 1.0f;
#pragma unroll
            for (int j = 0; j < 16; ++j) {
                const float sg = sigm(__uint_as_float(rz[j] << 16));
                run *= fmaxf(lbv + oml * sg, 1e-30f); pr[j] = run;
                kk[j] = oml * (1.0f - sg);
            }
            ((LAS float*)(lds + CQ))[tq * 128 + d] = run;
        }
        unsigned qv[16], vv[8];
#pragma unroll
        for (int j = 0; j < 16; ++j) { qv[j] = rq[j]; if (j & 1) vv[j >> 1] |= rv[j] << 16; else vv[j >> 1] = rv[j]; }
        if (c + 1 < SEQL / 64) {
#pragma unroll
            for (int j = 0; j < 16; ++j) { const int s = (c + 1) * 64 + tq * 16 + j; const size_t o = (size_t)(dir ? (SEQL - 1 - s) : s) * 512; rz[j] = fsrc[o]; rq[j] = qsrc[o]; rv[j] = vsrc[o]; }
        }
        LDS_BARRIER();
        {
            const LAS float* cq = (const LAS float*)(lds + CQ);
            const float c0 = cq[d], c1 = cq[128 + d], c2 = cq[256 + d], c3 = cq[384 + d];
            const float tot = (c0 * c1) * (c2 * c3);
            const float off = (tq == 0) ? 1.0f : (tq == 1) ? c0 : (tq == 2) ? (c0 * c1) : (c0 * c1) * c2;
            unsigned kd[8];
#pragma unroll
            for (int j = 0; j < 16; ++j) {
                const float e1 = off * pr[j];
                const float e2 = __builtin_amdgcn_rcpf(fmaxf(e1, 1.8e-35f));
                const int i = tq * 16 + j;
                *(LAS bf16_t*)(lds + QT + i * 272 + d * 2) = f2bf(__uint_as_float(qv[j] << 16) * e1);
                const float kt = kk[j] * e2;
                *(LAS bf16_t*)(lds + KT + i * 272 + d * 2) = f2bf(kt);
                const float kdv = kt * tot;
                if (j & 1) kd[j >> 1] = cvtpk(__uint_as_float(kd[j >> 1]), kdv); else kd[j >> 1] = __float_as_uint(kdv);
            }
            LAS u32x4* kp = (LAS u32x4*)(lds + KDT + d * 144 + tq * 32); kp[0] = (u32x4){kd[0], kd[1], kd[2], kd[3]}; kp[1] = (u32x4){kd[4], kd[5], kd[6], kd[7]};
            LAS u32x4* vp = (LAS u32x4*)(lds + VT + d * 144 + tq * 32);  vp[0] = (u32x4){vv[0], vv[1], vv[2], vv[3]}; vp[1] = (u32x4){vv[4], vv[5], vv[6], vv[7]};
            if (tq == 0) ((LAS float*)(lds + EL))[d] = tot;
        }
        LDS_BARRIER();
        {
            const int ti = w >> 1;
#pragma unroll
            for (int sj = 0; sj < 2; ++sj) {
                const int si = 2 * (w & 1) + sj;
                f32x4 acc = {0.f, 0.f, 0.f, 0.f};
                if (si <= ti) {
#pragma unroll
                    for (int k = 0; k < 4; ++k) {
                        const bf16x8 ka = *(const LAS bf16x8*)(lds + KT + (16 * si + fr) * 272 + (k * 32 + fq * 8) * 2);
                        const bf16x8 qb = *(const LAS bf16x8*)(lds + QT + (16 * ti + fr) * 272 + (k * 32 + fq * 8) * 2);
                        acc = MFMA16(ka, qb, acc);
                    }
                    if (si == ti) {
#pragma unroll
                        for (int r = 0; r < 4; ++r) if (4 * fq + r > fr) acc[r] = 0.f;
                    }
                }
                u32x2 pk; pk.x = cvtpk(acc[0], acc[1]); pk.y = cvtpk(acc[2], acc[3]);
                *(LAS u32x2*)(lds + AB + (16 * ti + fr) * 144 + (16 * si + 4 * fq) * 2) = pk;
            }
        }
        f32x4 oacc[4];
#pragma unroll
        for (int ti = 0; ti < 4; ++ti) oacc[ti] = (f32x4){0.f, 0.f, 0.f, 0.f};
#pragma unroll
        for (int k = 0; k < 4; ++k) {
            const bf16x8 sb = *(const LAS bf16x8*)(lds + ST + (16 * w + fr) * 272 + (k * 32 + fq * 8) * 2);
#pragma unroll
            for (int ti = 0; ti < 4; ++ti) { const bf16x8 qa = *(const LAS bf16x8*)(lds + QT + (16 * ti + fr) * 272 + (k * 32 + fq * 8) * 2); oacc[ti] = MFMA16(qa, sb, oacc[ti]); }
        }
        LDS_BARRIER();
        bf16x8 vb[2];
#pragma unroll
        for (int k = 0; k < 2; ++k) vb[k] = *(const LAS bf16x8*)(lds + VT + (16 * w + fr) * 144 + (k * 32 + fq * 8) * 2);
#pragma unroll
        for (int k = 0; k < 2; ++k)
#pragma unroll
            for (int ti = 0; ti < 4; ++ti) { const bf16x8 aa = *(const LAS bf16x8*)(lds + AB + (16 * ti + fr) * 144 + (k * 32 + fq * 8) * 2); oacc[ti] = MFMA16(aa, vb[k], oacc[ti]); }
        {
            bf16_t* op = A.o + ((size_t)dir * MT + row0) * 512 + h * 128 + 16 * w + fr;
#pragma unroll
            for (int ti = 0; ti < 4; ++ti)
#pragma unroll
                for (int r = 0; r < 4; ++r) { const int s = c * 64 + 16 * ti + 4 * fq + r; const int tok = dir ? (SEQL - 1 - s) : s; if (HG_WT) __hip_atomic_store(op + (size_t)tok * 512, f2bf(oacc[ti][r]), __ATOMIC_RELAXED, __HIP_MEMORY_SCOPE_AGENT); else op[(size_t)tok * 512] = f2bf(oacc[ti][r]); }
        }
#pragma unroll
        for (int di = 0; di < 8; ++di) {
            const f32x4 el = *(const LAS f32x4*)(lds + EL + (16 * di + 4 * fq) * 4);
            sacc[di] = sacc[di] * el;
#pragma unroll
            for (int k = 0; k < 2; ++k) { const bf16x8 ka = *(const LAS bf16x8*)(lds + KDT + (16 * di + fr) * 144 + (k * 32 + fq * 8) * 2); sacc[di] = MFMA16(ka, vb[k], sacc[di]); }
            u32x2 pk; pk.x = cvtpk(sacc[di][0], sacc[di][1]); pk.y = cvtpk(sacc[di][2], sacc[di][3]);
            *(LAS u32x2*)(lds + ST + (16 * w + fr) * 272 + (16 * di + 4 * fq) * 2) = pk;
        }
        LDS_BARRIER();
    }
    WAIT_VM0();
    if ((tid & 63) == 0) __hip_atomic_fetch_add(A.done, 1u, __ATOMIC_RELAXED, __HIP_MEMORY_SCOPE_AGENT);
}

struct QkArgs { bf16_t* aq; bf16_t* ak; const float* qn; const float* kn; int nq; };
__device__ __forceinline__ void qkprep_phase(const QkArgs& A, int first_block, int nblocks) {
    int tid_l = threadIdx.x; asm volatile("" : "+v"(tid_l)); const int tid = tid_l, j = tid & 15, axis = j >> 3, sub = j & 7;
    const int bid = (int)blockIdx.x - first_block; if (bid < 0 || bid >= nblocks) return;
    const int nh = A.nq + 2, stride = nblocks * 32;
    const int d1 = axis * 64 + 4 * sub, d2 = d1 + 32;
    float inv[4];
#pragma unroll
    for (int e = 0; e < 4; ++e) inv[e] = __builtin_amdgcn_exp2f(-(float)(4 * sub + e) * (13.287712379549449f / 32.0f));
    constexpr int NB = 5;
    for (int item0 = bid * 32 + (tid >> 4); item0 < MT * nh; item0 += NB * stride) {
        bf16_t* pp[NB]; const float* gn[NB]; u32x2 w1[NB], w2[NB]; int tt[NB]; bool ok[NB];
#pragma unroll
        for (int k = 0; k < NB; ++k) {
            const int item = item0 + k * stride; ok[k] = item < MT * nh;
            const int it = ok[k] ? item : item0;
            const int row = it / nh, hh = it - row * nh + (8 - A.nq);
            if (hh < 8) { pp[k] = A.aq + (size_t)row * 1024 + hh * 128; gn[k] = A.qn; } else { pp[k] = A.ak + (size_t)row * 256 + (hh - 8) * 128; gn[k] = A.kn; }
            tt[k] = row & (SEQL - 1);
            w1[k] = *(const u32x2*)(pp[k] + d1); w2[k] = *(const u32x2*)(pp[k] + d2);
        }
        __builtin_amdgcn_sched_barrier(0);
#pragma unroll
        for (int k = 0; k < NB; ++k) {
            float x1[4] = {bflo(w1[k].x), bfhi(w1[k].x), bflo(w1[k].y), bfhi(w1[k].y)}, x2[4] = {bflo(w2[k].x), bfhi(w2[k].x), bflo(w2[k].y), bfhi(w2[k].y)};
            float s = 0.f;
#pragma unroll
            for (int e = 0; e < 4; ++e) s += x1[e] * x1[e] + x2[e] * x2[e];
            s += xor_f<1>(s); s += xor_f<2>(s); s += xor_f<4>(s); s += xor_f<8>(s);
            const float rstd = __builtin_amdgcn_rsqf(s * (1.0f / 128.0f) + 1e-6f);
            const float pos = (float)(axis == 0 ? (tt[k] >> 6) : (tt[k] & 63));
            const f32x4 g1 = *(const f32x4*)(gn[k] + d1), g2 = *(const f32x4*)(gn[k] + d2);
            float o1[4], o2[4];
#pragma unroll
            for (int e = 0; e < 4; ++e) {
                const float ang = pos * inv[e], cs = __cosf(ang), sn = __sinf(ang);
                const float y1 = x1[e] * rstd * g1[e], y2 = x2[e] * rstd * g2[e];
                o1[e] = y1 * cs - y2 * sn; o2[e] = y2 * cs + y1 * sn;
            }
            u32x2 r1, r2; r1.x = cvtpk(o1[0], o1[1]); r1.y = cvtpk(o1[2], o1[3]); r2.x = cvtpk(o2[0], o2[1]); r2.y = cvtpk(o2[2], o2[3]);
            if (ok[k]) { *(u32x2*)(pp[k] + d1) = r1; *(u32x2*)(pp[k] + d2) = r2; }
        }
        __builtin_amdgcn_sched_barrier(0);
    }
}

struct HfArgs { const bf16_t* o; const bf16_t* g; const float* gain; bf16_t* y; };
__device__ __forceinline__ void hgfin_chunk(const HfArgs& A, int chunk) {
    int tid_l = threadIdx.x; asm volatile("" : "+v"(tid_l)); const int tid = tid_l, j = tid & 15;
    const f32x4 g0 = *(const f32x4*)(A.gain + j * 8), g1 = *(const f32x4*)(A.gain + j * 8 + 4);
#pragma unroll 1
    for (int trip = 0; trip < 2; ++trip) {
        const int item = chunk * 256 + trip * 128 + (tid >> 4);
        u32x4 oa[4], ob[4], gg[4];
#pragma unroll
        for (int k = 0; k < 4; ++k) { const size_t off = (size_t)(item + k * 32) * 128 + j * 8;
            oa[k] = *(const u32x4*)(A.o + off); ob[k] = *(const u32x4*)(A.o + (size_t)MT * 512 + off);
            gg[k] = *(const u32x4*)(A.g + off); }
        __builtin_amdgcn_sched_barrier(0);
#pragma unroll
        for (int k = 0; k < 4; ++k) { const int it = item + k * 32;
            const f32x4 s0 = {bflo(oa[k].x) + bflo(ob[k].x), bfhi(oa[k].x) + bfhi(ob[k].x), bflo(oa[k].y) + bflo(ob[k].y), bfhi(oa[k].y) + bfhi(ob[k].y)};
            const f32x4 s1 = {bflo(oa[k].z) + bflo(ob[k].z), bfhi(oa[k].z) + bfhi(ob[k].z), bflo(oa[k].w) + bflo(ob[k].w), bfhi(oa[k].w) + bfhi(ob[k].w)};
            float s = (s0[0] * s0[0] + s0[1] * s0[1]) + (s0[2] * s0[2] + s0[3] * s0[3]) + (s1[0] * s1[0] + s1[1] * s1[1]) + (s1[2] * s1[2] + s1[3] * s1[3]);
            s += xor_f<1>(s); s += xor_f<2>(s); s += xor_f<4>(s); s += xor_f<8>(s);
            const float rstd = __builtin_amdgcn_rsqf(s * (1.0f / 128.0f) + 1e-6f);
            u32x4 w;
            w.x = cvtpk(s0[0] * rstd * g0[0] * siluf(bflo(gg[k].x)), s0[1] * rstd * g0[1] * siluf(bfhi(gg[k].x)));
            w.y = cvtpk(s0[2] * rstd * g0[2] * siluf(bflo(gg[k].y)), s0[3] * rstd * g0[3] * siluf(bfhi(gg[k].y)));
            w.z = cvtpk(s1[0] * rstd * g1[0] * siluf(bflo(gg[k].z)), s1[1] * rstd * g1[1] * siluf(bfhi(gg[k].z)));
            w.w = cvtpk(s1[2] * rstd * g1[2] * siluf(bflo(gg[k].w)), s1[3] * rstd * g1[3] * siluf(bfhi(gg[k].w)));
            *(u32x4*)(A.y + (size_t)(it >> 2) * YLD + 512 + (it & 3) * 128 + j * 8) = w; }
        __builtin_amdgcn_sched_barrier(0);
    }
}
__device__ __forceinline__ void hgfin_phase(const HfArgs& A) {
    int tid_l = threadIdx.x; asm volatile("" : "+v"(tid_l)); const int tid = tid_l, j = tid & 15;
    const f32x4 g0 = *(const f32x4*)(A.gain + j * 8), g1 = *(const f32x4*)(A.gain + j * 8 + 4);
    const int stride = gridDim.x * 32;
    int item = blockIdx.x * 32 + (tid >> 4);
    for (; item + 3 * stride < MT * 4; item += 4 * stride) {
        u32x4 oa[4], ob[4], gg[4];
#pragma unroll
        for (int k = 0; k < 4; ++k) { const size_t off = (size_t)(item + k * stride) * 128 + j * 8;
            oa[k] = *(const u32x4*)(A.o + off); ob[k] = *(const u32x4*)(A.o + (size_t)MT * 512 + off);
            gg[k] = *(const u32x4*)(A.g + off); }
        __builtin_amdgcn_sched_barrier(0);
#pragma unroll
        for (int k = 0; k < 4; ++k) { const int it = item + k * stride;
            const f32x4 s0 = {bflo(oa[k].x) + bflo(ob[k].x), bfhi(oa[k].x) + bfhi(ob[k].x), bflo(oa[k].y) + bflo(ob[k].y), bfhi(oa[k].y) + bfhi(ob[k].y)};
            const f32x4 s1 = {bflo(oa[k].z) + bflo(ob[k].z), bfhi(oa[k].z) + bfhi(ob[k].z), bflo(oa[k].w) + bflo(ob[k].w), bfhi(oa[k].w) + bfhi(ob[k].w)};
            float s = (s0[0] * s0[0] + s0[1] * s0[1]) + (s0[2] * s0[2] + s0[3] * s0[3]) + (s1[0] * s1[0] + s1[1] * s1[1]) + (s1[2] * s1[2] + s1[3] * s1[3]);
            s += xor_f<1>(s); s += xor_f<2>(s); s += xor_f<4>(s); s += xor_f<8>(s);
            const float rstd = __builtin_amdgcn_rsqf(s * (1.0f / 128.0f) + 1e-6f);
            u32x4 w;
            w.x = cvtpk(s0[0] * rstd * g0[0] * siluf(bflo(gg[k].x)), s0[1] * rstd * g0[1] * siluf(bfhi(gg[k].x)));
            w.y = cvtpk(s0[2] * rstd * g0[2] * siluf(bflo(gg[k].y)), s0[3] * rstd * g0[3] * siluf(bfhi(gg[k].y)));
            w.z = cvtpk(s1[0] * rstd * g1[0] * siluf(bflo(gg[k].z)), s1[1] * rstd * g1[1] * siluf(bfhi(gg[k].z)));
            w.w = cvtpk(s1[2] * rstd * g1[2] * siluf(bflo(gg[k].w)), s1[3] * rstd * g1[3] * siluf(bfhi(gg[k].w)));
            *(u32x4*)(A.y + (size_t)(it >> 2) * YLD + 512 + (it & 3) * 128 + j * 8) = w; }
        __builtin_amdgcn_sched_barrier(0);
    }
    for (; item < MT * 4; item += stride) {
        const size_t off = (size_t)item * 128 + j * 8;
        const u32x4 oa = *(const u32x4*)(A.o + off), ob = *(const u32x4*)(A.o + (size_t)MT * 512 + off);
        const f32x4 s0 = {bflo(oa.x) + bflo(ob.x), bfhi(oa.x) + bfhi(ob.x), bflo(oa.y) + bflo(ob.y), bfhi(oa.y) + bfhi(ob.y)};
        const f32x4 s1 = {bflo(oa.z) + bflo(ob.z), bfhi(oa.z) + bfhi(ob.z), bflo(oa.w) + bflo(ob.w), bfhi(oa.w) + bfhi(ob.w)};
        float s = (s0[0] * s0[0] + s0[1] * s0[1]) + (s0[2] * s0[2] + s0[3] * s0[3]) + (s1[0] * s1[0] + s1[1] * s1[1]) + (s1[2] * s1[2] + s1[3] * s1[3]);
        s += xor_f<1>(s); s += xor_f<2>(s); s += xor_f<4>(s); s += xor_f<8>(s);
        const float rstd = __builtin_amdgcn_rsqf(s * (1.0f / 128.0f) + 1e-6f);
        const u32x4 gg = *(const u32x4*)(A.g + off);
        u32x4 w;
        w.x = cvtpk(s0[0] * rstd * g0[0] * siluf(bflo(gg.x)), s0[1] * rstd * g0[1] * siluf(bfhi(gg.x)));
        w.y = cvtpk(s0[2] * rstd * g0[2] * siluf(bflo(gg.y)), s0[3] * rstd * g0[3] * siluf(bfhi(gg.y)));
        w.z = cvtpk(s1[0] * rstd * g1[0] * siluf(bflo(gg.z)), s1[1] * rstd * g1[1] * siluf(bfhi(gg.z)));
        w.w = cvtpk(s1[2] * rstd * g1[2] * siluf(bflo(gg.w)), s1[3] * rstd * g1[3] * siluf(bfhi(gg.w)));
        *(u32x4*)(A.y + (size_t)(item >> 2) * YLD + 512 + (item & 3) * 128 + j * 8) = w;
    }
}
namespace att {
constexpr int D = 128, NW = 8, QBLK = 32, KVBLK = 64;
constexpr float SCALE = 0.088388347648318440f;
constexpr float THR = 8.f;
constexpr int LDQ = 1024, LDK = 256, LDO = 2048;
constexpr size_t SHM_V = KVBLK * D * 2, SHM_K = KVBLK * D * 2, SHM_ATTN = 2 * SHM_V + 2 * SHM_K + NW * 64 * 4;
#define KSWZ(row, colB) ((row) * 256 + ((colB) ^ (((row) & 7) << 4)))
#define SBAR() __builtin_amdgcn_sched_barrier(0)
__device__ __forceinline__ int crow(int r, int hi) { return (r & 3) + 8 * (r >> 2) + 4 * hi; }
__device__ __forceinline__ unsigned cvtpkv(float lo, float hi) { return cvtpk(lo, hi); }

__device__ __forceinline__ void partialSM(f32x16& p0, f32x16& p1, float& m_reg, float& mn, float& alpha) {
  constexpr float C = SCALE * 1.4426950408889634f;
  float pmax = p0[0]; for (int r = 1; r < 16; ++r) pmax = fmaxf(pmax, p0[r]); for (int r = 0; r < 16; ++r) pmax = fmaxf(pmax, p1[r]);
  { auto rr = __builtin_amdgcn_permlane32_swap(__float_as_uint(pmax), __float_as_uint(pmax), false, false);
    pmax = fmaxf(__uint_as_float(rr[0]), __uint_as_float(rr[1])); }
  if (__builtin_expect(__all(pmax - m_reg <= THR / SCALE), 1)) { mn = m_reg; alpha = 1.f; }
  else { mn = fmaxf(m_reg, pmax); alpha = __builtin_amdgcn_exp2f((m_reg - mn) * C); m_reg = mn; }
  float mnC = -mn * C;
  for (int r = 0; r < 16; ++r) p0[r] = fmaf(p0[r], C, mnC); for (int r = 0; r < 16; ++r) p1[r] = fmaf(p1[r], C, mnC);
  for (int r = 0; r < 16; ++r) p0[r] = __builtin_amdgcn_exp2f(p0[r]);
}
__device__ __forceinline__ void finishSM(f32x16& p0, f32x16& p1, float alpha, float& l_reg, bf16x8& pa0, bf16x8& pa1, bf16x8& pa2, bf16x8& pa3) {
  for (int r = 0; r < 16; ++r) p1[r] = __builtin_amdgcn_exp2f(p1[r]);
  float ps = 0; for (int r = 0; r < 16; ++r) ps += p0[r]; for (int r = 0; r < 16; ++r) ps += p1[r];
  { auto rr = __builtin_amdgcn_permlane32_swap(__float_as_uint(ps), __float_as_uint(ps), false, false);
    ps = __uint_as_float(rr[0]) + __uint_as_float(rr[1]); }
  l_reg = l_reg * alpha + ps;
#define PK4(P, BASE, OUT) do { unsigned a0 = cvtpkv(P[BASE + 0], P[BASE + 1]), a1 = cvtpkv(P[BASE + 2], P[BASE + 3]);   \
    unsigned b0 = cvtpkv(P[BASE + 4], P[BASE + 5]), b1 = cvtpkv(P[BASE + 6], P[BASE + 7]);                              \
    auto r0 = __builtin_amdgcn_permlane32_swap(a0, b0, false, false); auto r1 = __builtin_amdgcn_permlane32_swap(a1, b1, false, false); \
    u32x4 w = {r0[0], r1[0], r0[1], r1[1]}; OUT = *reinterpret_cast<bf16x8*>(&w); } while (0)
  PK4(p0, 0, pa0); PK4(p0, 8, pa1); PK4(p1, 0, pa2); PK4(p1, 8, pa3);
#undef PK4
}
__device__ __forceinline__ void qkt(f32x16& p0, f32x16& p1, const bf16_t* Ks, const bf16x8* qr, int r32, int hi) {
  p0 = f32x16{}; p1 = f32x16{};
  for (int d0 = 0; d0 < 8; ++d0) { int cb = (d0 * 16 + hi * 8) * 2;
    bf16x8 b0 = *reinterpret_cast<const bf16x8*>((const char*)Ks + KSWZ(r32, cb));
    bf16x8 b1 = *reinterpret_cast<const bf16x8*>((const char*)Ks + KSWZ(32 + r32, cb));
    p0 = __builtin_amdgcn_mfma_f32_32x32x16_bf16(b0, qr[d0], p0, 0, 0, 0);
    p1 = __builtin_amdgcn_mfma_f32_32x32x16_bf16(b1, qr[d0], p1, 0, 0, 0); }
}
__device__ __forceinline__ int v_st(int k, int c) { const int kk = (k & ~0xC) | ((k & 4) << 1) | ((k & 8) >> 1); return ((kk >> 3) * 4 + (c >> 5)) * 512 + ((kk & 7) * 32 + (c & 31)) * 2; }
__device__ __forceinline__ int v_rd_base(int lane) { return ((lane & 3) << 3) | (((lane >> 2) & 3) << 6) | (((lane >> 4) & 1) << 5) | (((lane >> 5) & 1) << 8); }
constexpr int v_rd_off(int d0, int ks, int half) { return d0 * 512 + ks * 4096 + half * 2048; }
template <int OFF> __device__ __forceinline__ s16x4 tr_read(int vb) {
  s16x4 r; asm volatile("ds_read_b64_tr_b16 %0, %1 offset:%2" : "=&v"(r) : "v"(vb), "i"(OFF) : "memory"); return r;
}
template <int D0> __device__ __forceinline__ void pv_one(f32x16& od, int vb, bf16x8 pa0, bf16x8 pa1, bf16x8 pa2, bf16x8 pa3) {
  const s16x4 l0 = tr_read<v_rd_off(D0, 0, 0)>(vb), h0 = tr_read<v_rd_off(D0, 0, 1)>(vb), l1 = tr_read<v_rd_off(D0, 1, 0)>(vb), h1 = tr_read<v_rd_off(D0, 1, 1)>(vb);
  const s16x4 l2 = tr_read<v_rd_off(D0, 2, 0)>(vb), h2 = tr_read<v_rd_off(D0, 2, 1)>(vb), l3 = tr_read<v_rd_off(D0, 3, 0)>(vb), h3 = tr_read<v_rd_off(D0, 3, 1)>(vb);
  asm volatile("s_waitcnt lgkmcnt(0)" ::: "memory"); SBAR();
#define PK(L, H) (bf16x8){L[0], L[1], L[2], L[3], H[0], H[1], H[2], H[3]}
  od = __builtin_amdgcn_mfma_f32_32x32x16_bf16(pa0, PK(l0, h0), od, 0, 0, 0);
  od = __builtin_amdgcn_mfma_f32_32x32x16_bf16(pa1, PK(l1, h1), od, 0, 0, 0);
  od = __builtin_amdgcn_mfma_f32_32x32x16_bf16(pa2, PK(l2, h2), od, 0, 0, 0);
  od = __builtin_amdgcn_mfma_f32_32x32x16_bf16(pa3, PK(l3, h3), od, 0, 0, 0);
#undef PK
}
__device__ __forceinline__ void pv_d0(f32x16* o, int vb, bf16x8 pa0, bf16x8 pa1, bf16x8 pa2, bf16x8 pa3) {
  pv_one<0>(o[0], vb, pa0, pa1, pa2, pa3); pv_one<1>(o[1], vb, pa0, pa1, pa2, pa3); pv_one<2>(o[2], vb, pa0, pa1, pa2, pa3); pv_one<3>(o[3], vb, pa0, pa1, pa2, pa3);
}
__device__ __forceinline__ void attn_dense_body(const bf16_t* __restrict__ Qb, const bf16_t* __restrict__ Kh, const bf16_t* __restrict__ Vh, bf16_t* __restrict__ Ob, int seq, char* lds, const float* qgain, int t0) {
  int tid_l = threadIdx.x; asm volatile("" : "+v"(tid_l)); const int tid = tid_l, wid = tid >> 6, lane = tid & 63, r32 = lane & 31, hi = lane >> 5;
  bf16_t* V_lds = (bf16_t*)lds; bf16_t* K_lds = (bf16_t*)(lds + 2 * SHM_V);
  float* ws = (float*)(lds + 2 * SHM_V + 2 * SHM_K) + wid * 64; float* li_l = ws; float* al_l = ws + 32;
  float m_reg = -1e30f, l_reg = 0; f32x16 o[4] = {}; bf16x8 qr[8];
  const bf16_t* Qw = Qb + (long)(wid * QBLK + r32) * LDQ + hi * 8;
#pragma unroll
  for (int d0 = 0; d0 < 8; ++d0) qr[d0] = *reinterpret_cast<const bf16x8*>(Qw + d0 * 16);
  if (qgain) {
    float ss = 0.f;
#pragma unroll
    for (int d0 = 0; d0 < 8; ++d0) { const u32x4 w = *reinterpret_cast<const u32x4*>(&qr[d0]);
      const float a0 = bflo(w.x), a1 = bfhi(w.x), a2 = bflo(w.y), a3 = bfhi(w.y), a4 = bflo(w.z), a5 = bfhi(w.z), a6 = bflo(w.w), a7 = bfhi(w.w);
      ss += (a0 * a0 + a1 * a1) + (a2 * a2 + a3 * a3) + (a4 * a4 + a5 * a5) + (a6 * a6 + a7 * a7); }
    ss = xor32_sum(ss);
    const float rstd = __builtin_amdgcn_rsqf(ss * (1.0f / 128.0f) + 1e-6f);
    const int t = t0 + wid * QBLK + r32; const float prow = (float)(t >> 6), pcol = (float)(t & 63);
#pragma unroll
    for (int ax = 0; ax < 2; ++ax)
#pragma unroll
      for (int dd = 0; dd < 2; ++dd) {
        const int d1 = ax * 4 + dd;
        const u32x4 w1 = *reinterpret_cast<const u32x4*>(&qr[d1]), w2 = *reinterpret_cast<const u32x4*>(&qr[d1 + 2]);
        float x1[8] = {bflo(w1.x), bfhi(w1.x), bflo(w1.y), bfhi(w1.y), bflo(w1.z), bfhi(w1.z), bflo(w1.w), bfhi(w1.w)};
        float x2[8] = {bflo(w2.x), bfhi(w2.x), bflo(w2.y), bfhi(w2.y), bflo(w2.z), bfhi(w2.z), bflo(w2.w), bfhi(w2.w)};
        const float* g1 = qgain + d1 * 16 + hi * 8; const float* g2 = g1 + 32;
#pragma unroll
        for (int e = 0; e < 8; ++e) {
          const float fi = (float)(dd * 16 + hi * 8 + e);
          const float inv = __builtin_amdgcn_exp2f(-fi * (13.287712379549449f / 32.0f)), ang = (ax ? pcol : prow) * inv, cs = __cosf(ang), sn = __sinf(ang);
          const float y1 = x1[e] * rstd * g1[e], y2 = x2[e] * rstd * g2[e];
          x1[e] = y1 * cs - y2 * sn; x2[e] = y2 * cs + y1 * sn; }
        u32x4 o1, o2;
        o1.x = cvtpk(x1[0], x1[1]); o1.y = cvtpk(x1[2], x1[3]); o1.z = cvtpk(x1[4], x1[5]); o1.w = cvtpk(x1[6], x1[7]);
        o2.x = cvtpk(x2[0], x2[1]); o2.y = cvtpk(x2[2], x2[3]); o2.z = cvtpk(x2[4], x2[5]); o2.w = cvtpk(x2[6], x2[7]);
        qr[d1] = *reinterpret_cast<bf16x8*>(&o1); qr[d1 + 2] = *reinterpret_cast<bf16x8*>(&o2);
      }
  }
  const int sr = tid >> 4, sc = (tid & 15) * 8, vst0 = v_st(sr, sc), vst1 = v_st(32 + sr, sc);
  const int vb0 = (int)(uintptr_t)V_lds + v_rd_base(lane);
  struct { bf16x8 vs0, vs1, ks0, ks1; } sr_[2];
#define SLOAD(i, k0) do { sr_[i].vs0 = *reinterpret_cast<const bf16x8*>(&Vh[(long)((k0) + sr) * LDK + sc]); sr_[i].vs1 = *reinterpret_cast<const bf16x8*>(&Vh[(long)((k0) + 32 + sr) * LDK + sc]); \
    sr_[i].ks0 = *reinterpret_cast<const bf16x8*>(&Kh[(long)((k0) + sr) * LDK + sc]); sr_[i].ks1 = *reinterpret_cast<const bf16x8*>(&Kh[(long)((k0) + 32 + sr) * LDK + sc]); } while (0)
#define SWRITE(b, i) do { *(bf16x8*)((char*)V_lds + (b) * SHM_V + vst0) = sr_[i].vs0;          \
    *(bf16x8*)((char*)V_lds + (b) * SHM_V + vst1) = sr_[i].vs1; int kc = sc * 2;               \
    *(bf16x8*)((char*)K_lds + (b) * SHM_K + KSWZ(sr, kc)) = sr_[i].ks0;                       \
    *(bf16x8*)((char*)K_lds + (b) * SHM_K + KSWZ(32 + sr, kc)) = sr_[i].ks1; } while (0)
#define SWAIT() asm volatile("s_waitcnt vmcnt(4)" ::: "memory")
#define RESC(a) do { if (__any((a) < 1.f)) { if (hi == 0) al_l[r32] = (a); asm volatile("s_waitcnt lgkmcnt(0)" ::: "memory"); \
    for (int d = 0; d < 4; ++d) for (int r = 0; r < 16; ++r) o[d][r] *= al_l[crow(r, hi)]; } } while (0)
  f32x16 pA0, pA1, pB0, pB1; float mnA, mnB, alA, alB; bf16x8 pa0, pa1, pa2, pa3; const int NT = seq / KVBLK;
  constexpr int SE = 0, SO = 1;
  SLOAD(SE, 0); asm volatile("s_waitcnt vmcnt(0)" ::: "memory"); SWRITE(0, SE); __syncthreads();
  qkt(pA0, pA1, K_lds, qr, r32, hi); partialSM(pA0, pA1, m_reg, mnA, alA);
  SLOAD(SO, KVBLK); if (2 < NT) SLOAD(SE, 2 * KVBLK);
  SWAIT(); SWRITE(1, SO); __syncthreads();
  for (int j = 1; j + 1 < NT; j += 2) {
    SBAR(); qkt(pB0, pB1, (bf16_t*)((char*)K_lds + SHM_K), qr, r32, hi);
    finishSM(pA0, pA1, alA, l_reg, pa0, pa1, pa2, pa3); SBAR();
    SLOAD(SO, (j + 2) * KVBLK); SBAR();
    pv_d0(o, vb0, pa0, pa1, pa2, pa3); partialSM(pB0, pB1, m_reg, mnB, alB);
    __syncthreads(); SWAIT(); SWRITE(0, SE);
    RESC(alB); __syncthreads();
    SBAR(); qkt(pA0, pA1, K_lds, qr, r32, hi);
    finishSM(pB0, pB1, alB, l_reg, pa0, pa1, pa2, pa3); SBAR();
    if (j + 3 < NT) SLOAD(SE, (j + 3) * KVBLK); SBAR();
    pv_d0(o, vb0 + (int)SHM_V, pa0, pa1, pa2, pa3); partialSM(pA0, pA1, m_reg, mnA, alA);
    __syncthreads(); SWAIT(); SWRITE(1, SO);
    RESC(alA); __syncthreads();
  }
  SBAR(); qkt(pB0, pB1, (bf16_t*)((char*)K_lds + SHM_K), qr, r32, hi);
  finishSM(pA0, pA1, alA, l_reg, pa0, pa1, pa2, pa3); SBAR();
  pv_d0(o, vb0, pa0, pa1, pa2, pa3); partialSM(pB0, pB1, m_reg, mnB, alB);
  __syncthreads(); RESC(alB);
  finishSM(pB0, pB1, alB, l_reg, pa0, pa1, pa2, pa3); SBAR();
  pv_d0(o, vb0 + (int)SHM_V, pa0, pa1, pa2, pa3);
  if (hi == 0) li_l[r32] = l_reg; asm volatile("s_waitcnt lgkmcnt(0)" ::: "memory");
  float rli[16];
#pragma unroll
  for (int r = 0; r < 16; ++r) rli[r] = __builtin_amdgcn_rcpf(li_l[crow(r, hi)]);
#if MRG_FP8
  unsigned char* Ow = (unsigned char*)Ob + (long)(wid * QBLK) * (YLD * 2);
#pragma unroll
  for (int r = 0; r < 16; ++r) { int orow = crow(r, hi);
    for (int d0 = 0; d0 < 4; ++d0) Ow[(long)orow * (YLD * 2) + d0 * 32 + r32] = (unsigned char)(__builtin_amdgcn_cvt_pk_fp8_f32(o[d0][r] * (rli[r] * YATT_SC), 0.f, 0, false) & 0xff); }
#else
  bf16_t* Ow = Ob + (long)(wid * QBLK) * LDO;
#pragma unroll
  for (int r = 0; r < 16; ++r) { int orow = crow(r, hi);
    for (int d0 = 0; d0 < 4; ++d0) Ow[(long)orow * LDO + d0 * 32 + r32] = f2bf(o[d0][r] * rli[r]); }
#endif
  __syncthreads();
#undef SLOAD
#undef SWRITE
#undef SWAIT
#undef RESC
}
}
#define XB_TMO      128
#define XB_XCNT(j)  (256  + 64 * (j))
#define XB_XSUB(j)  (1280 + 64 * (j))
#define XB_XGEN(j)  (2304 + 64 * (j))
#define XB_TOP      3328
#define XB_TOPGEN   3392
#define XCD_BAR_WORDS 3456
#define XB_SPIN_CAP (1u << 22)

__device__ __forceinline__ unsigned xb_ld(unsigned* p)              { return __hip_atomic_load(p, __ATOMIC_RELAXED, __HIP_MEMORY_SCOPE_AGENT); }
__device__ __forceinline__ unsigned xb_add(unsigned* p, unsigned v) { return __hip_atomic_fetch_add(p, v, __ATOMIC_RELAXED, __HIP_MEMORY_SCOPE_AGENT); }
__device__ __forceinline__ unsigned xb_xcc_id() { return (unsigned)__builtin_amdgcn_s_getreg((3 << 11) | 20) & 0xFu; }
#define XB_SPIN(cond, bar) do { unsigned _sp = 0; while (cond) { __builtin_amdgcn_s_sleep(1); \
    if ((++_sp & 255u) == 0u) { if (xb_ld(&(bar)[XB_TMO])) break; if (_sp > XB_SPIN_CAP) { atomicAdd(&(bar)[XB_TMO], 1u); break; } } } } while (0)

struct XcdBarrier {
    unsigned* bar; unsigned x;
    volatile LAS unsigned* st;
};

__device__ __forceinline__ XcdBarrier xcd_barrier_post(unsigned* bar, volatile LAS unsigned* st) {
    XcdBarrier b; b.bar = bar; b.x = xb_xcc_id(); b.st = st;
    if (threadIdx.x == 0) st[2] = xb_add(&bar[XB_XCNT(b.x)], 1u);
    return b;
}
__device__ __forceinline__ void xcd_barrier_complete(unsigned* bar, unsigned x, unsigned& nloc, unsigned& nx, unsigned& lo8) {
    const unsigned G = gridDim.x * gridDim.y * gridDim.z;
    unsigned sum, cnt, mine, sp = 0u;
    for (;;) {
        sum = 0u; cnt = 0u; mine = 0u; lo8 = 0u;
#pragma unroll
        for (unsigned j = 0; j < 16; ++j) { const unsigned c = xb_ld(&bar[XB_XCNT(j)]); sum += c; cnt += (c > 0u) ? 1u : 0u; lo8 += (j < 8u && c > 0u) ? 1u : 0u; mine = (j == x) ? c : mine; }
        if (sum == G) break;
        __builtin_amdgcn_s_sleep(1);
        if ((++sp & 255u) == 0u) { if (xb_ld(&bar[XB_TMO])) break; if (sp > XB_SPIN_CAP) { atomicAdd(&bar[XB_TMO], 1u); break; } }
    }
    nloc = mine > 0u ? mine : 1u; nx = cnt > 0u ? cnt : 1u;
}

__device__ __forceinline__ void xcd_barrier(const XcdBarrier& b) {
    asm volatile("s_waitcnt vmcnt(0)" ::: "memory");
    __syncthreads();
    if (threadIdx.x == 0) {
        unsigned* bar = b.bar;
        __builtin_amdgcn_s_waitcnt(0);
        unsigned nloc = b.st[0], nx = b.st[1];
        if (nloc == 0u) { unsigned lo8; xcd_barrier_complete(bar, b.x, nloc, nx, lo8); b.st[0] = nloc; b.st[1] = nx; b.st[3] = (lo8 == 8u && nx == 8u) ? 1u : 0u; }
        const unsigned old = xb_add(&bar[XB_XSUB(b.x)], 1u);
        const unsigned gen = old / nloc;
        if (old + 1u == (gen + 1u) * nloc) {
            __builtin_amdgcn_fence(__ATOMIC_RELEASE, "agent");
            asm volatile("s_waitcnt vmcnt(0)" ::: "memory");
            const unsigned og = xb_add(&bar[XB_TOP], 1u);
            const unsigned tg = og / nx;
            if (og + 1u == (tg + 1u) * nx) xb_add(&bar[XB_TOPGEN], 1u);
            else XB_SPIN(xb_ld(&bar[XB_TOPGEN]) == tg, bar);
            __builtin_amdgcn_fence(__ATOMIC_ACQUIRE, "agent");
            xb_add(&bar[XB_XGEN(b.x)], 1u);
            asm volatile("s_waitcnt vmcnt(0)" ::: "memory");
        } else {
            XB_SPIN(xb_ld(&bar[XB_XGEN(b.x)]) == gen, bar);
            __builtin_amdgcn_fence(__ATOMIC_ACQUIRE, "agent");
            asm volatile("s_waitcnt vmcnt(0)" ::: "memory");
        }
    }
    __syncthreads();
}

__device__ __forceinline__ void xcd_barrier_local(const XcdBarrier& b) {
    asm volatile("s_waitcnt vmcnt(0)" ::: "memory");
    __syncthreads();
    if (threadIdx.x == 0) {
        unsigned* bar = b.bar;
        __builtin_amdgcn_s_waitcnt(0);
        const unsigned nloc = b.st[0];
        const unsigned old = xb_add(&bar[XB_XSUB(b.x)], 1u);
        const unsigned gen = old / nloc;
        if (old + 1u == (gen + 1u) * nloc) xb_add(&bar[XB_XGEN(b.x)], 1u);
        else XB_SPIN(xb_ld(&bar[XB_XGEN(b.x)]) == gen, bar);
        __builtin_amdgcn_fence(__ATOMIC_ACQUIRE, "agent");
        asm volatile("s_waitcnt vmcnt(0)" ::: "memory");
    }
    __syncthreads();
}
#ifdef SELFCHECK
#ifndef CHK_ROW0
#define CHK_ROW0 18432
#endif
constexpr size_t CK_STATS = 0, CK_CKS = 4096, CK_A = 65536, CK_T0 = CK_A + 84 * MiB, CK_T1 = CK_T0 + 16 * MiB, CK_T2 = CK_T1 + 16 * MiB, CK_T3 = CK_T2 + 16 * MiB, CK_T4 = CK_T3 + 16 * MiB;
constexpr size_t CHK_BYTES = CK_T4 + 16 * MiB;
constexpr int CK_NPH = 12;
struct CkStat { double d2, r2; unsigned mx, pad; };

__global__ void ck_sum(const unsigned* p, size_t nwords, unsigned long long* out) {
    unsigned long long s = 0;
    for (size_t i = (size_t)blockIdx.x * blockDim.x + threadIdx.x; i < nwords; i += (size_t)gridDim.x * blockDim.x) s += (unsigned long long)p[i] * (2ull * i + 1ull);
    for (int o = 32; o >= 1; o >>= 1) s += __shfl_xor(s, o);
    if ((threadIdx.x & 63) == 0) atomicAdd(out, s);
}
__global__ void ck_cmp(const void* fast, int is_bf16, long ldf, const float* ref, long ldr, int rows, int cols, int mode, CkStat* st) {
    double d2 = 0, r2 = 0; float mx = 0;
    for (size_t i = (size_t)blockIdx.x * blockDim.x + threadIdx.x; i < (size_t)rows * cols; i += (size_t)gridDim.x * blockDim.x) {
        const int r = (int)(i / cols), c = (int)(i % cols);
        const float f = is_bf16 ? bf2f(((const bf16_t*)fast)[(size_t)r * ldf + c]) : ((const float*)fast)[(size_t)r * ldf + c];
        float g = ref[(size_t)r * ldr + c]; if (mode == 1) g = 1.0f / (1.0f + expf(-g));
        float d = f - g; if (!(d == d)) d = 1e30f;
        d2 += (double)d * d; r2 += (double)g * g; mx = fmaxf(mx, fabsf(d));
    }
    for (int o = 32; o >= 1; o >>= 1) { d2 += __shfl_xor(d2, o); r2 += __shfl_xor(r2, o); mx = fmaxf(mx, __shfl_xor(mx, o)); }
    if ((threadIdx.x & 63) == 0) { atomicAdd(&st->d2, d2); atomicAdd(&st->r2, r2); atomicMax(&st->mx, __float_as_uint(mx)); }
}
__global__ void nk_rows(const float* xp, const float* xs, int row0, float* dst) {
    const size_t i = (size_t)blockIdx.x * 256 + threadIdx.x; const int r = row0 + (int)(i / DM), c = (int)(i % DM);
    dst[i] = (r < PROMPT_ROWS) ? xp[(size_t)r * DM + c] : xs[(size_t)(r - PROMPT_ROWS) * DM + c];
}
__global__ void nk_rmsnorm(const float* src, const float* gain, float* dst) {
    __shared__ float red[256]; const float* x = src + (size_t)blockIdx.x * DM; float s = 0;
    for (int c = threadIdx.x; c < DM; c += 256) s += x[c] * x[c];
    red[threadIdx.x] = s; __syncthreads();
    for (int o = 128; o >= 1; o >>= 1) { if (threadIdx.x < o) red[threadIdx.x] += red[threadIdx.x + o]; __syncthreads(); }
    const float rstd = 1.0f / sqrtf(red[0] / DM + 1e-6f);
    for (int c = threadIdx.x; c < DM; c += 256) dst[(size_t)blockIdx.x * DM + c] = x[c] * rstd * gain[c];
}
template <int MODE> __global__ void __launch_bounds__(256) nk_gemm(const float* A, int lda, const float* W, int ldw, int K, float* C, int ldc, int N2) {
    __shared__ float As[16][65], Bs[16][64], Bs2[16][64];
    const int t = threadIdx.x, tx = t & 15, ty = t >> 4, m0 = blockIdx.y * 64, n0 = blockIdx.x * 64;
    float acc[4][4] = {}, acc2[4][4] = {};
    for (int k0 = 0; k0 < K; k0 += 16) {
#pragma unroll
        for (int i = 0; i < 4; ++i) { const int idx = t + 256 * i; { const int m = idx >> 4, kk = idx & 15; As[kk][m] = A[(size_t)(m0 + m) * lda + k0 + kk]; }
            { const int kk = idx >> 6, n = idx & 63; Bs[kk][n] = W[(size_t)(k0 + kk) * ldw + n0 + n]; if (MODE == 1) Bs2[kk][n] = W[(size_t)(k0 + kk) * ldw + n0 + n + N2]; } }
        __syncthreads();
#pragma unroll
        for (int kk = 0; kk < 16; ++kk) {
            float a[4], b[4], b2[4];
#pragma unroll
            for (int i = 0; i < 4; ++i) { a[i] = As[kk][ty * 4 + i]; b[i] = Bs[kk][tx * 4 + i]; b2[i] = (MODE == 1) ? Bs2[kk][tx * 4 + i] : 0.f; }
#pragma unroll
            for (int i = 0; i < 4; ++i)
#pragma unroll
                for (int j = 0; j < 4; ++j) { acc[i][j] += a[i] * b[j]; if (MODE == 1) acc2[i][j] += a[i] * b2[j]; }
        }
        __syncthreads();
    }
#pragma unroll
    for (int i = 0; i < 4; ++i)
#pragma unroll
        for (int j = 0; j < 4; ++j) { float v = acc[i][j]; if (MODE == 1) v = v / (1.0f + expf(-v)) * acc2[i][j]; C[(size_t)(m0 + ty * 4 + i) * ldc + n0 + tx * 4 + j] = v; }
}
__global__ void nk_axpy(float* h, const float* d, float s, size_t n) { const size_t i = (size_t)blockIdx.x * 256 + threadIdx.x; if (i < n) h[i] += s * d[i]; }
__global__ void nk_s5(const float* ru, const float* lam_re, const float* lam_im, const float* log_dt, const float* b_re, const float* b_im, const float* c_re, const float* c_im, float* yd) {
    __shared__ float xr_s[64], xi_s[64], us[16], cr[16][64], ci[16][64];
    const int dg = blockIdx.x, dir = dg >> 5, g = dg & 31, n = threadIdx.x;
    const double dt = exp_d((double)log_dt[dg]); const double lr = lam_re[dg * 64 + n], li = lam_im[dg * 64 + n];
    const double mag = exp_d(lr * dt); double sn, cs; sincos_d(li * dt, sn, cs);
    const double are = mag * cs, aim = mag * sn, den = lr * lr + li * li, nre = are - 1.0, cre = (nre * lr + aim * li) / den, cim = (aim * lr - nre * li) / den;
    float bbr[16], bbi[16];
#pragma unroll
    for (int p = 0; p < 16; ++p) { const double br = b_re[(size_t)(dg * 64 + n) * 16 + p], bi = b_im[(size_t)(dg * 64 + n) * 16 + p]; bbr[p] = (float)(cre * br - cim * bi); bbi[p] = (float)(cre * bi + cim * br); }
    for (int i = n; i < 1024; i += 64) { cr[i >> 6][i & 63] = c_re[(size_t)dg * 1024 + i]; ci[i >> 6][i & 63] = c_im[(size_t)dg * 1024 + i]; }
    float xr = 0, xi = 0; const float ar = (float)are, ai = (float)aim;
    __syncthreads();
    for (int s = 0; s < SEQL; ++s) {
        const int t = dir ? SEQL - 1 - s : s;
        if (n < 16) us[n] = ru[(size_t)t * NIN + g * 16 + n];
        __syncthreads();
        float bur = 0, bui = 0;
#pragma unroll
        for (int p = 0; p < 16; ++p) { bur += bbr[p] * us[p]; bui += bbi[p] * us[p]; }
        const float nr = ar * xr - ai * xi + bur, ni = ar * xi + ai * xr + bui; xr = nr; xi = ni;
        xr_s[n] = xr; xi_s[n] = xi;
        __syncthreads();
        if (n < 16) { float y = 0; for (int m = 0; m < 64; ++m) y += xr_s[m] * cr[n][m] - xi_s[m] * ci[n][m]; yd[((size_t)dir * SEQL + t) * 512 + g * 16 + n] = y; }
        __syncthreads();
    }
}
__global__ void nk_s5z(const float* ru, const float* yd, const float* dsk, float* z) {
    const size_t i = (size_t)blockIdx.x * 256 + threadIdx.x; const int t = (int)(i >> 9), ch = (int)(i & 511);
    const float y = dsk[ch] * ru[(size_t)t * NIN + ch] + yd[i] + yd[(size_t)SEQL * 512 + i];
    z[i] = 0.5f * y * (1.0f + tanhf(0.7978845608028654f * (y + 0.044715f * y * y * y)));
}
__global__ void nk_glu(const float* z, const float* zw, float* ycat) { const size_t i = (size_t)blockIdx.x * 256 + threadIdx.x; const int t = (int)(i >> 9), ch = (int)(i & 511); ycat[(size_t)t * DM + ch] = z[i] / (1.0f + expf(-zw[i])); }
__device__ float nk_lb(const float* logits, int layer, int idx) {
    float lg[DEPTH], mx = -1e30f;
#pragma unroll
    for (int l = 0; l < DEPTH; ++l) { lg[l] = logits[l * 1024 + idx]; mx = fmaxf(mx, lg[l]); }
    float sum = 0;
#pragma unroll
    for (int l = 0; l < DEPTH; ++l) { lg[l] = expf(lg[l] - mx); sum += lg[l]; }
    float cum = 0;
#pragma unroll
    for (int l = 0; l < DEPTH; ++l) if (l <= layer) cum += lg[l] / sum;
    return fminf(fmaxf(cum - lg[0] / sum, 0.f), 1.0f - 1e-6f);
}
__global__ void __launch_bounds__(128) nk_hgrn(const float* ru, const float* logits, int layer, float* od, float* sd) {
    __shared__ float qs[128], ks[128], fs[128];
    const int h = blockIdx.x >> 1, dir = blockIdx.x & 1, v = threadIdx.x, col = h * 128 + v;
    const float lb = nk_lb(logits, layer, dir * 512 + col);
    float S[128];
#pragma unroll
    for (int d = 0; d < 128; ++d) S[d] = 0.f;
    for (int s = 0; s < SEQL; ++s) {
        const int t = dir ? SEQL - 1 - s : s; const float* r = ru + (size_t)t * NIN;
        const float z = r[(dir ? 1536 : 1024) + col], sg = 1.0f / (1.0f + expf(-z));
        fs[v] = fmaxf(lb, 1e-30f) + (1.0f - lb) * sg; ks[v] = (1.0f - lb) * (1.0f / (1.0f + expf(z)));
        { const float q = r[512 + col]; qs[v] = q / (1.0f + expf(-q)); }
        const float vt = r[2048 + col];
        __syncthreads();
        float o = 0;
#pragma unroll
        for (int d = 0; d < 128; ++d) { S[d] = fs[d] * S[d] + ks[d] * vt; o += qs[d] * S[d]; }
        od[((size_t)dir * SEQL + t) * 512 + col] = o;
        if (sd && (s == 63 || s == 127)) {
#pragma unroll
            for (int d = 0; d < 128; ++d) sd[(((size_t)(s >> 6) * 8 + blockIdx.x) * 128 + d) * 128 + v] = S[d];
        }
        __syncthreads();
    }
}
__global__ void nk_hgfin(const float* od, const float* ru, const float* gain, float* ycat) {
    __shared__ float red[128]; const int t = blockIdx.x >> 2, h = blockIdx.x & 3, v = threadIdx.x, col = h * 128 + v;
    const float s = od[(size_t)t * 512 + col] + od[((size_t)SEQL + t) * 512 + col];
    red[v] = s * s; __syncthreads();
    for (int o = 64; o >= 1; o >>= 1) { if (v < o) red[v] += red[v + o]; __syncthreads(); }
    const float rstd = 1.0f / sqrtf(red[0] / 128.0f + 1e-6f); const float g = ru[(size_t)t * NIN + 2560 + col];
    ycat[(size_t)t * DM + 512 + col] = s * rstd * gain[v] * (g / (1.0f + expf(-g)));
}
__global__ void nk_qkprep(const float* ru, const float* qn, const float* kn, float* qr, float* kr) {
    __shared__ float red[128], ys[128]; const int t = blockIdx.x / 10, hh = blockIdx.x % 10, d = threadIdx.x;
    const float x = (hh < 8) ? ru[(size_t)t * NIN + 3072 + hh * 128 + d] : ru[(size_t)t * NIN + 4096 + (hh - 8) * 128 + d];
    red[d] = x * x; __syncthreads();
    for (int o = 64; o >= 1; o >>= 1) { if (d < o) red[d] += red[d + o]; __syncthreads(); }
    const float y = x / sqrtf(red[0] / 128.0f + 1e-6f) * ((hh < 8) ? qn[d] : kn[d]);
    ys[d] = y; __syncthreads();
    const int axis = d >> 6, w = d & 63, i = w & 31; const float pos = (float)(axis == 0 ? (t >> 6) : (t & 63));
    const float inv = (float)exp_d(-(double)i / 32.0 * 9.210340371976184); double sn, cs; sincos_d((double)(pos * inv), sn, cs);
    const float o = (w < 32) ? y * (float)cs - ys[d + 32] * (float)sn : y * (float)cs + ys[d - 32] * (float)sn;
    if (hh < 8) qr[(size_t)t * 1024 + hh * 128 + d] = o; else kr[(size_t)t * 256 + (hh - 8) * 128 + d] = o;
}
__global__ void __launch_bounds__(256) nk_attn(const float* qr, const float* kr, const float* ru, float* ycat) {
    __shared__ float ps[4][2048], qs[4][128];
    const int w = threadIdx.x >> 6, lane = threadIdx.x & 63, item = blockIdx.x * 4 + w, h = item >> 11, t = item & 2047, kvh = h >> 2;
    qs[w][lane] = qr[(size_t)t * 1024 + h * 128 + lane]; qs[w][lane + 64] = qr[(size_t)t * 1024 + h * 128 + lane + 64];
    __syncthreads();
    float sc[32], mx = -1e30f;
#pragma unroll
    for (int kb = 0; kb < 32; ++kb) { const float* kp = kr + (size_t)(kb * 64 + lane) * 256 + kvh * 128; float s = 0; for (int d = 0; d < 128; ++d) s += qs[w][d] * kp[d]; sc[kb] = s * 0.08838834764831845f; mx = fmaxf(mx, sc[kb]); }
    for (int o = 32; o >= 1; o >>= 1) mx = fmaxf(mx, __shfl_xor(mx, o));
    float sum = 0;
#pragma unroll
    for (int kb = 0; kb < 32; ++kb) { const float p = expf(sc[kb] - mx); sum += p; ps[w][kb * 64 + lane] = p; }
    for (int o = 32; o >= 1; o >>= 1) sum += __shfl_xor(sum, o);
    __syncthreads();
    float o0 = 0, o1 = 0;
    for (int k = 0; k < SEQL; ++k) { const float p = ps[w][k]; const float* vp = ru + (size_t)k * NIN + 4352 + kvh * 128; o0 += p * vp[lane]; o1 += p * vp[lane + 64]; }
    ycat[(size_t)t * DM + 1024 + h * 128 + lane] = o0 / sum; ycat[(size_t)t * DM + 1024 + h * 128 + lane + 64] = o1 / sum;
}
__global__ void nk_gate(const float* ru, int b, const float* P, float* mg, int first) {
    const size_t i = (size_t)blockIdx.x * 256 + threadIdx.x; const int t = (int)(i >> 11), c = (int)(i & 2047);
    const float g = 1.0f / (1.0f + expf(-ru[(size_t)t * NIN + 4608 + b * 2048 + c]));
    mg[i] = (first ? 0.f : mg[i]) + g * P[i];
}
__global__ void ck_fill0(float* out, size_t n) { for (size_t i = (size_t)blockIdx.x * 256 + threadIdx.x; i < n; i += (size_t)gridDim.x * 256) out[i] = 0.f; }
#ifndef CHK_MODE
#define CHK_MODE 0
#endif
__device__ double ck_rel(const CkStat* st, int i) { return sqrt(st[i].d2 / (st[i].r2 + 1e-30)); }
__global__ void ck_encode(const CkStat* st, const unsigned long long* cks, int nchk, float* out) {
    if (threadIdx.x != 0 || blockIdx.x != 0) return;
    int v = 0;
    if (CHK_MODE == 0) {
        int dp = 48; for (int ph = CK_NPH - 1; ph >= 0; --ph) for (int r = 3; r >= 0; --r) if (cks[(0 * 16 + ph) * 4 + r] != cks[(1 * 16 + ph) * 4 + r]) dp = ph * 4 + r;
        int fi = nchk; for (int i = nchk - 1; i >= 0; --i) if (!(ck_rel(st, i) < 0.03)) fi = i;
        v = dp + 49 * fi;
    } else if (CHK_MODE == 1) {
        for (int r = 0; r < 4; ++r) if (cks[(0 * 16 + 5) * 4 + r] != cks[(1 * 16 + 5) * 4 + r]) v |= 1 << r;
        if (!(ck_rel(st, 19) < 0.03)) v |= 16; if (!(ck_rel(st, 20) < 0.03)) v |= 32; if (!(ck_rel(st, 21) < 0.03)) v |= 64; if (!(ck_rel(st, 11) < 0.03)) v |= 128;
        const double r19 = ck_rel(st, 19); v |= (r19 < 0.03 ? 0 : r19 < 0.3 ? 1 : r19 < 3 ? 2 : 3) << 8;
    } else if (CHK_MODE == 2) {
        if (!(ck_rel(st, 22) < 0.03)) v |= 1; if (!(ck_rel(st, 23) < 0.03)) v |= 2;
        if (cks[(0 * 16 + 5) * 4 + 1] != cks[(1 * 16 + 5) * 4 + 1]) v |= 4;
        if (!(ck_rel(st, 20) < 0.03)) v |= 8; if (!(ck_rel(st, 19) < 0.03)) v |= 16;
        const double r = ck_rel(st, 20); v |= (r < 0.03 ? 0 : r < 0.3 ? 1 : r < 3 ? 2 : 3) << 5;
    } else if (CHK_MODE == 6) {
        int fi = nchk; for (int i = nchk - 1; i >= 0; --i) if (!(ck_rel(st, i) < 0.03)) fi = i;
        v = fi;
    } else if (CHK_MODE == 5) {
        int dp = 48; for (int ph = CK_NPH - 1; ph >= 0; --ph) for (int r = 3; r >= 0; --r) if (cks[(0 * 16 + ph) * 4 + r] != cks[(1 * 16 + ph) * 4 + r]) dp = ph * 4 + r;
        v = dp;
    } else {
        const double rel = ck_rel(st, CHK_MODE - 100); double q = 20.0 * log10(rel + 1e-12) + 200.0; q = q < 0 ? 0 : (q > 1900 ? 1900 : q); v = (int)(q + 0.5);
    }
    out[0] = (float)(10 + v % 80) * __builtin_powif(10.0f, 5 + v / 80);
}

struct CkCtx { void* const* d_in; float* out; unsigned char* ws; hipStream_t s; };
static inline const float* ck_in(const CkCtx& c, int i) { return (const float*)c.d_in[i]; }
static void ck_cksum(const CkCtx& c, int run, int ph, int slot, const void* p, size_t bytes) {
    unsigned long long* o = (unsigned long long*)(c.ws + WS_CHK + CK_CKS) + (run * 16 + ph) * 4 + slot;
    hipLaunchKernelGGL(ck_sum, dim3(2048), dim3(256), 0, c.s, (const unsigned*)p, bytes / 4, o);
}
static void ck_compare(const CkCtx& c, int idx, const void* fast, int is_bf16, long ldf, const float* ref, long ldr, int rows, int cols, int mode) {
    hipLaunchKernelGGL(ck_cmp, dim3(1024), dim3(256), 0, c.s, fast, is_bf16, ldf, ref, ldr, rows, cols, mode, (CkStat*)(c.ws + WS_CHK + CK_STATS) + idx);
}
static void ck_gemm(const CkCtx& c, const float* A, int lda, const float* W, int ldw, int K, float* C, int ldc, int N) { hipLaunchKernelGGL(nk_gemm<0>, dim3(N / 64, 32), dim3(256), 0, c.s, A, lda, W, ldw, K, C, ldc, 0); }
constexpr int CK_NCHK = 20;
static void selfcheck_after_phase(const CkCtx& c, int run, int ph) {
    unsigned char* ws = c.ws; unsigned char* R = ws + WS_R; unsigned char* CK = ws + WS_CHK;
    float* bufA = (float*)(CK + CK_A); float* T0 = (float*)(CK + CK_T0); float* T1 = (float*)(CK + CK_T1); float* T2 = (float*)(CK + CK_T2); float* T3 = (float*)(CK + CK_T3); float* T4 = (float*)(CK + CK_T4);
    const int r0 = CHK_ROW0; const size_t OUTB = (size_t)MT * DM * 4, HBB = (size_t)MT * DM * 2;
    switch (ph) {
    case 0: ck_cksum(c, run, ph, 0, ws + WS_HB, HBB); ck_cksum(c, run, ph, 1, ws + WS_SSQ, (size_t)MT * 128); ck_cksum(c, run, ph, 2, ws + WS_ATAB, WS_LB + 16384 - WS_ATAB); break;
    case 1: ck_cksum(c, run, ph, 0, ws + WS_WB, WB_END); break;
    case 2: case 10: ck_cksum(c, run, ph, 0, R + R_HID, (size_t)MT * DFF * 2); break;
    case 3: case 9: case 11: ck_cksum(c, run, ph, 0, c.out, OUTB); ck_cksum(c, run, ph, 1, ws + WS_HB, HBB); ck_cksum(c, run, ph, 2, ws + WS_SSQ, (size_t)MT * 128); break;
    case 4: ck_cksum(c, run, ph, 0, R + R_US, 6 * SZ512); ck_cksum(c, run, ph, 1, R + R_AQ, 3 * SZ512); ck_cksum(c, run, ph, 2, R + R_GATE, 12 * SZ512); break;
    case 5: ck_cksum(c, run, ph, 3, R + R_AK, SZ512 / 2); break;
    case 6: ck_cksum(c, run, ph, 0, R + R_YD, 4 * SZ512); ck_cksum(c, run, ph, 1, R + R_OHG, 4 * SZ512); ck_cksum(c, run, ph, 2, R + R_US, SZ512); break;
    case 7: ck_cksum(c, run, ph, 0, R + R_YSS, 4 * SZ512); break;
    case 8: ck_cksum(c, run, ph, 0, R + R_MRG, 4 * SZ512); break;
    }
    if (run != 0) return;
    const bf16_t* hb = (const bf16_t*)(ws + WS_HB) + (size_t)r0 * DM;
    const int EW = 2048 * 2048 / 256;
    switch (ph) {
    case 0:
        hipLaunchKernelGGL(nk_rows, dim3(EW), dim3(256), 0, c.s, ck_in(c, 0), ck_in(c, 1), r0, T0);
        ck_compare(c, 0, hb, 1, DM, T0, DM, 2048, DM, 0);
        break;
    case 2:
        hipLaunchKernelGGL(nk_rmsnorm, dim3(2048), dim3(256), 0, c.s, T0, ck_in(c, 2), T1);
        hipLaunchKernelGGL(nk_gemm<1>, dim3(DFF / 64, 32), dim3(256), 0, c.s, T1, DM, ck_in(c, 3), 2 * DFF, DM, bufA, DFF, DFF);
        ck_compare(c, 1, (const bf16_t*)(R + R_HID) + (size_t)r0 * DFF, 1, DFF, bufA, DFF, 2048, DFF, 0);
        break;
    case 3:
        ck_gemm(c, bufA, DFF, ck_in(c, 4), DM, DFF, T1, DM, DM);
        hipLaunchKernelGGL(nk_axpy, dim3(EW), dim3(256), 0, c.s, T0, T1, 0.5f, (size_t)2048 * 2048);
        ck_compare(c, 2, c.out + (size_t)r0 * DM, 0, DM, T0, DM, 2048, DM, 0);
        ck_compare(c, 3, hb, 1, DM, T0, DM, 2048, DM, 0);
        break;
    case 4:
        hipLaunchKernelGGL(nk_rmsnorm, dim3(2048), dim3(256), 0, c.s, T0, ck_in(c, 5), T1);
        ck_gemm(c, T1, DM, ck_in(c, 6), NIN, DM, bufA, NIN, NIN);
        ck_compare(c, 4, (const bf16_t*)(R + R_US) + (size_t)r0 * 512, 1, 512, bufA, NIN, 2048, 512, 0);
        for (int k = 1; k < 5; ++k) ck_compare(c, 5, (const bf16_t*)(R + R_HGQ + k * SZ512) + (size_t)r0 * 512, 1, 512, bufA + 512 + 512 * k, NIN, 2048, 512, 0);
        ck_compare(c, 6, (const bf16_t*)(R + R_AQ) + (size_t)r0 * 1024, 1, 1024, bufA + 3072, NIN, 2048, 1024, 0);
        ck_compare(c, 6, (const bf16_t*)(R + R_AK) + (size_t)r0 * 256, 1, 256, bufA + 4096, NIN, 2048, 256, 0);
        ck_compare(c, 6, (const bf16_t*)(R + R_AV) + (size_t)r0 * 256, 1, 256, bufA + 4352, NIN, 2048, 256, 0);
        for (int g = 0; g < 3; ++g) ck_compare(c, 7, (const bf16_t*)(R + R_GATE + (size_t)g * 4 * SZ512) + (size_t)r0 * DM, 1, DM, bufA + 4608 + 2048 * g, NIN, 2048, DM, 1);
        break;
    case 5:
        hipLaunchKernelGGL(nk_s5, dim3(64), dim3(64), 0, c.s, bufA, ck_in(c, 7), ck_in(c, 8), ck_in(c, 9), ck_in(c, 10), ck_in(c, 11), ck_in(c, 12), ck_in(c, 13), T3);
        ck_compare(c, 8, (const float*)(R + R_YD) + (size_t)r0 * 512, 0, 512, T3, 512, 2048, 512, 0);
        ck_compare(c, 8, (const float*)(R + R_YD) + ((size_t)MT + r0) * 512, 0, 512, T3 + (size_t)SEQL * 512, 512, 2048, 512, 0);
        hipLaunchKernelGGL(nk_s5z, dim3(2048 * 512 / 256), dim3(256), 0, c.s, bufA, T3, ck_in(c, 14), T3 + 2 * 1048576);
        ck_compare(c, 9, (const bf16_t*)(R + R_US) + (size_t)r0 * 512, 1, 512, T3 + 2 * 1048576, 512, 2048, 512, 0);
        hipLaunchKernelGGL(nk_qkprep, dim3(2048 * 10), dim3(128), 0, c.s, bufA, ck_in(c, 18), ck_in(c, 19), T4, T4 + 2 * 1048576);
        ck_compare(c, 10, (const bf16_t*)(R + R_AQ) + (size_t)r0 * 1024, 1, 1024, T4, 1024, 2048, 1024, 0);
        ck_compare(c, 10, (const bf16_t*)(R + R_AK) + (size_t)r0 * 256, 1, 256, T4 + 2 * 1048576, 256, 2048, 256, 0);
        ck_gemm(c, T3 + 2 * 1048576, 512, ck_in(c, 15), 512, 512, T1, 512, 512);
        hipLaunchKernelGGL(nk_glu, dim3(2048 * 512 / 256), dim3(256), 0, c.s, T3 + 2 * 1048576, T1, T2);
        hipLaunchKernelGGL(nk_hgrn, dim3(8), dim3(128), 0, c.s, bufA, ck_in(c, 16), 0, T3, nullptr);
        ck_compare(c, 11, (const float*)(R + R_OHG) + (size_t)r0 * 512, 0, 512, T3, 512, 2048, 512, 0);
        ck_compare(c, 11, (const float*)(R + R_OHG) + ((size_t)MT + r0) * 512, 0, 512, T3 + (size_t)SEQL * 512, 512, 2048, 512, 0);
        ck_compare(c, 19, (const float*)(R + R_OHG) + (size_t)r0 * 512, 0, 512, T3, 512, 64, 512, 0);
        ck_compare(c, 20, (const float*)(R + R_OHG) + (size_t)(r0 + 64) * 512, 0, 512, T3 + (size_t)64 * 512, 512, 64, 512, 0);
        ck_compare(c, 21, (const float*)(R + R_OHG) + ((size_t)MT + r0 + 1984) * 512, 0, 512, T3 + (size_t)(SEQL + 1984) * 512, 512, 64, 512, 0);
        break;
    case 6:
        hipLaunchKernelGGL(nk_hgfin, dim3(2048 * 4), dim3(128), 0, c.s, T3, bufA, ck_in(c, 17), T2);
        ck_compare(c, 12, (const bf16_t*)(R + R_YHG) + (size_t)r0 * 512, 1, 512, T2 + 512, DM, 2048, 512, 0);
        hipLaunchKernelGGL(nk_attn, dim3(8 * 2048 / 4), dim3(256), 0, c.s, T4, T4 + 2 * 1048576, bufA, T2);
        ck_compare(c, 13, (const bf16_t*)(R + R_YAT) + (size_t)r0 * 1024, 1, 1024, T2 + 1024, DM, 2048, 1024, 0);
        break;
    case 7: ck_compare(c, 14, (const bf16_t*)(R + R_YSS) + (size_t)r0 * 512, 1, 512, T2, DM, 2048, 512, 0); break;
    case 8:
        ck_gemm(c, T2, DM, ck_in(c, 20), DM, 512, T3, DM, DM);
        hipLaunchKernelGGL(nk_gate, dim3(EW), dim3(256), 0, c.s, bufA, 0, T3, T1, 1);
        ck_gemm(c, T2 + 512, DM, ck_in(c, 20) + (size_t)512 * DM, DM, 512, T3, DM, DM);
        hipLaunchKernelGGL(nk_gate, dim3(EW), dim3(256), 0, c.s, bufA, 1, T3, T1, 0);
        ck_gemm(c, T2 + 1024, DM, ck_in(c, 20) + (size_t)1024 * DM, DM, 1024, T3, DM, DM);
        hipLaunchKernelGGL(nk_gate, dim3(EW), dim3(256), 0, c.s, bufA, 2, T3, T1, 0);
        ck_compare(c, 15, (const bf16_t*)(R + R_MRG) + (size_t)r0 * DM, 1, DM, T1, DM, 2048, DM, 0);
        break;
    case 9:
        ck_gemm(c, T1, DM, ck_in(c, 21), DM, DM, T3, DM, DM);
        hipLaunchKernelGGL(nk_axpy, dim3(EW), dim3(256), 0, c.s, T0, T3, 1.0f, (size_t)2048 * 2048);
        ck_compare(c, 16, c.out + (size_t)r0 * DM, 0, DM, T0, DM, 2048, DM, 0);
        break;
    case 10:
        hipLaunchKernelGGL(nk_rmsnorm, dim3(2048), dim3(256), 0, c.s, T0, ck_in(c, 22), T1);
        hipLaunchKernelGGL(nk_gemm<1>, dim3(DFF / 64, 32), dim3(256), 0, c.s, T1, DM, ck_in(c, 23), 2 * DFF, DM, bufA, DFF, DFF);
        ck_compare(c, 17, (const bf16_t*)(R + R_HID) + (size_t)r0 * DFF, 1, DFF, bufA, DFF, 2048, DFF, 0);
        break;
    case 11:
        ck_gemm(c, bufA, DFF, ck_in(c, 24), DM, DFF, T1, DM, DM);
        hipLaunchKernelGGL(nk_axpy, dim3(EW), dim3(256), 0, c.s, T0, T1, 0.5f, (size_t)2048 * 2048);
        ck_compare(c, 18, c.out + (size_t)r0 * DM, 0, DM, T0, DM, 2048, DM, 0);
        break;
    }
}
static void selfcheck_finish(const CkCtx& c) {
    hipLaunchKernelGGL(ck_fill0, dim3(4096), dim3(256), 0, c.s, c.out, (size_t)MT * DM);
    hipLaunchKernelGGL(ck_encode, dim3(1), dim3(64), 0, c.s, (const CkStat*)(c.ws + WS_CHK + CK_STATS), (const unsigned long long*)(c.ws + WS_CHK + CK_CKS), 19, c.out);
}
#endif
constexpr int PH_PER_LAYER = 11, N_PHASES = 1 + PH_PER_LAYER * DEPTH;
struct Params { const float* in[25]; float* out; unsigned char* ws; int ph_lo, ph_hi; };
static_assert(sizeof(Params) == 27 * 8 + 8, "Params has no padding");

#ifdef SELFCHECK
#define HG_DBG_PTR ((l == 0) ? (float*)(ws + WS_CHK + CK_T4 + 10 * MiB) : nullptr)
#else
#define HG_DBG_PTR nullptr
#endif
#ifndef DUP_GU
#define DUP_GU 1
#endif
#ifndef DUP_NULL
#define DUP_NULL 0
#endif
#ifndef DUP_CVT
#define DUP_CVT 1
#endif
#ifndef NULLX
#define NULLX 0
#endif
#ifndef DUP_MRG
#define DUP_MRG 1
#endif
#ifndef DUP_BAR
#define DUP_BAR 1
#endif
#ifndef DUP_ATT
#define DUP_ATT 1
#endif
#ifndef DUP_HG
#define DUP_HG 1
#endif
#ifndef WGM_N2048
#define WGM_N2048 4
#endif
#ifndef WGM_WIDE
#define WGM_WIDE 4
#endif
#ifndef CVT_AHEAD
#define CVT_AHEAD 0
#endif
#ifndef DUP_D0
#define DUP_D0 1
#endif
#ifndef STAGGER_US
#define STAGGER_US 0
#endif
#ifndef KPREP_TAIL
#define KPREP_TAIL 0
#endif
#ifndef XCC_LOCAL
#define XCC_LOCAL 0
#endif
#ifndef HGFIN_IN_QUEUE
#define HGFIN_IN_QUEUE 0
#endif
#ifndef XATT
#define XATT 0
#endif
#ifndef QMIX
#define QMIX 0
#endif
#ifndef GATE_FP8
#define GATE_FP8 1
#endif
#ifndef N8_COLS
#define N8_COLS (3 * DM + 1536)
#endif
constexpr int N8 = N8_COLS;
#ifndef WGM_F8
#define WGM_F8 4
#endif
#ifndef DUP_WIN
#define DUP_WIN 1
#endif
#ifndef PG8_ALIGN_EPI
#define PG8_ALIGN_EPI true
#endif
#ifndef PG8_SP2
#define PG8_SP2 true
#endif
template <class Epi, int F8FROM = -1>
__device__ __forceinline__ void run_gemm(LAS unsigned char* lds, const bf16_t* A, const bf16_t* Bt, int N, int K, const Epi& E) {
    int zz = 0; asm volatile("" : "+s"(zz));
    pg8::Gemm g{A, Bt, MT, N, K}; pg8::StaticOrder S; S.init(MT, N, (int)gridDim.x + zz, (int)blockIdx.x + zz, (F8FROM == 0) ? WGM_F8 : (N == DM) ? WGM_N2048 : ((N > DM) ? WGM_WIDE : 4));
    {
        volatile LAS unsigned* st = (volatile LAS unsigned*)(lds + LDS_MISC);
        const int xok = __builtin_amdgcn_readfirstlane((int)st[3]), nloc = __builtin_amdgcn_readfirstlane((int)st[0]), rank = __builtin_amdgcn_readfirstlane((int)st[2]);
        if (XCC_LOCAL && xok) S.init_x((int)xb_xcc_id() + zz, rank, nloc);
    }
    if (threadIdx.x == 0) ((volatile LAS int*)(lds + LDS_MISC + 1024))[256] = -1;
    if (STAGGER_US > 0) {
        const int nwg = (MT / 256) * (N / 256), rem = nwg % (int)gridDim.x;
        if (rem && (int)blockIdx.x >= rem) {
            constexpr int NG = 3; const int grp = ((int)blockIdx.x - rem) % NG + 1;
            const unsigned long long t0 = wall_clock64(), dt = (unsigned long long)(STAGGER_US * 100 * grp / (NG + 1));
            while (wall_clock64() - t0 < dt) __builtin_amdgcn_s_sleep(16);
        }
    }
    __syncthreads();
    pg8::gemm_phase<Epi, pg8::StaticOrder, PG8_ALIGN_EPI, PG8_SP2, F8FROM>(lds, g, S, E);
}

__global__ void __launch_bounds__(NTHREADS, 2) k_fwd(Params p) {
    extern __shared__ __attribute__((aligned(16))) unsigned char lds_raw[];
    LAS unsigned char* lds = (LAS unsigned char*)lds_raw;
    const int tid = threadIdx.x, G = gridDim.x;
    unsigned char* const ws0 = p.ws; float* const out0 = p.out; unsigned char* ws = ws0;
#define PH_LOCALS size_t z_ = 0; asm volatile("" : "+s"(z_)); unsigned char* ws = ws0 + z_; float* outp = (float*)((unsigned char*)out0 + z_); unsigned char* R = ws + WS_R; unsigned char* WB = ws + WS_WB; float* ssq = (float*)(ws + WS_SSQ); bf16_t* hb = (bf16_t*)(ws + WS_HB); \
    const CAS unsigned long long* PT = (const CAS unsigned long long*)(ws + WS_PTAB); (void)R; (void)WB; (void)ssq; (void)hb; (void)PT; (void)outp;
    if (tid < 4) ((LAS unsigned*)(lds + LDS_MISC))[tid] = 0u;
    __syncthreads();
    const int lo = p.ph_lo, hi = p.ph_hi;
    if (hi - lo > 1) (void)xcd_barrier_post((unsigned*)(ws + WS_BAR), (volatile LAS unsigned*)(lds + LDS_MISC));
#ifndef PH_MASK
#define PH_MASK 0xfff
#endif
#define IN(k) (lo <= (k) && (k) < hi)
#ifdef PROBE_T
#define STAMP(k) do { if (blockIdx.x == 0 && tid == 0) ((unsigned long long*)(ws + WS_BAR + 14336))[k] = wall_clock64(); } while (0)
#else
#define STAMP(k) do { } while (0)
#endif
#ifdef PROBE_SKEW
#define SKEW_PRE(k) do { if (tid == 0) ((unsigned*)(ws0 + WS_CHK))[(size_t)(k) * 256 + blockIdx.x] = (unsigned)wall_clock64(); } while (0)
#define SKEW_POST(k) do { } while (0)
#else
#define SKEW_PRE(k) do { } while (0)
#define SKEW_POST(k) do { } while (0)
#endif
#ifdef PROBE_IDLE
#define IDLE_() do { const unsigned long long t0_ = wall_clock64(); while (wall_clock64() - t0_ < (unsigned long long)(PROBE_IDLE * 100)) __builtin_amdgcn_s_sleep(8); } while (0)
#else
#define IDLE_() do { } while (0)
#endif
#define SEAM(k) do { if (IN(k) && IN((k) + 1)) { IDLE_(); SKEW_PRE(k); XcdBarrier b_; b_.bar = (unsigned*)(ws0 + WS_BAR); b_.x = xb_xcc_id(); b_.st = (volatile LAS unsigned*)(lds + LDS_MISC); for (int rb_ = 0; rb_ < DUP_BAR; ++rb_) xcd_barrier(b_); SKEW_POST(k); } STAMP((k) + 1); } while (0)

#define SEAM_L(k) do { if (IN(k) && IN((k) + 1)) { SKEW_PRE(k); XcdBarrier b_; b_.bar = (unsigned*)(ws0 + WS_BAR); b_.x = xb_xcc_id(); b_.st = (volatile LAS unsigned*)(lds + LDS_MISC); \
        const int xl_ = __builtin_amdgcn_readfirstlane((int)b_.st[3]); if (XCC_LOCAL && xl_) xcd_barrier_local(b_); else xcd_barrier(b_); SKEW_POST(k); } STAMP((k) + 1); } while (0)
    STAMP(0);
    if ((PH_MASK & 1) && IN(0)) {
        if (blockIdx.x == 0 && tid < 25) ((unsigned long long*)(ws + WS_PTAB))[tid] = (unsigned long long)p.in[tid];
        ProArgs A{p.in[0], p.in[1], p.in[7], p.in[8], p.in[9], p.in[10], p.in[11], p.in[12], p.in[13], p.in[16], ws};
        prologue_phase(A);
    }
    SEAM(0);
#ifdef PROBE_XOK
    if (((volatile LAS unsigned*)(lds + LDS_MISC))[3] == 0u) { const unsigned long long t0 = wall_clock64(); while (wall_clock64() - t0 < 200000ull) __builtin_amdgcn_s_sleep(16); }
#endif
    for (int l = 0; l < DEPTH; ++l) {
        const int pb = 1 + PH_PER_LAYER * l;
#define INP(i) ((const float*)(const GAS float*)PT[i])
        if (((PH_MASK >> 1) & 1) && IN(pb + 0)) { PH_LOCALS
          for (int rep = 0; rep < DUP_CVT; ++rep) {
            int base = 0;
            if (l == 0 || !CVT_AHEAD) {
            { CvtJob J{INP(3) + (size_t)l * DM * 2 * DFF, INP(2) + l * DM, (bf16_t*)(WB + WB_GU1), 2 * DFF, DM, 2 * DFF, 1}; cvt_job(lds, J, base); }
            { CvtJob J{INP(4) + (size_t)l * DFF * DM, nullptr, (bf16_t*)(WB + WB_D1), DM, DFF, DM, 0}; cvt_job(lds, J, base); }
#if GATE_FP8
            { CvtJob J{INP(6) + (size_t)l * DM * NIN, INP(5) + l * DM, (bf16_t*)(WB + WB_IN), NIN, DM, NIN - N8, 0}; cvt_job(lds, J, base); }
            { CvtJob J{INP(6) + (size_t)l * DM * NIN + (NIN - N8), INP(5) + l * DM, (bf16_t*)(R + R_W8), NIN, DM, N8, 0}; cvt_job8(lds, J, 32.0f, base, DM); }
#else
            { CvtJob J{INP(6) + (size_t)l * DM * NIN, INP(5) + l * DM, (bf16_t*)(WB + WB_IN), NIN, DM, NIN, 0}; cvt_job(lds, J, base); }
#endif
            }
            { CvtJob J{INP(15) + (size_t)l * 512 * 512, nullptr, (bf16_t*)(WB + WB_GLU), 512, 512, 512, 0}; cvt_job(lds, J, base); }
#if MRG_FP8
            { CvtJob J{INP(20) + (size_t)l * DM * DM, nullptr, (bf16_t*)(WB + WB_BS), DM, 1024, DM, 0, YLD}; cvt_job(lds, J, base); }
            { CvtJob J{INP(20) + (size_t)l * DM * DM + (size_t)1024 * DM, nullptr, (bf16_t*)(WB + WB_BS + 2048), DM, 1024, DM, 0, 0}; cvt_job8(lds, J, WBR_SC, base, 3072); }
#else
            { CvtJob J{INP(20) + (size_t)l * DM * DM, nullptr, (bf16_t*)(WB + WB_BS), DM, DM, DM, 0}; cvt_job(lds, J, base); }
#endif
            { CvtJob J{INP(21) + (size_t)l * DM * DM, nullptr, (bf16_t*)(WB + WB_OUT), DM, DM, DM, 0}; cvt_job(lds, J, base); }
            { CvtJob J{INP(23) + (size_t)l * DM * 2 * DFF, INP(22) + l * DM, (bf16_t*)(WB + WB_GU2), 2 * DFF, DM, 2 * DFF, 1}; cvt_job(lds, J, base); }
            { CvtJob J{INP(24) + (size_t)l * DFF * DM, nullptr, (bf16_t*)(WB + WB_D2), DM, DFF, DM, 0}; cvt_job(lds, J, base); }
          }
        }
        SEAM(pb + 0);
        if (((PH_MASK >> 2) & 1) && IN(pb + 1)) { PH_LOCALS epi::Swiglu E{(bf16_t*)(R + R_HID), ssq, (LAS float*)(lds + LDS_MISC + 1024)}; if (DUP_NULL) { epi::NullEpi E0{ssq}; run_gemm(lds, hb, (const bf16_t*)(WB + WB_GU1), 2 * DFF, DM, E0); } for (int rep = 0; rep < DUP_GU; ++rep) run_gemm(lds, hb, (const bf16_t*)(WB + WB_GU1), 2 * DFF, DM, E); }
        SEAM_L(pb + 1);
        if (((PH_MASK >> 3) & 1) && IN(pb + 2)) { PH_LOCALS
            if (NULLX == 2) { epi::NullEpi E0{ssq}; run_gemm(lds, (const bf16_t*)(R + R_HID), (const bf16_t*)(WB + WB_D1), DM, DFF, E0); }
            if (l == 0) { epi::Resid<true, false, GATE_FP8 != 0> E{INP(0), INP(1), PROMPT_ROWS, 0.5f, nullptr, hb, ssq, R + R_HB8}; run_gemm(lds, (const bf16_t*)(R + R_HID), (const bf16_t*)(WB + WB_D1), DM, DFF, E); }
            else        { epi::Resid<false, false, GATE_FP8 != 0> E{nullptr, nullptr, 0, 0.5f, nullptr, hb, ssq, R + R_HB8}; run_gemm(lds, (const bf16_t*)(R + R_HID), (const bf16_t*)(WB + WB_D1), DM, DFF, E); }
        }
        SEAM_L(pb + 2);
        if (((PH_MASK >> 4) & 1) && IN(pb + 3)) { PH_LOCALS unsigned* kdone = (unsigned*)(ws + WS_BAR + 16128) + l * 16;
#if GATE_FP8
            { epi::WinSplit E8{R, ssq, (LAS float*)(lds + LDS_MISC + 1024), kdone, (NIN - N8) / 256, 1.0f / 32.0f}; run_gemm<epi::WinSplit, 0>(lds, (const bf16_t*)(R + R_HB8), (const bf16_t*)(R + R_W8), N8, DM / 2, E8); }
            { epi::WinSplit E{R, ssq, (LAS float*)(lds + LDS_MISC + 1024), kdone, 0, 1.0f}; run_gemm(lds, hb, (const bf16_t*)(WB + WB_IN), NIN - N8, DM, E); }
#else
            epi::WinSplit E{R, ssq, (LAS float*)(lds + LDS_MISC + 1024), kdone, 0, 1.0f}; if (NULLX == 3) { epi::NullEpi E0{ssq}; run_gemm(lds, hb, (const bf16_t*)(WB + WB_IN), NIN, DM, E0); } for (int rep = 0; rep < DUP_WIN; ++rep) run_gemm(lds, hb, (const bf16_t*)(WB + WB_IN), NIN, DM, E);
#endif

            if (CVT_AHEAD && l + 1 < DEPTH) {
                const int rem = ((MT / 256) * (NIN / 256)) % G, wg0 = rem, nw = rem ? G - rem : 0; int base = 0;
                { CvtJob J{INP(3) + (size_t)(l + 1) * DM * 2 * DFF, INP(2) + (l + 1) * DM, (bf16_t*)(WB + WB_GU1), 2 * DFF, DM, 2 * DFF, 1}; cvt_job(lds, J, base, wg0, nw); }
                { CvtJob J{INP(4) + (size_t)(l + 1) * DFF * DM, nullptr, (bf16_t*)(WB + WB_D1), DM, DFF, DM, 0}; cvt_job(lds, J, base, wg0, nw); }
            }
#if KPREP_TAIL
            {
                const int rem = ((MT / 256) * (NIN / 256)) % G, fb = rem, nb = G - rem;
                if ((int)blockIdx.x >= fb) {
                    if (tid == 0) {
                        const unsigned long long t0 = wall_clock64();
                        while (__hip_atomic_load(kdone, __ATOMIC_RELAXED, __HIP_MEMORY_SCOPE_AGENT) < (unsigned)(MT / 256) * 8u) { if (wall_clock64() - t0 > 2000000ull) break; __builtin_amdgcn_s_sleep(2); }
                        __builtin_amdgcn_fence(__ATOMIC_ACQUIRE, "agent");
                        asm volatile("s_waitcnt vmcnt(0)" ::: "memory");
                    }
                    __syncthreads();
                    QkArgs Q{(bf16_t*)(R + R_AQ), (bf16_t*)(R + R_AK), INP(18) + l * 128, INP(19) + l * 128, 0};
                    qkprep_phase(Q, fb, nb);
                }
            }
#endif
        }
        SEAM(pb + 3);
#if !KPREP_TAIL
        if (((PH_MASK >> 5) & 1) && IN(pb + 4)) { PH_LOCALS
            QkArgs Q{(bf16_t*)(R + R_AQ), (bf16_t*)(R + R_AK), INP(18) + l * 128, INP(19) + l * 128, 0};
            qkprep_phase(Q, 0, G);
        }
        SEAM(pb + 4);
#endif
        if (((PH_MASK >> 6) & 1) && IN(pb + 5)) { PH_LOCALS
            HgArgs H{(const bf16_t*)(R + R_HGQ), (const bf16_t*)(R + R_HGQ + SZ512), (const bf16_t*)(R + R_HGQ + 2 * SZ512), (const bf16_t*)(R + R_HGQ + 3 * SZ512), (bf16_t*)(R + R_OHG), (const float*)(ws + WS_LB) + l * 1024, (unsigned*)(ws + WS_BAR + 16128) + l * 16};
            S5Args S{(bf16_t*)(R + R_US), (float*)(R + R_YD), (const f32x2*)(ws + WS_ATAB) + (size_t)l * 2 * 32 * 64, (const bf16_t*)(ws + WS_BM) + (size_t)l * 64 * 128 * 16, (const bf16_t*)(ws + WS_CM) + (size_t)l * 64 * 16 * 128, INP(14) + l * 512};
            unsigned* qctr = (unsigned*)(ws + WS_BAR + 15360) + l * 16;
            volatile LAS unsigned* qslot = (volatile LAS unsigned*)(lds + LDS_MISC + 16);
#define QGRAB(u) do { if (tid == 0) *qslot = __hip_atomic_fetch_add(qctr, 1u, __ATOMIC_RELAXED, __HIP_MEMORY_SCOPE_AGENT); __syncthreads(); (u) = (int)*qslot; __syncthreads(); } while (0)
#if XATT
#define QGRAB_C(u) do { if (tid == 0) *qslot = __hip_atomic_fetch_add(qctr, 1u, __ATOMIC_RELAXED, __HIP_MEMORY_SCOPE_AGENT); __syncthreads(); (u) = (int)*qslot; __syncthreads(); } while (0)
#undef QGRAB
#define QGRAB(u) do { if (tid == 0) { unsigned got_ = 1600u; const unsigned x0_ = xb_xcc_id() & 7u; for (unsigned k_ = 0; k_ < 8u; ++k_) { const unsigned xx_ = (x0_ + k_) & 7u; \
                const unsigned v_ = __hip_atomic_fetch_add(qctr + 1 + xx_, 1u, __ATOMIC_RELAXED, __HIP_MEMORY_SCOPE_AGENT); if (v_ < 160u) { got_ = 320u + (xx_ + 8u * (v_ >> 5)) * 32u + (v_ & 31u); break; } } *qslot = got_; } \
            __syncthreads(); (u) = (int)*qslot; __syncthreads(); } while (0)
            int u; QGRAB_C(u);
            while (u < 160) { hgrn_unit(lds, H, u); QGRAB_C(u); }
            while (u < 320) { s5_unit(lds, S, u - 160); QGRAB_C(u); }
            QGRAB(u);
#undef QGRAB_C
#elif QMIX
#define QGRAB_C(u) do { if (tid == 0) *qslot = __hip_atomic_fetch_add(qctr, 1u, __ATOMIC_RELAXED, __HIP_MEMORY_SCOPE_AGENT); __syncthreads(); (u) = (int)*qslot; __syncthreads(); } while (0)
#undef QGRAB
#define QGRAB(u) do { if (tid == 0) *qslot = 320u + __hip_atomic_fetch_add(qctr + 8, 1u, __ATOMIC_RELAXED, __HIP_MEMORY_SCOPE_AGENT); __syncthreads(); (u) = (int)*qslot; __syncthreads(); } while (0)
            int u = 320;
            if ((int)blockIdx.x < QMIX) QGRAB_C(u);
            while (u < 160) { hgrn_unit(lds, H, u); QGRAB_C(u); }
            while (u < 320) { s5_unit(lds, S, u - 160); QGRAB_C(u); }
            QGRAB(u);
#undef QGRAB_C
#else
            int u; QGRAB(u);
            while (u < 160) { hgrn_unit(lds, H, u); if (DUP_HG > 1) hgrn_unit(lds, H, u); QGRAB(u); }
            while (u < 320) { s5_unit(lds, S, u - 160); QGRAB(u); }
#endif
            while (u < 320 + NSEQ * 64) {
                const int a = u - 320, qb = a & 7, h = (a >> 3) & 7, b = a >> 6;
                const size_t tok0 = (size_t)b * SEQL;
                att::attn_dense_body((const bf16_t*)(R + R_AQ) + (tok0 + qb * 256) * 1024 + h * 128, (const bf16_t*)(R + R_AK) + tok0 * 256 + (h >> 2) * 128,
                                     (const bf16_t*)(R + R_AV) + tok0 * 256 + (h >> 2) * 128, (bf16_t*)(R + R_YSS) + (tok0 + qb * 256) * YLD + 1024 + (MRG_FP8 ? h * 64 : h * 128), SEQL, (char*)lds_raw,
                                     INP(18) + l * 128, qb * 256);
                if (DUP_ATT > 1) att::attn_dense_body((const bf16_t*)(R + R_AQ) + (tok0 + qb * 256) * 1024 + h * 128, (const bf16_t*)(R + R_AK) + tok0 * 256 + (h >> 2) * 128,
                                     (const bf16_t*)(R + R_AV) + tok0 * 256 + (h >> 2) * 128, (bf16_t*)(R + R_YSS) + (tok0 + qb * 256) * YLD + 1024 + (MRG_FP8 ? h * 64 : h * 128), SEQL, (char*)lds_raw,
                                     INP(18) + l * 128, qb * 256);
                QGRAB(u);
            }
#if HGFIN_IN_QUEUE
            if (u < 1600 + MT / 64) {
                if (tid == 0) {
                    const unsigned long long t0 = wall_clock64();
                    while (__hip_atomic_load(H.done, __ATOMIC_RELAXED, __HIP_MEMORY_SCOPE_AGENT) < 160u * 8u) { if (wall_clock64() - t0 > 2000000ull) break; __builtin_amdgcn_s_sleep(2); }
                    __builtin_amdgcn_fence(__ATOMIC_ACQUIRE, "agent");
                    asm volatile("s_waitcnt vmcnt(0)" ::: "memory");
                }
                __syncthreads();
                HfArgs F{(const bf16_t*)(R + R_OHG), (const bf16_t*)(R + R_HGQ + 4 * SZ512), INP(17) + l * 128, (bf16_t*)(R + R_YSS)};
                while (u < 1600 + MT / 64) { hgfin_chunk(F, u - 1600); QGRAB(u); }
            }
#endif
#undef QGRAB
        }
        SEAM(pb + 5);
#if !HGFIN_IN_QUEUE
        if (((PH_MASK >> 7) & 1) && IN(pb + 6)) { PH_LOCALS
            HfArgs F{(const bf16_t*)(R + R_OHG), (const bf16_t*)(R + R_HGQ + 4 * SZ512), INP(17) + l * 128, (bf16_t*)(R + R_YSS)};
            hgfin_phase(F);
        }
#endif
        if (((PH_MASK >> 7) & 1) && IN(pb + 6)) { PH_LOCALS epi::Glu E{(const bf16_t*)(R + R_US), (bf16_t*)(R + R_YSS)}; run_gemm(lds, (const bf16_t*)(R + R_US), (const bf16_t*)(WB + WB_GLU), 512, 512, E); }
        SEAM(pb + 6);
        if (((PH_MASK >> 8) & 1) && IN(pb + 7)) { PH_LOCALS
            epi::MergeFused E{(const unsigned char*)(R + R_GATE), (bf16_t*)(R + R_MRG)}; if (NULLX == 7) { epi::NullEpi E0{ssq}; run_gemm(lds, (const bf16_t*)(R + R_YSS), (const bf16_t*)(WB + WB_BS), DM, DM, E0); } for (int rep = 0; rep < DUP_MRG; ++rep) run_gemm<epi::MergeFused, (MRG_FP8 ? 16 : -1)>(lds, (const bf16_t*)(R + R_YSS), (const bf16_t*)(WB + WB_BS), DM, YLD, E);
        }
        SEAM_L(pb + 7);
        if (((PH_MASK >> 9) & 1) && IN(pb + 8)) { PH_LOCALS
            epi::Resid<false, false> E{nullptr, nullptr, 0, 1.0f, nullptr, hb, ssq};
            if (NULLX == 8) { epi::NullEpi E0{ssq}; run_gemm(lds, (const bf16_t*)(R + R_MRG), (const bf16_t*)(WB + WB_OUT), DM, DM, E0); }
            run_gemm(lds, (const bf16_t*)(R + R_MRG), (const bf16_t*)(WB + WB_OUT), DM, DM, E);
        }
        SEAM_L(pb + 8);
        if (((PH_MASK >> 10) & 1) && IN(pb + 9)) { PH_LOCALS epi::Swiglu E{(bf16_t*)(R + R_HID), ssq, (LAS float*)(lds + LDS_MISC + 1024)}; if (DUP_NULL) { epi::NullEpi E0{ssq}; run_gemm(lds, hb, (const bf16_t*)(WB + WB_GU2), 2 * DFF, DM, E0); } for (int rep = 0; rep < DUP_GU; ++rep) run_gemm(lds, hb, (const bf16_t*)(WB + WB_GU2), 2 * DFF, DM, E);
            if (CVT_AHEAD && l + 1 < DEPTH) {
                const int rem = ((MT / 256) * (2 * DFF / 256)) % G, wg0 = rem, nw = rem ? G - rem : 0; int base = 0;
                { CvtJob J{INP(6) + (size_t)(l + 1) * DM * NIN, INP(5) + (l + 1) * DM, (bf16_t*)(WB + WB_IN), NIN, DM, NIN, 0}; cvt_job(lds, J, base, wg0, nw); }
            }
        }
        SEAM_L(pb + 9);
        if (((PH_MASK >> 11) & 1) && IN(pb + 10)) { PH_LOCALS
            if (NULLX == 2) { epi::NullEpi E0{ssq}; run_gemm(lds, (const bf16_t*)(R + R_HID), (const bf16_t*)(WB + WB_D2), DM, DFF, E0); }
            if (l + 1 < DEPTH) { epi::Resid<false, false> E{nullptr, nullptr, 0, 0.5f, nullptr, hb, ssq}; run_gemm(lds, (const bf16_t*)(R + R_HID), (const bf16_t*)(WB + WB_D2), DM, DFF, E); }
            else               { epi::Resid<false, true>  E{nullptr, nullptr, 0, 0.5f, outp, hb, ssq};    run_gemm(lds, (const bf16_t*)(R + R_HID), (const bf16_t*)(WB + WB_D2), DM, DFF, E); }
        }
        SEAM(pb + 10);
    }
#ifdef PROBE_SKEW
    { XcdBarrier b_; b_.bar = (unsigned*)(ws0 + WS_BAR); b_.x = xb_xcc_id(); b_.st = (volatile LAS unsigned*)(lds + LDS_MISC); xcd_barrier(b_); }
    if (blockIdx.x == 0 && tid == 0) {
        float tot = 0.f;
        for (int k_ = 0; k_ < N_PHASES - 1; ++k_) { const unsigned* a_ = (const unsigned*)(ws0 + WS_CHK) + (size_t)k_ * 256; const unsigned v0_ = a_[0]; int mx_ = -2000000000; float sm_ = 0.f;
            for (int i_ = 0; i_ < (int)gridDim.x; ++i_) { const int d_ = (int)(a_[i_] - v0_); mx_ = d_ > mx_ ? d_ : mx_; sm_ += (float)d_; }
            tot += (float)mx_ * (float)gridDim.x - sm_; }
        const float us = tot * 0.01f / (float)gridDim.x;
        int la = (int)(3.0f * log2f(us / 20.0f) + 0.5f); la = la < 0 ? 0 : (la > 79 ? 79 : la);
        out0[0] = (float)(10 + la) * 1e5f;
    }
#endif
#ifdef PROBE_T
    { XcdBarrier b_; b_.bar = (unsigned*)(ws0 + WS_BAR); b_.x = xb_xcc_id(); b_.st = (volatile LAS unsigned*)(lds + LDS_MISC); xcd_barrier(b_); }
    if (blockIdx.x == 0 && tid == 0) {
        const unsigned long long* ts = (const unsigned long long*)(ws + WS_BAR + 14336);
        unsigned long long ta = 0, tb = 0;
        for (int l = 0; l < DEPTH; ++l) { const int pb = 1 + PH_PER_LAYER * l;
            for (int c = 0; c < PH_PER_LAYER; ++c) { const unsigned long long d = ts[pb + c + 1] - ts[pb + c]; if ((PROBE_A >> c) & 1) ta += d; if ((PROBE_B >> c) & 1) tb += d; } }
        if (PROBE_A == 0) ta = ts[1] - ts[0];
        if (PROBE_B == 0) tb = ts[N_PHASES] - ts[0];
        const float ua = (float)ta * 0.01f, ub = (float)tb * 0.01f;
        int la = (int)(6.0f * log2f(ua / 20.0f) + 0.5f); (void)ub;
        la = la < 0 ? 0 : (la > 79 ? 79 : la);
        const int v = la;
        out0[0] = (float)(10 + v % 80) * __builtin_powif(10.0f, 5 + v / 80);
    }
#endif
#undef INP
#undef IN
#undef SEAM
}

#ifndef N_LAUNCH_MODE
#define N_LAUNCH_MODE 1
#endif
extern "C" void kernel_launch(void* const* d_in, const int* in_sizes, int n_in, void* d_out, int out_size, void* d_ws, size_t ws_size, hipStream_t stream) {
    static int grid = 0;
    if (grid == 0) {
        size_t need = WS_END;
#ifdef SELFCHECK
        need = WS_CHK + CHK_BYTES;
#endif
        if (n_in != 25 || out_size != MT * DM || ws_size < need) { fprintf(stderr, "kernel_launch: unexpected shapes: n_in %d out %d ws %zu (need %zu)\n", n_in, out_size, ws_size, need); grid = -1; return; }
        int dev = 0, cus = 0, per_cu = 0;
        if (hipGetDevice(&dev) != hipSuccess || hipDeviceGetAttribute(&cus, hipDeviceAttributeMultiprocessorCount, dev) != hipSuccess) { grid = -1; return; }
        if (hipFuncSetAttribute((const void*)k_fwd, hipFuncAttributeMaxDynamicSharedMemorySize, LDS_BYTES) != hipSuccess) { fprintf(stderr, "kernel_launch: hipFuncSetAttribute failed\n"); grid = -1; return; }
        if (hipOccupancyMaxActiveBlocksPerMultiprocessor(&per_cu, (const void*)k_fwd, NTHREADS, LDS_BYTES) != hipSuccess || per_cu < 1) { fprintf(stderr, "kernel_launch: occupancy query says %d\n", per_cu); (void)hipGetLastError(); grid = -1; return; }
        grid = cus;
    }
    if (grid < 0) return;
    (void)hipMemsetAsync((char*)d_ws + WS_BAR, 0, 16384, stream);
    Params p{};
    for (int i = 0; i < 25; ++i) p.in[i] = (const float*)d_in[i];
    p.out = (float*)d_out; p.ws = (unsigned char*)d_ws;
#ifdef SELFCHECK
    {
        CkCtx c{d_in, (float*)d_out, (unsigned char*)d_ws, stream};
        (void)hipMemsetAsync((char*)d_ws + WS_CHK, 0, 65536, stream);
        for (int run = 0; run < 2; ++run)
            for (int ph = 0; ph < CK_NPH; ++ph) {
                if (ph == 0) (void)hipMemsetAsync((char*)d_ws + WS_BAR + 15360, 0, 512, stream);
                p.ph_lo = ph; p.ph_hi = ph + 1;
                hipLaunchKernelGGL(k_fwd, dim3(grid), dim3(NTHREADS), LDS_BYTES, stream, p);
                selfcheck_after_phase(c, run, ph);
            }
        selfcheck_finish(c);
    }
#elif N_LAUNCH_MODE == 1
    p.ph_lo = 0; p.ph_hi = N_PHASES;
    hipLaunchKernelGGL(k_fwd, dim3(grid), dim3(NTHREADS), LDS_BYTES, stream, p);
#else
    for (int ph = 0; ph < N_PHASES; ++ph) {
        p.ph_lo = ph; p.ph_hi = ph + 1;
        hipLaunchKernelGGL(k_fwd, dim3(grid), dim3(NTHREADS), LDS_BYTES, stream, p);
    }
#endif
    const hipError_t le = hipPeekAtLastError();
    if (le != hipSuccess) fprintf(stderr, "kernel_launch: launch failed: %s\n", hipGetErrorName(le));
}
```

```cpp
#include <hip/hip_runtime.h>
#include <cstdio>
#include <cstdint>
#include <cstring>

#define LAS __attribute__((address_space(3)))
#define CAS __attribute__((address_space(4)))
#define GAS __attribute__((address_space(1)))
#ifndef CHK_ROW0
#define CHK_ROW0 18432
#endif
typedef unsigned short bf16_t;
typedef short bf16x8 __attribute__((ext_vector_type(8)));
typedef short s16x4 __attribute__((ext_vector_type(4)));
typedef float f32x2 __attribute__((ext_vector_type(2)));
typedef float f32x4 __attribute__((ext_vector_type(4)));
typedef float f32x8 __attribute__((ext_vector_type(8)));
typedef float f32x16 __attribute__((ext_vector_type(16)));
typedef unsigned u32x2 __attribute__((ext_vector_type(2)));
typedef unsigned u32x4 __attribute__((ext_vector_type(4)));

constexpr int MT = 40960;
constexpr int NSEQ = 20, SEQL = 2048, PROMPT_ROWS = 8192;
constexpr int DM = 2048, DFF = 5632, NIN = 10752, DEPTH = 4;
constexpr int NTHREADS = 512;
constexpr int LDS_BYTES = 147456;
constexpr int LDS_MISC = 131072;

#ifndef HG_WT
#define HG_WT 0
#endif
#ifndef MRG_FP8
#define MRG_FP8 1
#endif
constexpr int YLD = MRG_FP8 ? 1536 : 2048;
constexpr float YATT_SC = 16.0f, WBR_SC = 32.0f;
constexpr size_t MiB = 1048576;
constexpr size_t WS_BAR  = 0;
constexpr size_t WS_PTAB = 15872;
constexpr size_t WS_SSQ  = 2359296;
constexpr size_t WS_ATAB = 65536;
constexpr size_t WS_BM   = WS_ATAB + 131072;
constexpr size_t WS_CM   = WS_BM + 1048576;
constexpr size_t WS_LB   = WS_CM + 1048576;
constexpr size_t WS_WB   = 8 * MiB; static_assert(WS_LB + 16384 <= WS_SSQ && WS_SSQ + (size_t)MT * 128 <= WS_WB, "small tables");
constexpr size_t WB_GU1 = 0;
constexpr size_t WB_D1  = WB_GU1 + (size_t)11264 * 2048 * 2;
constexpr size_t WB_IN  = WB_D1 + (size_t)2048 * 5632 * 2;
constexpr size_t WB_GLU = WB_IN + (size_t)NIN * 2048 * 2;
constexpr size_t WB_BS  = WB_GLU + (size_t)512 * 512 * 2;
constexpr size_t WB_BH  = WB_BS + (size_t)2048 * 512 * 2;
constexpr size_t WB_BA  = WB_BH + (size_t)2048 * 512 * 2;
constexpr size_t WB_OUT = WB_BA + (size_t)2048 * 1024 * 2;
constexpr size_t WB_GU2 = WB_OUT + (size_t)2048 * 2048 * 2;
constexpr size_t WB_D2  = WB_GU2 + (size_t)11264 * 2048 * 2;
constexpr size_t WB_END = WB_D2 + (size_t)2048 * 5632 * 2;
constexpr size_t WS_HB   = WS_WB + 192 * MiB;
constexpr size_t WS_R    = WS_HB + (size_t)MT * 2048 * 2;
static_assert(WB_END <= 192 * MiB, "weights region");
constexpr size_t R_HID  = 0;
constexpr size_t SZ512  = (size_t)MT * 512 * 2;
constexpr size_t R_US   = 0;
constexpr size_t R_HGQ  = R_US + SZ512;
constexpr size_t R_MRG  = R_HGQ;
constexpr size_t R_AQ   = R_HGQ + 5 * SZ512;
constexpr size_t R_AK   = R_AQ + 2 * SZ512;
constexpr size_t R_AV   = R_AK + SZ512 / 2;
constexpr size_t R_GATE = R_AV + SZ512 / 2;
constexpr size_t R_YD   = R_GATE + 12 * SZ512;
constexpr size_t R_OHG  = R_YD + 4 * SZ512;
constexpr size_t R_YSS  = R_OHG + 4 * SZ512;
constexpr size_t R_HB8  = R_YD;
constexpr size_t R_W8   = R_OHG;
constexpr size_t R_YHG  = R_YSS + SZ512;
constexpr size_t R_YAT  = R_YHG + SZ512;
constexpr size_t R_END  = R_YAT + 2 * SZ512;
static_assert(R_MRG + 4 * SZ512 <= R_HGQ + 4 * SZ512, "merged overlay");
static_assert((size_t)MT * DFF * 2 <= R_END, "hid fits");
static_assert((size_t)MT * DFF * 2 <= R_YD, "hid clear of the fp8 copies");
constexpr size_t WS_END  = WS_R + R_END;
constexpr size_t WS_CHK  = WS_END;

typedef __bf16 bf16x2_n __attribute__((ext_vector_type(2)));
__device__ __forceinline__ unsigned cvtpk(float lo, float hi) { f32x2 v = {lo, hi}; bf16x2_n b = __builtin_convertvector(v, bf16x2_n); return __builtin_bit_cast(unsigned, b); }
__device__ __forceinline__ float bf2f(bf16_t b) { return __uint_as_float(((unsigned)b) << 16); }
__device__ __forceinline__ float bflo(unsigned w) { return __uint_as_float(w << 16); }
__device__ __forceinline__ float bfhi(unsigned w) { return __uint_as_float(w & 0xffff0000u); }
__device__ __forceinline__ bf16_t f2bf(float f) { return (bf16_t)(cvtpk(f, 0.f) & 0xffffu); }
__device__ __forceinline__ float sigm(float x) { return __builtin_amdgcn_rcpf(1.0f + __expf(-x)); }
__device__ __forceinline__ float siluf(float x) { return x * sigm(x); }
__device__ __forceinline__ float gelu_tanh(float x) {
    const float u = 0.7978845608028654f * (x + 0.044715f * x * x * x);
    return x * sigm(2.0f * u);
}
template <int X> __device__ __forceinline__ float xor_f(float v) { static_assert(X >= 1 && X <= 16, "inside a 32-lane half"); return __uint_as_float((unsigned)__builtin_amdgcn_ds_swizzle((int)__float_as_uint(v), (X << 10) | 0x1f)); }
__device__ __forceinline__ float xor32_sum(float v) { auto r = __builtin_amdgcn_permlane32_swap(__float_as_uint(v), __float_as_uint(v), false, false); return __uint_as_float(r[0]) + __uint_as_float(r[1]); }
#define WAIT_VM0() asm volatile("s_waitcnt vmcnt(0)" ::: "memory")
#define WAIT_LGKM0() asm volatile("s_waitcnt lgkmcnt(0)" ::: "memory")
namespace pg8 {
#define PG8_LAS __attribute__((address_space(3)))
typedef unsigned short bf16_t;
typedef short bf16x8 __attribute__((ext_vector_type(8)));
typedef float f32x4 __attribute__((ext_vector_type(4)));
typedef unsigned u32x4 __attribute__((ext_vector_type(4)));
constexpr int BM = 256, BK = 64, HALF = 128, HTB = HALF * BK * 2  , STAGE_BYTES = 8 * HTB, NXCD = 8;
#ifndef PG8_WGM
#define PG8_WGM 4
#endif
constexpr int WGM = PG8_WGM;

__host__ __device__ __forceinline__ int lds_byte(int r, int c) { const int st = (r >> 4) * 2 + (c >> 5), rr = r & 15, cc = c & 31, ob = rr * 64 + cc * 2; return st * 1024 + (ob ^ (((ob >> 9) & 1) << 5)); }
__host__ __device__ __forceinline__ void stage_rc(int b, int& R, int& C) { const int st = b / 1024, sb = b % 1024, swz = sb ^ (((sb >> 9) & 1) << 5); R = (st >> 1) * 16 + swz / 64; C = (st & 1) * 32 + (swz % 64) / 2; }
__host__ __device__ __forceinline__ int perm32(int rho) { const int n = rho >> 4, i = rho & 15; return 8 * (i >> 2) + 4 * n + (i & 3); }

struct Unit { int pm, pn; };
struct Gemm { const bf16_t* A; const bf16_t* Bt; int M, N, K; };

struct StaticOrder {
    int nM, nN, nwg, G, c, wgm, xm, xx, xr, xW;
    __host__ __device__ void init(int M, int N, int G_, int c_, int wgm_ = WGM) { nM = M / BM; nN = N / BM; nwg = nM * nN; G = G_; c = c_; wgm = wgm_; xm = 0; xx = 0; xr = 0; xW = 1; }
    __host__ __device__ void init_x(int x, int rank, int W) { xm = 1; xx = x; xr = rank; xW = W; }
    __host__ __device__ bool next(int i, Unit& u) const {
        int wgid;
        if (xm) { const int q = nwg / NXCD, r = nwg % NXCD, qx = q + (xx < r ? 1 : 0), off = i * xW + xr; if (off >= qx) return false; wgid = (xx < r ? xx * (q + 1) : r * (q + 1) + (xx - r) * q) + off; }
        else {
        const long L = (long)i * G + c; if (L >= nwg) return false;
        wgid = (int)L; { const int q = nwg / NXCD, r = nwg % NXCD, xcd = wgid % NXCD, off = wgid / NXCD; wgid = (xcd < r ? xcd * (q + 1) : r * (q + 1) + (xcd - r) * q) + off; }
        }
        const int nig = wgm * nN, gid = wgid / nig, fm = gid * wgm, gsz = (nM - fm) < wgm ? (nM - fm) : wgm;
        u.pm = fm + ((wgid % nig) % gsz); u.pn = (wgid % nig) / gsz; return true;
    }
    __device__ __forceinline__ void a_ready(const Unit&) const {}
    __device__ __forceinline__ void done(const Unit&) const {}
};


#ifndef PG8_RELAX
#define PG8_RELAX 0
#endif
template <int N> __device__ __forceinline__ void wait_vm() { asm volatile("s_waitcnt vmcnt(%0)" :: "n"(N) : "memory"); }
typedef int pg8_i32x4 __attribute__((ext_vector_type(4)));
typedef int pg8_i32x8 __attribute__((ext_vector_type(8)));
template <class Epi, class Sched, bool ALIGN_EPI = false, bool SP2 = false, int F8FROM = -1>
__device__ __forceinline__ void gemm_phase(PG8_LAS unsigned char* lds, const Gemm g, const Sched& S, const Epi& E) {
    int tid_l = threadIdx.x; asm volatile("" : "+v"(tid_l));
    const int tid = tid_l, wid = __builtin_amdgcn_readfirstlane(tid >> 6), lane = tid & 63, wr = wid >> 2, wc = wid & 3, fr = lane & 15, fq = lane >> 4;
    const int K = g.K, nt = K / BK;
    unsigned voffA[2], voffB[2];
#pragma unroll
    for (int i = 0; i < 2; ++i) { int R, C; stage_rc(tid * 16 + i * 8192, R, C); const int Rb = Epi::PERM ? ((R & ~31) + perm32(R & 31)) : R;
        voffA[i] = (unsigned)(R * K + C) * 2u; voffB[i] = (unsigned)(Rb * K + C) * 2u; }
    const size_t kstep = (size_t)(BK * 2);
    const size_t hstep = (size_t)HALF * K * 2;
    const size_t tstep = 2 * hstep;
    const unsigned ldsw = (unsigned)wid * 1024u;
    const int aoff = lds_byte(wr * 64 + fr, fq * 8), boff = lds_byte(wc * 32 + fr, fq * 8);
#define PG8_SA(b, h) (((b) * 2 + (h)) * HTB)
#define PG8_SB(b, h) ((4 + (b) * 2 + (h)) * HTB)
#define PG8_STAGE(bufoff, gbase, voff) do { _Pragma("unroll") for (int _i = 0; _i < 2; ++_i) \
        __builtin_amdgcn_global_load_lds((const unsigned*)((const char*)(gbase) + (voff)[_i]), (PG8_LAS unsigned*)(lds + (bufoff) + ldsw + _i * 8192), 16, 0, 0); } while (0)
#define PG8_LDA(dst, b, h) do { _Pragma("unroll") for (int m = 0; m < 4; ++m) _Pragma("unroll") for (int k = 0; k < 2; ++k) dst[m][k] = *(const PG8_LAS bf16x8*)(lds + PG8_SA(b, h) + aoff + m * 2048 + k * 1024); } while (0)
#define PG8_LDB(dst, b, h) do { _Pragma("unroll") for (int n = 0; n < 2; ++n) _Pragma("unroll") for (int k = 0; k < 2; ++k) dst[n][k] = *(const PG8_LAS bf16x8*)(lds + PG8_SB(b, h) + boff + n * 2048 + k * 1024); } while (0)
#define PG8_CAT8(lo, hi) __builtin_shufflevector(__builtin_bit_cast(pg8_i32x4, lo), __builtin_bit_cast(pg8_i32x4, hi), 0, 1, 2, 3, 4, 5, 6, 7)
#define PG8_MMA(ai, bj, At, Bt) do { __builtin_amdgcn_s_setprio(1); _Pragma("unroll") for (int m = 0; m < 4; ++m) _Pragma("unroll") for (int n = 0; n < 2; ++n) { \
        if constexpr (F8T) acc[ai][bj][m][n] = __builtin_amdgcn_mfma_scale_f32_16x16x128_f8f6f4(PG8_CAT8(Bt[n][0], Bt[n][1]), PG8_CAT8(At[m][0], At[m][1]), acc[ai][bj][m][n], 0, 0, 0, 0, 0, 0); \
        else { _Pragma("unroll") for (int k = 0; k < 2; ++k) acc[ai][bj][m][n] = __builtin_amdgcn_mfma_f32_16x16x32_bf16(Bt[n][k], At[m][k], acc[ai][bj][m][n], 0, 0, 0); } } __builtin_amdgcn_s_setprio(0); } while (0)
#define PG8_WAIT_V(n) asm volatile("s_waitcnt vmcnt(" #n ")" ::: "memory")
#define PG8_WAIT_L(n) asm volatile("s_waitcnt lgkmcnt(" #n ")" ::: "memory")
#define PG8_BAR __builtin_amdgcn_s_barrier()
#define PG8_SCHED __builtin_amdgcn_sched_barrier(0)
    Unit cur, nxt; int ui = 0;
    if (!S.next(0, cur)) return;
    f32x4 acc[2][2][4][2];
#pragma unroll
    for (int a = 0; a < 2; ++a)
#pragma unroll
        for (int b = 0; b < 2; ++b)
#pragma unroll
            for (int m = 0; m < 4; ++m)
#pragma unroll
                for (int n = 0; n < 2; ++n) acc[a][b][m][n] = (f32x4){0.f, 0.f, 0.f, 0.f};
    bf16x8 At[4][2], B0[2][2], B1[2][2];
    const char* cA = (const char*)g.A + (size_t)cur.pm * tstep; const char* cB = (const char*)g.Bt + (size_t)cur.pn * tstep;
    S.a_ready(cur);
    if constexpr (SP2) {
        PG8_STAGE(PG8_SB(0, 0), cB, voffB); PG8_STAGE(PG8_SB(0, 1), cB + hstep, voffB); PG8_STAGE(PG8_SA(0, 0), cA, voffA); PG8_STAGE(PG8_SA(0, 1), cA + hstep, voffA);
        if (wr == 1) PG8_BAR;
        PG8_WAIT_V(2); PG8_BAR;
        PG8_STAGE(PG8_SB(1, 0), cB + kstep, voffB); PG8_STAGE(PG8_SA(1, 0), cA + kstep, voffA); PG8_STAGE(PG8_SB(1, 1), cB + hstep + kstep, voffB);
        PG8_WAIT_V(6); PG8_BAR;
    } else {
        PG8_STAGE(PG8_SB(0, 0), cB, voffB); PG8_STAGE(PG8_SA(0, 0), cA, voffA); PG8_STAGE(PG8_SB(0, 1), cB + hstep, voffB); PG8_STAGE(PG8_SA(0, 1), cA + hstep, voffA);
        if (wr == 1) PG8_BAR;
        PG8_WAIT_V(4); PG8_BAR;
        PG8_STAGE(PG8_SB(1, 0), cB + kstep, voffB); PG8_STAGE(PG8_SA(1, 0), cA + kstep, voffA); PG8_STAGE(PG8_SB(1, 1), cB + hstep + kstep, voffB);
        PG8_WAIT_V(6); PG8_BAR;
    }
    for (;;) {
        const bool has_next = S.next(ui + 1, nxt);
        const char* nA = has_next ? (const char*)g.A + (size_t)nxt.pm * tstep : cA; const char* nB = has_next ? (const char*)g.Bt + (size_t)nxt.pn * tstep : cB;
        if constexpr (F8FROM > 0) { constexpr bool F8T = false, MID8_ = true, MID16_ = (F8FROM > 16);
        for (int t = 0; t < F8FROM; t += 2) {
            const bool last = (t == nt - 2);
            const char* a1 = cA + (size_t)(t + 1) * kstep;
            const char* a2 = last ? nA : cA + (size_t)(t + 2) * kstep; const char* b2 = last ? nB : cB + (size_t)(t + 2) * kstep;
            const char* a3 = a2 + kstep; const char* b3 = b2 + kstep;
            if (last && has_next) S.a_ready(nxt);
            int relax = __builtin_amdgcn_readfirstlane((PG8_RELAX && (t == 0) && (ui > 0)) ? 1 : 0); asm volatile("" : "+s"(relax));
            if constexpr (Epi::MIDK) { if ((MID8_ && t == 8) || (MID16_ && t == 16)) E.mid(acc, cur, t >> 3, wr, wc, fr, fq); }
            if constexpr (SP2) {
            PG8_LDB(B0, 0, 0); PG8_LDB(B1, 0, 1); PG8_SCHED; PG8_LDA(At, 0, 0); PG8_STAGE(PG8_SA(1, 1), a1 + hstep, voffA);
            if (relax) wait_vm<8 + Epi::NSTORE>(); else PG8_WAIT_V(8); PG8_WAIT_L(0); PG8_BAR; PG8_MMA(0, 0, At, B0); PG8_MMA(0, 1, At, B1); PG8_BAR; PG8_SCHED;
            PG8_LDA(At, 0, 1); PG8_STAGE(PG8_SB(0, 0), b2, voffB); PG8_STAGE(PG8_SB(0, 1), b2 + hstep, voffB); PG8_STAGE(PG8_SA(0, 0), a2, voffA);
            if (relax) wait_vm<8 + Epi::NSTORE>(); else PG8_WAIT_V(8); PG8_WAIT_L(0); PG8_BAR; PG8_MMA(1, 0, At, B0); PG8_MMA(1, 1, At, B1); PG8_BAR; PG8_SCHED;
            PG8_LDB(B0, 1, 0); PG8_LDB(B1, 1, 1); PG8_SCHED; PG8_LDA(At, 1, 0); PG8_STAGE(PG8_SA(0, 1), a2 + hstep, voffA);
            PG8_WAIT_V(8); PG8_WAIT_L(0); PG8_BAR; PG8_MMA(0, 0, At, B0); PG8_MMA(0, 1, At, B1); PG8_BAR; PG8_SCHED;
            PG8_LDA(At, 1, 1); PG8_STAGE(PG8_SB(1, 0), b3, voffB); PG8_STAGE(PG8_SB(1, 1), b3 + hstep, voffB); PG8_STAGE(PG8_SA(1, 0), a3, voffA);
            PG8_WAIT_V(8); PG8_WAIT_L(0); PG8_BAR; PG8_MMA(1, 0, At, B0); PG8_MMA(1, 1, At, B1); PG8_BAR; PG8_SCHED;
            } else {
            PG8_LDB(B0, 0, 0); PG8_SCHED; PG8_LDA(At, 0, 0); PG8_STAGE(PG8_SA(1, 1), a1 + hstep, voffA);
            PG8_WAIT_L(8); PG8_BAR; PG8_WAIT_L(0); PG8_MMA(0, 0, At, B0); PG8_BAR; PG8_SCHED;
            PG8_LDB(B1, 0, 1); PG8_STAGE(PG8_SB(0, 0), b2, voffB);
            PG8_BAR; PG8_WAIT_L(0); PG8_MMA(0, 1, At, B1); PG8_BAR;
            PG8_LDA(At, 0, 1); PG8_STAGE(PG8_SA(0, 0), a2, voffA);
            PG8_BAR; PG8_WAIT_L(0); PG8_MMA(1, 0, At, B0); PG8_BAR; PG8_SCHED;
            PG8_STAGE(PG8_SB(0, 1), b2 + hstep, voffB);
            PG8_WAIT_V(6); PG8_BAR; PG8_MMA(1, 1, At, B1); PG8_BAR;
            PG8_LDB(B0, 1, 0); PG8_SCHED; PG8_LDA(At, 1, 0); PG8_STAGE(PG8_SA(0, 1), a2 + hstep, voffA);
            PG8_WAIT_L(8); PG8_BAR; PG8_WAIT_L(0); PG8_MMA(0, 0, At, B0); PG8_BAR; PG8_SCHED;
            PG8_LDB(B1, 1, 1); PG8_STAGE(PG8_SB(1, 0), b3, voffB);
            PG8_BAR; PG8_WAIT_L(0); PG8_MMA(0, 1, At, B1); PG8_BAR;
            PG8_LDA(At, 1, 1); PG8_STAGE(PG8_SA(1, 0), a3, voffA);
            PG8_BAR; PG8_WAIT_L(0); PG8_MMA(1, 0, At, B0); PG8_BAR; PG8_SCHED;
            PG8_STAGE(PG8_SB(1, 1), b3 + hstep, voffB);
            PG8_WAIT_V(6); PG8_BAR; PG8_MMA(1, 1, At, B1); PG8_BAR;
            }
        } }
        if constexpr (Epi::MIDK && F8FROM == 16) E.mid(acc, cur, 2, wr, wc, fr, fq);
        { constexpr bool F8T = (F8FROM >= 0), MID8_ = (F8FROM <= 0), MID16_ = (F8FROM != 16);
        for (int t = (F8FROM > 0 ? F8FROM : 0); t < nt; t += 2) {
            const bool last = (t == nt - 2);
            const char* a1 = cA + (size_t)(t + 1) * kstep;
            const char* a2 = last ? nA : cA + (size_t)(t + 2) * kstep; const char* b2 = last ? nB : cB + (size_t)(t + 2) * kstep;
            const char* a3 = a2 + kstep; const char* b3 = b2 + kstep;
            if (last && has_next) S.a_ready(nxt);
            int relax = __builtin_amdgcn_readfirstlane((PG8_RELAX && (t == 0) && (ui > 0)) ? 1 : 0); asm volatile("" : "+s"(relax));
            if constexpr (Epi::MIDK) { if ((MID8_ && t == 8) || (MID16_ && t == 16)) E.mid(acc, cur, t >> 3, wr, wc, fr, fq); }
            if constexpr (SP2) {
            PG8_LDB(B0, 0, 0); PG8_LDB(B1, 0, 1); PG8_SCHED; PG8_LDA(At, 0, 0); PG8_STAGE(PG8_SA(1, 1), a1 + hstep, voffA);
            if (relax) wait_vm<8 + Epi::NSTORE>(); else PG8_WAIT_V(8); PG8_WAIT_L(0); PG8_BAR; PG8_MMA(0, 0, At, B0); PG8_MMA(0, 1, At, B1); PG8_BAR; PG8_SCHED;
            PG8_LDA(At, 0, 1); PG8_STAGE(PG8_SB(0, 0), b2, voffB); PG8_STAGE(PG8_SB(0, 1), b2 + hstep, voffB); PG8_STAGE(PG8_SA(0, 0), a2, voffA);
            if (relax) wait_vm<8 + Epi::NSTORE>(); else PG8_WAIT_V(8); PG8_WAIT_L(0); PG8_BAR; PG8_MMA(1, 0, At, B0); PG8_MMA(1, 1, At, B1); PG8_BAR; PG8_SCHED;
            PG8_LDB(B0, 1, 0); PG8_LDB(B1, 1, 1); PG8_SCHED; PG8_LDA(At, 1, 0); PG8_STAGE(PG8_SA(0, 1), a2 + hstep, voffA);
            PG8_WAIT_V(8); PG8_WAIT_L(0); PG8_BAR; PG8_MMA(0, 0, At, B0); PG8_MMA(0, 1, At, B1); PG8_BAR; PG8_SCHED;
            PG8_LDA(At, 1, 1); PG8_STAGE(PG8_SB(1, 0), b3, voffB); PG8_STAGE(PG8_SB(1, 1), b3 + hstep, voffB); PG8_STAGE(PG8_SA(1, 0), a3, voffA);
            PG8_WAIT_V(8); PG8_WAIT_L(0); PG8_BAR; PG8_MMA(1, 0, At, B0); PG8_MMA(1, 1, At, B1); PG8_BAR; PG8_SCHED;
            } else {
            PG8_LDB(B0, 0, 0); PG8_SCHED; PG8_LDA(At, 0, 0); PG8_STAGE(PG8_SA(1, 1), a1 + hstep, voffA);
            PG8_WAIT_L(8); PG8_BAR; PG8_WAIT_L(0); PG8_MMA(0, 0, At, B0); PG8_BAR; PG8_SCHED;
            PG8_LDB(B1, 0, 1); PG8_STAGE(PG8_SB(0, 0), b2, voffB);
            PG8_BAR; PG8_WAIT_L(0); PG8_MMA(0, 1, At, B1); PG8_BAR;
            PG8_LDA(At, 0, 1); PG8_STAGE(PG8_SA(0, 0), a2, voffA);
            PG8_BAR; PG8_WAIT_L(0); PG8_MMA(1, 0, At, B0); PG8_BAR; PG8_SCHED;
            PG8_STAGE(PG8_SB(0, 1), b2 + hstep, voffB);
            PG8_WAIT_V(6); PG8_BAR; PG8_MMA(1, 1, At, B1); PG8_BAR;
            PG8_LDB(B0, 1, 0); PG8_SCHED; PG8_LDA(At, 1, 0); PG8_STAGE(PG8_SA(0, 1), a2 + hstep, voffA);
            PG8_WAIT_L(8); PG8_BAR; PG8_WAIT_L(0); PG8_MMA(0, 0, At, B0); PG8_BAR; PG8_SCHED;
            PG8_LDB(B1, 1, 1); PG8_STAGE(PG8_SB(1, 0), b3, voffB);
            PG8_BAR; PG8_WAIT_L(0); PG8_MMA(0, 1, At, B1); PG8_BAR;
            PG8_LDA(At, 1, 1); PG8_STAGE(PG8_SA(1, 0), a3, voffA);
            PG8_BAR; PG8_WAIT_L(0); PG8_MMA(1, 0, At, B0); PG8_BAR; PG8_SCHED;
            PG8_STAGE(PG8_SB(1, 1), b3 + hstep, voffB);
            PG8_WAIT_V(6); PG8_BAR; PG8_MMA(1, 1, At, B1); PG8_BAR;
            }
        } }
        if constexpr (ALIGN_EPI) { if (wr == 0) PG8_BAR; }
        if constexpr (!Epi::AFTER_DRAIN) { E(acc, cur, wr, wc, fr, fq); S.done(cur); }
        if (!has_next) break;
#pragma unroll
        for (int a = 0; a < 2; ++a)
#pragma unroll
            for (int b = 0; b < 2; ++b)
#pragma unroll
                for (int m = 0; m < 4; ++m)
#pragma unroll
                    for (int n = 0; n < 2; ++n) acc[a][b][m][n] = (f32x4){0.f, 0.f, 0.f, 0.f};
        cur = nxt; cA = nA; cB = nB; ++ui;
        if constexpr (ALIGN_EPI) { if (wr == 1) PG8_BAR; }
    }
    PG8_WAIT_V(0);
    if constexpr (!ALIGN_EPI) { if (wr == 0) PG8_BAR; }
    PG8_BAR;
    if constexpr (Epi::AFTER_DRAIN) { E.fused(acc, cur, wr, wc, fr, fq, lds, wid, lane); S.done(cur); }
#undef PG8_SA
#undef PG8_SB
#undef PG8_STAGE
#undef PG8_LDA
#undef PG8_LDB
#undef PG8_MMA
#undef PG8_WAIT_V
#undef PG8_WAIT_L
#undef PG8_BAR
#undef PG8_SCHED
}
}
namespace epi {
using pg8::Unit;
constexpr float RMS_EPS = 1e-6f;
__device__ __forceinline__ float row_rstd(const float* ssq, int row) {
    const f32x4* p = (const f32x4*)(ssq + (size_t)row * 32);
    f32x4 a = p[0] + p[1], b = p[2] + p[3], c = p[4] + p[5], d = p[6] + p[7];
    a = (a + b) + (c + d);
    return __builtin_amdgcn_rsqf(((a[0] + a[1]) + (a[2] + a[3])) * (1.0f / 2048.0f) + RMS_EPS);
}

__device__ __forceinline__ void unit_rstd_table(const float* ssq, LAS float* tab, int pm, int wr, int wc, int fr, int fq) {
    const int have = __builtin_amdgcn_readfirstlane(((volatile LAS int*)tab)[256]);
    if (have != pm) {
        const int t = (wr * 4 + wc) * 64 + fq * 16 + fr, row = t >> 1, h = t & 1;
        const f32x4* p = (const f32x4*)(ssq + (size_t)(pm * 256 + row) * 32 + h * 16);
        f32x4 a = (p[0] + p[1]) + (p[2] + p[3]);
        float s = (a[0] + a[1]) + (a[2] + a[3]);
        s += xor_f<1>(s);
        if (h == 0) tab[row] = __builtin_amdgcn_rsqf(s * (1.0f / 2048.0f) + RMS_EPS);
        asm volatile("s_waitcnt lgkmcnt(0)" ::: "memory"); __builtin_amdgcn_s_barrier(); asm volatile("" ::: "memory");
        if (t == 0) ((volatile LAS int*)tab)[256] = pm;
    }
}

struct Swiglu {
    static constexpr bool PERM = true, AFTER_DRAIN = false, MIDK = false; static constexpr int NSTORE = 8;
    bf16_t* H; const float* ssq; LAS float* tab;
    __device__ __forceinline__ void operator()(const f32x4 (&acc)[2][2][4][2], const Unit& u, int wr, int wc, int fr, int fq) const {
        const int row0 = u.pm * 256 + wr * 64 + fr, col0 = u.pn * 128 + wc * 32 + 8 * fq;
        unit_rstd_table(ssq, tab, u.pm, wr, wc, fr, fq);
#pragma unroll
        for (int ai = 0; ai < 2; ++ai)
#pragma unroll
            for (int m = 0; m < 4; ++m) {
                const int row = row0 + ai * 128 + m * 16;
                const float rstd = tab[wr * 64 + fr + ai * 128 + m * 16];
                float o[8];
#pragma unroll
                for (int n = 0; n < 2; ++n)
#pragma unroll
                    for (int j = 0; j < 4; ++j) { const float g = acc[ai][0][m][n][j] * rstd, up = acc[ai][1][m][n][j] * rstd; o[n * 4 + j] = siluf(g) * up; }
                u32x4 w; w.x = cvtpk(o[0], o[1]); w.y = cvtpk(o[2], o[3]); w.z = cvtpk(o[4], o[5]); w.w = cvtpk(o[6], o[7]);
                __builtin_nontemporal_store(w, (u32x4*)(H + (size_t)row * DFF + col0));
            }
    }
};

#ifndef RESID_NB
#define RESID_NB 1
#endif
__device__ __forceinline__ u32x2 pk8_fp8(const f32x4& a, const f32x4& b) {
    int p0 = __builtin_amdgcn_cvt_pk_fp8_f32(a[0], a[1], 0, false); p0 = __builtin_amdgcn_cvt_pk_fp8_f32(a[2], a[3], p0, true);
    int p1 = __builtin_amdgcn_cvt_pk_fp8_f32(b[0], b[1], 0, false); p1 = __builtin_amdgcn_cvt_pk_fp8_f32(b[2], b[3], p1, true);
    u32x2 r; r.x = (unsigned)p0; r.y = (unsigned)p1; return r;
}
template <bool BASEF32, bool OUTF32, bool F8 = false>
struct Resid {
    static constexpr bool PERM = true, AFTER_DRAIN = false, MIDK = false; static constexpr int NSTORE = 16;
    const float* base0; const float* base1; int split_row; float scale; float* out; bf16_t* hb; float* ssq_out; unsigned char* hb8;
    __device__ __forceinline__ void operator()(const f32x4 (&acc)[2][2][4][2], const Unit& u, int wr, int wc, int fr, int fq) const {
        const int row0 = u.pm * 256 + wr * 64 + fr, col0 = u.pn * 256 + wc * 32 + 8 * fq;
        if constexpr (BASEF32) {
            const int prow = u.pm * 256;
            const float* bsel = (prow < split_row) ? base0 : base1 - (size_t)split_row * DM;
            size_t rowoff = ((size_t)row0 * DM + col0);
            asm volatile("" : "+v"(rowoff));
            const char* bp0 = (const char*)(bsel + rowoff); char* hp = (char*)(hb + rowoff);
#pragma unroll
            for (int ai = 0; ai < 2; ++ai) {
                f32x4 b[4][2][2];
#pragma unroll
                for (int m = 0; m < 4; ++m)
#pragma unroll
                    for (int bj = 0; bj < 2; ++bj) { const float* bp = (const float*)(bp0 + ((size_t)(ai * 128 + m * 16) * DM + bj * 128) * 4); b[m][bj][0] = *(const f32x4*)bp; b[m][bj][1] = *(const f32x4*)(bp + 4); }
                __builtin_amdgcn_sched_barrier(0);
#pragma unroll
                for (int m = 0; m < 4; ++m) { const int row = row0 + ai * 128 + m * 16; float s = 0.f;
#pragma unroll
                    for (int bj = 0; bj < 2; ++bj) {
                        const f32x4 o0 = b[m][bj][0] + acc[ai][bj][m][0] * scale, o1 = b[m][bj][1] + acc[ai][bj][m][1] * scale;
                        s += (o0[0] * o0[0] + o0[1] * o0[1]) + (o0[2] * o0[2] + o0[3] * o0[3]) + (o1[0] * o1[0] + o1[1] * o1[1]) + (o1[2] * o1[2] + o1[3] * o1[3]);
                        u32x4 w; w.x = cvtpk(o0[0], o0[1]); w.y = cvtpk(o0[2], o0[3]); w.z = cvtpk(o1[0], o1[1]); w.w = cvtpk(o1[2], o1[3]);
                        *(u32x4*)(hp + ((size_t)(ai * 128 + m * 16) * DM + bj * 128) * 2) = w;
                        if constexpr (F8) *(u32x2*)(hb8 + rowoff + ((size_t)(ai * 128 + m * 16) * DM + bj * 128)) = pk8_fp8(o0, o1);
                    }
                    s += xor_f<16>(s); s = xor32_sum(s);
                    if (fq == 0) ssq_out[(size_t)row * 32 + u.pn * 4 + wc] = s;
                }
                __builtin_amdgcn_sched_barrier(0);
            }
        } else {
            size_t rowoff = ((size_t)row0 * DM + col0) * 2;
            asm volatile("" : "+v"(rowoff));
            char* hp = (char*)hb + rowoff; char* op0 = (char*)out + 2 * rowoff; (void)op0;
#pragma unroll
            for (int ai = 0; ai < RESID_NB; ++ai) {
                constexpr int NA = 2 / RESID_NB;
                u32x4 b[NA][4][2];
#pragma unroll
                for (int a2 = 0; a2 < NA; ++a2)
#pragma unroll
                    for (int m = 0; m < 4; ++m)
#pragma unroll
                        for (int bj = 0; bj < 2; ++bj) b[a2][m][bj] = *(const u32x4*)(hp + ((size_t)((ai * NA + a2) * 128 + m * 16) * DM + bj * 128) * 2);
                __builtin_amdgcn_sched_barrier(0);
#pragma unroll
                for (int a2 = 0; a2 < NA; ++a2)
#pragma unroll
                    for (int m = 0; m < 4; ++m) { const int aa = ai * NA + a2; const int row = row0 + aa * 128 + m * 16; float s = 0.f;
#pragma unroll
                        for (int bj = 0; bj < 2; ++bj) {
                            const u32x4 bb = b[a2][m][bj];
                            const f32x4 h0 = {bflo(bb.x), bfhi(bb.x), bflo(bb.y), bfhi(bb.y)}, h1 = {bflo(bb.z), bfhi(bb.z), bflo(bb.w), bfhi(bb.w)};
                            const f32x4 o0 = h0 + acc[aa][bj][m][0] * scale, o1 = h1 + acc[aa][bj][m][1] * scale;
                            if constexpr (OUTF32) {
                                float* op = (float*)(op0 + ((size_t)(aa * 128 + m * 16) * DM + bj * 128) * 4); *(f32x4*)op = o0; *(f32x4*)(op + 4) = o1;
                            } else {
                                s += (o0[0] * o0[0] + o0[1] * o0[1]) + (o0[2] * o0[2] + o0[3] * o0[3]) + (o1[0] * o1[0] + o1[1] * o1[1]) + (o1[2] * o1[2] + o1[3] * o1[3]);
                                u32x4 w; w.x = cvtpk(o0[0], o0[1]); w.y = cvtpk(o0[2], o0[3]); w.z = cvtpk(o1[0], o1[1]); w.w = cvtpk(o1[2], o1[3]);
                                *(u32x4*)(hp + ((size_t)(aa * 128 + m * 16) * DM + bj * 128) * 2) = w;
                                if constexpr (F8) *(u32x2*)(hb8 + (rowoff >> 1) + ((size_t)(aa * 128 + m * 16) * DM + bj * 128)) = pk8_fp8(o0, o1);
                            }
                        }
                        if constexpr (!OUTF32) { s += xor_f<16>(s); s = xor32_sum(s); if (fq == 0) ssq_out[(size_t)row * 32 + u.pn * 4 + wc] = s; }
                    }
                __builtin_amdgcn_sched_barrier(0);
            }
        }
    }
};

struct WinSplit {
    static constexpr bool PERM = true, AFTER_DRAIN = false, MIDK = false; static constexpr int NSTORE = 16;
    unsigned char* R; const float* ssq; LAS float* tab; unsigned* kdone; int pn0; float sc;
    template <int ACT, bool WT = false>
    __device__ __forceinline__ void body(const f32x4 (&acc)[2][2][4][2], bf16_t* dst, int ld, int row0, int col0, int wr, int fr) const {
#pragma unroll
        for (int ai = 0; ai < 2; ++ai)
#pragma unroll
            for (int m = 0; m < 4; ++m) {
                const int row = row0 + ai * 128 + m * 16;
                const float rstd = tab[wr * 64 + fr + ai * 128 + m * 16] * sc;
#pragma unroll
                for (int bj = 0; bj < 2; ++bj) {
                    f32x4 v0 = acc[ai][bj][m][0] * rstd, v1 = acc[ai][bj][m][1] * rstd;
                    if (ACT == 1) {
#pragma unroll
                        for (int j = 0; j < 4; ++j) { v0[j] = 1.0f + __expf(fminf(-v0[j], 30.f)); v1[j] = 1.0f + __expf(fminf(-v1[j], 30.f)); }
                    }
                    if (ACT == 2) {
#pragma unroll
                        for (int j = 0; j < 4; ++j) { v0[j] = siluf(v0[j]); v1[j] = siluf(v1[j]); }
                    }
                    u32x4 w; w.x = cvtpk(v0[0], v0[1]); w.y = cvtpk(v0[2], v0[3]); w.z = cvtpk(v1[0], v1[1]); w.w = cvtpk(v1[2], v1[3]);
                    if (WT) { unsigned long long* q8 = (unsigned long long*)(dst + (size_t)row * ld + col0 + bj * 128);
                        __hip_atomic_store(q8, ((unsigned long long)w.y << 32) | w.x, __ATOMIC_RELAXED, __HIP_MEMORY_SCOPE_AGENT); __hip_atomic_store(q8 + 1, ((unsigned long long)w.w << 32) | w.z, __ATOMIC_RELAXED, __HIP_MEMORY_SCOPE_AGENT); }
                    else __builtin_nontemporal_store(w, (u32x4*)(dst + (size_t)row * ld + col0 + bj * 128));
                }
            }
    }
    __device__ __forceinline__ void body_gate(const f32x4 (&acc)[2][2][4][2], unsigned char* dst, int row0, int col0, int wr, int fr) const {
#pragma unroll
        for (int ai = 0; ai < 2; ++ai)
#pragma unroll
            for (int m = 0; m < 4; ++m) {
                const int row = row0 + ai * 128 + m * 16;
                const float rstd = tab[wr * 64 + fr + ai * 128 + m * 16] * sc;
#pragma unroll
                for (int bj = 0; bj < 2; ++bj) {
                    const f32x4 v0 = acc[ai][bj][m][0] * rstd, v1 = acc[ai][bj][m][1] * rstd;
                    unsigned lo = 0u, hi = 0u;
#pragma unroll
                    for (int j = 0; j < 4; ++j) {
                        lo = __builtin_amdgcn_cvt_pk_u8_f32(fmaxf(sigm(v0[j]) * 255.0f, 1.0f), j, lo);
                        hi = __builtin_amdgcn_cvt_pk_u8_f32(fmaxf(sigm(v1[j]) * 255.0f, 1.0f), j, hi);
                    }
                    u32x2 w; w.x = lo; w.y = hi;
                    __builtin_nontemporal_store(w, (u32x2*)(dst + (size_t)row * DM + col0 + bj * 128));
                }
            }
    }
    __device__ __forceinline__ void operator()(const f32x4 (&acc)[2][2][4][2], const Unit& u, int wr, int wc, int fr, int fq) const {
        const int pn = __builtin_amdgcn_readfirstlane(u.pn) + pn0; bf16_t* dst; int ld, colt;
        if (pn < 12)       { dst = (bf16_t*)(R + R_US + (size_t)(pn >> 1) * SZ512); ld = 512; colt = (pn & 1) * 256; }
        else if (pn < 16)  { dst = (bf16_t*)(R + R_AQ); ld = 1024; colt = (pn - 12) * 256; }
        else if (pn == 16) { dst = (bf16_t*)(R + R_AK); ld = 256; colt = 0; }
        else if (pn == 17) { dst = (bf16_t*)(R + R_AV); ld = 256; colt = 0; }
        else { const int g = (pn - 18) >> 3; dst = (bf16_t*)(R + R_GATE + (size_t)g * 4 * SZ512); ld = 2048; colt = ((pn - 18) & 7) * 256; }
        const int row0 = u.pm * 256 + wr * 64 + fr, col0 = colt + wc * 32 + 8 * fq;
        unit_rstd_table(ssq, tab, u.pm, wr, wc, fr, fq);
        if (pn >= 18) body_gate(acc, R + R_GATE + (size_t)((pn - 18) >> 3) * MT * DM, row0, col0, wr, fr);
        else if (pn == 2 || pn == 3) body<2>(acc, dst, ld, row0, col0, wr, fr);
        else if (pn == 16) {
            body<0, true>(acc, dst, ld, row0, col0, wr, fr);
            asm volatile("s_waitcnt vmcnt(0)" ::: "memory");
            if ((fr | fq) == 0) __hip_atomic_fetch_add(kdone, 1u, __ATOMIC_RELAXED, __HIP_MEMORY_SCOPE_AGENT);
        }
        else body<0>(acc, dst, ld, row0, col0, wr, fr);
    }
};

struct Glu {
    static constexpr bool PERM = true, AFTER_DRAIN = false, MIDK = false; static constexpr int NSTORE = 16;
    const bf16_t* Z; bf16_t* Y;
    __device__ __forceinline__ void operator()(const f32x4 (&acc)[2][2][4][2], const Unit& u, int wr, int wc, int fr, int fq) const {
        const int row0 = u.pm * 256 + wr * 64 + fr, col0 = u.pn * 256 + wc * 32 + 8 * fq;
#pragma unroll
        for (int ai = 0; ai < 2; ++ai) {
            u32x4 zz[4][2];
#pragma unroll
            for (int m = 0; m < 4; ++m)
#pragma unroll
                for (int bj = 0; bj < 2; ++bj) zz[m][bj] = *(const u32x4*)(Z + (size_t)(row0 + ai * 128 + m * 16) * 512 + col0 + bj * 128);
            __builtin_amdgcn_sched_barrier(0);
#pragma unroll
            for (int m = 0; m < 4; ++m)
#pragma unroll
                for (int bj = 0; bj < 2; ++bj) {
                    const size_t offy = (size_t)(row0 + ai * 128 + m * 16) * YLD + col0 + bj * 128;
                    const u32x4 z = zz[m][bj];
                    const f32x4 a0 = acc[ai][bj][m][0], a1 = acc[ai][bj][m][1];
                    u32x4 w;
                    w.x = cvtpk(bflo(z.x) * sigm(a0[0]), bfhi(z.x) * sigm(a0[1])); w.y = cvtpk(bflo(z.y) * sigm(a0[2]), bfhi(z.y) * sigm(a0[3]));
                    w.z = cvtpk(bflo(z.z) * sigm(a1[0]), bfhi(z.z) * sigm(a1[1])); w.w = cvtpk(bflo(z.w) * sigm(a1[2]), bfhi(z.w) * sigm(a1[3]));
                    *(u32x4*)(Y + offy) = w;
                }
            __builtin_amdgcn_sched_barrier(0);
        }
    }
};

#ifndef MID_NB
#define MID_NB 1
#endif
struct MergeFused {
    static constexpr bool PERM = true, AFTER_DRAIN = false, MIDK = true; static constexpr int NSTORE = 16;
    const unsigned char* G; bf16_t* Mg;
#define UB0(w) ((float)((w) & 0xffu))
#define UB1(w) ((float)(((w) >> 8) & 0xffu))
#define UB2(w) ((float)(((w) >> 16) & 0xffu))
#define UB3(w) ((float)((w) >> 24))
    __device__ __forceinline__ void mid(f32x4 (&acc)[2][2][4][2], const Unit& u, int b, int wr, int wc, int fr, int fq) const {
        const int row0 = u.pm * 256 + wr * 64 + fr, col0 = u.pn * 256 + wc * 32 + 8 * fq;
        size_t rowoff = (size_t)row0 * DM + col0;
        asm volatile("" : "+v"(rowoff));
        const unsigned char* Ga = G + (size_t)(b - 1) * MT * DM + rowoff; const unsigned char* Gb = G + (size_t)b * MT * DM + rowoff;
#pragma unroll
        for (int ai = 0; ai < 2; ++ai) {
            u32x2 ga[4][2], gb[4][2];
#pragma unroll
            for (int mm = 0; mm < 4; ++mm)
#pragma unroll
                for (int bj = 0; bj < 2; ++bj) {
                    const size_t off = (size_t)(ai * 128 + mm * 16) * DM + bj * 128;
                    asm volatile("global_load_dwordx2 %0, %1, off" : "=&v"(ga[mm][bj]) : "v"(Ga + off) : "memory");
                    asm volatile("global_load_dwordx2 %0, %1, off" : "=&v"(gb[mm][bj]) : "v"(Gb + off) : "memory");
                }
            asm volatile("s_waitcnt vmcnt(0)" ::: "memory");
#pragma unroll
            for (int m = 0; m < 4; ++m)
#pragma unroll
                for (int bj = 0; bj < 2; ++bj) {
                    u32x2 a = ga[m][bj], c = gb[m][bj];
                    asm volatile("" : "+v"(a), "+v"(c));
                    f32x4 r0, r1;
                    r0[0] = UB0(a.x) * __builtin_amdgcn_rcpf(UB0(c.x)); r0[1] = UB1(a.x) * __builtin_amdgcn_rcpf(UB1(c.x));
                    r0[2] = UB2(a.x) * __builtin_amdgcn_rcpf(UB2(c.x)); r0[3] = UB3(a.x) * __builtin_amdgcn_rcpf(UB3(c.x));
                    r1[0] = UB0(a.y) * __builtin_amdgcn_rcpf(UB0(c.y)); r1[1] = UB1(a.y) * __builtin_amdgcn_rcpf(UB1(c.y));
                    r1[2] = UB2(a.y) * __builtin_amdgcn_rcpf(UB2(c.y)); r1[3] = UB3(a.y) * __builtin_amdgcn_rcpf(UB3(c.y));
                    if (MRG_FP8 && b == 2) { r0 = r0 * (YATT_SC * WBR_SC); r1 = r1 * (YATT_SC * WBR_SC); }
                    acc[ai][bj][m][0] = acc[ai][bj][m][0] * r0; acc[ai][bj][m][1] = acc[ai][bj][m][1] * r1;
                }
        }
    }
    __device__ __forceinline__ void operator()(const f32x4 (&acc)[2][2][4][2], const Unit& u, int wr, int wc, int fr, int fq) const {
        const int row0 = u.pm * 256 + wr * 64 + fr, col0 = u.pn * 256 + wc * 32 + 8 * fq;
        size_t rowoff = (size_t)row0 * DM + col0;
        asm volatile("" : "+v"(rowoff));
        const unsigned char* G2 = G + (size_t)2 * MT * DM + rowoff; char* Mo = (char*)Mg + 2 * rowoff;
        constexpr float FS = (1.0f / 255.0f) * (MRG_FP8 ? 1.0f / (YATT_SC * WBR_SC) : 1.0f);
#pragma unroll
        for (int ai = 0; ai < 2; ++ai) {
            u32x2 gg[4][2];
#pragma unroll
            for (int m = 0; m < 4; ++m)
#pragma unroll
                for (int bj = 0; bj < 2; ++bj) asm volatile("global_load_dwordx2 %0, %1, off" : "=&v"(gg[m][bj]) : "v"(G2 + ((size_t)(ai * 128 + m * 16) * DM + bj * 128)) : "memory");
            asm volatile("s_waitcnt vmcnt(0)" ::: "memory");
#pragma unroll
            for (int m = 0; m < 4; ++m)
#pragma unroll
                for (int bj = 0; bj < 2; ++bj) {
                    u32x2 g = gg[m][bj]; asm volatile("" : "+v"(g));
                    const f32x4 a0 = acc[ai][bj][m][0] * FS, a1 = acc[ai][bj][m][1] * FS;
                    u32x4 w;
                    w.x = cvtpk(UB0(g.x) * a0[0], UB1(g.x) * a0[1]); w.y = cvtpk(UB2(g.x) * a0[2], UB3(g.x) * a0[3]);
                    w.z = cvtpk(UB0(g.y) * a1[0], UB1(g.y) * a1[1]); w.w = cvtpk(UB2(g.y) * a1[2], UB3(g.y) * a1[3]);
                    *(u32x4*)(Mo + ((size_t)(ai * 128 + m * 16) * DM + bj * 128) * 2) = w;
                }
        }
    }
#undef UB0
#undef UB1
#undef UB2
#undef UB3
};
struct NullEpi {
    static constexpr bool PERM = true, AFTER_DRAIN = false, MIDK = false; static constexpr int NSTORE = 0;
    float* sink;
    __device__ __forceinline__ void operator()(const f32x4 (&acc)[2][2][4][2], const Unit& u, int wr, int wc, int fr, int fq) const {
        f32x4 s = {0.f, 0.f, 0.f, 0.f};
#pragma unroll
        for (int ai = 0; ai < 2; ++ai)
#pragma unroll
            for (int bj = 0; bj < 2; ++bj)
#pragma unroll
                for (int m = 0; m < 4; ++m) { s = s + acc[ai][bj][m][0]; s = s + acc[ai][bj][m][1]; }
        const float t = (s[0] + s[1]) + (s[2] + s[3]);
        if (t == 1.2345e37f) sink[u.pm] = t;
    }
};
}
#define LDS_BARRIER() do { asm volatile("s_waitcnt lgkmcnt(0)" ::: "memory"); __builtin_amdgcn_s_barrier(); asm volatile("" ::: "memory"); } while (0)
#define MFMA16(a, b, c) __builtin_amdgcn_mfma_f32_16x16x32_bf16((a), (b), (c), 0, 0, 0)
#define MFMA32(a, b, c) __builtin_amdgcn_mfma_f32_32x32x16_bf16((a), (b), (c), 0, 0, 0)

struct CvtJob { const float* W; const float* gain; bf16_t* dst; int ldw, K, Np, mode, ldd; };
__device__ __forceinline__ int cvt_col(int np, int mode) { if (mode == 0) return np; const int t = np >> 8, w = np & 255; return (w < 128) ? t * 128 + w : DFF + t * 128 + (w - 128); }
struct CvtRegs { f32x4 v[4]; float g[4]; };
__device__ __forceinline__ void cvt_load(const CvtJob& J, int tn, int tk, int c4, int r, CvtRegs& X) {
    const int k0 = tk * 128, col = cvt_col(tn * 64 + 4 * c4, J.mode);
    const float* src = J.W + (size_t)k0 * J.ldw + col;
#pragma unroll
    for (int i = 0; i < 4; ++i) { const int k = r + 32 * i; X.v[i] = *(const f32x4*)(src + (size_t)k * J.ldw); X.g[i] = J.gain ? J.gain[k0 + k] : 1.0f; }
}
__device__ __forceinline__ unsigned char f2fp8(float x) { return (unsigned char)(__builtin_amdgcn_cvt_pk_fp8_f32(x, x, 0, false) & 0xff); }
__device__ __forceinline__ void cvt_load8(const CvtJob& J, int tn, int tk, int c4, int r, CvtRegs& X) {
    const int k0 = tk * 128, col = tn * 64 + 4 * c4;
    const float* src = J.W + (size_t)k0 * J.ldw + col;
#pragma unroll
    for (int i = 0; i < 4; ++i) { const int k = 4 * r + i; X.v[i] = *(const f32x4*)(src + (size_t)k * J.ldw); X.g[i] = J.gain ? J.gain[k0 + k] : 1.0f; }
}
__device__ __forceinline__ void cvt_job8(LAS unsigned char* lds, const CvtJob& J, float scale, int& base, int ldd8) {
    LAS unsigned* T = (LAS unsigned*)lds;
    int tid_l = threadIdx.x; asm volatile("" : "+v"(tid_l)); const int tid = tid_l, c4 = tid & 15, r = tid >> 4, row = tid >> 3, seg = tid & 7;
    const int ntn = J.Np / 64, ntk = J.K / 128, nt = ntn * ntk;
    const int G = (int)gridDim.x, rank = (int)blockIdx.x;
    int first = rank - (base % G); if (first < 0) first += G;
    base += nt;
    if (first >= nt) return;
    CvtRegs X; cvt_load8(J, first % ntn, first / ntn, c4, r, X);
    for (int t = first; t < nt; t += G) {
        const int tn = t % ntn, tk = t / ntn;
        const float g0 = X.g[0] * scale, g1 = X.g[1] * scale, g2 = X.g[2] * scale, g3 = X.g[3] * scale;
#pragma unroll
        for (int e = 0; e < 4; ++e) {
            int w = __builtin_amdgcn_cvt_pk_fp8_f32(X.v[0][e] * g0, X.v[1][e] * g1, 0, false); w = __builtin_amdgcn_cvt_pk_fp8_f32(X.v[2][e] * g2, X.v[3][e] * g3, w, true);
            T[(4 * c4 + e) * 33 + r] = (unsigned)w; }
        if (t + G < nt) cvt_load8(J, (t + G) % ntn, (t + G) / ntn, c4, r, X);
        LDS_BARRIER();
        u32x4 v; v.x = T[row * 33 + seg * 4]; v.y = T[row * 33 + seg * 4 + 1]; v.z = T[row * 33 + seg * 4 + 2]; v.w = T[row * 33 + seg * 4 + 3];
        *(u32x4*)((unsigned char*)J.dst + (size_t)(tn * 64 + row) * ldd8 + tk * 128 + seg * 16) = v;
        LDS_BARRIER();
    }
}
__device__ __forceinline__ void cvt_job(LAS unsigned char* lds, const CvtJob& J, int& base, int wg0 = 0, int nw = 0) {
    LAS bf16_t* T = (LAS bf16_t*)lds;
    int tid_l = threadIdx.x; asm volatile("" : "+v"(tid_l)); const int tid = tid_l, c4 = tid & 15, r = tid >> 4, row = tid >> 3, seg = tid & 7;
    const int ntn = J.Np / 64, ntk = J.K / 128, nt = ntn * ntk;
    const int G = nw ? nw : (int)gridDim.x;
    const int rank = (int)blockIdx.x - wg0;
    int first = rank - (base % G); if (first < 0) first += G;
    base += nt;
    if (rank < 0 || rank >= G || first >= nt) return;
    CvtRegs X; cvt_load(J, first % ntn, first / ntn, c4, r, X);
    for (int t = first; t < nt; t += G) {
        const int tn = t % ntn, tk = t / ntn;
#pragma unroll
        for (int i = 0; i < 4; ++i) { const int k = r + 32 * i;
#pragma unroll
            for (int e = 0; e < 4; ++e) T[(4 * c4 + e) * 136 + k] = f2bf(X.v[i][e] * X.g[i]); }
        if (t + G < nt) cvt_load(J, (t + G) % ntn, (t + G) / ntn, c4, r, X);
        LDS_BARRIER();
        const LAS u32x4* s = (const LAS u32x4*)(T + row * 136 + seg * 16);
        u32x4* d = (u32x4*)(J.dst + (size_t)(tn * 64 + row) * (J.ldd ? J.ldd : J.K) + tk * 128 + seg * 16);
        d[0] = s[0]; d[1] = s[1];
        LDS_BARRIER();
    }
}

__device__ __forceinline__ void sincos_d(double x, double& s, double& c) {
    const double k = rint(x * 0.63661977236758134308);
    const double r = (x - k * 1.5707963267948966192) - k * 6.123233995736766e-17;
    const double r2 = r * r;
    double sp = -1.0 / 1307674368000.0; sp = sp * r2 + 1.0 / 6227020800.0; sp = sp * r2 - 1.0 / 39916800.0; sp = sp * r2 + 1.0 / 362880.0; sp = sp * r2 - 1.0 / 5040.0; sp = sp * r2 + 1.0 / 120.0; sp = sp * r2 - 1.0 / 6.0; sp = sp * r2 + 1.0;
    double cp = 1.0 / 20922789888000.0; cp = cp * r2 - 1.0 / 87178291200.0; cp = cp * r2 + 1.0 / 479001600.0; cp = cp * r2 - 1.0 / 3628800.0; cp = cp * r2 + 1.0 / 40320.0; cp = cp * r2 - 1.0 / 720.0; cp = cp * r2 + 1.0 / 24.0; cp = cp * r2 - 0.5; cp = cp * r2 + 1.0;
    const double sr = sp * r, cr = cp;
    const int q = ((int)k) & 3;
    s = (q == 0) ? sr : (q == 1) ? cr : (q == 2) ? -sr : -cr;
    c = (q == 0) ? cr : (q == 1) ? -sr : (q == 2) ? -cr : sr;
}
__device__ __forceinline__ double exp_d(double x) {
    const double k = rint(x * 1.4426950408889634074);
    const double r = x - k * 0.69314718055994530942;
    double p = 1.0 / 479001600.0; p = p * r + 1.0 / 39916800.0; p = p * r + 1.0 / 3628800.0; p = p * r + 1.0 / 362880.0; p = p * r + 1.0 / 40320.0; p = p * r + 1.0 / 5040.0; p = p * r + 1.0 / 720.0;
    p = p * r + 1.0 / 120.0; p = p * r + 1.0 / 24.0; p = p * r + 1.0 / 6.0; p = p * r + 0.5; p = p * r + 1.0; p = p * r + 1.0;
    return ldexp(p, (int)k);
}

struct ProArgs {
    const float* x_prompt; const float* x_sample;
    const float* lam_re; const float* lam_im; const float* log_dt; const float* b_re; const float* b_im; const float* c_re; const float* c_im; const float* lb_logits;
    unsigned char* ws;
};
__device__ __forceinline__ void prologue_phase(const ProArgs& A) {
    int tid_l = threadIdx.x; asm volatile("" : "+v"(tid_l)); const int tid = tid_l, G = gridDim.x; const size_t gtid = (size_t)blockIdx.x * NTHREADS + tid, gstride = (size_t)G * NTHREADS;
    for (size_t i = gtid; i < (size_t)DEPTH * 2 * 32 * 64; i += gstride) {
        const int n = (int)(i & 63); const size_t ldg = i >> 6;
        const double dt = exp_d((double)A.log_dt[ldg]);
        const double lr = (double)A.lam_re[i], li = (double)A.lam_im[i];
        const double mag = exp_d(lr * dt); double sn, cs; sincos_d(li * dt, sn, cs);
        const double are = mag * cs, aim = mag * sn;
        const double den = lr * lr + li * li, nre = are - 1.0;
        const double cre = (nre * lr + aim * li) / den, cim = (aim * lr - nre * li) / den;
        ((f32x2*)(A.ws + WS_ATAB))[i] = (f32x2){(float)are, (float)aim};
        bf16_t* Bm = (bf16_t*)(A.ws + WS_BM) + ldg * 128 * 16; bf16_t* Cm = (bf16_t*)(A.ws + WS_CM) + ldg * 16 * 128;
        const float* bre = A.b_re + i * 16; const float* bim = A.b_im + i * 16;
#pragma unroll
        for (int p = 0; p < 16; ++p) {
            const double br = (double)bre[p], bi = (double)bim[p];
            Bm[n * 16 + p] = f2bf((float)(cre * br - cim * bi));
            Bm[(64 + n) * 16 + p] = f2bf((float)(cre * bi + cim * br));
            Cm[p * 128 + n] = f2bf(A.c_re[(ldg * 16 + p) * 64 + n]);
            Cm[p * 128 + 64 + n] = f2bf(-A.c_im[(ldg * 16 + p) * 64 + n]);
        }
    }
    for (size_t i = gtid; i < 1024; i += gstride) {
        float lg[DEPTH], mx = -1e30f;
#pragma unroll
        for (int l = 0; l < DEPTH; ++l) { lg[l] = A.lb_logits[l * 1024 + i]; mx = fmaxf(mx, lg[l]); }
        float sum = 0.f;
#pragma unroll
        for (int l = 0; l < DEPTH; ++l) { lg[l] = expf(lg[l] - mx); sum += lg[l]; }
        float cum = 0.f; const float p0 = lg[0] / sum;
#pragma unroll
        for (int l = 0; l < DEPTH; ++l) { cum += lg[l] / sum; float v = cum - p0; v = fminf(fmaxf(v, 0.f), 1.0f - 1e-6f); ((float*)(A.ws + WS_LB))[l * 1024 + i] = v; }
    }
    {
        const int wave = tid >> 6, lane = tid & 63; float* ssq = (float*)(A.ws + WS_SSQ); bf16_t* hb = (bf16_t*)(A.ws + WS_HB);
        for (int row0 = blockIdx.x * 8 + wave; row0 < MT; row0 += 2 * G * 8) {
            f32x4 a[2][4], b[2][4]; bool ok[2];
#pragma unroll
            for (int k = 0; k < 2; ++k) { const int row = row0 + k * G * 8; ok[k] = row < MT; const int rr = ok[k] ? row : row0;
                const float* xp = (rr < PROMPT_ROWS) ? A.x_prompt + (size_t)rr * DM : A.x_sample + (size_t)(rr - PROMPT_ROWS) * DM;
#pragma unroll
                for (int i = 0; i < 4; ++i) { const int c = (i * 64 + lane) * 8; a[k][i] = *(const f32x4*)(xp + c); b[k][i] = *(const f32x4*)(xp + c + 4); } }
            __builtin_amdgcn_sched_barrier(0);
#pragma unroll
            for (int k = 0; k < 2; ++k) { const int row = row0 + k * G * 8; float s = 0.f;
#pragma unroll
                for (int i = 0; i < 4; ++i) { const int c = (i * 64 + lane) * 8; const f32x4 av = a[k][i], bv = b[k][i];
                    s += (av[0] * av[0] + av[1] * av[1]) + (av[2] * av[2] + av[3] * av[3]) + (bv[0] * bv[0] + bv[1] * bv[1]) + (bv[2] * bv[2] + bv[3] * bv[3]);
                    u32x4 w; w.x = cvtpk(av[0], av[1]); w.y = cvtpk(av[2], av[3]); w.z = cvtpk(bv[0], bv[1]); w.w = cvtpk(bv[2], bv[3]);
                    if (ok[k]) *(u32x4*)(hb + (size_t)row * DM + c) = w; }
                s = xor32_sum(s); s += xor_f<16>(s); s += xor_f<8>(s); s += xor_f<4>(s); s += xor_f<2>(s); s += xor_f<1>(s);
                if (ok[k] && lane < 32) ssq[(size_t)row * 32 + lane] = (lane == 0) ? s : 0.f; }
        }
    }
}

struct S5Args { bf16_t* us; float* yd; const f32x2* atab; const bf16_t* Bm; const bf16_t* Cm; const float* dskip; };
__device__ __forceinline__ int crow16(int r) { return (r & 3) + 8 * (r >> 2); }
__device__ __forceinline__ void s5_unit(LAS unsigned char* lds, const S5Args& A, int unit) {
    int tid_l = threadIdx.x; asm volatile("" : "+v"(tid_l)); const int tid = tid_l, w = __builtin_amdgcn_readfirstlane(tid >> 6), lane = tid & 63, l31 = lane & 31, hi = lane >> 5, fr = lane & 15, fq = lane >> 4;
    const int b = unit >> 3, gq = unit & 7, dir = w >> 2, g = gq * 4 + (w & 3);
    const size_t row0 = (size_t)b * SEQL;
    const f32x2 a = A.atab[(dir * 32 + g) * 64 + lane];
    const bf16_t* Bm = A.Bm + (size_t)(dir * 32 + g) * 128 * 16;
    const bf16_t* Cm = A.Cm + (size_t)(dir * 32 + g) * 16 * 128;
    bf16x8 bfrag[4], cfrag[4];
#pragma unroll
    for (int j = 0; j < 4; ++j) { bfrag[j] = *(const bf16x8*)(Bm + (j * 32 + l31) * 16 + hi * 8); cfrag[j] = *(const bf16x8*)(Cm + fr * 128 + j * 32 + fq * 8); }
    LAS unsigned char* X = lds + w * 8704;
    const bf16_t* ug = A.us + row0 * 512 + g * 16 + hi * 8;
    float* ydw = A.yd + ((size_t)dir * MT + row0) * 512 + g * 16 + fr;
    float xr = 0.f, xi = 0.f;
    const float one = (A.dskip != nullptr) ? 1.0f : 0.0f;
    const int tA0 = dir ? (SEQL - 1 - l31) : l31;
#define S5_LD(R, c_) do { const int cc_ = (c_) < SEQL / 32 ? (c_) : SEQL / 32 - 1; const int tn_ = dir ? tA0 - 32 * cc_ : tA0 + 32 * cc_; \
        asm volatile("global_load_dwordx4 %0, %1, off" : "=&v"(R) : "v"(ug + (size_t)tn_ * 512) : "memory"); } while (0)
    bf16x8 uA, uB, uC;
    S5_LD(uA, 0); S5_LD(uB, 1);
    asm volatile("s_waitcnt vmcnt(0)" : "+v"(uA), "+v"(uB) :: "memory");
    auto chunk = [&](const int c, bf16x8& ua, bf16x8& unext) __attribute__((always_inline)) {
        S5_LD(unext, c + 2);
        asm volatile("s_waitcnt vmcnt(17)" : "+v"(ua) :: "memory");
        const f32x16 zero = {};
        f32x16 d0 = MFMA32(ua, bfrag[0], zero), d1 = MFMA32(ua, bfrag[1], zero), d2 = MFMA32(ua, bfrag[2], zero), d3 = MFMA32(ua, bfrag[3], zero);
        asm volatile("" :: "v"(ua));
        float p0r[16], p1r[16], p0i[16], p1i[16];
#pragma unroll
        for (int r = 0; r < 16; ++r) { d0[r] *= one; d1[r] *= one; d2[r] *= one; d3[r] *= one; }
#pragma unroll
        for (int r = 0; r < 16; ++r) {
            auto s = __builtin_amdgcn_permlane32_swap(__float_as_uint(d0[r]), __float_as_uint(d1[r]), false, false);
            p0r[r] = __uint_as_float(s[0]); p1r[r] = __uint_as_float(s[1]);
            auto q = __builtin_amdgcn_permlane32_swap(__float_as_uint(d2[r]), __float_as_uint(d3[r]), false, false);
            p0i[r] = __uint_as_float(q[0]); p1i[r] = __uint_as_float(q[1]);
        }
#pragma unroll
        for (int t8 = 0; t8 < 4; ++t8) {
#pragma unroll
            for (int q = 0; q < 4; ++q) { const int r = 4 * t8 + q; const float nr = a.x * xr - a.y * xi + p0r[r], ni = a.x * xi + a.y * xr + p0i[r]; xr = nr; xi = ni; p0r[r] = xr; p0i[r] = xi; }
#pragma unroll
            for (int q = 0; q < 4; ++q) { const int r = 4 * t8 + q; const float nr = a.x * xr - a.y * xi + p1r[r], ni = a.x * xi + a.y * xr + p1i[r]; xr = nr; xi = ni; p1r[r] = xr; p1i[r] = xi; }
        }
        asm volatile("" ::: "memory");
#pragma unroll
        for (int r = 0; r < 16; ++r) {
            const int t0 = crow16(r);
            *(LAS bf16_t*)(X + t0 * 272 + lane * 2) = f2bf(p0r[r]);       *(LAS bf16_t*)(X + t0 * 272 + 128 + lane * 2) = f2bf(p0i[r]);
            *(LAS bf16_t*)(X + (t0 + 4) * 272 + lane * 2) = f2bf(p1r[r]); *(LAS bf16_t*)(X + (t0 + 4) * 272 + 128 + lane * 2) = f2bf(p1i[r]);
        }
        asm volatile("" ::: "memory"); __builtin_amdgcn_wave_barrier(); asm volatile("" ::: "memory");
#pragma unroll
        for (int tt = 0; tt < 2; ++tt) {
            f32x4 y = {0.f, 0.f, 0.f, 0.f};
#pragma unroll
            for (int kk = 0; kk < 4; ++kk) { const bf16x8 af = *(const LAS bf16x8*)(X + (tt * 16 + fr) * 272 + (kk * 32 + fq * 8) * 2); y = MFMA16(af, cfrag[kk], y); }
#pragma unroll
            for (int r = 0; r < 4; ++r) { const int s = c * 32 + tt * 16 + 4 * fq + r; const int tok = dir ? (SEQL - 1 - s) : s; ydw[(size_t)tok * 512] = y[r]; }
        }
        asm volatile("" ::: "memory"); __builtin_amdgcn_wave_barrier(); asm volatile("" ::: "memory");
    };
    static_assert((SEQL / 32) % 3 == 1, "chunk loop: 3 per trip + 1");
#pragma unroll 1
    for (int c = 0; c + 2 < SEQL / 32; c += 3) { chunk(c, uA, uC); chunk(c + 1, uB, uA); chunk(c + 2, uC, uB); }
    chunk(SEQL / 32 - 1, uA, uC);
    asm volatile("s_waitcnt vmcnt(0)" : "+v"(uA), "+v"(uB), "+v"(uC) :: "memory");
#undef S5_LD
    __threadfence(); __syncthreads();
    {
        const int c8 = (tid & 7) * 8, tt = tid >> 3;
        const f32x4 d0 = *(const f32x4*)(A.dskip + gq * 64 + c8), d1 = *(const f32x4*)(A.dskip + gq * 64 + c8 + 4);
        bf16_t* up = A.us + row0 * 512 + gq * 64 + c8; const float* y0 = A.yd + row0 * 512 + gq * 64 + c8; const float* y1 = y0 + (size_t)MT * 512;
        for (int it = 0; it < SEQL / 64; it += 4) {
            u32x4 uu[4]; f32x4 a0[4], a1[4], b0[4], b1[4];
#pragma unroll
            for (int k = 0; k < 4; ++k) { const size_t o = (size_t)((it + k) * 64 + tt) * 512;
                uu[k] = *(const u32x4*)(up + o); a0[k] = *(const f32x4*)(y0 + o); a1[k] = *(const f32x4*)(y0 + o + 4); b0[k] = *(const f32x4*)(y1 + o); b1[k] = *(const f32x4*)(y1 + o + 4); }
            __builtin_amdgcn_sched_barrier(0);
#pragma unroll
            for (int k = 0; k < 4; ++k) { const size_t o = (size_t)((it + k) * 64 + tt) * 512;
                const f32x4 u0 = {bflo(uu[k].x), bfhi(uu[k].x), bflo(uu[k].y), bfhi(uu[k].y)}, u1 = {bflo(uu[k].z), bfhi(uu[k].z), bflo(uu[k].w), bfhi(uu[k].w)};
                const f32x4 y_0 = d0 * u0 + a0[k] + b0[k], y_1 = d1 * u1 + a1[k] + b1[k];
                u32x4 w; w.x = cvtpk(gelu_tanh(y_0[0]), gelu_tanh(y_0[1])); w.y = cvtpk(gelu_tanh(y_0[2]), gelu_tanh(y_0[3])); w.z = cvtpk(gelu_tanh(y_1[0]), gelu_tanh(y_1[1])); w.w = cvtpk(gelu_tanh(y_1[2]), gelu_tanh(y_1[3]));
                *(u32x4*)(up + o) = w; }
            __builtin_amdgcn_sched_barrier(0);
        }
    }
    __syncthreads();
}

struct HgArgs { const bf16_t* q; const bf16_t* ff; const bf16_t* fb; const bf16_t* iv; bf16_t* o; const float* lb; unsigned* done; };
namespace hg {
constexpr int QT = 0, KT = 17408, KDT = 34816, VT = 53248, ST = 71680, AB = 106496, CQ = 115712, EL = 117760, END = 118272;
}
__device__ __forceinline__ void hgrn_unit(LAS unsigned char* lds, const HgArgs& A, int unit) {
    using namespace hg;
    int tid_l = threadIdx.x; asm volatile("" : "+v"(tid_l)); const int tid = tid_l, w = __builtin_amdgcn_readfirstlane(tid >> 6), lane = tid & 63, fr = lane & 15, fq = lane >> 4;
    const int dir = unit & 1, h = (unit >> 1) & 3, b = unit >> 3;
    const size_t row0 = (size_t)b * SEQL;
    const int d = tid & 127, tq = tid >> 7, col = h * 128 + d;
    const float lbv = A.lb[dir * 512 + col], oml = 1.0f - lbv;
    const bf16_t* fsrc = (dir ? A.fb : A.ff) + row0 * 512 + col;
    const bf16_t* qsrc = A.q + row0 * 512 + col;
    const bf16_t* vsrc = A.iv + row0 * 512 + col;
    f32x4 sacc[8];
#pragma unroll
    for (int i = 0; i < 8; ++i) sacc[i] = (f32x4){0.f, 0.f, 0.f, 0.f};
    { unsigned z0; asm volatile("v_mov_b32 %0, 0" : "=v"(z0));
      for (int i = tid; i < 34816 / 16; i += NTHREADS) *(LAS u32x4*)(lds + ST + i * 16) = (u32x4){z0, z0, z0, z0}; }
    unsigned rz[16], rq[16], rv[16];
#pragma unroll
    for (int j = 0; j < 16; ++j) { const int s = tq * 16 + j; const size_t o = (size_t)(dir ? (SEQL - 1 - s) : s) * 512; rz[j] = fsrc[o]; rq[j] = qsrc[o]; rv[j] = vsrc[o]; }
    LDS_BARRIER();
    for (int c = 0; c < SEQL / 64; ++c) {
        float pr[16], kk[16];
        {
            float run = 1.0f;
#pragma unroll
            for (int j = 0; j < 16; ++j) {
                const float sg = sigm(__uint_as_float(rz[j] << 16));
                run *= fmaxf(lbv + oml * sg, 1e-30f); pr[j] = run;
                kk[j] = oml * (1.0f - sg);
            }
            ((LAS float*)(lds + CQ))[tq * 128 + d] = run;
        }
        unsigned qv[16], vv[8];
#pragma unroll
        for (int j = 0; j < 16; ++j) { qv[j] = rq[j]; if (j & 1) vv[j >> 1] |= rv[j] << 16; else vv[j >> 1] = rv[j]; }
        if (c + 1 < SEQL / 64) {
#pragma unroll
            for (int j = 0; j < 16; ++j) { const int s = (c + 1) * 64 + tq * 16 + j; const size_t o = (size_t)(dir ? (SEQL - 1 - s) : s) * 512; rz[j] = fsrc[o]; rq[j] = qsrc[o]; rv[j] = vsrc[o]; }
        }
        LDS_BARRIER();
        {
            const LAS float* cq = (const LAS float*)(lds + CQ);
            const float c0 = cq[d], c1 = cq[128 + d], c2 = cq[256 + d], c3 = cq[384 + d];
            const float tot = (c0 * c1) * (c2 * c3);
            const float off = (tq == 0) ? 1.0f : (tq == 1) ? c0 : (tq == 2) ? (c0 * c1) : (c0 * c1) * c2;
            unsigned kd[8];
#pragma unroll
            for (int j = 0; j < 16; ++j) {
                const float e1 = off * pr[j];
                const float e2 = __builtin_amdgcn_rcpf(fmaxf(e1, 1.8e-35f));
                const int i = tq * 16 + j;
                *(LAS bf16_t*)(lds + QT + i * 272 + d * 2) = f2bf(__uint_as_float(qv[j] << 16) * e1);
                const float kt = kk[j] * e2;
                *(LAS bf16_t*)(lds + KT + i * 272 + d * 2) = f2bf(kt);
                const float kdv = kt * tot;
                if (j & 1) kd[j >> 1] = cvtpk(__uint_as_float(kd[j >> 1]), kdv); else kd[j >> 1] = __float_as_uint(kdv);
            }
            LAS u32x4* kp = (LAS u32x4*)(lds + KDT + d * 144 + tq * 32); kp[0] = (u32x4){kd[0], kd[1], kd[2], kd[3]}; kp[1] = (u32x4){kd[4], kd[5], kd[6], kd[7]};
            LAS u32x4* vp = (LAS u32x4*)(lds + VT + d * 144 + tq * 32);  vp[0] = (u32x4){vv[0], vv[1], vv[2], vv[3]}; vp[1] = (u32x4){vv[4], vv[5], vv[6], vv[7]};
            if (tq == 0) ((LAS float*)(lds + EL))[d] = tot;
        }
        LDS_BARRIER();
        {
            const int ti = w >> 1;
#pragma unroll
            for (int sj = 0; sj < 2; ++sj) {
                const int si = 2 * (w & 1) + sj;
                f32x4 acc = {0.f, 0.f, 0.f, 0.f};
                if (si <= ti) {
#pragma unroll
                    for (int k = 0; k < 4; ++k) {
                        const bf16x8 ka = *(const LAS bf16x8*)(lds + KT + (16 * si + fr) * 272 + (k * 32 + fq * 8) * 2);
                        const bf16x8 qb = *(const LAS bf16x8*)(lds + QT + (16 * ti + fr) * 272 + (k * 32 + fq * 8) * 2);
                        acc = MFMA16(ka, qb, acc);
                    }
                    if (si == ti) {
#pragma unroll
                        for (int r = 0; r < 4; ++r) if (4 * fq + r > fr) acc[r] = 0.f;
                    }
                }
                u32x2 pk; pk.x = cvtpk(acc[0], acc[1]); pk.y = cvtpk(acc[2], acc[3]);
                *(LAS u32x2*)(lds + AB + (16 * ti + fr) * 144 + (16 * si + 4 * fq) * 2) = pk;
            }
        }
        f32x4 oacc[4];
#pragma unroll
        for (int ti = 0; ti < 4; ++ti) oacc[ti] = (f32x4){0.f, 0.f, 0.f, 0.f};
#pragma unroll
        for (int k = 0; k < 4; ++k) {
            const bf16x8 sb = *(const LAS bf16x8*)(lds + ST + (16 * w + fr) * 272 + (k * 32 + fq * 8) * 2);
#pragma unroll
            for (int ti = 0; ti < 4; ++ti) { const bf16x8 qa = *(const LAS bf16x8*)(lds + QT + (16 * ti + fr) * 272 + (k * 32 + fq * 8) * 2); oacc[ti] = MFMA16(qa, sb, oacc[ti]); }
        }
        LDS_BARRIER();
        bf16x8 vb[2];
#pragma unroll
        for (int k = 0; k < 2; ++k) vb[k] = *(const LAS bf16x8*)(lds + VT + (16 * w + fr) * 144 + (k * 32 + fq * 8) * 2);
#pragma unroll
        for (int k = 0; k < 2; ++k)
#pragma unroll
            for (int ti = 0; ti < 4; ++ti) { const bf16x8 aa = *(const LAS bf16x8*)(lds + AB + (16 * ti + fr) * 144 + (k * 32 + fq * 8) * 2); oacc[ti] = MFMA16(aa, vb[k], oacc[ti]); }
        {
            bf16_t* op = A.o + ((size_t)dir * MT + row0) * 512 + h * 128 + 16 * w + fr;
#pragma unroll
            for (int ti = 0; ti < 4; ++ti)
#pragma unroll
                for (int r = 0; r < 4; ++r) { const int s = c * 64 + 16 * ti + 4 * fq + r; const int tok = dir ? (SEQL - 1 - s) : s; if (HG_WT) __hip_atomic_store(op + (size_t)tok * 512, f2bf(oacc[ti][r]), __ATOMIC_RELAXED, __HIP_MEMORY_SCOPE_AGENT); else op[(size_t)tok * 512] = f2bf(oacc[ti][r]); }
        }
#pragma unroll
        for (int di = 0; di < 8; ++di) {
            const f32x4 el = *(const LAS f32x4*)(lds + EL + (16 * di + 4 * fq) * 4);
            sacc[di] = sacc[di] * el;
#pragma unroll
            for (int k = 0; k < 2; ++k) { const bf16x8 ka = *(const LAS bf16x8*)(lds + KDT + (16 * di + fr) * 144 + (k * 32 + fq * 8) * 2); sacc[di] = MFMA16(ka, vb[k], sacc[di]); }
            u32x2 pk; pk.x = cvtpk(sacc[di][0], sacc[di][1]); pk.y = cvtpk(sacc[di][2], sacc[di][3]);
            *(LAS u32x2*)(lds + ST + (16 * w + fr) * 272 + (16 * di + 4 * fq) * 2) = pk;
        }
        LDS_BARRIER();
    }
    WAIT_VM0();
    if ((tid & 63) == 0) __hip_atomic_fetch_add(A.done, 1u, __ATOMIC_RELAXED, __HIP_MEMORY_SCOPE_AGENT);
}

struct QkArgs { bf16_t* aq; bf16_t* ak; const float* qn; const float* kn; int nq; };
__device__ __forceinline__ void qkprep_phase(const QkArgs& A, int first_block, int nblocks) {
    int tid_l = threadIdx.x; asm volatile("" : "+v"(tid_l)); const int tid = tid_l, j = tid & 15, axis = j >> 3, sub = j & 7;
    const int bid = (int)blockIdx.x - first_block; if (bid < 0 || bid >= nblocks) return;
    const int nh = A.nq + 2, stride = nblocks * 32;
    const int d1 = axis * 64 + 4 * sub, d2 = d1 + 32;
    float inv[4];
#pragma unroll
    for (int e = 0; e < 4; ++e) inv[e] = __builtin_amdgcn_exp2f(-(float)(4 * sub + e) * (13.287712379549449f / 32.0f));
    constexpr int NB = 5;
    for (int item0 = bid * 32 + (tid >> 4); item0 < MT * nh; item0 += NB * stride) {
        bf16_t* pp[NB]; const float* gn[NB]; u32x2 w1[NB], w2[NB]; int tt[NB]; bool ok[NB];
#pragma unroll
        for (int k = 0; k < NB; ++k) {
            const int item = item0 + k * stride; ok[k] = item < MT * nh;
            const int it = ok[k] ? item : item0;
            const int row = it / nh, hh = it - row * nh + (8 - A.nq);
            if (hh < 8) { pp[k] = A.aq + (size_t)row * 1024 + hh * 128; gn[k] = A.qn; } else { pp[k] = A.ak + (size_t)row * 256 + (hh - 8) * 128; gn[k] = A.kn; }
            tt[k] = row & (SEQL - 1);
            w1[k] = *(const u32x2*)(pp[k] + d1); w2[k] = *(const u32x2*)(pp[k] + d2);
        }
        __builtin_amdgcn_sched_barrier(0);
#pragma unroll
        for (int k = 0; k < NB; ++k) {
            float x1[4] = {bflo(w1[k].x), bfhi(w1[k].x), bflo(w1[k].y), bfhi(w1[k].y)}, x2[4] = {bflo(w2[k].x), bfhi(w2[k].x), bflo(w2[k].y), bfhi(w2[k].y)};
            float s = 0.f;
#pragma unroll
            for (int e = 0; e < 4; ++e) s += x1[e] * x1[e] + x2[e] * x2[e];
            s += xor_f<1>(s); s += xor_f<2>(s); s += xor_f<4>(s); s += xor_f<8>(s);
            const float rstd = __builtin_amdgcn_rsqf(s * (1.0f / 128.0f) + 1e-6f);
            const float pos = (float)(axis == 0 ? (tt[k] >> 6) : (tt[k] & 63));
            const f32x4 g1 = *(const f32x4*)(gn[k] + d1), g2 = *(const f32x4*)(gn[k] + d2);
            float o1[4], o2[4];
#pragma unroll
            for (int e = 0; e < 4; ++e) {
                const float ang = pos * inv[e], cs = __cosf(ang), sn = __sinf(ang);
                const float y1 = x1[e] * rstd * g1[e], y2 = x2[e] * rstd * g2[e];
                o1[e] = y1 * cs - y2 * sn; o2[e] = y2 * cs + y1 * sn;
            }
            u32x2 r1, r2; r1.x = cvtpk(o1[0], o1[1]); r1.y = cvtpk(o1[2], o1[3]); r2.x = cvtpk(o2[0], o2[1]); r2.y = cvtpk(o2[2], o2[3]);
            if (ok[k]) { *(u32x2*)(pp[k] + d1) = r1; *(u32x2*)(pp[k] + d2) = r2; }
        }
        __builtin_amdgcn_sched_barrier(0);
    }
}

struct HfArgs { const bf16_t* o; const bf16_t* g; const float* gain; bf16_t* y; };
__device__ __forceinline__ void hgfin_chunk(const HfArgs& A, int chunk) {
    int tid_l = threadIdx.x; asm volatile("" : "+v"(tid_l)); const int tid = tid_l, j = tid & 15;
    const f32x4 g0 = *(const f32x4*)(A.gain + j * 8), g1 = *(const f32x4*)(A.gain + j * 8 + 4);
#pragma unroll 1
    for (int trip = 0; trip < 2; ++trip) {
        const int item = chunk * 256 + trip * 128 + (tid >> 4);
        u32x4 oa[4], ob[4], gg[4];
#pragma unroll
        for (int k = 0; k < 4; ++k) { const size_t off = (size_t)(item + k * 32) * 128 + j * 8;
            oa[k] = *(const u32x4*)(A.o + off); ob[k] = *(const u32x4*)(A.o + (size_t)MT * 512 + off);
            gg[k] = *(const u32x4*)(A.g + off); }
        __builtin_amdgcn_sched_barrier(0);
#pragma unroll
        for (int k = 0; k < 4; ++k) { const int it = item + k * 32;
            const f32x4 s0 = {bflo(oa[k].x) + bflo(ob[k].x), bfhi(oa[k].x) + bfhi(ob[k].x), bflo(oa[k].y) + bflo(ob[k].y), bfhi(oa[k].y) + bfhi(ob[k].y)};
            const f32x4 s1 = {bflo(oa[k].z) + bflo(ob[k].z), bfhi(oa[k].z) + bfhi(ob[k].z), bflo(oa[k].w) + bflo(ob[k].w), bfhi(oa[k].w) + bfhi(ob[k].w)};
            float s = (s0[0] * s0[0] + s0[1] * s0[1]) + (s0[2] * s0[2] + s0[3] * s0[3]) + (s1[0] * s1[0] + s1[1] * s1[1]) + (s1[2] * s1[2] + s1[3] * s1[3]);
            s += xor_f<1>(s); s += xor_f<2>(s); s += xor_f<4>(s); s += xor_f<8>(s);
            const float rstd = __builtin_amdgcn_rsqf(s * (1.0f / 128.0f) + 1e-6f);
            u32x4 w;
            w.x = cvtpk(s0[0] * rstd * g0[0] * siluf(bflo(gg[k].x)), s0[1] * rstd * g0[1] * siluf(bfhi(gg[k].x)));
            w.y = cvtpk(s0[2] * rstd * g0[2] * siluf(bflo(gg[k].y)), s0[3] * rstd * g0[3] * siluf(bfhi(gg[k].y)));
            w.z = cvtpk(s1[0] * rstd * g1[0] * siluf(bflo(gg[k].z)), s1[1] * rstd * g1[1] * siluf(bfhi(gg[k].z)));
            w.w = cvtpk(s1[2] * rstd * g1[2] * siluf(bflo(gg[k].w)), s1[3] * rstd * g1[3] * siluf(bfhi(gg[k].w)));
            *(u32x4*)(A.y + (size_t)(it >> 2) * YLD + 512 + (it & 3) * 128 + j * 8) = w; }
        __builtin_amdgcn_sched_barrier(0);
    }
}
__device__ __forceinline__ void hgfin_phase(const HfArgs& A) {
    int tid_l = threadIdx.x; asm volatile("" : "+v"(tid_l)); const int tid = tid_l, j = tid & 15;
    const f32x4 g0 = *(const f32x4*)(A.gain + j * 8), g1 = *(const f32x4*)(A.gain + j * 8 + 4);
    const int stride = gridDim.x * 32;
    int item = blockIdx.x * 32 + (tid >> 4);
    for (; item + 3 * stride < MT * 4; item += 4 * stride) {
        u32x4 oa[4], ob[4], gg[4];
#pragma unroll
        for (int k = 0; k < 4; ++k) { const size_t off = (size_t)(item + k * stride) * 128 + j * 8;
            oa[k] = *(const u32x4*)(A.o + off); ob[k] = *(const u32x4*)(A.o + (size_t)MT * 512 + off);
            gg[k] = *(const u32x4*)(A.g + off); }
        __builtin_amdgcn_sched_barrier(0);
#pragma unroll
        for (int k = 0; k < 4; ++k) { const int it = item + k * stride;
            const f32x4 s0 = {bflo(oa[k].x) + bflo(ob[k].x), bfhi(oa[k].x) + bfhi(ob[k].x), bflo(oa[k].y) + bflo(ob[k].y), bfhi(oa[k].y) + bfhi(ob[k].y)};
            const f32x4 s1 = {bflo(oa[k].z) + bflo(ob[k].z), bfhi(oa[k].z) + bfhi(ob[k].z), bflo(oa[k].w) + bflo(ob[k].w), bfhi(oa[k].w) + bfhi(ob[k].w)};
            float s = (s0[0] * s0[0] + s0[1] * s0[1]) + (s0[2] * s0[2] + s0[3] * s0[3]) + (s1[0] * s1[0] + s1[1] * s1[1]) + (s1[2] * s1[2] + s1[3] * s1[3]);
            s += xor_f<1>(s); s += xor_f<2>(s); s += xor_f<4>(s); s += xor_f<8>(s);
            const float rstd = __builtin_amdgcn_rsqf(s * (1.0f / 128.0f) + 1e-6f);
            u32x4 w;
            w.x = cvtpk(s0[0] * rstd * g0[0] * siluf(bflo(gg[k].x)), s0[1] * rstd * g0[1] * siluf(bfhi(gg[k].x)));
            w.y = cvtpk(s0[2] * rstd * g0[2] * siluf(bflo(gg[k].y)), s0[3] * rstd * g0[3] * siluf(bfhi(gg[k].y)));
            w.z = cvtpk(s1[0] * rstd * g1[0] * siluf(bflo(gg[k].z)), s1[1] * rstd * g1[1] * siluf(bfhi(gg[k].z)));
            w.w = cvtpk(s1[2] * rstd * g1[2] * siluf(bflo(gg[k].w)), s1[3] * rstd * g1[3] * siluf(bfhi(gg[k].w)));
            *(u32x4*)(A.y + (size_t)(it >> 2) * YLD + 512 + (it & 3) * 128 + j * 8) = w; }
        __builtin_amdgcn_sched_barrier(0);
    }
    for (; item < MT * 4; item += stride) {
        const size_t off = (size_t)item * 128 + j * 8;
        const u32x4 oa = *(const u32x4*)(A.o + off), ob = *(const u32x4*)(A.o + (size_t)MT * 512 + off);
        const f32x4 s0 = {bflo(oa.x) + bflo(ob.x), bfhi(oa.x) + bfhi(ob.x), bflo(oa.y) + bflo(ob.y), bfhi(oa.y) + bfhi(ob.y)};
        const f32x4 s1 = {bflo(oa.z) + bflo(ob.z), bfhi(oa.z) + bfhi(ob.z), bflo(oa.w) + bflo(ob.w), bfhi(oa.w) + bfhi(ob.w)};
        float s = (s0[0] * s0[0] + s0[1] * s0[1]) + (s0[2] * s0[2] + s0[3] * s0[3]) + (s1[0] * s1[0] + s1[1] * s1[1]) + (s1[2] * s1[2] + s1[3] * s1[3]);
        s += xor_f<1>(s); s += xor_f<2>(s); s += xor_f<4>(s); s += xor_f<8>(s);
        const float rstd = __builtin_amdgcn_rsqf(s * (1.0f / 128.0f) + 1e-6f);
        const u32x4 gg = *(const u32x4*)(A.g + off);
        u32x4 w;
        w.x = cvtpk(s0[0] * rstd * g0[0] * siluf(bflo(gg.x)), s0[1] * rstd * g0[1] * siluf(bfhi(gg.x)));
        w.y = cvtpk(s0[2] * rstd * g0[2] * siluf(bflo(gg.y)), s0[3] * rstd * g0[3] * siluf(bfhi(gg.y)));
        w.z = cvtpk(s1[0] * rstd * g1[0] * siluf(bflo(gg.z)), s1[1] * rstd * g1[1] * siluf(bfhi(gg.z)));
        w.w = cvtpk(s1[2] * rstd * g1[2] * siluf(bflo(gg.w)), s1[3] * rstd * g1[3] * siluf(bfhi(gg.w)));
        *(u32x4*)(A.y + (size_t)(item >> 2) * YLD + 512 + (item & 3) * 128 + j * 8) = w;
    }
}
namespace att {
constexpr int D = 128, NW = 8, QBLK = 32, KVBLK = 64;
constexpr float SCALE = 0.088388347648318440f;
constexpr float THR = 8.f;
constexpr int LDQ = 1024, LDK = 256, LDO = 2048;
constexpr size_t SHM_V = KVBLK * D * 2, SHM_K = KVBLK * D * 2, SHM_ATTN = 2 * SHM_V + 2 * SHM_K + NW * 64 * 4;
#define KSWZ(row, colB) ((row) * 256 + ((colB) ^ (((row) & 7) << 4)))
#define SBAR() __builtin_amdgcn_sched_barrier(0)
__device__ __forceinline__ int crow(int r, int hi) { return (r & 3) + 8 * (r >> 2) + 4 * hi; }
__device__ __forceinline__ unsigned cvtpkv(float lo, float hi) { return cvtpk(lo, hi); }

__device__ __forceinline__ void partialSM(f32x16& p0, f32x16& p1, float& m_reg, float& mn, float& alpha) {
  constexpr float C = SCALE * 1.4426950408889634f;
  float pmax = p0[0]; for (int r = 1; r < 16; ++r) pmax = fmaxf(pmax, p0[r]); for (int r = 0; r < 16; ++r) pmax = fmaxf(pmax, p1[r]);
  { auto rr = __builtin_amdgcn_permlane32_swap(__float_as_uint(pmax), __float_as_uint(pmax), false, false);
    pmax = fmaxf(__uint_as_float(rr[0]), __uint_as_float(rr[1])); }
  if (__builtin_expect(__all(pmax - m_reg <= THR / SCALE), 1)) { mn = m_reg; alpha = 1.f; }
  else { mn = fmaxf(m_reg, pmax); alpha = __builtin_amdgcn_exp2f((m_reg - mn) * C); m_reg = mn; }
  float mnC = -mn * C;
  for (int r = 0; r < 16; ++r) p0[r] = fmaf(p0[r], C, mnC); for (int r = 0; r < 16; ++r) p1[r] = fmaf(p1[r], C, mnC);
  for (int r = 0; r < 16; ++r) p0[r] = __builtin_amdgcn_exp2f(p0[r]);
}
__device__ __forceinline__ void finishSM(f32x16& p0, f32x16& p1, float alpha, float& l_reg, bf16x8& pa0, bf16x8& pa1, bf16x8& pa2, bf16x8& pa3) {
  for (int r = 0; r < 16; ++r) p1[r] = __builtin_amdgcn_exp2f(p1[r]);
  float ps = 0; for (int r = 0; r < 16; ++r) ps += p0[r]; for (int r = 0; r < 16; ++r) ps += p1[r];
  { auto rr = __builtin_amdgcn_permlane32_swap(__float_as_uint(ps), __float_as_uint(ps), false, false);
    ps = __uint_as_float(rr[0]) + __uint_as_float(rr[1]); }
  l_reg = l_reg * alpha + ps;
#define PK4(P, BASE, OUT) do { unsigned a0 = cvtpkv(P[BASE + 0], P[BASE + 1]), a1 = cvtpkv(P[BASE + 2], P[BASE + 3]);   \
    unsigned b0 = cvtpkv(P[BASE + 4], P[BASE + 5]), b1 = cvtpkv(P[BASE + 6], P[BASE + 7]);                              \
    auto r0 = __builtin_amdgcn_permlane32_swap(a0, b0, false, false); auto r1 = __builtin_amdgcn_permlane32_swap(a1, b1, false, false); \
    u32x4 w = {r0[0], r1[0], r0[1], r1[1]}; OUT = *reinterpret_cast<bf16x8*>(&w); } while (0)
  PK4(p0, 0, pa0); PK4(p0, 8, pa1); PK4(p1, 0, pa2); PK4(p1, 8, pa3);
#undef PK4
}
__device__ __forceinline__ void qkt(f32x16& p0, f32x16& p1, const bf16_t* Ks, const bf16x8* qr, int r32, int hi) {
  p0 = f32x16{}; p1 = f32x16{};
  for (int d0 = 0; d0 < 8; ++d0) { int cb = (d0 * 16 + hi * 8) * 2;
    bf16x8 b0 = *reinterpret_cast<const bf16x8*>((const char*)Ks + KSWZ(r32, cb));
    bf16x8 b1 = *reinterpret_cast<const bf16x8*>((const char*)Ks + KSWZ(32 + r32, cb));
    p0 = __builtin_amdgcn_mfma_f32_32x32x16_bf16(b0, qr[d0], p0, 0, 0, 0);
    p1 = __builtin_amdgcn_mfma_f32_32x32x16_bf16(b1, qr[d0], p1, 0, 0, 0); }
}
__device__ __forceinline__ int v_st(int k, int c) { const int kk = (k & ~0xC) | ((k & 4) << 1) | ((k & 8) >> 1); return ((kk >> 3) * 4 + (c >> 5)) * 512 + ((kk & 7) * 32 + (c & 31)) * 2; }
__device__ __forceinline__ int v_rd_base(int lane) { return ((lane & 3) << 3) | (((lane >> 2) & 3) << 6) | (((lane >> 4) & 1) << 5) | (((lane >> 5) & 1) << 8); }
constexpr int v_rd_off(int d0, int ks, int half) { return d0 * 512 + ks * 4096 + half * 2048; }
template <int OFF> __device__ __forceinline__ s16x4 tr_read(int vb) {
  s16x4 r; asm volatile("ds_read_b64_tr_b16 %0, %1 offset:%2" : "=&v"(r) : "v"(vb), "i"(OFF) : "memory"); return r;
}
template <int D0> __device__ __forceinline__ void pv_one(f32x16& od, int vb, bf16x8 pa0, bf16x8 pa1, bf16x8 pa2, bf16x8 pa3) {
  const s16x4 l0 = tr_read<v_rd_off(D0, 0, 0)>(vb), h0 = tr_read<v_rd_off(D0, 0, 1)>(vb), l1 = tr_read<v_rd_off(D0, 1, 0)>(vb), h1 = tr_read<v_rd_off(D0, 1, 1)>(vb);
  const s16x4 l2 = tr_read<v_rd_off(D0, 2, 0)>(vb), h2 = tr_read<v_rd_off(D0, 2, 1)>(vb), l3 = tr_read<v_rd_off(D0, 3, 0)>(vb), h3 = tr_read<v_rd_off(D0, 3, 1)>(vb);
  asm volatile("s_waitcnt lgkmcnt(0)" ::: "memory"); SBAR();
#define PK(L, H) (bf16x8){L[0], L[1], L[2], L[3], H[0], H[1], H[2], H[3]}
  od = __builtin_amdgcn_mfma_f32_32x32x16_bf16(pa0, PK(l0, h0), od, 0, 0, 0);
  od = __builtin_amdgcn_mfma_f32_32x32x16_bf16(pa1, PK(l1, h1), od, 0, 0, 0);
  od = __builtin_amdgcn_mfma_f32_32x32x16_bf16(pa2, PK(l2, h2), od, 0, 0, 0);
  od = __builtin_amdgcn_mfma_f32_32x32x16_bf16(pa3, PK(l3, h3), od, 0, 0, 0);
#undef PK
}
__device__ __forceinline__ void pv_d0(f32x16* o, int vb, bf16x8 pa0, bf16x8 pa1, bf16x8 pa2, bf16x8 pa3) {
  pv_one<0>(o[0], vb, pa0, pa1, pa2, pa3); pv_one<1>(o[1], vb, pa0, pa1, pa2, pa3); pv_one<2>(o[2], vb, pa0, pa1, pa2, pa3); pv_one<3>(o[3], vb, pa0, pa1, pa2, pa3);
}
__device__ __forceinline__ void attn_dense_body(const bf16_t* __restrict__ Qb, const bf16_t* __restrict__ Kh, const bf16_t* __restrict__ Vh, bf16_t* __restrict__ Ob, int seq, char* lds, const float* qgain, int t0) {
  int tid_l = threadIdx.x; asm volatile("" : "+v"(tid_l)); const int tid = tid_l, wid = tid >> 6, lane = tid & 63, r32 = lane & 31, hi = lane >> 5;
  bf16_t* V_lds = (bf16_t*)lds; bf16_t* K_lds = (bf16_t*)(lds + 2 * SHM_V);
  float* ws = (float*)(lds + 2 * SHM_V + 2 * SHM_K) + wid * 64; float* li_l = ws; float* al_l = ws + 32;
  float m_reg = -1e30f, l_reg = 0; f32x16 o[4] = {}; bf16x8 qr[8];
  const bf16_t* Qw = Qb + (long)(wid * QBLK + r32) * LDQ + hi * 8;
#pragma unroll
  for (int d0 = 0; d0 < 8; ++d0) qr[d0] = *reinterpret_cast<const bf16x8*>(Qw + d0 * 16);
  if (qgain) {
    float ss = 0.f;
#pragma unroll
    for (int d0 = 0; d0 < 8; ++d0) { const u32x4 w = *reinterpret_cast<const u32x4*>(&qr[d0]);
      const float a0 = bflo(w.x), a1 = bfhi(w.x), a2 = bflo(w.y), a3 = bfhi(w.y), a4 = bflo(w.z), a5 = bfhi(w.z), a6 = bflo(w.w), a7 = bfhi(w.w);
      ss += (a0 * a0 + a1 * a1) + (a2 * a2 + a3 * a3) + (a4 * a4 + a5 * a5) + (a6 * a6 + a7 * a7); }
    ss = xor32_sum(ss);
    const float rstd = __builtin_amdgcn_rsqf(ss * (1.0f / 128.0f) + 1e-6f);
    const int t = t0 + wid * QBLK + r32; const float prow = (float)(t >> 6), pcol = (float)(t & 63);
#pragma unroll
    for (int ax = 0; ax < 2; ++ax)
#pragma unroll
      for (int dd = 0; dd < 2; ++dd) {
        const int d1 = ax * 4 + dd;
        const u32x4 w1 = *reinterpret_cast<const u32x4*>(&qr[d1]), w2 = *reinterpret_cast<const u32x4*>(&qr[d1 + 2]);
        float x1[8] = {bflo(w1.x), bfhi(w1.x), bflo(w1.y), bfhi(w1.y), bflo(w1.z), bfhi(w1.z), bflo(w1.w), bfhi(w1.w)};
        float x2[8] = {bflo(w2.x), bfhi(w2.x), bflo(w2.y), bfhi(w2.y), bflo(w2.z), bfhi(w2.z), bflo(w2.w), bfhi(w2.w)};
        const float* g1 = qgain + d1 * 16 + hi * 8; const float* g2 = g1 + 32;
#pragma unroll
        for (int e = 0; e < 8; ++e) {
          const float fi = (float)(dd * 16 + hi * 8 + e);
          const float inv = __builtin_amdgcn_exp2f(-fi * (13.287712379549449f / 32.0f)), ang = (ax ? pcol : prow) * inv, cs = __cosf(ang), sn = __sinf(ang);
          const float y1 = x1[e] * rstd * g1[e], y2 = x2[e] * rstd * g2[e];
          x1[e] = y1 * cs - y2 * sn; x2[e] = y2 * cs + y1 * sn; }
        u32x4 o1, o2;
        o1.x = cvtpk(x1[0], x1[1]); o1.y = cvtpk(x1[2], x1[3]); o1.z = cvtpk(x1[4], x1[5]); o1.w = cvtpk(x1[6], x1[7]);
        o2.x = cvtpk(x2[0], x2[1]); o2.y = cvtpk(x2[2], x2[3]); o2.z = cvtpk(x2[4], x2[5]); o2.w = cvtpk(x2[6], x2[7]);
        qr[d1] = *reinterpret_cast<bf16x8*>(&o1); qr[d1 + 2] = *reinterpret_cast<bf16x8*>(&o2);
      }
  }
  const int sr = tid >> 4, sc = (tid & 15) * 8, vst0 = v_st(sr, sc), vst1 = v_st(32 + sr, sc);
  const int vb0 = (int)(uintptr_t)V_lds + v_rd_base(lane);
  struct { bf16x8 vs0, vs1, ks0, ks1; } sr_[2];
#define SLOAD(i, k0) do { sr_[i].vs0 = *reinterpret_cast<const bf16x8*>(&Vh[(long)((k0) + sr) * LDK + sc]); sr_[i].vs1 = *reinterpret_cast<const bf16x8*>(&Vh[(long)((k0) + 32 + sr) * LDK + sc]); \
    sr_[i].ks0 = *reinterpret_cast<const bf16x8*>(&Kh[(long)((k0) + sr) * LDK + sc]); sr_[i].ks1 = *reinterpret_cast<const bf16x8*>(&Kh[(long)((k0) + 32 + sr) * LDK + sc]); } while (0)
#define SWRITE(b, i) do { *(bf16x8*)((char*)V_lds + (b) * SHM_V + vst0) = sr_[i].vs0;          \
    *(bf16x8*)((char*)V_lds + (b) * SHM_V + vst1) = sr_[i].vs1; int kc = sc * 2;               \
    *(bf16x8*)((char*)K_lds + (b) * SHM_K + KSWZ(sr, kc)) = sr_[i].ks0;                       \
    *(bf16x8*)((char*)K_lds + (b) * SHM_K + KSWZ(32 + sr, kc)) = sr_[i].ks1; } while (0)
#define SWAIT() asm volatile("s_waitcnt vmcnt(4)" ::: "memory")
#define RESC(a) do { if (__any((a) < 1.f)) { if (hi == 0) al_l[r32] = (a); asm volatile("s_waitcnt lgkmcnt(0)" ::: "memory"); \
    for (int d = 0; d < 4; ++d) for (int r = 0; r < 16; ++r) o[d][r] *= al_l[crow(r, hi)]; } } while (0)
  f32x16 pA0, pA1, pB0, pB1; float mnA, mnB, alA, alB; bf16x8 pa0, pa1, pa2, pa3; const int NT = seq / KVBLK;
  constexpr int SE = 0, SO = 1;
  SLOAD(SE, 0); asm volatile("s_waitcnt vmcnt(0)" ::: "memory"); SWRITE(0, SE); __syncthreads();
  qkt(pA0, pA1, K_lds, qr, r32, hi); partialSM(pA0, pA1, m_reg, mnA, alA);
  SLOAD(SO, KVBLK); if (2 < NT) SLOAD(SE, 2 * KVBLK);
  SWAIT(); SWRITE(1, SO); __syncthreads();
  for (int j = 1; j + 1 < NT; j += 2) {
    SBAR(); qkt(pB0, pB1, (bf16_t*)((char*)K_lds + SHM_K), qr, r32, hi);
    finishSM(pA0, pA1, alA, l_reg, pa0, pa1, pa2, pa3); SBAR();
    SLOAD(SO, (j + 2) * KVBLK); SBAR();
    pv_d0(o, vb0, pa0, pa1, pa2, pa3); partialSM(pB0, pB1, m_reg, mnB, alB);
    __syncthreads(); SWAIT(); SWRITE(0, SE);
    RESC(alB); __syncthreads();
    SBAR(); qkt(pA0, pA1, K_lds, qr, r32, hi);
    finishSM(pB0, pB1, alB, l_reg, pa0, pa1, pa2, pa3); SBAR();
    if (j + 3 < NT) SLOAD(SE, (j + 3) * KVBLK); SBAR();
    pv_d0(o, vb0 + (int)SHM_V, pa0, pa1, pa2, pa3); partialSM(pA0, pA1, m_reg, mnA, alA);
    __syncthreads(); SWAIT(); SWRITE(1, SO);
    RESC(alA); __syncthreads();
  }
  SBAR(); qkt(pB0, pB1, (bf16_t*)((char*)K_lds + SHM_K), qr, r32, hi);
  finishSM(pA0, pA1, alA, l_reg, pa0, pa1, pa2, pa3); SBAR();
  pv_d0(o, vb0, pa0, pa1, pa2, pa3); partialSM(pB0, pB1, m_reg, mnB, alB);
  __syncthreads(); RESC(alB);
  finishSM(pB0, pB1, alB, l_reg, pa0, pa1, pa2, pa3); SBAR();
  pv_d0(o, vb0 + (int)SHM_V, pa0, pa1, pa2, pa3);
  if (hi == 0) li_l[r32] = l_reg; asm volatile("s_waitcnt lgkmcnt(0)" ::: "memory");
  float rli[16];
#pragma unroll
  for (int r = 0; r < 16; ++r) rli[r] = __builtin_amdgcn_rcpf(li_l[crow(r, hi)]);
#if MRG_FP8
  unsigned char* Ow = (unsigned char*)Ob + (long)(wid * QBLK) * (YLD * 2);
#pragma unroll
  for (int r = 0; r < 16; ++r) { int orow = crow(r, hi);
    for (int d0 = 0; d0 < 4; ++d0) Ow[(long)orow * (YLD * 2) + d0 * 32 + r32] = (unsigned char)(__builtin_amdgcn_cvt_pk_fp8_f32(o[d0][r] * (rli[r] * YATT_SC), 0.f, 0, false) & 0xff); }
#else
  bf16_t* Ow = Ob + (long)(wid * QBLK) * LDO;
#pragma unroll
  for (int r = 0; r < 16; ++r) { int orow = crow(r, hi);
    for (int d0 = 0; d0 < 4; ++d0) Ow[(long)orow * LDO + d0 * 32 + r32] = f2bf(o[d0][r] * rli[r]); }
#endif
  __syncthreads();
#undef SLOAD
#undef SWRITE
#undef SWAIT
#undef RESC
}
}
#define XB_TMO      128
#define XB_XCNT(j)  (256  + 64 * (j))
#define XB_XSUB(j)  (1280 + 64 * (j))
#define XB_XGEN(j)  (2304 + 64 * (j))
#define XB_TOP      3328
#define XB_TOPGEN   3392
#define XCD_BAR_WORDS 3456
#define XB_SPIN_CAP (1u << 22)

__device__ __forceinline__ unsigned xb_ld(unsigned* p)              { return __hip_atomic_load(p, __ATOMIC_RELAXED, __HIP_MEMORY_SCOPE_AGENT); }
__device__ __forceinline__ unsigned xb_add(unsigned* p, unsigned v) { return __hip_atomic_fetch_add(p, v, __ATOMIC_RELAXED, __HIP_MEMORY_SCOPE_AGENT); }
__device__ __forceinline__ unsigned xb_xcc_id() { return (unsigned)__builtin_amdgcn_s_getreg((3 << 11) | 20) & 0xFu; }
#define XB_SPIN(cond, bar) do { unsigned _sp = 0; while (cond) { __builtin_amdgcn_s_sleep(1); \
    if ((++_sp & 255u) == 0u) { if (xb_ld(&(bar)[XB_TMO])) break; if (_sp > XB_SPIN_CAP) { atomicAdd(&(bar)[XB_TMO], 1u); break; } } } } while (0)

struct XcdBarrier {
    unsigned* bar; unsigned x;
    volatile LAS unsigned* st;
};

__device__ __forceinline__ XcdBarrier xcd_barrier_post(unsigned* bar, volatile LAS unsigned* st) {
    XcdBarrier b; b.bar = bar; b.x = xb_xcc_id(); b.st = st;
    if (threadIdx.x == 0) st[2] = xb_add(&bar[XB_XCNT(b.x)], 1u);
    return b;
}
__device__ __forceinline__ void xcd_barrier_complete(unsigned* bar, unsigned x, unsigned& nloc, unsigned& nx, unsigned& lo8) {
    const unsigned G = gridDim.x * gridDim.y * gridDim.z;
    unsigned sum, cnt, mine, sp = 0u;
    for (;;) {
        sum = 0u; cnt = 0u; mine = 0u; lo8 = 0u;
#pragma unroll
        for (unsigned j = 0; j < 16; ++j) { const unsigned c = xb_ld(&bar[XB_XCNT(j)]); sum += c; cnt += (c > 0u) ? 1u : 0u; lo8 += (j < 8u && c > 0u) ? 1u : 0u; mine = (j == x) ? c : mine; }
        if (sum == G) break;
        __builtin_amdgcn_s_sleep(1);
        if ((++sp & 255u) == 0u) { if (xb_ld(&bar[XB_TMO])) break; if (sp > XB_SPIN_CAP) { atomicAdd(&bar[XB_TMO], 1u); break; } }
    }
    nloc = mine > 0u ? mine : 1u; nx = cnt > 0u ? cnt : 1u;
}

__device__ __forceinline__ void xcd_barrier(const XcdBarrier& b) {
    asm volatile("s_waitcnt vmcnt(0)" ::: "memory");
    __syncthreads();
    if (threadIdx.x == 0) {
        unsigned* bar = b.bar;
        __builtin_amdgcn_s_waitcnt(0);
        unsigned nloc = b.st[0], nx = b.st[1];
        if (nloc == 0u) { unsigned lo8; xcd_barrier_complete(bar, b.x, nloc, nx, lo8); b.st[0] = nloc; b.st[1] = nx; b.st[3] = (lo8 == 8u && nx == 8u) ? 1u : 0u; }
        const unsigned old = xb_add(&bar[XB_XSUB(b.x)], 1u);
        const unsigned gen = old / nloc;
        if (old + 1u == (gen + 1u) * nloc) {
            __builtin_amdgcn_fence(__ATOMIC_RELEASE, "agent");
            asm volatile("s_waitcnt vmcnt(0)" ::: "memory");
            const unsigned og = xb_add(&bar[XB_TOP], 1u);
            const unsigned tg = og / nx;
            if (og + 1u == (tg + 1u) * nx) xb_add(&bar[XB_TOPGEN], 1u);
            else XB_SPIN(xb_ld(&bar[XB_TOPGEN]) == tg, bar);
            __builtin_amdgcn_fence(__ATOMIC_ACQUIRE, "agent");
            xb_add(&bar[XB_XGEN(b.x)], 1u);
            asm volatile("s_waitcnt vmcnt(0)" ::: "memory");
        } else {
            XB_SPIN(xb_ld(&bar[XB_XGEN(b.x)]) == gen, bar);
            __builtin_amdgcn_fence(__ATOMIC_ACQUIRE, "agent");
            asm volatile("s_waitcnt vmcnt(0)" ::: "memory");
        }
    }
    __syncthreads();
}

__device__ __forceinline__ void xcd_barrier_local(const XcdBarrier& b) {
    asm volatile("s_waitcnt vmcnt(0)" ::: "memory");
    __syncthreads();
    if (threadIdx.x == 0) {
        unsigned* bar = b.bar;
        __builtin_amdgcn_s_waitcnt(0);
        const unsigned nloc = b.st[0];
        const unsigned old = xb_add(&bar[XB_XSUB(b.x)], 1u);
        const unsigned gen = old / nloc;
        if (old + 1u == (gen + 1u) * nloc) xb_add(&bar[XB_XGEN(b.x)], 1u);
        else XB_SPIN(xb_ld(&bar[XB_XGEN(b.x)]) == gen, bar);
        __builtin_amdgcn_fence(__ATOMIC_ACQUIRE, "agent");
        asm volatile("s_waitcnt vmcnt(0)" ::: "memory");
    }
    __syncthreads();
}
#ifdef SELFCHECK
#ifndef CHK_ROW0
#define CHK_ROW0 18432
#endif
constexpr size_t CK_STATS = 0, CK_CKS = 4096, CK_A = 65536, CK_T0 = CK_A + 84 * MiB, CK_T1 = CK_T0 + 16 * MiB, CK_T2 = CK_T1 + 16 * MiB, CK_T3 = CK_T2 + 16 * MiB, CK_T4 = CK_T3 + 16 * MiB;
constexpr size_t CHK_BYTES = CK_T4 + 16 * MiB;
constexpr int CK_NPH = 12;
struct CkStat { double d2, r2; unsigned mx, pad; };

__global__ void ck_sum(const unsigned* p, size_t nwords, unsigned long long* out) {
    unsigned long long s = 0;
    for (size_t i = (size_t)blockIdx.x * blockDim.x + threadIdx.x; i < nwords; i += (size_t)gridDim.x * blockDim.x) s += (unsigned long long)p[i] * (2ull * i + 1ull);
    for (int o = 32; o >= 1; o >>= 1) s += __shfl_xor(s, o);
    if ((threadIdx.x & 63) == 0) atomicAdd(out, s);
}
__global__ void ck_cmp(const void* fast, int is_bf16, long ldf, const float* ref, long ldr, int rows, int cols, int mode, CkStat* st) {
    double d2 = 0, r2 = 0; float mx = 0;
    for (size_t i = (size_t)blockIdx.x * blockDim.x + threadIdx.x; i < (size_t)rows * cols; i += (size_t)gridDim.x * blockDim.x) {
        const int r = (int)(i / cols), c = (int)(i % cols);
        const float f = is_bf16 ? bf2f(((const bf16_t*)fast)[(size_t)r * ldf + c]) : ((const float*)fast)[(size_t)r * ldf + c];
        float g = ref[(size_t)r * ldr + c]; if (mode == 1) g = 1.0f / (1.0f + expf(-g));
        float d = f - g; if (!(d == d)) d = 1e30f;
        d2 += (double)d * d; r2 += (double)g * g; mx = fmaxf(mx, fabsf(d));
    }
    for (int o = 32; o >= 1; o >>= 1) { d2 += __shfl_xor(d2, o); r2 += __shfl_xor(r2, o); mx = fmaxf(mx, __shfl_xor(mx, o)); }
    if ((threadIdx.x & 63) == 0) { atomicAdd(&st->d2, d2); atomicAdd(&st->r2, r2); atomicMax(&st->mx, __float_as_uint(mx)); }
}
__global__ void nk_rows(const float* xp, const float* xs, int row0, float* dst) {
    const size_t i = (size_t)blockIdx.x * 256 + threadIdx.x; const int r = row0 + (int)(i / DM), c = (int)(i % DM);
    dst[i] = (r < PROMPT_ROWS) ? xp[(size_t)r * DM + c] : xs[(size_t)(r - PROMPT_ROWS) * DM + c];
}
__global__ void nk_rmsnorm(const float* src, const float* gain, float* dst) {
    __shared__ float red[256]; const float* x = src + (size_t)blockIdx.x * DM; float s = 0;
    for (int c = threadIdx.x; c < DM; c += 256) s += x[c] * x[c];
    red[threadIdx.x] = s; __syncthreads();
    for (int o = 128; o >= 1; o >>= 1) { if (threadIdx.x < o) red[threadIdx.x] += red[threadIdx.x + o]; __syncthreads(); }
    const float rstd = 1.0f / sqrtf(red[0] / DM + 1e-6f);
    for (int c = threadIdx.x; c < DM; c += 256) dst[(size_t)blockIdx.x * DM + c] = x[c] * rstd * gain[c];
}
template <int MODE> __global__ void __launch_bounds__(256) nk_gemm(const float* A, int lda, const float* W, int ldw, int K, float* C, int ldc, int N2) {
    __shared__ float As[16][65], Bs[16][64], Bs2[16][64];
    const int t = threadIdx.x, tx = t & 15, ty = t >> 4, m0 = blockIdx.y * 64, n0 = blockIdx.x * 64;
    float acc[4][4] = {}, acc2[4][4] = {};
    for (int k0 = 0; k0 < K; k0 += 16) {
#pragma unroll
        for (int i = 0; i < 4; ++i) { const int idx = t + 256 * i; { const int m = idx >> 4, kk = idx & 15; As[kk][m] = A[(size_t)(m0 + m) * lda + k0 + kk]; }
            { const int kk = idx >> 6, n = idx & 63; Bs[kk][n] = W[(size_t)(k0 + kk) * ldw + n0 + n]; if (MODE == 1) Bs2[kk][n] = W[(size_t)(k0 + kk) * ldw + n0 + n + N2]; } }
        __syncthreads();
#pragma unroll
        for (int kk = 0; kk < 16; ++kk) {
            float a[4], b[4], b2[4];
#pragma unroll
            for (int i = 0; i < 4; ++i) { a[i] = As[kk][ty * 4 + i]; b[i] = Bs[kk][tx * 4 + i]; b2[i] = (MODE == 1) ? Bs2[kk][tx * 4 + i] : 0.f; }
#pragma unroll
            for (int i = 0; i < 4; ++i)
#pragma unroll
                for (int j = 0; j < 4; ++j) { acc[i][j] += a[i] * b[j]; if (MODE == 1) acc2[i][j] += a[i] * b2[j]; }
        }
        __syncthreads();
    }
#pragma unroll
    for (int i = 0; i < 4; ++i)
#pragma unroll
        for (int j = 0; j < 4; ++j) { float v = acc[i][j]; if (MODE == 1) v = v / (1.0f + expf(-v)) * acc2[i][j]; C[(size_t)(m0 + ty * 4 + i) * ldc + n0 + tx * 4 + j] = v; }
}
__global__ void nk_axpy(float* h, const float* d, float s, size_t n) { const size_t i = (size_t)blockIdx.x * 256 + threadIdx.x; if (i < n) h[i] += s * d[i]; }
__global__ void nk_s5(const float* ru, const float* lam_re, const float* lam_im, const float* log_dt, const float* b_re, const float* b_im, const float* c_re, const float* c_im, float* yd) {
    __shared__ float xr_s[64], xi_s[64], us[16], cr[16][64], ci[16][64];
    const int dg = blockIdx.x, dir = dg >> 5, g = dg & 31, n = threadIdx.x;
    const double dt = exp_d((double)log_dt[dg]); const double lr = lam_re[dg * 64 + n], li = lam_im[dg * 64 + n];
    const double mag = exp_d(lr * dt); double sn, cs; sincos_d(li * dt, sn, cs);
    const double are = mag * cs, aim = mag * sn, den = lr * lr + li * li, nre = are - 1.0, cre = (nre * lr + aim * li) / den, cim = (aim * lr - nre * li) / den;
    float bbr[16], bbi[16];
#pragma unroll
    for (int p = 0; p < 16; ++p) { const double br = b_re[(size_t)(dg * 64 + n) * 16 + p], bi = b_im[(size_t)(dg * 64 + n) * 16 + p]; bbr[p] = (float)(cre * br - cim * bi); bbi[p] = (float)(cre * bi + cim * br); }
    for (int i = n; i < 1024; i += 64) { cr[i >> 6][i & 63] = c_re[(size_t)dg * 1024 + i]; ci[i >> 6][i & 63] = c_im[(size_t)dg * 1024 + i]; }
    float xr = 0, xi = 0; const float ar = (float)are, ai = (float)aim;
    __syncthreads();
    for (int s = 0; s < SEQL; ++s) {
        const int t = dir ? SEQL - 1 - s : s;
        if (n < 16) us[n] = ru[(size_t)t * NIN + g * 16 + n];
        __syncthreads();
        float bur = 0, bui = 0;
#pragma unroll
        for (int p = 0; p < 16; ++p) { bur += bbr[p] * us[p]; bui += bbi[p] * us[p]; }
        const float nr = ar * xr - ai * xi + bur, ni = ar * xi + ai * xr + bui; xr = nr; xi = ni;
        xr_s[n] = xr; xi_s[n] = xi;
        __syncthreads();
        if (n < 16) { float y = 0; for (int m = 0; m < 64; ++m) y += xr_s[m] * cr[n][m] - xi_s[m] * ci[n][m]; yd[((size_t)dir * SEQL + t) * 512 + g * 16 + n] = y; }
        __syncthreads();
    }
}
__global__ void nk_s5z(const float* ru, const float* yd, const float* dsk, float* z) {
    const size_t i = (size_t)blockIdx.x * 256 + threadIdx.x; const int t = (int)(i >> 9), ch = (int)(i & 511);
    const float y = dsk[ch] * ru[(size_t)t * NIN + ch] + yd[i] + yd[(size_t)SEQL * 512 + i];
    z[i] = 0.5f * y * (1.0f + tanhf(0.7978845608028654f * (y + 0.044715f * y * y * y)));
}
__global__ void nk_glu(const float* z, const float* zw, float* ycat) { const size_t i = (size_t)blockIdx.x * 256 + threadIdx.x; const int t = (int)(i >> 9), ch = (int)(i & 511); ycat[(size_t)t * DM + ch] = z[i] / (1.0f + expf(-zw[i])); }
__device__ float nk_lb(const float* logits, int layer, int idx) {
    float lg[DEPTH], mx = -1e30f;
#pragma unroll
    for (int l = 0; l < DEPTH; ++l) { lg[l] = logits[l * 1024 + idx]; mx = fmaxf(mx, lg[l]); }
    float sum = 0;
#pragma unroll
    for (int l = 0; l < DEPTH; ++l) { lg[l] = expf(lg[l] - mx); sum += lg[l]; }
    float cum = 0;
#pragma unroll
    for (int l = 0; l < DEPTH; ++l) if (l <= layer) cum += lg[l] / sum;
    return fminf(fmaxf(cum - lg[0] / sum, 0.f), 1.0f - 1e-6f);
}
__global__ void __launch_bounds__(128) nk_hgrn(const float* ru, const float* logits, int layer, float* od, float* sd) {
    __shared__ float qs[128], ks[128], fs[128];
    const int h = blockIdx.x >> 1, dir = blockIdx.x & 1, v = threadIdx.x, col = h * 128 + v;
    const float lb = nk_lb(logits, layer, dir * 512 + col);
    float S[128];
#pragma unroll
    for (int d = 0; d < 128; ++d) S[d] = 0.f;
    for (int s = 0; s < SEQL; ++s) {
        const int t = dir ? SEQL - 1 - s : s; const float* r = ru + (size_t)t * NIN;
        const float z = r[(dir ? 1536 : 1024) + col], sg = 1.0f / (1.0f + expf(-z));
        fs[v] = fmaxf(lb, 1e-30f) + (1.0f - lb) * sg; ks[v] = (1.0f - lb) * (1.0f / (1.0f + expf(z)));
        { const float q = r[512 + col]; qs[v] = q / (1.0f + expf(-q)); }
        const float vt = r[2048 + col];
        __syncthreads();
        float o = 0;
#pragma unroll
        for (int d = 0; d < 128; ++d) { S[d] = fs[d] * S[d] + ks[d] * vt; o += qs[d] * S[d]; }
        od[((size_t)dir * SEQL + t) * 512 + col] = o;
        if (sd && (s == 63 || s == 127)) {
#pragma unroll
            for (int d = 0; d < 128; ++d) sd[(((size_t)(s >> 6) * 8 + blockIdx.x) * 128 + d) * 128 + v] = S[d];
        }
        __syncthreads();
    }
}
__global__ void nk_hgfin(const float* od, const float* ru, const float* gain, float* ycat) {
    __shared__ float red[128]; const int t = blockIdx.x >> 2, h = blockIdx.x & 3, v = threadIdx.x, col = h * 128 + v;
    const float s = od[(size_t)t * 512 + col] + od[((size_t)SEQL + t) * 512 + col];
    red[v] = s * s; __syncthreads();
    for (int o = 64; o >= 1; o >>= 1) { if (v < o) red[v] += red[v + o]; __syncthreads(); }
    const float rstd = 1.0f / sqrtf(red[0] / 128.0f + 1e-6f); const float g = ru[(size_t)t * NIN + 2560 + col];
    ycat[(size_t)t * DM + 512 + col] = s * rstd * gain[v] * (g / (1.0f + expf(-g)));
}
__global__ void nk_qkprep(const float* ru, const float* qn, const float* kn, float* qr, float* kr) {
    __shared__ float red[128], ys[128]; const int t = blockIdx.x / 10, hh = blockIdx.x % 10, d = threadIdx.x;
    const float x = (hh < 8) ? ru[(size_t)t * NIN + 3072 + hh * 128 + d] : ru[(size_t)t * NIN + 4096 + (hh - 8) * 128 + d];
    red[d] = x * x; __syncthreads();
    for (int o = 64; o >= 1; o >>= 1) { if (d < o) red[d] += red[d + o]; __syncthreads(); }
    const float y = x / sqrtf(red[0] / 128.0f + 1e-6f) * ((hh < 8) ? qn[d] : kn[d]);
    ys[d] = y; __syncthreads();
    const int axis = d >> 6, w = d & 63, i = w & 31; const float pos = (float)(axis == 0 ? (t >> 6) : (t & 63));
    const float inv = (float)exp_d(-(double)i / 32.0 * 9.210340371976184); double sn, cs; sincos_d((double)(pos * inv), sn, cs);
    const float o = (w < 32) ? y * (float)cs - ys[d + 32] * (float)sn : y * (float)cs + ys[d - 32] * (float)sn;
    if (hh < 8) qr[(size_t)t * 1024 + hh * 128 + d] = o; else kr[(size_t)t * 256 + (hh - 8) * 128 + d] = o;
}
__global__ void __launch_bounds__(256) nk_attn(const float* qr, const float* kr, const float* ru, float* ycat) {
    __shared__ float ps[4][2048], qs[4][128];
    const int w = threadIdx.x >> 6, lane = threadIdx.x & 63, item = blockIdx.x * 4 + w, h = item >> 11, t = item & 2047, kvh = h >> 2;
    qs[w][lane] = qr[(size_t)t * 1024 + h * 128 + lane]; qs[w][lane + 64] = qr[(size_t)t * 1024 + h * 128 + lane + 64];
    __syncthreads();
    float sc[32], mx = -1e30f;
#pragma unroll
    for (int kb = 0; kb < 32; ++kb) { const float* kp = kr + (size_t)(kb * 64 + lane) * 256 + kvh * 128; float s = 0; for (int d = 0; d < 128; ++d) s += qs[w][d] * kp[d]; sc[kb] = s * 0.08838834764831845f; mx = fmaxf(mx, sc[kb]); }
    for (int o = 32; o >= 1; o >>= 1) mx = fmaxf(mx, __shfl_xor(mx, o));
    float sum = 0;
#pragma unroll
    for (int kb = 0; kb < 32; ++kb) { const float p = expf(sc[kb] - mx); sum += p; ps[w][kb * 64 + lane] = p; }
    for (int o = 32; o >= 1; o >>= 1) sum += __shfl_xor(sum, o);
    __syncthreads();
    float o0 = 0, o1 = 0;
    for (int k = 0; k < SEQL; ++k) { const float p = ps[w][k]; const float* vp = ru + (size_t)k * NIN + 4352 + kvh * 128; o0 += p * vp[lane]; o1 += p * vp[lane + 64]; }
    ycat[(size_t)t * DM + 1024 + h * 128 + lane] = o0 / sum; ycat[(size_t)t * DM + 1024 + h * 128 + lane + 64] = o1 / sum;
}
__global__ void nk_gate(const float* ru, int b, const float* P, float* mg, int first) {
    const size_t i = (size_t)blockIdx.x * 256 + threadIdx.x; const int t = (int)(i >> 11), c = (int)(i & 2047);
    const float g = 1.0f / (1.0f + expf(-ru[(size_t)t * NIN + 4608 + b * 2048 + c]));
    mg[i] = (first ? 0.f : mg[i]) + g * P[i];
}
__global__ void ck_fill0(float* out, size_t n) { for (size_t i = (size_t)blockIdx.x * 256 + threadIdx.x; i < n; i += (size_t)gridDim.x * 256) out[i] = 0.f; }
#ifndef CHK_MODE
#define CHK_MODE 0
#endif
__device__ double ck_rel(const CkStat* st, int i) { return sqrt(st[i].d2 / (st[i].r2 + 1e-30)); }
__global__ void ck_encode(const CkStat* st, const unsigned long long* cks, int nchk, float* out) {
    if (threadIdx.x != 0 || blockIdx.x != 0) return;
    int v = 0;
    if (CHK_MODE == 0) {
        int dp = 48; for (int ph = CK_NPH - 1; ph >= 0; --ph) for (int r = 3; r >= 0; --r) if (cks[(0 * 16 + ph) * 4 + r] != cks[(1 * 16 + ph) * 4 + r]) dp = ph * 4 + r;
        int fi = nchk; for (int i = nchk - 1; i >= 0; --i) if (!(ck_rel(st, i) < 0.03)) fi = i;
        v = dp + 49 * fi;
    } else if (CHK_MODE == 1) {
        for (int r = 0; r < 4; ++r) if (cks[(0 * 16 + 5) * 4 + r] != cks[(1 * 16 + 5) * 4 + r]) v |= 1 << r;
        if (!(ck_rel(st, 19) < 0.03)) v |= 16; if (!(ck_rel(st, 20) < 0.03)) v |= 32; if (!(ck_rel(st, 21) < 0.03)) v |= 64; if (!(ck_rel(st, 11) < 0.03)) v |= 128;
        const double r19 = ck_rel(st, 19); v |= (r19 < 0.03 ? 0 : r19 < 0.3 ? 1 : r19 < 3 ? 2 : 3) << 8;
    } else if (CHK_MODE == 2) {
        if (!(ck_rel(st, 22) < 0.03)) v |= 1; if (!(ck_rel(st, 23) < 0.03)) v |= 2;
        if (cks[(0 * 16 + 5) * 4 + 1] != cks[(1 * 16 + 5) * 4 + 1]) v |= 4;
        if (!(ck_rel(st, 20) < 0.03)) v |= 8; if (!(ck_rel(st, 19) < 0.03)) v |= 16;
        const double r = ck_rel(st, 20); v |= (r < 0.03 ? 0 : r < 0.3 ? 1 : r < 3 ? 2 : 3) << 5;
    } else if (CHK_MODE == 6) {
        int fi = nchk; for (int i = nchk - 1; i >= 0; --i) if (!(ck_rel(st, i) < 0.03)) fi = i;
        v = fi;
    } else if (CHK_MODE == 5) {
        int dp = 48; for (int ph = CK_NPH - 1; ph >= 0; --ph) for (int r = 3; r >= 0; --r) if (cks[(0 * 16 + ph) * 4 + r] != cks[(1 * 16 + ph) * 4 + r]) dp = ph * 4 + r;
        v = dp;
    } else {
        const double rel = ck_rel(st, CHK_MODE - 100); double q = 20.0 * log10(rel + 1e-12) + 200.0; q = q < 0 ? 0 : (q > 1900 ? 1900 : q); v = (int)(q + 0.5);
    }
    out[0] = (float)(10 + v % 80) * __builtin_powif(10.0f, 5 + v / 80);
}

struct CkCtx { void* const* d_in; float* out; unsigned char* ws; hipStream_t s; };
static inline const float* ck_in(const CkCtx& c, int i) { return (const float*)c.d_in[i]; }
static void ck_cksum(const CkCtx& c, int run, int ph, int slot, const void* p, size_t bytes) {
    unsigned long long* o = (unsigned long long*)(c.ws + WS_CHK + CK_CKS) + (run * 16 + ph) * 4 + slot;
    hipLaunchKernelGGL(ck_sum, dim3(2048), dim3(256), 0, c.s, (const unsigned*)p, bytes / 4, o);
}
static void ck_compare(const CkCtx& c, int idx, const void* fast, int is_bf16, long ldf, const float* ref, long ldr, int rows, int cols, int mode) {
    hipLaunchKernelGGL(ck_cmp, dim3(1024), dim3(256), 0, c.s, fast, is_bf16, ldf, ref, ldr, rows, cols, mode, (CkStat*)(c.ws + WS_CHK + CK_STATS) + idx);
}
static void ck_gemm(const CkCtx& c, const float* A, int lda, const float* W, int ldw, int K, float* C, int ldc, int N) { hipLaunchKernelGGL(nk_gemm<0>, dim3(N / 64, 32), dim3(256), 0, c.s, A, lda, W, ldw, K, C, ldc, 0); }
constexpr int CK_NCHK = 20;
static void selfcheck_after_phase(const CkCtx& c, int run, int ph) {
    unsigned char* ws = c.ws; unsigned char* R = ws + WS_R; unsigned char* CK = ws + WS_CHK;
    float* bufA = (float*)(CK + CK_A); float* T0 = (float*)(CK + CK_T0); float* T1 = (float*)(CK + CK_T1); float* T2 = (float*)(CK + CK_T2); float* T3 = (float*)(CK + CK_T3); float* T4 = (float*)(CK + CK_T4);
    const int r0 = CHK_ROW0; const size_t OUTB = (size_t)MT * DM * 4, HBB = (size_t)MT * DM * 2;
    switch (ph) {
    case 0: ck_cksum(c, run, ph, 0, ws + WS_HB, HBB); ck_cksum(c, run, ph, 1, ws + WS_SSQ, (size_t)MT * 128); ck_cksum(c, run, ph, 2, ws + WS_ATAB, WS_LB + 16384 - WS_ATAB); break;
    case 1: ck_cksum(c, run, ph, 0, ws + WS_WB, WB_END); break;
    case 2: case 10: ck_cksum(c, run, ph, 0, R + R_HID, (size_t)MT * DFF * 2); break;
    case 3: case 9: case 11: ck_cksum(c, run, ph, 0, c.out, OUTB); ck_cksum(c, run, ph, 1, ws + WS_HB, HBB); ck_cksum(c, run, ph, 2, ws + WS_SSQ, (size_t)MT * 128); break;
    case 4: ck_cksum(c, run, ph, 0, R + R_US, 6 * SZ512); ck_cksum(c, run, ph, 1, R + R_AQ, 3 * SZ512); ck_cksum(c, run, ph, 2, R + R_GATE, 12 * SZ512); break;
    case 5: ck_cksum(c, run, ph, 3, R + R_AK, SZ512 / 2); break;
    case 6: ck_cksum(c, run, ph, 0, R + R_YD, 4 * SZ512); ck_cksum(c, run, ph, 1, R + R_OHG, 4 * SZ512); ck_cksum(c, run, ph, 2, R + R_US, SZ512); break;
    case 7: ck_cksum(c, run, ph, 0, R + R_YSS, 4 * SZ512); break;
    case 8: ck_cksum(c, run, ph, 0, R + R_MRG, 4 * SZ512); break;
    }
    if (run != 0) return;
    const bf16_t* hb = (const bf16_t*)(ws + WS_HB) + (size_t)r0 * DM;
    const int EW = 2048 * 2048 / 256;
    switch (ph) {
    case 0:
        hipLaunchKernelGGL(nk_rows, dim3(EW), dim3(256), 0, c.s, ck_in(c, 0), ck_in(c, 1), r0, T0);
        ck_compare(c, 0, hb, 1, DM, T0, DM, 2048, DM, 0);
        break;
    case 2:
        hipLaunchKernelGGL(nk_rmsnorm, dim3(2048), dim3(256), 0, c.s, T0, ck_in(c, 2), T1);
        hipLaunchKernelGGL(nk_gemm<1>, dim3(DFF / 64, 32), dim3(256), 0, c.s, T1, DM, ck_in(c, 3), 2 * DFF, DM, bufA, DFF, DFF);
        ck_compare(c, 1, (const bf16_t*)(R + R_HID) + (size_t)r0 * DFF, 1, DFF, bufA, DFF, 2048, DFF, 0);
        break;
    case 3:
        ck_gemm(c, bufA, DFF, ck_in(c, 4), DM, DFF, T1, DM, DM);
        hipLaunchKernelGGL(nk_axpy, dim3(EW), dim3(256), 0, c.s, T0, T1, 0.5f, (size_t)2048 * 2048);
        ck_compare(c, 2, c.out + (size_t)r0 * DM, 0, DM, T0, DM, 2048, DM, 0);
        ck_compare(c, 3, hb, 1, DM, T0, DM, 2048, DM, 0);
        break;
    case 4:
        hipLaunchKernelGGL(nk_rmsnorm, dim3(2048), dim3(256), 0, c.s, T0, ck_in(c, 5), T1);
        ck_gemm(c, T1, DM, ck_in(c, 6), NIN, DM, bufA, NIN, NIN);
        ck_compare(c, 4, (const bf16_t*)(R + R_US) + (size_t)r0 * 512, 1, 512, bufA, NIN, 2048, 512, 0);
        for (int k = 1; k < 5; ++k) ck_compare(c, 5, (const bf16_t*)(R + R_HGQ + k * SZ512) + (size_t)r0 * 512, 1, 512, bufA + 512 + 512 * k, NIN, 2048, 512, 0);
        ck_compare(c, 6, (const bf16_t*)(R + R_AQ) + (size_t)r0 * 1024, 1, 1024, bufA + 3072, NIN, 2048, 1024, 0);
        ck_compare(c, 6, (const bf16_t*)(R + R_AK) + (size_t)r0 * 256, 1, 256, bufA + 4096, NIN, 2048, 256, 0);
        ck_compare(c, 6, (const bf16_t*)(R + R_AV) + (size_t)r0 * 256, 1, 256, bufA + 4352, NIN, 2048, 256, 0);
        for (int g = 0; g < 3; ++g) ck_compare(c, 7, (const bf16_t*)(R + R_GATE + (size_t)g * 4 * SZ512) + (size_t)r0 * DM, 1, DM, bufA + 4608 + 2048 * g, NIN, 2048, DM, 1);
        break;
    case 5:
        hipLaunchKernelGGL(nk_s5, dim3(64), dim3(64), 0, c.s, bufA, ck_in(c, 7), ck_in(c, 8), ck_in(c, 9), ck_in(c, 10), ck_in(c, 11), ck_in(c, 12), ck_in(c, 13), T3);
        ck_compare(c, 8, (const float*)(R + R_YD) + (size_t)r0 * 512, 0, 512, T3, 512, 2048, 512, 0);
        ck_compare(c, 8, (const float*)(R + R_YD) + ((size_t)MT + r0) * 512, 0, 512, T3 + (size_t)SEQL * 512, 512, 2048, 512, 0);
        hipLaunchKernelGGL(nk_s5z, dim3(2048 * 512 / 256), dim3(256), 0, c.s, bufA, T3, ck_in(c, 14), T3 + 2 * 1048576);
        ck_compare(c, 9, (const bf16_t*)(R + R_US) + (size_t)r0 * 512, 1, 512, T3 + 2 * 1048576, 512, 2048, 512, 0);
        hipLaunchKernelGGL(nk_qkprep, dim3(2048 * 10), dim3(128), 0, c.s, bufA, ck_in(c, 18), ck_in(c, 19), T4, T4 + 2 * 1048576);
        ck_compare(c, 10, (const bf16_t*)(R + R_AQ) + (size_t)r0 * 1024, 1, 1024, T4, 1024, 2048, 1024, 0);
        ck_compare(c, 10, (const bf16_t*)(R + R_AK) + (size_t)r0 * 256, 1, 256, T4 + 2 * 1048576, 256, 2048, 256, 0);
        ck_gemm(c, T3 + 2 * 1048576, 512, ck_in(c, 15), 512, 512, T1, 512, 512);
        hipLaunchKernelGGL(nk_glu, dim3(2048 * 512 / 256), dim3(256), 0, c.s, T3 + 2 * 1048576, T1, T2);
        hipLaunchKernelGGL(nk_hgrn, dim3(8), dim3(128), 0, c.s, bufA, ck_in(c, 16), 0, T3, nullptr);
        ck_compare(c, 11, (const float*)(R + R_OHG) + (size_t)r0 * 512, 0, 512, T3, 512, 2048, 512, 0);
        ck_compare(c, 11, (const float*)(R + R_OHG) + ((size_t)MT + r0) * 512, 0, 512, T3 + (size_t)SEQL * 512, 512, 2048, 512, 0);
        ck_compare(c, 19, (const float*)(R + R_OHG) + (size_t)r0 * 512, 0, 512, T3, 512, 64, 512, 0);
        ck_compare(c, 20, (const float*)(R + R_OHG) + (size_t)(r0 + 64) * 512, 0, 512, T3 + (size_t)64 * 512, 512, 64, 512, 0);
        ck_compare(c, 21, (const float*)(R + R_OHG) + ((size_t)MT + r0 + 1984) * 512, 0, 512, T3 + (size_t)(SEQL + 1984) * 512, 512, 64, 512, 0);
        break;
    case 6:
        hipLaunchKernelGGL(nk_hgfin, dim3(2048 * 4), dim3(128), 0, c.s, T3, bufA, ck_in(c, 17), T2);
        ck_compare(c, 12, (const bf16_t*)(R + R_YHG) + (size_t)r0 * 512, 1, 512, T2 + 512, DM, 2048, 512, 0);
        hipLaunchKernelGGL(nk_attn, dim3(8 * 2048 / 4), dim3(256), 0, c.s, T4, T4 + 2 * 1048576, bufA, T2);
        ck_compare(c, 13, (const bf16_t*)(R + R_YAT) + (size_t)r0 * 1024, 1, 1024, T2 + 1024, DM, 2048, 1024, 0);
        break;
    case 7: ck_compare(c, 14, (const bf16_t*)(R + R_YSS) + (size_t)r0 * 512, 1, 512, T2, DM, 2048, 512, 0); break;
    case 8:
        ck_gemm(c, T2, DM, ck_in(c, 20), DM, 512, T3, DM, DM);
        hipLaunchKernelGGL(nk_gate, dim3(EW), dim3(256), 0, c.s, bufA, 0, T3, T1, 1);
        ck_gemm(c, T2 + 512, DM, ck_in(c, 20) + (size_t)512 * DM, DM, 512, T3, DM, DM);
        hipLaunchKernelGGL(nk_gate, dim3(EW), dim3(256), 0, c.s, bufA, 1, T3, T1, 0);
        ck_gemm(c, T2 + 1024, DM, ck_in(c, 20) + (size_t)1024 * DM, DM, 1024, T3, DM, DM);
        hipLaunchKernelGGL(nk_gate, dim3(EW), dim3(256), 0, c.s, bufA, 2, T3, T1, 0);
        ck_compare(c, 15, (const bf16_t*)(R + R_MRG) + (size_t)r0 * DM, 1, DM, T1, DM, 2048, DM, 0);
        break;
    case 9:
        ck_gemm(c, T1, DM, ck_in(c, 21), DM, DM, T3, DM, DM);
        hipLaunchKernelGGL(nk_axpy, dim3(EW), dim3(256), 0, c.s, T0, T3, 1.0f, (size_t)2048 * 2048);
        ck_compare(c, 16, c.out + (size_t)r0 * DM, 0, DM, T0, DM, 2048, DM, 0);
        break;
    case 10:
        hipLaunchKernelGGL(nk_rmsnorm, dim3(2048), dim3(256), 0, c.s, T0, ck_in(c, 22), T1);
        hipLaunchKernelGGL(nk_gemm<1>, dim3(DFF / 64, 32), dim3(256), 0, c.s, T1, DM, ck_in(c, 23), 2 * DFF, DM, bufA, DFF, DFF);
        ck_compare(c, 17, (const bf16_t*)(R + R_HID) + (size_t)r0 * DFF, 1, DFF, bufA, DFF, 2048, DFF, 0);
        break;
    case 11:
        ck_gemm(c, bufA, DFF, ck_in(c, 24), DM, DFF, T1, DM, DM);
        hipLaunchKernelGGL(nk_axpy, dim3(EW), dim3(256), 0, c.s, T0, T1, 0.5f, (size_t)2048 * 2048);
        ck_compare(c, 18, c.out + (size_t)r0 * DM, 0, DM, T0, DM, 2048, DM, 0);
        break;
    }
}
static void selfcheck_finish(const CkCtx& c) {
    hipLaunchKernelGGL(ck_fill0, dim3(4096), dim3(256), 0, c.s, c.out, (size_t)MT * DM);
    hipLaunchKernelGGL(ck_encode, dim3(1), dim3(64), 0, c.s, (const CkStat*)(c.ws + WS_CHK + CK_STATS), (const unsigned long long*)(c.ws + WS_CHK + CK_CKS), 19, c.out);
}
#endif
constexpr int PH_PER_LAYER = 11, N_PHASES = 1 + PH_PER_LAYER * DEPTH;
struct Params { const float* in[25]; float* out; unsigned char* ws; int ph_lo, ph_hi; };
static_assert(sizeof(Params) == 27 * 8 + 8, "Params has no padding");

#ifdef SELFCHECK
#define HG_DBG_PTR ((l == 0) ? (float*)(ws + WS_CHK + CK_T4 + 10 * MiB) : nullptr)
#else
#define HG_DBG_PTR nullptr
#endif
#ifndef DUP_GU
#define DUP_GU 1
#endif
#ifndef DUP_NULL
#define DUP_NULL 0
#endif
#ifndef DUP_CVT
#define DUP_CVT 1
#endif
#ifndef NULLX
#define NULLX 0
#endif
#ifndef DUP_MRG
#define DUP_MRG 1
#endif
#ifndef DUP_BAR
#define DUP_BAR 1
#endif
#ifndef DUP_ATT
#define DUP_ATT 1
#endif
#ifndef DUP_HG
#define DUP_HG 1
#endif
#ifndef WGM_N2048
#define WGM_N2048 4
#endif
#ifndef WGM_WIDE
#define WGM_WIDE 4
#endif
#ifndef CVT_AHEAD
#define CVT_AHEAD 0
#endif
#ifndef DUP_D0
#define DUP_D0 1
#endif
#ifndef STAGGER_US
#define STAGGER_US 0
#endif
#ifndef KPREP_TAIL
#define KPREP_TAIL 0
#endif
#ifndef XCC_LOCAL
#define XCC_LOCAL 0
#endif
#ifndef HGFIN_IN_QUEUE
#define HGFIN_IN_QUEUE 0
#endif
#ifndef XATT
#define XATT 0
#endif
#ifndef QMIX
#define QMIX 0
#endif
#ifndef GATE_FP8
#define GATE_FP8 1
#endif
#ifndef N8_COLS
#define N8_COLS (3 * DM + 1536)
#endif
constexpr int N8 = N8_COLS;
#ifndef WGM_F8
#define WGM_F8 4
#endif
#ifndef DUP_WIN
#define DUP_WIN 1
#endif
#ifndef PG8_ALIGN_EPI
#define PG8_ALIGN_EPI true
#endif
#ifndef PG8_SP2
#define PG8_SP2 true
#endif
template <class Epi, int F8FROM = -1>
__device__ __forceinline__ void run_gemm(LAS unsigned char* lds, const bf16_t* A, const bf16_t* Bt, int N, int K, const Epi& E) {
    int zz = 0; asm volatile("" : "+s"(zz));
    pg8::Gemm g{A, Bt, MT, N, K}; pg8::StaticOrder S; S.init(MT, N, (int)gridDim.x + zz, (int)blockIdx.x + zz, (F8FROM == 0) ? WGM_F8 : (N == DM) ? WGM_N2048 : ((N > DM) ? WGM_WIDE : 4));
    {
        volatile LAS unsigned* st = (volatile LAS unsigned*)(lds + LDS_MISC);
        const int xok = __builtin_amdgcn_readfirstlane((int)st[3]), nloc = __builtin_amdgcn_readfirstlane((int)st[0]), rank = __builtin_amdgcn_readfirstlane((int)st[2]);
        if (XCC_LOCAL && xok) S.init_x((int)xb_xcc_id() + zz, rank, nloc);
    }
    if (threadIdx.x == 0) ((volatile LAS int*)(lds + LDS_MISC + 1024))[256] = -1;
    if (STAGGER_US > 0) {
        const int nwg = (MT / 256) * (N / 256), rem = nwg % (int)gridDim.x;
        if (rem && (int)blockIdx.x >= rem) {
            constexpr int NG = 3; const int grp = ((int)blockIdx.x - rem) % NG + 1;
            const unsigned long long t0 = wall_clock64(), dt = (unsigned long long)(STAGGER_US * 100 * grp / (NG + 1));
            while (wall_clock64() - t0 < dt) __builtin_amdgcn_s_sleep(16);
        }
    }
    __syncthreads();
    pg8::gemm_phase<Epi, pg8::StaticOrder, PG8_ALIGN_EPI, PG8_SP2, F8FROM>(lds, g, S, E);
}

__global__ void __launch_bounds__(NTHREADS, 2) k_fwd(Params p) {
    extern __shared__ __attribute__((aligned(16))) unsigned char lds_raw[];
    LAS unsigned char* lds = (LAS unsigned char*)lds_raw;
    const int tid = threadIdx.x, G = gridDim.x;
    unsigned char* const ws0 = p.ws; float* const out0 = p.out; unsigned char* ws = ws0;
#define PH_LOCALS size_t z_ = 0; asm volatile("" : "+s"(z_)); unsigned char* ws = ws0 + z_; float* outp = (float*)((unsigned char*)out0 + z_); unsigned char* R = ws + WS_R; unsigned char* WB = ws + WS_WB; float* ssq = (float*)(ws + WS_SSQ); bf16_t* hb = (bf16_t*)(ws + WS_HB); \
    const CAS unsigned long long* PT = (const CAS unsigned long long*)(ws + WS_PTAB); (void)R; (void)WB; (void)ssq; (void)hb; (void)PT; (void)outp;
    if (tid < 4) ((LAS unsigned*)(lds + LDS_MISC))[tid] = 0u;
    __syncthreads();
    const int lo = p.ph_lo, hi = p.ph_hi;
    if (hi - lo > 1) (void)xcd_barrier_post((unsigned*)(ws + WS_BAR), (volatile LAS unsigned*)(lds + LDS_MISC));
#ifndef PH_MASK
#define PH_MASK 0xfff
#endif
#define IN(k) (lo <= (k) && (k) < hi)
#ifdef PROBE_T
#define STAMP(k) do { if (blockIdx.x == 0 && tid == 0) ((unsigned long long*)(ws + WS_BAR + 14336))[k] = wall_clock64(); } while (0)
#else
#define STAMP(k) do { } while (0)
#endif
#ifdef PROBE_SKEW
#define SKEW_PRE(k) do { if (tid == 0) ((unsigned*)(ws0 + WS_CHK))[(size_t)(k) * 256 + blockIdx.x] = (unsigned)wall_clock64(); } while (0)
#define SKEW_POST(k) do { } while (0)
#else
#define SKEW_PRE(k) do { } while (0)
#define SKEW_POST(k) do { } while (0)
#endif
#ifdef PROBE_IDLE
#define IDLE_() do { const unsigned long long t0_ = wall_clock64(); while (wall_clock64() - t0_ < (unsigned long long)(PROBE_IDLE * 100)) __builtin_amdgcn_s_sleep(8); } while (0)
#else
#define IDLE_() do { } while (0)
#endif
#define SEAM(k) do { if (IN(k) && IN((k) + 1)) { IDLE_(); SKEW_PRE(k); XcdBarrier b_; b_.bar = (unsigned*)(ws0 + WS_BAR); b_.x = xb_xcc_id(); b_.st = (volatile LAS unsigned*)(lds + LDS_MISC); for (int rb_ = 0; rb_ < DUP_BAR; ++rb_) xcd_barrier(b_); SKEW_POST(k); } STAMP((k) + 1); } while (0)

#define SEAM_L(k) do { if (IN(k) && IN((k) + 1)) { SKEW_PRE(k); XcdBarrier b_; b_.bar = (unsigned*)(ws0 + WS_BAR); b_.x = xb_xcc_id(); b_.st = (volatile LAS unsigned*)(lds + LDS_MISC); \
        const int xl_ = __builtin_amdgcn_readfirstlane((int)b_.st[3]); if (XCC_LOCAL && xl_) xcd_barrier_local(b_); else xcd_barrier(b_); SKEW_POST(k); } STAMP((k) + 1); } while (0)
    STAMP(0);
    if ((PH_MASK & 1) && IN(0)) {
        if (blockIdx.x == 0 && tid < 25) ((unsigned long long*)(ws + WS_PTAB))[tid] = (unsigned long long)p.in[tid];
        ProArgs A{p.in[0], p.in[1], p.in[7], p.in[8], p.in[9], p.in[10], p.in[11], p.in[12], p.in[13], p.in[16], ws};
        prologue_phase(A);
    }
    SEAM(0);
#ifdef PROBE_XOK
    if (((volatile LAS unsigned*)(lds + LDS_MISC))[3] == 0u) { const unsigned long long t0 = wall_clock64(); while (wall_clock64() - t0 < 200000ull) __builtin_amdgcn_s_sleep(16); }
#endif
    for (int l = 0; l < DEPTH; ++l) {
        const int pb = 1 + PH_PER_LAYER * l;
#define INP(i) ((const float*)(const GAS float*)PT[i])
        if (((PH_MASK >> 1) & 1) && IN(pb + 0)) { PH_LOCALS
          for (int rep = 0; rep < DUP_CVT; ++rep) {
            int base = 0;
            if (l == 0 || !CVT_AHEAD) {
            { CvtJob J{INP(3) + (size_t)l * DM * 2 * DFF, INP(2) + l * DM, (bf16_t*)(WB + WB_GU1), 2 * DFF, DM, 2 * DFF, 1}; cvt_job(lds, J, base); }
            { CvtJob J{INP(4) + (size_t)l * DFF * DM, nullptr, (bf16_t*)(WB + WB_D1), DM, DFF, DM, 0}; cvt_job(lds, J, base); }
#if GATE_FP8
            { CvtJob J{INP(6) + (size_t)l * DM * NIN, INP(5) + l * DM, (bf16_t*)(WB + WB_IN), NIN, DM, NIN - N8, 0}; cvt_job(lds, J, base); }
            { CvtJob J{INP(6) + (size_t)l * DM * NIN + (NIN - N8), INP(5) + l * DM, (bf16_t*)(R + R_W8), NIN, DM, N8, 0}; cvt_job8(lds, J, 32.0f, base, DM); }
#else
            { CvtJob J{INP(6) + (size_t)l * DM * NIN, INP(5) + l * DM, (bf16_t*)(WB + WB_IN), NIN, DM, NIN, 0}; cvt_job(lds, J, base); }
#endif
            }
            { CvtJob J{INP(15) + (size_t)l * 512 * 512, nullptr, (bf16_t*)(WB + WB_GLU), 512, 512, 512, 0}; cvt_job(lds, J, base); }
#if MRG_FP8
            { CvtJob J{INP(20) + (size_t)l * DM * DM, nullptr, (bf16_t*)(WB + WB_BS), DM, 1024, DM, 0, YLD}; cvt_job(lds, J, base); }
            { CvtJob J{INP(20) + (size_t)l * DM * DM + (size_t)1024 * DM, nullptr, (bf16_t*)(WB + WB_BS + 2048), DM, 1024, DM, 0, 0}; cvt_job8(lds, J, WBR_SC, base, 3072); }
#else
            { CvtJob J{INP(20) + (size_t)l * DM * DM, nullptr, (bf16_t*)(WB + WB_BS), DM, DM, DM, 0}; cvt_job(lds, J, base); }
#endif
            { CvtJob J{INP(21) + (size_t)l * DM * DM, nullptr, (bf16_t*)(WB + WB_OUT), DM, DM, DM, 0}; cvt_job(lds, J, base); }
            { CvtJob J{INP(23) + (size_t)l * DM * 2 * DFF, INP(22) + l * DM, (bf16_t*)(WB + WB_GU2), 2 * DFF, DM, 2 * DFF, 1}; cvt_job(lds, J, base); }
            { CvtJob J{INP(24) + (size_t)l * DFF * DM, nullptr, (bf16_t*)(WB + WB_D2), DM, DFF, DM, 0}; cvt_job(lds, J, base); }
          }
        }
        SEAM(pb + 0);
        if (((PH_MASK >> 2) & 1) && IN(pb + 1)) { PH_LOCALS epi::Swiglu E{(bf16_t*)(R + R_HID), ssq, (LAS float*)(lds + LDS_MISC + 1024)}; if (DUP_NULL) { epi::NullEpi E0{ssq}; run_gemm(lds, hb, (const bf16_t*)(WB + WB_GU1), 2 * DFF, DM, E0); } for (int rep = 0; rep < DUP_GU; ++rep) run_gemm(lds, hb, (const bf16_t*)(WB + WB_GU1), 2 * DFF, DM, E); }
        SEAM_L(pb + 1);
        if (((PH_MASK >> 3) & 1) && IN(pb + 2)) { PH_LOCALS
            if (NULLX == 2) { epi::NullEpi E0{ssq}; run_gemm(lds, (const bf16_t*)(R + R_HID), (const bf16_t*)(WB + WB_D1), DM, DFF, E0); }
            if (l == 0) { epi::Resid<true, false, GATE_FP8 != 0> E{INP(0), INP(1), PROMPT_ROWS, 0.5f, nullptr, hb, ssq, R + R_HB8}; run_gemm(lds, (const bf16_t*)(R + R_HID), (const bf16_t*)(WB + WB_D1), DM, DFF, E); }
            else        { epi::Resid<false, false, GATE_FP8 != 0> E{nullptr, nullptr, 0, 0.5f, nullptr, hb, ssq, R + R_HB8}; run_gemm(lds, (const bf16_t*)(R + R_HID), (const bf16_t*)(WB + WB_D1), DM, DFF, E); }
        }
        SEAM_L(pb + 2);
        if (((PH_MASK >> 4) & 1) && IN(pb + 3)) { PH_LOCALS unsigned* kdone = (unsigned*)(ws + WS_BAR + 16128) + l * 16;
#if GATE_FP8
            { epi::WinSplit E8{R, ssq, (LAS float*)(lds + LDS_MISC + 1024), kdone, (NIN - N8) / 256, 1.0f / 32.0f}; run_gemm<epi::WinSplit, 0>(lds, (const bf16_t*)(R + R_HB8), (const bf16_t*)(R + R_W8), N8, DM / 2, E8); }
            { epi::WinSplit E{R, ssq, (LAS float*)(lds + LDS_MISC + 1024), kdone, 0, 1.0f}; run_gemm(lds, hb, (const bf16_t*)(WB + WB_IN), NIN - N8, DM, E); }
#else
            epi::WinSplit E{R, ssq, (LAS float*)(lds + LDS_MISC + 1024), kdone, 0, 1.0f}; if (NULLX == 3) { epi::NullEpi E0{ssq}; run_gemm(lds, hb, (const bf16_t*)(WB + WB_IN), NIN, DM, E0); } for (int rep = 0; rep < DUP_WIN; ++rep) run_gemm(lds, hb, (const bf16_t*)(WB + WB_IN), NIN, DM, E);
#endif

            if (CVT_AHEAD && l + 1 < DEPTH) {
                const int rem = ((MT / 256) * (NIN / 256)) % G, wg0 = rem, nw = rem ? G - rem : 0; int base = 0;
                { CvtJob J{INP(3) + (size_t)(l + 1) * DM * 2 * DFF, INP(2) + (l + 1) * DM, (bf16_t*)(WB + WB_GU1), 2 * DFF, DM, 2 * DFF, 1}; cvt_job(lds, J, base, wg0, nw); }
                { CvtJob J{INP(4) + (size_t)(l + 1) * DFF * DM, nullptr, (bf16_t*)(WB + WB_D1), DM, DFF, DM, 0}; cvt_job(lds, J, base, wg0, nw); }
            }
#if KPREP_TAIL
            {
                const int rem = ((MT / 256) * (NIN / 256)) % G, fb = rem, nb = G - rem;
                if ((int)blockIdx.x >= fb) {
                    if (tid == 0) {
                        const unsigned long long t0 = wall_clock64();
                        while (__hip_atomic_load(kdone, __ATOMIC_RELAXED, __HIP_MEMORY_SCOPE_AGENT) < (unsigned)(MT / 256) * 8u) { if (wall_clock64() - t0 > 2000000ull) break; __builtin_amdgcn_s_sleep(2); }
                        __builtin_amdgcn_fence(__ATOMIC_ACQUIRE, "agent");
                        asm volatile("s_waitcnt vmcnt(0)" ::: "memory");
                    }
                    __syncthreads();
                    QkArgs Q{(bf16_t*)(R + R_AQ), (bf16_t*)(R + R_AK), INP(18) + l * 128, INP(19) + l * 128, 0};
                    qkprep_phase(Q, fb, nb);
                }
            }
#endif
        }
        SEAM(pb + 3);
#if !KPREP_TAIL
        if (((PH_MASK >> 5) & 1) && IN(pb + 4)) { PH_LOCALS
            QkArgs Q{(bf16_t*)(R + R_AQ), (bf16_t*)(R + R_AK), INP(18) + l * 128, INP(19) + l * 128, 0};
            qkprep_phase(Q, 0, G);
        }
        SEAM(pb + 4);
#endif
        if (((PH_MASK >> 6) & 1) && IN(pb + 5)) { PH_LOCALS
            HgArgs H{(const bf16_t*)(R + R_HGQ), (const bf16_t*)(R + R_HGQ + SZ512), (const bf16_t*)(R + R_HGQ + 2 * SZ512), (const bf16_t*)(R + R_HGQ + 3 * SZ512), (bf16_t*)(R + R_OHG), (const float*)(ws + WS_LB) + l * 1024, (unsigned*)(ws + WS_BAR + 16128) + l * 16};
            S5Args S{(bf16_t*)(R + R_US), (float*)(R + R_YD), (const f32x2*)(ws + WS_ATAB) + (size_t)l * 2 * 32 * 64, (const bf16_t*)(ws + WS_BM) + (size_t)l * 64 * 128 * 16, (const bf16_t*)(ws + WS_CM) + (size_t)l * 64 * 16 * 128, INP(14) + l * 512};
            unsigned* qctr = (unsigned*)(ws + WS_BAR + 15360) + l * 16;
            volatile LAS unsigned* qslot = (volatile LAS unsigned*)(lds + LDS_MISC + 16);
#define QGRAB(u) do { if (tid == 0) *qslot = __hip_atomic_fetch_add(qctr, 1u, __ATOMIC_RELAXED, __HIP_MEMORY_SCOPE_AGENT); __syncthreads(); (u) = (int)*qslot; __syncthreads(); } while (0)
#if XATT
#define QGRAB_C(u) do { if (tid == 0) *qslot = __hip_atomic_fetch_add(qctr, 1u, __ATOMIC_RELAXED, __HIP_MEMORY_SCOPE_AGENT); __syncthreads(); (u) = (int)*qslot; __syncthreads(); } while (0)
#undef QGRAB
#define QGRAB(u) do { if (tid == 0) { unsigned got_ = 1600u; const unsigned x0_ = xb_xcc_id() & 7u; for (unsigned k_ = 0; k_ < 8u; ++k_) { const unsigned xx_ = (x0_ + k_) & 7u; \
                const unsigned v_ = __hip_atomic_fetch_add(qctr + 1 + xx_, 1u, __ATOMIC_RELAXED, __HIP_MEMORY_SCOPE_AGENT); if (v_ < 160u) { got_ = 320u + (xx_ + 8u * (v_ >> 5)) * 32u + (v_ & 31u); break; } } *qslot = got_; } \
            __syncthreads(); (u) = (int)*qslot; __syncthreads(); } while (0)
            int u; QGRAB_C(u);
            while (u < 160) { hgrn_unit(lds, H, u); QGRAB_C(u); }
            while (u < 320) { s5_unit(lds, S, u - 160); QGRAB_C(u); }
            QGRAB(u);
#undef QGRAB_C
#elif QMIX
#define QGRAB_C(u) do { if (tid == 0) *qslot = __hip_atomic_fetch_add(qctr, 1u, __ATOMIC_RELAXED, __HIP_MEMORY_SCOPE_AGENT); __syncthreads(); (u) = (int)*qslot; __syncthreads(); } while (0)
#undef QGRAB
#define QGRAB(u) do { if (tid == 0) *qslot = 320u + __hip_atomic_fetch_add(qctr + 8, 1u, __ATOMIC_RELAXED, __HIP_MEMORY_SCOPE_AGENT); __syncthreads(); (u) = (int)*qslot; __syncthreads(); } while (0)
            int u = 320;
            if ((int)blockIdx.x < QMIX) QGRAB_C(u);
            while (u < 160) { hgrn_unit(lds, H, u); QGRAB_C(u); }
            while (u < 320) { s5_unit(lds, S, u - 160); QGRAB_C(u); }
            QGRAB(u);
#undef QGRAB_C
#else
            int u; QGRAB(u);
            while (u < 160) { hgrn_unit(lds, H, u); if (DUP_HG > 1) hgrn_unit(lds, H, u); QGRAB(u); }
            while (u < 320) { s5_unit(lds, S, u - 160); QGRAB(u); }
#endif
            while (u < 320 + NSEQ * 64) {
                const int a = u - 320, qb = a & 7, h = (a >> 3) & 7, b = a >> 6;
                const size_t tok0 = (size_t)b * SEQL;
                att::attn_dense_body((const bf16_t*)(R + R_AQ) + (tok0 + qb * 256) * 1024 + h * 128, (const bf16_t*)(R + R_AK) + tok0 * 256 + (h >> 2) * 128,
                                     (const bf16_t*)(R + R_AV) + tok0 * 256 + (h >> 2) * 128, (bf16_t*)(R + R_YSS) + (tok0 + qb * 256) * YLD + 1024 + (MRG_FP8 ? h * 64 : h * 128), SEQL, (char*)lds_raw,
                                     INP(18) + l * 128, qb * 256);
                if (DUP_ATT > 1) att::attn_dense_body((const bf16_t*)(R + R_AQ) + (tok0 + qb * 256) * 1024 + h * 128, (const bf16_t*)(R + R_AK) + tok0 * 256 + (h >> 2) * 128,
                                     (const bf16_t*)(R + R_AV) + tok0 * 256 + (h >> 2) * 128, (bf16_t*)(R + R_YSS) + (tok0 + qb * 256) * YLD + 1024 + (MRG_FP8 ? h * 64 : h * 128), SEQL, (char*)lds_raw,
                                     INP(18) + l * 128, qb * 256);
                QGRAB(u);
            }
#if HGFIN_IN_QUEUE
            if (u < 1600 + MT / 64) {
                if (tid == 0) {
                    const unsigned long long t0 = wall_clock64();
                    while (__hip_atomic_load(H.done, __ATOMIC_RELAXED, __HIP_MEMORY_SCOPE_AGENT) < 160u * 8u) { if (wall_clock64() - t0 > 2000000ull) break; __builtin_amdgcn_s_sleep(2); }
                    __builtin_amdgcn_fence(__ATOMIC_ACQUIRE, "agent");
                    asm volatile("s_waitcnt vmcnt(0)" ::: "memory");
                }
                __syncthreads();
                HfArgs F{(const bf16_t*)(R + R_OHG), (const bf16_t*)(R + R_HGQ + 4 * SZ512), INP(17) + l * 128, (bf16_t*)(R + R_YSS)};
                while (u < 1600 + MT / 64) { hgfin_chunk(F, u - 1600); QGRAB(u); }
            }
#endif
#undef QGRAB
        }
        SEAM(pb + 5);
#if !HGFIN_IN_QUEUE
        if (((PH_MASK >> 7) & 1) && IN(pb + 6)) { PH_LOCALS
            HfArgs F{(const bf16_t*)(R + R_OHG), (const bf16_t*)(R + R_HGQ + 4 * SZ512), INP(17) + l * 128, (bf16_t*)(R + R_YSS)};
            hgfin_phase(F);
        }
#endif
        if (((PH_MASK >> 7) & 1) && IN(pb + 6)) { PH_LOCALS epi::Glu E{(const bf16_t*)(R + R_US), (bf16_t*)(R + R_YSS)}; run_gemm(lds, (const bf16_t*)(R + R_US), (const bf16_t*)(WB + WB_GLU), 512, 512, E); }
        SEAM(pb + 6);
        if (((PH_MASK >> 8) & 1) && IN(pb + 7)) { PH_LOCALS
            epi::MergeFused E{(const unsigned char*)(R + R_GATE), (bf16_t*)(R + R_MRG)}; if (NULLX == 7) { epi::NullEpi E0{ssq}; run_gemm(lds, (const bf16_t*)(R + R_YSS), (const bf16_t*)(WB + WB_BS), DM, DM, E0); } for (int rep = 0; rep < DUP_MRG; ++rep) run_gemm<epi::MergeFused, (MRG_FP8 ? 16 : -1)>(lds, (const bf16_t*)(R + R_YSS), (const bf16_t*)(WB + WB_BS), DM, YLD, E);
        }
        SEAM_L(pb + 7);
        if (((PH_MASK >> 9) & 1) && IN(pb + 8)) { PH_LOCALS
            epi::Resid<false, false> E{nullptr, nullptr, 0, 1.0f, nullptr, hb, ssq};
            if (NULLX == 8) { epi::NullEpi E0{ssq}; run_gemm(lds, (const bf16_t*)(R + R_MRG), (const bf16_t*)(WB + WB_OUT), DM, DM, E0); }
            run_gemm(lds, (const bf16_t*)(R + R_MRG), (const bf16_t*)(WB + WB_OUT), DM, DM, E);
        }
        SEAM_L(pb + 8);
        if (((PH_MASK >> 10) & 1) && IN(pb + 9)) { PH_LOCALS epi::Swiglu E{(bf16_t*)(R + R_HID), ssq, (LAS float*)(lds + LDS_MISC + 1024)}; if (DUP_NULL) { epi::NullEpi E0{ssq}; run_gemm(lds, hb, (const bf16_t*)(WB + WB_GU2), 2 * DFF, DM, E0); } for (int rep = 0; rep < DUP_GU; ++rep) run_gemm(lds, hb, (const bf16_t*)(WB + WB_GU2), 2 * DFF, DM, E);
            if (CVT_AHEAD && l + 1 < DEPTH) {
                const int rem = ((MT / 256) * (2 * DFF / 256)) % G, wg0 = rem, nw = rem ? G - rem : 0; int base = 0;
                { CvtJob J{INP(6) + (size_t)(l + 1) * DM * NIN, INP(5) + (l + 1) * DM, (bf16_t*)(WB + WB_IN), NIN, DM, NIN, 0}; cvt_job(lds, J, base, wg0, nw); }
            }
        }
        SEAM_L(pb + 9);
        if (((PH_MASK >> 11) & 1) && IN(pb + 10)) { PH_LOCALS
            if (NULLX == 2) { epi::NullEpi E0{ssq}; run_gemm(lds, (const bf16_t*)(R + R_HID), (const bf16_t*)(WB + WB_D2), DM, DFF, E0); }
            if (l + 1 < DEPTH) { epi::Resid<false, false> E{nullptr, nullptr, 0, 0.5f, nullptr, hb, ssq}; run_gemm(lds, (const bf16_t*)(R + R_HID), (const bf16_t*)(WB + WB_D2), DM, DFF, E); }
            else               { epi::Resid<false, true>  E{nullptr, nullptr, 0, 0.5f, outp, hb, ssq};    run_gemm(lds, (const bf16_t*)(R + R_HID), (const bf16_t*)(WB + WB_D2), DM, DFF, E); }
        }
        SEAM(pb + 10);
    }
#ifdef PROBE_SKEW
    { XcdBarrier b_; b_.bar = (unsigned*)(ws0 + WS_BAR); b_.x = xb_xcc_id(); b_.st = (volatile LAS unsigned*)(lds + LDS_MISC); xcd_barrier(b_); }
    if (blockIdx.x == 0 && tid == 0) {
        float tot = 0.f;
        for (int k_ = 0; k_ < N_PHASES - 1; ++k_) { const unsigned* a_ = (const unsigned*)(ws0 + WS_CHK) + (size_t)k_ * 256; const unsigned v0_ = a_[0]; int mx_ = -2000000000; float sm_ = 0.f;
            for (int i_ = 0; i_ < (int)gridDim.x; ++i_) { const int d_ = (int)(a_[i_] - v0_); mx_ = d_ > mx_ ? d_ : mx_; sm_ += (float)d_; }
            tot += (float)mx_ * (float)gridDim.x - sm_; }
        const float us = tot * 0.01f / (float)gridDim.x;
        int la = (int)(3.0f * log2f(us / 20.0f) + 0.5f); la = la < 0 ? 0 : (la > 79 ? 79 : la);
        out0[0] = (float)(10 + la) * 1e5f;
    }
#endif
#ifdef PROBE_T
    { XcdBarrier b_; b_.bar = (unsigned*)(ws0 + WS_BAR); b_.x = xb_xcc_id(); b_.st = (volatile LAS unsigned*)(lds + LDS_MISC); xcd_barrier(b_); }
    if (blockIdx.x == 0 && tid == 0) {
        const unsigned long long* ts = (const unsigned long long*)(ws + WS_BAR + 14336);
        unsigned long long ta = 0, tb = 0;
        for (int l = 0; l < DEPTH; ++l) { const int pb = 1 + PH_PER_LAYER * l;
            for (int c = 0; c < PH_PER_LAYER; ++c) { const unsigned long long d = ts[pb + c + 1] - ts[pb + c]; if ((PROBE_A >> c) & 1) ta += d; if ((PROBE_B >> c) & 1) tb += d; } }
        if (PROBE_A == 0) ta = ts[1] - ts[0];
        if (PROBE_B == 0) tb = ts[N_PHASES] - ts[0];
        const float ua = (float)ta * 0.01f, ub = (float)tb * 0.01f;
        int la = (int)(6.0f * log2f(ua / 20.0f) + 0.5f); (void)ub;
        la = la < 0 ? 0 : (la > 79 ? 79 : la);
        const int v = la;
        out0[0] = (float)(10 + v % 80) * __builtin_powif(10.0f, 5 + v / 80);
    }
#endif
#undef INP
#undef IN
#undef SEAM
}

#ifndef N_LAUNCH_MODE
#define N_LAUNCH_MODE 1
#endif
extern "C" void kernel_launch(void* const* d_in, const int* in_sizes, int n_in, void* d_out, int out_size, void* d_ws, size_t ws_size, hipStream_t stream) {
    static int grid = 0;
    if (grid == 0) {
        size_t need = WS_END;
#ifdef SELFCHECK
        need = WS_CHK + CHK_BYTES;
#endif
        if (n_in != 25 || out_size != MT * DM || ws_size < need) { fprintf(stderr, "kernel_launch: unexpected shapes: n_in %d out %d ws %zu (need %zu)\n", n_in, out_size, ws_size, need); grid = -1; return; }
        int dev = 0, cus = 0, per_cu = 0;
        if (hipGetDevice(&dev) != hipSuccess || hipDeviceGetAttribute(&cus, hipDeviceAttributeMultiprocessorCount, dev) != hipSuccess) { grid = -1; return; }
        if (hipFuncSetAttribute((const void*)k_fwd, hipFuncAttributeMaxDynamicSharedMemorySize, LDS_BYTES) != hipSuccess) { fprintf(stderr, "kernel_launch: hipFuncSetAttribute failed\n"); grid = -1; return; }
        if (hipOccupancyMaxActiveBlocksPerMultiprocessor(&per_cu, (const void*)k_fwd, NTHREADS, LDS_BYTES) != hipSuccess || per_cu < 1) { fprintf(stderr, "kernel_launch: occupancy query says %d\n", per_cu); (void)hipGetLastError(); grid = -1; return; }
        grid = cus;
    }
    if (grid < 0) return;
    (void)hipMemsetAsync((char*)d_ws + WS_BAR, 0, 16384, stream);
    Params p{};
    for (int i = 0; i < 25; ++i) p.in[i] = (const float*)d_in[i];
    p.out = (float*)d_out; p.ws = (unsigned char*)d_ws;
#ifdef SELFCHECK
    {
        CkCtx c{d_in, (float*)d_out, (unsigned char*)d_ws, stream};
        (void)hipMemsetAsync((char*)d_ws + WS_CHK, 0, 65536, stream);
        for (int run = 0; run < 2; ++run)
            for (int ph = 0; ph < CK_NPH; ++ph) {
                if (ph == 0) (void)hipMemsetAsync((char*)d_ws + WS_BAR + 15360, 0, 512, stream);
                p.ph_lo = ph; p.ph_hi = ph + 1;
                hipLaunchKernelGGL(k_fwd, dim3(grid), dim3(NTHREADS), LDS_BYTES, stream, p);
                selfcheck_after_phase(c, run, ph);
            }
        selfcheck_finish(c);
    }
#elif N_LAUNCH_MODE == 1
    p.ph_lo = 0; p.ph_hi = N_PHASES;
    hipLaunchKernelGGL(k_fwd, dim3(grid), dim3(NTHREADS), LDS_BYTES, stream, p);
#else
    for (int ph = 0; ph < N_PHASES; ++ph) {
        p.ph_lo = ph; p.ph_hi = ph + 1;
        hipLaunchKernelGGL(k_fwd, dim3(grid), dim3(NTHREADS), LDS_BYTES, stream, p);
    }
#endif
    const hipError_t le = hipPeekAtLastError();
    if (le != hipSuccess) fprintf(stderr, "kernel_launch: launch failed: %s\n", hipGetErrorName(le));
}
```
